# Optimizing an MI355X kernel written in HIP

```python
import math
import jax, jax.numpy as jnp
from jax import lax
import numpy as np

D_MODEL = 1024
BATCH = 2
SEQ = 8192
DEPTH = 2

CHUNK = 64
N_MIXERS = 2
N_LAYERS_A = (DEPTH + N_MIXERS - 1) // N_MIXERS
N_LAYERS_B = DEPTH // N_MIXERS

A_HEADS = 8
A_HEAD_DIM = 128
A_WIDTH = A_HEADS * A_HEAD_DIM
CONV_WIDTH = 4
A_IN_COLS = 4 * A_WIDTH + 2 * A_HEADS

B_HEADS = 8
B_HEAD_DIM = 128
B_WIDTH = B_HEADS * B_HEAD_DIM
B_IN_COLS = 4 * B_WIDTH + B_HEADS
Q_BLOCK = 128

EPS = 1e-6

kernel_name = "hybrid_gdn_fox_interleaved"


def rms_norm(x, w):
    xf = x.astype(jnp.float32)
    y = xf * lax.rsqrt(jnp.mean(xf * xf, axis=-1, keepdims=True) + EPS)
    return (y * w.astype(jnp.float32)).astype(x.dtype)


def l2_normalize(x):
    xf = x.astype(jnp.float32)
    return xf * lax.rsqrt(jnp.sum(xf * xf, axis=-1, keepdims=True) + EPS)


def causal_depthwise_conv(x, w):
    c = x.shape[-1]
    return lax.conv_general_dilated(
        x, w[:, None, :].astype(x.dtype), window_strides=(1,),
        padding=[(CONV_WIDTH - 1, 0)], dimension_numbers=("NWC", "WIO", "NWC"),
        feature_group_count=c)


def chunk_gated_delta_rule(q, k, v, beta, g_log):
    b_, t_, h_, dk = q.shape
    dv = v.shape[-1]
    n = t_ // CHUNK

    def to_chunks(t):
        t = t.reshape((b_, n, CHUNK, h_) + t.shape[3:])
        return jnp.moveaxis(t, (1, 3), (0, 2))

    q = to_chunks(q) * (dk ** -0.5)
    k = to_chunks(k)
    v = to_chunks(v)
    beta = to_chunks(beta)
    g = jnp.cumsum(to_chunks(g_log), axis=-1)

    idx = jnp.arange(CHUNK)
    incl = idx[:, None] >= idx[None, :]
    strict = idx[:, None] > idx[None, :]
    gdiff = g[..., :, None] - g[..., None, :]
    decay_incl = jnp.exp(jnp.where(incl, gdiff, -jnp.inf))
    decay_strict = jnp.where(strict, decay_incl, 0.0)

    kb = k * beta[..., None]
    a_mat = jnp.einsum("nbhid,nbhjd->nbhij", kb, k) * decay_strict
    eye = jnp.eye(CHUNK, dtype=jnp.float32)
    t_mat = lax.linalg.triangular_solve(
        eye + a_mat, jnp.broadcast_to(eye, a_mat.shape),
        left_side=True, lower=True, unit_diagonal=True)
    u = t_mat @ (v * beta[..., None])
    w = t_mat @ (kb * jnp.exp(g)[..., None])
    attn_intra = jnp.einsum("nbhid,nbhjd->nbhij", q, k) * decay_incl
    q_decayed = q * jnp.exp(g)[..., None]
    k_to_end = k * jnp.exp(g[..., -1:] - g)[..., None]
    g_end = jnp.exp(g[..., -1])

    def step(state, xs):
        u_c, w_c, qd_c, kend_c, attn_c, gend_c = xs
        v_new = u_c - w_c @ state
        o_c = qd_c @ state + attn_c @ v_new
        state = state * gend_c[..., None, None] + jnp.swapaxes(kend_c, -1, -2) @ v_new
        return state, o_c

    s0 = jnp.zeros((b_, h_, dk, dv), jnp.float32)
    _, o = lax.scan(step, s0, (u, w, q_decayed, k_to_end, attn_intra, g_end))
    o = jnp.moveaxis(o, (0, 2), (1, 3))
    return o.reshape(b_, t_, h_, dv)


def gated_deltanet_mixer(h, w_in, conv_w, a_log, dt_bias, o_norm_w, w_out):
    b_, t_, _ = h.shape
    proj = h @ w_in
    qkv, z, b_raw, a_raw = jnp.split(
        proj, [3 * A_WIDTH, 4 * A_WIDTH, 4 * A_WIDTH + A_HEADS], axis=-1)
    qkv = jax.nn.silu(causal_depthwise_conv(qkv, conv_w))
    q, k, v = jnp.split(qkv, 3, axis=-1)
    hs = (b_, t_, A_HEADS, A_HEAD_DIM)
    q = l2_normalize(q.reshape(hs))
    k = l2_normalize(k.reshape(hs))
    v = v.reshape(hs).astype(jnp.float32)
    beta = jax.nn.sigmoid(b_raw.astype(jnp.float32))
    g_log = -jnp.exp(a_log.astype(jnp.float32)) * jax.nn.softplus(
        a_raw.astype(jnp.float32) + dt_bias.astype(jnp.float32))
    o = chunk_gated_delta_rule(q, k, v, beta, g_log)
    o = rms_norm(o, o_norm_w).astype(h.dtype)
    y = o * jax.nn.silu(z).reshape(hs)
    return y.reshape(b_, t_, A_WIDTH) @ w_out


def forgetting_attention_mixer(h, w_in, f_bias, q_norm_w, k_norm_w, w_out):
    b_, t_, _ = h.shape
    proj = h @ w_in
    q, k, v, z, f_raw = jnp.split(
        proj, [B_WIDTH, 2 * B_WIDTH, 3 * B_WIDTH, 4 * B_WIDTH], axis=-1)
    hs = (b_, t_, B_HEADS, B_HEAD_DIM)
    q = rms_norm(q.reshape(hs), q_norm_w)
    k = rms_norm(k.reshape(hs), k_norm_w)
    v = v.reshape(hs)
    log_f = jax.nn.log_sigmoid(f_raw.astype(jnp.float32) + f_bias.astype(jnp.float32))
    c = jnp.transpose(jnp.cumsum(log_f, axis=1), (0, 2, 1))
    qh = jnp.transpose(q, (0, 2, 1, 3))
    kh = jnp.transpose(k, (0, 2, 1, 3))
    vh = jnp.transpose(v, (0, 2, 1, 3))
    n_blocks = t_ // Q_BLOCK
    q_blocks = jnp.moveaxis(qh.reshape(b_, B_HEADS, n_blocks, Q_BLOCK, B_HEAD_DIM), 2, 0)
    c_blocks = jnp.moveaxis(c.reshape(b_, B_HEADS, n_blocks, Q_BLOCK), 2, 0)
    key_pos = jnp.arange(t_)
    scale = B_HEAD_DIM ** -0.5

    def attend(args):
        qb, cb, blk = args
        s = jnp.einsum("bhqd,bhkd->bhqk", qb, kh).astype(jnp.float32) * scale
        s = s + cb[..., :, None] - c[..., None, :]
        q_pos = blk * Q_BLOCK + jnp.arange(Q_BLOCK)
        mask = key_pos[None, :] <= q_pos[:, None]
        p = jax.nn.softmax(jnp.where(mask, s, -jnp.inf), axis=-1)
        return jnp.einsum("bhqk,bhkd->bhqd", p.astype(vh.dtype), vh)

    o = lax.map(attend, (q_blocks, c_blocks, jnp.arange(n_blocks)))
    o = jnp.moveaxis(o, (0, 2), (1, 3)).reshape(hs)
    y = o * jax.nn.silu(z).reshape(hs)
    return y.reshape(b_, t_, B_WIDTH) @ w_out


def setup_inputs(seed: int = 0) -> dict:
    key = jax.random.key(seed)
    ks = jax.random.split(key, 16)
    f32 = jnp.float32
    x = jax.random.normal(ks[0], (BATCH, SEQ, D_MODEL), f32)
    a_norm_w = 1.0 + 0.02 * jax.random.normal(ks[1], (N_LAYERS_A, D_MODEL), f32)
    a_w_in = jax.random.normal(ks[2], (N_LAYERS_A, D_MODEL, A_IN_COLS), f32) * D_MODEL ** -0.5
    a_conv_w = jax.random.normal(ks[3], (N_LAYERS_A, CONV_WIDTH, 3 * A_WIDTH), f32) * CONV_WIDTH ** -0.5
    a_A_log = jnp.log(jax.random.uniform(ks[4], (N_LAYERS_A, A_HEADS), f32, 1.0, 16.0))
    dt = jnp.exp(jax.random.uniform(ks[5], (N_LAYERS_A, A_HEADS), f32,
                                    math.log(1e-3), math.log(1e-1)))
    a_dt_bias = dt + jnp.log(-jnp.expm1(-dt))
    a_o_norm_w = 1.0 + 0.02 * jax.random.normal(ks[6], (N_LAYERS_A, A_HEAD_DIM), f32)
    a_w_out = jax.random.normal(ks[7], (N_LAYERS_A, A_WIDTH, D_MODEL), f32) * A_WIDTH ** -0.5
    b_norm_w = 1.0 + 0.02 * jax.random.normal(ks[8], (N_LAYERS_B, D_MODEL), f32)
    b_w_in = jax.random.normal(ks[9], (N_LAYERS_B, D_MODEL, B_IN_COLS), f32) * D_MODEL ** -0.5
    b_f_bias = 3.0 + 0.5 * jax.random.normal(ks[10], (N_LAYERS_B, B_HEADS), f32)
    b_q_norm_w = 1.0 + 0.02 * jax.random.normal(ks[11], (N_LAYERS_B, B_HEAD_DIM), f32)
    b_k_norm_w = 1.0 + 0.02 * jax.random.normal(ks[12], (N_LAYERS_B, B_HEAD_DIM), f32)
    b_w_out = jax.random.normal(ks[13], (N_LAYERS_B, B_WIDTH, D_MODEL), f32) * B_WIDTH ** -0.5
    final_norm_w = 1.0 + 0.02 * jax.random.normal(ks[14], (D_MODEL,), f32)
    return {"x": x, "a_norm_w": a_norm_w, "a_w_in": a_w_in, "a_conv_w": a_conv_w,
            "a_A_log": a_A_log, "a_dt_bias": a_dt_bias, "a_o_norm_w": a_o_norm_w,
            "a_w_out": a_w_out, "b_norm_w": b_norm_w, "b_w_in": b_w_in,
            "b_f_bias": b_f_bias, "b_q_norm_w": b_q_norm_w, "b_k_norm_w": b_k_norm_w,
            "b_w_out": b_w_out, "final_norm_w": final_norm_w}


def reference(x, a_norm_w, a_w_in, a_conv_w, a_A_log, a_dt_bias, a_o_norm_w, a_w_out,
              b_norm_w, b_w_in, b_f_bias, b_q_norm_w, b_k_norm_w, b_w_out, final_norm_w):
    h = x
    for i in range(DEPTH):
        j = i // N_MIXERS
        if i % N_MIXERS == 0:
            h = h + gated_deltanet_mixer(rms_norm(h, a_norm_w[j]), a_w_in[j], a_conv_w[j],
                                         a_A_log[j], a_dt_bias[j], a_o_norm_w[j], a_w_out[j])
        else:
            h = h + forgetting_attention_mixer(rms_norm(h, b_norm_w[j]), b_w_in[j], b_f_bias[j],
                                               b_q_norm_w[j], b_k_norm_w[j], b_w_out[j])
    return rms_norm(h, final_norm_w)
```

```cpp
#include <hip/hip_runtime.h>
#include <hip/hip_cooperative_groups.h>
#include <cstdio>
namespace cg = cooperative_groups;

typedef unsigned short u16;
typedef __attribute__((ext_vector_type(8))) short bf16x8;
typedef __attribute__((ext_vector_type(4))) float f32x4;
typedef __attribute__((ext_vector_type(4))) unsigned u32x4;
typedef __attribute__((ext_vector_type(2))) unsigned u32x2;
#define DI __device__ __forceinline__

constexpr int kThreads = 256;
constexpr int kLds = 69632;
constexpr float kEps = 1e-6f;
constexpr float kScale = 0.08838834764831845f;
constexpr float kLog2e = 1.4426950408889634f;

constexpr size_t MiB = 1048576;
constexpr size_t OFF_WTA_IN = 0;
constexpr size_t OFF_WTA_OUT = 8650752;
constexpr size_t OFF_WTB_IN = 10747904;
constexpr size_t OFF_WTB_OUT = 19398656;
constexpr size_t OFF_SMALL = 21495808;
constexpr size_t OFF_RS0 = OFF_SMALL;
constexpr size_t OFF_SS1 = OFF_RS0 + 65536;
constexpr size_t OFF_SS2 = OFF_SS1 + 65536;
constexpr size_t OFF_BRAW = OFF_SS2 + 65536;
constexpr size_t OFF_FRAW = OFF_BRAW + 1048576;
constexpr size_t OFF_CCUM = OFF_FRAW + 1048576;
constexpr size_t OFF_GEND = OFF_CCUM + 524288;
constexpr size_t OFF_BAR = OFF_GEND + 8192;
constexpr size_t OFF_FLAGS = OFF_BAR + 13824 + 512;
constexpr size_t CTL_BYTES = 13824 + 512 + 8192;
constexpr size_t OFF_PROJ = OFF_SMALL + 3 * MiB;
constexpr size_t OFF_R = OFF_PROJ + 128 * MiB;

struct Params {
  const float *x, *a_norm_w, *a_w_in, *a_conv_w, *a_A_log, *a_dt_bias, *a_o_norm_w, *a_w_out;
  const float *b_norm_w, *b_w_in, *b_f_bias, *b_q_norm_w, *b_k_norm_w, *b_w_out, *final_norm_w;
  float* out;
  char* ws;
};

typedef __attribute__((ext_vector_type(2))) float f32x2;
typedef __attribute__((ext_vector_type(2))) __bf16 bf16x2_t;
DI unsigned pack2(float a, float b) { f32x2 v = {a, b}; return __builtin_bit_cast(unsigned, __builtin_convertvector(v, bf16x2_t)); }
DI unsigned f2bf(float x) { return pack2(x, 0.f) & 0xffffu; }
DI float bflo(unsigned u) { return __uint_as_float(u << 16); }
DI float bfhi(unsigned u) { return __uint_as_float(u & 0xffff0000u); }
DI f32x4 mfma16(bf16x8 a, bf16x8 b, f32x4 c) { return __builtin_amdgcn_mfma_f32_16x16x32_bf16(a, b, c, 0, 0, 0); }
DI bf16x8 mk8(u32x2 lo, u32x2 hi) { u32x4 v = {lo.x, lo.y, hi.x, hi.y}; return __builtin_bit_cast(bf16x8, v); }
DI bf16x8 pack8(f32x4 a, f32x4 b) { u32x4 v = {pack2(a[0], a[1]), pack2(a[2], a[3]), pack2(b[0], b[1]), pack2(b[2], b[3])}; return __builtin_bit_cast(bf16x8, v); }
DI bf16x8 ld2(const u16* p) { return mk8(*(const u32x2*)p, *(const u32x2*)(p + 16)); }
DI int relaunder(int t) { asm volatile("" : "+v"(t)); return t; }
DI int tidx() { int t = threadIdx.x; asm volatile("" : "+v"(t)); return t; }
DI float silu(float x) { return x / (1.f + __expf(-x)); }
DI void unpack8(u32x4 v, float* f) {
  f[0] = bflo(v.x); f[1] = bfhi(v.x); f[2] = bflo(v.y); f[3] = bfhi(v.y);
  f[4] = bflo(v.z); f[5] = bfhi(v.z); f[6] = bflo(v.w); f[7] = bfhi(v.w);
}
DI u32x4 packf8(const float* f) { u32x4 v = {pack2(f[0], f[1]), pack2(f[2], f[3]), pack2(f[4], f[5]), pack2(f[6], f[7])}; return v; }


#define XB_TMO      128
#define XB_XCNT(j)  (256  + 64 * (j))
#define XB_XSUB(j)  (1280 + 64 * (j))
#define XB_XGEN(j)  (2304 + 64 * (j))
#define XB_TOP      3328
#define XB_TOPGEN   3392
#define XCD_BAR_WORDS 3456
#define XB_SPIN_CAP (1u << 23)
#define LAS __attribute__((address_space(3)))
DI unsigned xb_ld(unsigned* p) { return __hip_atomic_load(p, __ATOMIC_RELAXED, __HIP_MEMORY_SCOPE_AGENT); }
DI unsigned xb_add(unsigned* p, unsigned v) { return __hip_atomic_fetch_add(p, v, __ATOMIC_RELAXED, __HIP_MEMORY_SCOPE_AGENT); }
DI unsigned xb_xcc_id() { return (unsigned)__builtin_amdgcn_s_getreg((3 << 11) | 20) & 0xFu; }
#define XB_SPIN(cond, bar) do { unsigned _sp = 0; while (cond) { __builtin_amdgcn_s_sleep(1); \
    if ((++_sp & 255u) == 0u) { if (xb_ld(&(bar)[XB_TMO])) break; if (_sp > XB_SPIN_CAP) { atomicAdd(&(bar)[XB_TMO], 1u); break; } } } } while (0)
struct XcdBarrier { unsigned* bar; unsigned x; volatile LAS unsigned* st; };
DI XcdBarrier xcd_barrier_post(unsigned* bar, volatile LAS unsigned* st) {
  XcdBarrier b; b.bar = bar; b.x = xb_xcc_id(); b.st = st;
  if (threadIdx.x == 0) (void)xb_add(&bar[XB_XCNT(b.x)], 1u);
  return b;
}
DI void xcd_barrier_complete(unsigned* bar, unsigned x, unsigned& nloc, unsigned& nx) {
  const unsigned G = gridDim.x * gridDim.y * gridDim.z;
  unsigned sum, cnt, mine, sp = 0u;
  for (;;) {
    sum = 0u; cnt = 0u; mine = 0u;
#pragma unroll
    for (unsigned j = 0; j < 16; ++j) { const unsigned c = xb_ld(&bar[XB_XCNT(j)]); sum += c; cnt += (c > 0u) ? 1u : 0u; mine = (j == x) ? c : mine; }
    if (sum == G) break;
    __builtin_amdgcn_s_sleep(1);
    if ((++sp & 255u) == 0u) { if (xb_ld(&bar[XB_TMO])) break; if (sp > XB_SPIN_CAP) { atomicAdd(&bar[XB_TMO], 1u); break; } }
  }
  nloc = mine > 0u ? mine : 1u; nx = cnt > 0u ? cnt : 1u;
}
DI void xcd_barrier(const XcdBarrier& b) {
  asm volatile("s_waitcnt vmcnt(0)" ::: "memory");
  __syncthreads();
  if (threadIdx.x == 0) {
    unsigned* bar = b.bar;
    __builtin_amdgcn_s_waitcnt(0);
    unsigned nloc = b.st[0], nx = b.st[1];
    if (nloc == 0u) { xcd_barrier_complete(bar, b.x, nloc, nx); b.st[0] = nloc; b.st[1] = nx; }
    const unsigned old = xb_add(&bar[XB_XSUB(b.x)], 1u);
    const unsigned gen = old / nloc;
    if (old + 1u == (gen + 1u) * nloc) {
      __builtin_amdgcn_fence(__ATOMIC_RELEASE, "agent");
      asm volatile("s_waitcnt vmcnt(0)" ::: "memory");
      const unsigned og = xb_add(&bar[XB_TOP], 1u);
      const unsigned tg = og / nx;
      if (og + 1u == (tg + 1u) * nx) xb_add(&bar[XB_TOPGEN], 1u);
      else XB_SPIN(xb_ld(&bar[XB_TOPGEN]) == tg, bar);
      __builtin_amdgcn_fence(__ATOMIC_ACQUIRE, "agent");
      xb_add(&bar[XB_XGEN(b.x)], 1u);
      asm volatile("s_waitcnt vmcnt(0)" ::: "memory");
    } else {
      XB_SPIN(xb_ld(&bar[XB_XGEN(b.x)]) == gen, bar);
      __builtin_amdgcn_fence(__ATOMIC_ACQUIRE, "agent");
      asm volatile("s_waitcnt vmcnt(0)" ::: "memory");
    }
  }
  __syncthreads();
}

DI void transpose_tile(const float* __restrict__ W, int N, int Npad, const float* __restrict__ kscale, u16* __restrict__ WT, int tile, char* smem) {
  float(*t)[65] = (float(*)[65])smem;
  const int nt = Npad / 64;
  const int k0 = (tile / nt) * 64, n0 = (tile % nt) * 64;
  const int tid = tidx();
  {
    const int tx = tid & 63, ty = tid >> 6;
#pragma unroll 4
    for (int i = 0; i < 16; ++i) {
      const int k = k0 + ty + 4 * i, n = n0 + tx;
      float v = 0.f;
      if (n < N) { v = W[(size_t)k * N + n]; if (kscale) v *= kscale[k]; }
      t[ty + 4 * i][tx] = v;
    }
  }
  __syncthreads();
  {
    const int kx2 = (tid & 31) * 2, ny0 = tid >> 5;
#pragma unroll 4
    for (int i = 0; i < 8; ++i) {
      const int ny = ny0 + 8 * i;
      *(unsigned*)(WT + (size_t)(n0 + ny) * 1024 + k0 + kx2) = pack2(t[kx2][ny], t[kx2 + 1][ny]);
    }
  }
  __syncthreads();
}

DI void phase0(const Params& p, char* smem) {
  char* ws = p.ws;
  {
    float* ss = (float*)(ws + OFF_SS1);
    for (int i = blockIdx.x * kThreads + tidx(); i < 32768; i += gridDim.x * kThreads) ss[i] = 0.f;
  }
  for (int t = blockIdx.x; t < 1312; t += gridDim.x) {
    if (t < 1056) transpose_tile(p.a_w_in, 4112, 4224, p.a_norm_w, (u16*)(ws + OFF_WTA_IN), t, smem);
    else transpose_tile(p.a_w_out, 1024, 1024, nullptr, (u16*)(ws + OFF_WTA_OUT), t - 1056, smem);
  }
  const int tid0 = tidx();
  const int lane = tid0 & 63;
  const int gw = blockIdx.x * 4 + (tid0 >> 6), nw = gridDim.x * 4;
  u16* xb = (u16*)(ws + OFF_R);
  float* rs0 = (float*)(ws + OFF_RS0);
  for (int row = gw; row < 16384; row += 4 * nw) {
    f32x4 v[4][4];
#pragma unroll
    for (int k = 0; k < 4; ++k) {
      const int rr = row + k * nw;
      const f32x4* xr = (const f32x4*)(p.x + (size_t)(rr < 16384 ? rr : row) * 1024);
#pragma unroll
      for (int i = 0; i < 4; ++i) v[k][i] = xr[lane + 64 * i];
    }
#pragma unroll
    for (int k = 0; k < 4; ++k) {
      const int rr = row + k * nw;
      float ss = 0.f;
#pragma unroll
      for (int i = 0; i < 4; ++i) ss += v[k][i][0] * v[k][i][0] + v[k][i][1] * v[k][i][1] + v[k][i][2] * v[k][i][2] + v[k][i][3] * v[k][i][3];
#pragma unroll
      for (int o = 32; o >= 1; o >>= 1) ss += __shfl_xor(ss, o);
      if (rr < 16384) {
        u32x2* xo = (u32x2*)(xb + (size_t)rr * 1024);
#pragma unroll
        for (int i = 0; i < 4; ++i) { u32x2 o = {pack2(v[k][i][0], v[k][i][1]), pack2(v[k][i][2], v[k][i][3])}; xo[lane + 64 * i] = o; }
        if (lane == 0) rs0[rr] = rsqrtf(ss * (1.f / 1024.f) + kEps);
      }
    }
  }
}

DI void phase0b(const Params& p, char* smem, int first, int nblk) {
  char* ws = p.ws;
  for (int t = (int)blockIdx.x - first; t < 1312; t += nblk) {
    if (t < 1056) transpose_tile(p.b_w_in, 4104, 4224, p.b_norm_w, (u16*)(ws + OFF_WTB_IN), t, smem);
    else transpose_tile(p.b_w_out, 1024, 1024, nullptr, (u16*)(ws + OFF_WTB_OUT), t - 1056, smem);
  }
}

template <int EPI>
DI void gemm_phase(const Params& p, const u16* __restrict__ A, const u16* __restrict__ Bt, int nTn, char* smem) {
  const int tid = tidx(), lane = tid & 63, wave = tid >> 6;
  const int wr = wave >> 1, wc = wave & 1;
  const int l15 = lane & 15, quad = lane >> 4;
  char* ws = p.ws;
  const int NX = ((gridDim.x & 7) == 0) ? 8 : 1;
  const int xg = blockIdx.x % NX, lb = blockIdx.x / NX, Lb = gridDim.x / NX;
  const int nTnG = nTn >> 3, nSuper = 16 * nTnG;
  const int srow = wave * 8 + (lane >> 3);
  const int sch = (lane & 7) ^ ((((wave & 1) << 2) + (lane >> 4)) & 7);
#define GEMM_TILE(seq_, tm_, tn_, ok_)                                                            \
  do {                                                                                            \
    const int sidx_ = xg + NX * ((seq_) >> 6);                                                    \
    ok_ = sidx_ < nSuper;                                                                         \
    const int tl_ = (seq_) & 63;                                                                  \
    tm_ = (sidx_ / nTnG) * 8 + (tl_ & 7);                                                         \
    tn_ = (sidx_ % nTnG) * 8 + (tl_ >> 3);                                                        \
  } while (0)
#define GEMM_STAGE(buf, kt)                                                                                                   \
  do {                                                                                                                        \
    _Pragma("unroll") for (int i = 0; i < 4; ++i) {                                                                           \
      __builtin_amdgcn_global_load_lds((const unsigned*)(Ag + (size_t)i * 32 * 1024 + (kt) * 64),                             \
                                       (unsigned*)(smem + (buf) * 32768 + (i * 4 + wave) * 1024), 16, 0, 0);                  \
      __builtin_amdgcn_global_load_lds((const unsigned*)(Bg + (size_t)i * 32 * 1024 + (kt) * 64),                             \
                                       (unsigned*)(smem + (buf) * 32768 + 16384 + (i * 4 + wave) * 1024), 16, 0, 0);          \
    }                                                                                                                         \
  } while (0)
  int seq = lb, tm, tn;
  bool ok;
  GEMM_TILE(seq, tm, tn, ok);
  const u16* Ag = A + (size_t)(tm * 128 + srow) * 1024 + sch * 8;
  const u16* Bg = Bt + (size_t)(tn * 128 + srow) * 1024 + sch * 8;
  if (ok) GEMM_STAGE(0, 0);
  while (ok) {
    int tm2, tn2;
    bool ok2;
    GEMM_TILE(seq + Lb, tm2, tn2, ok2);
    f32x4 acc[4][4];
#pragma unroll
    for (int a = 0; a < 4; ++a)
#pragma unroll
      for (int b = 0; b < 4; ++b) acc[a][b] = (f32x4){0.f, 0.f, 0.f, 0.f};
    asm volatile("s_waitcnt vmcnt(0)" ::: "memory");
    __syncthreads();
    for (int kt = 0; kt < 16; ++kt) {
      const int cur = kt & 1;
      if (kt + 1 < 16) GEMM_STAGE(cur ^ 1, kt + 1);
      else if (ok2) {
        Ag = A + (size_t)(tm2 * 128 + srow) * 1024 + sch * 8;
        Bg = Bt + (size_t)(tn2 * 128 + srow) * 1024 + sch * 8;
        GEMM_STAGE(0, 0);
      }
      const char* sa = smem + cur * 32768;
      const char* sb = sa + 16384;
#pragma unroll
      for (int ks = 0; ks < 2; ++ks) {
        bf16x8 fa[4], fb[4];
        const int ch = ks * 4 + quad;
#pragma unroll
        for (int mi = 0; mi < 4; ++mi) {
          const int row = wr * 64 + mi * 16 + l15;
          fa[mi] = *(const bf16x8*)(sa + row * 128 + ((ch ^ ((row >> 1) & 7)) << 4));
        }
#pragma unroll
        for (int ni = 0; ni < 4; ++ni) {
          const int row = wc * 64 + ni * 16 + l15;
          fb[ni] = *(const bf16x8*)(sb + row * 128 + ((ch ^ ((row >> 1) & 7)) << 4));
        }
#pragma unroll
        for (int ni = 0; ni < 4; ++ni)
#pragma unroll
          for (int mi = 0; mi < 4; ++mi) acc[ni][mi] = mfma16(fb[ni], fa[mi], acc[ni][mi]);
      }
      if (kt < 15) {
        asm volatile("s_waitcnt vmcnt(0)" ::: "memory");
        __syncthreads();
      }
    }
    float hnorm[4] = {1.f, 1.f, 1.f, 1.f};
    if constexpr (EPI == 3) {
      if (tn < 16) {
        float* part = (float*)(smem + 65536);
        float ssq[4];
#pragma unroll
        for (int mi = 0; mi < 4; ++mi) {
          const float rs = rsqrtf(((const float*)(ws + OFF_SS1))[tm * 128 + wr * 64 + mi * 16 + l15] * (1.f / 1024.f) + kEps);
          float s = 0.f;
#pragma unroll
          for (int ni = 0; ni < 4; ++ni) { const f32x4 v = acc[ni][mi] * rs; s += v[0] * v[0] + v[1] * v[1] + v[2] * v[2] + v[3] * v[3]; }
          s += __shfl_xor(s, 16);
          s += __shfl_xor(s, 32);
          ssq[mi] = s;
          if (quad == 0) part[(wr * 2 + wc) * 64 + mi * 16 + l15] = s;
        }
        __syncthreads();
#pragma unroll
        for (int mi = 0; mi < 4; ++mi) {
          const float tot = ssq[mi] + part[(wr * 2 + (wc ^ 1)) * 64 + mi * 16 + l15];
          hnorm[mi] = rsqrtf(tot * (1.f / 128.f) + kEps) * (tn < 8 ? kScale * kLog2e : 1.f);
        }
      }
    }
#pragma unroll
    for (int mi = 0; mi < 4; ++mi) {
      const int m = tm * 128 + wr * 64 + mi * 16 + l15;
      if constexpr (EPI == 1) {
        const float rs = ((const float*)(ws + OFF_RS0))[m];
        u16* proj = (u16*)(ws + OFF_PROJ);
        float* braw = (float*)(ws + OFF_BRAW);
#pragma unroll
        for (int ni = 0; ni < 4; ++ni) {
          const int nb = tn * 128 + wc * 64 + ni * 16 + quad * 4;
          f32x4 v = acc[ni][mi] * rs;
          if (nb < 4096) { u32x2 o = {pack2(v[0], v[1]), pack2(v[2], v[3])}; *(u32x2*)(proj + (size_t)m * 4096 + nb) = o; }
          else if (nb < 4112) { *(f32x4*)(braw + (size_t)m * 16 + (nb - 4096)) = v; }
        }
      } else if constexpr (EPI == 2 || EPI == 4) {
        float* ssp = (float*)(ws + (EPI == 2 ? OFF_SS1 : OFF_SS2));
        u16* hb = (u16*)(ws + OFF_R);
        float ssq = 0.f;
#pragma unroll
        for (int ni = 0; ni < 4; ++ni) {
          const int nb = tn * 128 + wc * 64 + ni * 16 + quad * 4;
          f32x4 v;
          if constexpr (EPI == 2) {
            v = acc[ni][mi] + *(const f32x4*)(p.x + (size_t)m * 1024 + nb);
            u32x2 o = {pack2(v[0], v[1]), pack2(v[2], v[3])};
            *(u32x2*)(hb + (size_t)m * 1024 + nb) = o;
            v[0] = bflo(o.x); v[1] = bfhi(o.x); v[2] = bflo(o.y); v[3] = bfhi(o.y);
          } else {
            const u32x2 r = *(const u32x2*)(hb + (size_t)m * 1024 + nb);
            v = acc[ni][mi];
            v[0] += bflo(r.x); v[1] += bfhi(r.x); v[2] += bflo(r.y); v[3] += bfhi(r.y);
            const u32x2 o = {pack2(v[0], v[1]), pack2(v[2], v[3])};
            *(u32x2*)(hb + (size_t)m * 1024 + nb) = o;
            v[0] = bflo(o.x); v[1] = bfhi(o.x); v[2] = bflo(o.y); v[3] = bfhi(o.y);
          }
          ssq += v[0] * v[0] + v[1] * v[1] + v[2] * v[2] + v[3] * v[3];
        }
        ssq += __shfl_xor(ssq, 16);
        ssq += __shfl_xor(ssq, 32);
        if (quad == 0) atomicAdd(ssp + m, ssq);
      } else if constexpr (EPI == 3) {
        const float rs = rsqrtf(((const float*)(ws + OFF_SS1))[m] * (1.f / 1024.f) + kEps);
        u16* proj = (u16*)(ws + OFF_PROJ);
        u16* vT = (u16*)(ws + OFF_R + 32 * MiB);
        float* fraw = (float*)(ws + OFF_FRAW);
        float hs = 1.f;
        if (tn < 16) hs = hnorm[mi];
#pragma unroll
        for (int ni = 0; ni < 4; ++ni) {
          const int nb = tn * 128 + wc * 64 + ni * 16 + quad * 4;
          f32x4 v = acc[ni][mi] * rs;
          if (tn < 16) {
            const f32x4 wv = *(const f32x4*)((tn < 8 ? p.b_q_norm_w : p.b_k_norm_w) + (nb & 127));
            v = v * hs * wv;
          }
          if (nb < 4096) {
            if ((nb >> 10) != 2) { u32x2 o = {pack2(v[0], v[1]), pack2(v[2], v[3])}; *(u32x2*)(proj + (size_t)m * 4096 + nb) = o; }
            else {
              const int hd = nb - 2048;
              const int b = m >> 13, t = m & 8191;
              u16* dst = vT + ((size_t)(b * 1024 + hd)) * 8192 + t;
#pragma unroll
              for (int jj = 0; jj < 4; ++jj) dst[(size_t)jj * 8192] = (u16)f2bf(v[jj]);
            }
          } else if (nb < 4104) { *(f32x4*)(fraw + (size_t)m * 16 + (nb - 4096)) = v; }
        }
      }
    }
    seq += Lb; tm = tm2; tn = tn2; ok = ok2;
  }
#undef GEMM_STAGE
#undef GEMM_TILE
}


template <int MODE>
DI void skinny_gemm(const Params& p, const u16* __restrict__ A, const u16* __restrict__ Wt16, float* __restrict__ out) {
  const int tid = tidx(), lane = tid & 63, l15 = lane & 15, quad = lane >> 4;
  const int gw = blockIdx.x * 4 + (tid >> 6), nw = gridDim.x * 4;
  for (int mt = gw; mt < 1024; mt += nw) {
    const int m = mt * 16 + l15;
    const u16* ap = A + (size_t)m * 1024 + quad * 8;
    const u16* bp = Wt16 + (size_t)l15 * 1024 + quad * 8;
    f32x4 acc = {0.f, 0.f, 0.f, 0.f};
#pragma unroll 8
    for (int ks = 0; ks < 32; ++ks) acc = mfma16(*(const bf16x8*)(bp + ks * 32), *(const bf16x8*)(ap + ks * 32), acc);
    float rs;
    if constexpr (MODE == 0) rs = ((const float*)(p.ws + OFF_RS0))[m];
    else rs = rsqrtf(((const float*)(p.ws + OFF_SS1))[m] * (1.f / 1024.f) + kEps);
    *(f32x4*)(out + (size_t)m * 16 + 4 * quad) = acc * rs;
  }
}

DI void delta_prep(const Params& p, char* smem, int first, int nblk) {
  char* ws = p.ws;
  const u16* proj = (const u16*)(ws + OFF_PROJ);
  const float* braw = (const float*)(ws + OFF_BRAW);
  u16* qd_g = (u16*)(ws + OFF_R);
  u16* kT_g = (u16*)(ws + OFF_R + 32 * MiB);
  u16* at_g = (u16*)(ws + OFF_R + 64 * MiB);
  u16* uT_g = (u16*)p.out;
  u16* w_g = (u16*)((char*)p.out + 32 * MiB);
  float* gend_g = (float*)(ws + OFF_GEND);
  char* qL = smem;
  char* kL = smem + 16384;
  char* vL = smem + 32768;
  float* As = (float*)(smem + 49152);
  float* sc = (float*)(smem + 66560);
  float* g_s = sc;
  float* beta_s = sc + 64;
  float* rq_s = sc + 128;
  float* rk_s = sc + 192;
  float* ssq_s = sc + 256;
  float* fu_s = sc + 384;
  float* fw_s = sc + 448;
  const int tid_ = tidx();

  unsigned* flags = (unsigned*)(ws + OFF_FLAGS);
  const __amdgpu_buffer_rsrc_t r_qd = __builtin_amdgcn_make_buffer_rsrc(qd_g, 0, 32 << 20, 0x00020000);
  const __amdgpu_buffer_rsrc_t r_kT = __builtin_amdgcn_make_buffer_rsrc(kT_g, 0, 32 << 20, 0x00020000);
  const __amdgpu_buffer_rsrc_t r_at = __builtin_amdgcn_make_buffer_rsrc(at_g, 0, 16 << 20, 0x00020000);
  const __amdgpu_buffer_rsrc_t r_uT = __builtin_amdgcn_make_buffer_rsrc(uT_g, 0, 32 << 20, 0x00020000);
  const __amdgpu_buffer_rsrc_t r_w = __builtin_amdgcn_make_buffer_rsrc(w_g, 0, 32 << 20, 0x00020000);
  for (int j = (int)blockIdx.x - first; j < 2048; j += nblk) {
    const int c = j >> 4, b = (j >> 3) & 1, h = j & 7;
    const int item = (b * 128 + c) * 8 + h;
    const int tok0 = b * 8192 + c * 64;
    const int tid = relaunder(tid_), lane = tid & 63, wave = tid >> 6, l15 = lane & 15, quad = lane >> 4;
    if (wave == 3) {
      const int row = tok0 + lane;
      const float br = braw[(size_t)row * 16 + h];
      const float ar = braw[(size_t)row * 16 + 8 + h] + p.a_dt_bias[h];
      const float beta = 1.f / (1.f + __expf(-br));
      const float sp = fmaxf(ar, 0.f) + log1pf(__expf(-fabsf(ar)));
      float g = -__expf(p.a_A_log[h]) * sp;
#pragma unroll
      for (int o = 1; o < 64; o <<= 1) { float t = __shfl_up(g, o); if (lane >= o) g += t; }
      g_s[lane] = g;
      beta_s[lane] = beta;
    } else {
      const int sec = wave, cgi = l15, rr = quad;
      const int col = sec * 1024 + h * 128 + cgi * 8;
      float w0[8], w1[8], w2[8], w3[8];
#pragma unroll
      for (int e = 0; e < 8; ++e) {
        w0[e] = p.a_conv_w[0 * 3072 + col + e]; w1[e] = p.a_conv_w[1 * 3072 + col + e];
        w2[e] = p.a_conv_w[2 * 3072 + col + e]; w3[e] = p.a_conv_w[3 * 3072 + col + e];
      }
      const u16* src = proj + (size_t)(tok0 + rr * 16) * 4096 + col;
      float x0[8], x1[8], x2[8], x3[8];
      if (c == 0 && rr == 0) {
#pragma unroll
        for (int e = 0; e < 8; ++e) { x0[e] = 0.f; x1[e] = 0.f; x2[e] = 0.f; }
      } else {
        unpack8(*(const u32x4*)(src - 3 * 4096), x0);
        unpack8(*(const u32x4*)(src - 2 * 4096), x1);
        unpack8(*(const u32x4*)(src - 1 * 4096), x2);
      }
      char* dstL = smem + sec * 16384;
#pragma unroll 4
      for (int r = 0; r < 16; ++r) {
        unpack8(*(const u32x4*)(src + (size_t)r * 4096), x3);
        float y[8];
        float ssq = 0.f;
#pragma unroll
        for (int e = 0; e < 8; ++e) {
          float v = w0[e] * x0[e] + w1[e] * x1[e] + w2[e] * x2[e] + w3[e] * x3[e];
          v = silu(v);
          y[e] = v;
          ssq += v * v;
          x0[e] = x1[e]; x1[e] = x2[e]; x2[e] = x3[e];
        }
        ssq += __shfl_xor(ssq, 1); ssq += __shfl_xor(ssq, 2); ssq += __shfl_xor(ssq, 4); ssq += __shfl_xor(ssq, 8);
        const int row = rr * 16 + r;
        if (sec < 2 && cgi == 0) ssq_s[sec * 64 + row] = ssq;
        *(u32x4*)(dstL + row * 256 + ((cgi ^ (row & 15)) << 4)) = packf8(y);
      }
    }
    __syncthreads();
    if (tid < 64) {
      const float rq = rsqrtf(ssq_s[tid] + kEps), rk = rsqrtf(ssq_s[64 + tid] + kEps);
      const float gi = g_s[tid], g63 = g_s[63];
      const float eg = __expf(gi);
      rq_s[tid] = rq; rk_s[tid] = rk;
      const float be = beta_s[tid];
      fu_s[tid] = be;
      fw_s[tid] = be * rk * eg;
      ssq_s[tid] = rq * kScale * eg;
      ssq_s[64 + tid] = rk * __expf(g63 - gi);
      if (tid == 0) __hip_atomic_store(gend_g + item, __expf(g63), __ATOMIC_RELAXED, __HIP_MEMORY_SCOPE_AGENT);
    }
    __syncthreads();
    {
      const int tid = relaunder(tid_), lane = tid & 63, wave = tid >> 6, l15 = lane & 15, quad = lane >> 4;
      bf16x8 bk[4], bq[4];
      const int rowI = 16 * wave + l15;
#pragma unroll
      for (int ks = 0; ks < 4; ++ks) {
        const int off = rowI * 256 + (((ks * 4 + quad) ^ (rowI & 15)) << 4);
        bk[ks] = *(const bf16x8*)(kL + off);
        bq[ks] = *(const bf16x8*)(qL + off);
      }
      const int i = rowI;
      const float gi = g_s[i], bi = beta_s[i] * rk_s[i], qi = kScale * rq_s[i];
      u32x2 keep = {0u, 0u};
#pragma unroll
      for (int J = 0; J < 4; ++J) {
        f32x4 skk = {0.f, 0.f, 0.f, 0.f}, sqk = {0.f, 0.f, 0.f, 0.f};
        const int rowJ = 16 * J + l15;
#pragma unroll
        for (int ks = 0; ks < 4; ++ks) {
          const bf16x8 ak = *(const bf16x8*)(kL + rowJ * 256 + (((ks * 4 + quad) ^ (rowJ & 15)) << 4));
          skk = mfma16(ak, bk[ks], skk);
          sqk = mfma16(ak, bq[ks], sqk);
        }
        const f32x4 gj4 = *(const f32x4*)(g_s + 16 * J + 4 * quad);
        const f32x4 rk4 = *(const f32x4*)(rk_s + 16 * J + 4 * quad);
        f32x4 a4, t4;
#pragma unroll
        for (int jj = 0; jj < 4; ++jj) {
          const int j = 16 * J + 4 * quad + jj;
          const float dec = (i >= j) ? __expf(gi - gj4[jj]) : 0.f;
          a4[jj] = (i > j) ? bi * rk4[jj] * skk[jj] * dec : 0.f;
          t4[jj] = qi * rk4[jj] * sqk[jj] * dec;
        }
        *(f32x4*)(As + i * 68 + 16 * J + 4 * quad) = a4;
        const u32x2 half = {pack2(t4[0], t4[1]), pack2(t4[2], t4[3])};
        if ((J & 1) == 0) keep = half;
        else {
          const u32x4 fr = {keep.x, keep.y, half.x, half.y};
          __builtin_amdgcn_raw_buffer_store_b128(fr, r_at, item * 8192 + ((wave * 2 + (J >> 1)) * 64 + lane) * 16, 0, 16);
        }
      }
    }
    {
      const int tid = relaunder(tid_);
#pragma unroll
      for (int it = 0; it < 4; ++it) {
        const int idx = tid + 256 * it;
        const int f = idx >> 6, ln = idx & 63, fl = ln & 15, fq = ln >> 4;
        {
          const int mt = f >> 2, ks = f & 3, i = 16 * mt + fl;
          const int c0 = 4 * ks + (fq >> 1), o8 = (fq & 1) * 8;
          const u32x2 lo = *(const u32x2*)(qL + i * 256 + ((c0 ^ (i & 15)) << 4) + o8);
          const u32x2 hi = *(const u32x2*)(qL + i * 256 + (((c0 + 2) ^ (i & 15)) << 4) + o8);
          const float s = ssq_s[i];
          const u32x4 o = {pack2(bflo(lo.x) * s, bfhi(lo.x) * s), pack2(bflo(lo.y) * s, bfhi(lo.y) * s),
                           pack2(bflo(hi.x) * s, bfhi(hi.x) * s), pack2(bflo(hi.y) * s, bfhi(hi.y) * s)};
          __builtin_amdgcn_raw_buffer_store_b128(o, r_qd, item * 16384 + idx * 16, 0, 16);
        }
        {
          const int mt = f >> 1, ks = f & 1, dk = 16 * mt + fl;
          float v[8];
#pragma unroll
          for (int e = 0; e < 8; ++e) {
            const int i = 32 * ks + ((e < 4) ? (4 * fq + e) : (16 + 4 * fq + e - 4));
            const u16 raw = *(const u16*)(kL + i * 256 + (((dk >> 3) ^ (i & 15)) << 4) + (dk & 7) * 2);
            v[e] = __uint_as_float(((unsigned)raw) << 16) * ssq_s[64 + i];
          }
          __builtin_amdgcn_raw_buffer_store_b128(packf8(v), r_kT, item * 16384 + idx * 16, 0, 16);
        }
      }
    }
    __syncthreads();
    {
      float U[64];
      const int tid = relaunder(tid_), wave = tid >> 6;
      const int cc = tid & 127, ch = cc >> 3, e2 = (cc & 7) * 2;
      const char* srcL = (wave < 2) ? vL : kL;
      const float* fr = (wave < 2) ? fu_s : fw_s;
#pragma unroll
      for (int i = 0; i < 64; ++i) {
        int ii = i;
        asm volatile("" : "+v"(ii));
        const u16 raw = *(const u16*)(srcL + ii * 256 + ((ch ^ (ii & 15)) << 4) + e2);
        float acc = __uint_as_float(((unsigned)raw) << 16) * fr[ii];
#pragma unroll
        for (int j = 0; j < i; ++j) acc -= As[i * 68 + j] * U[j];
        U[i] = acc;
      }
      if (wave < 2) {
        const int dofs = item * 16384 + (((cc >> 4) * 4) * 256 + (cc & 15) * 4) * 2;
#pragma unroll
        for (int mi = 0; mi < 4; ++mi)
#pragma unroll
          for (int q4 = 0; q4 < 4; ++q4) {
            const u32x2 o = {pack2(U[16 * mi + 4 * q4], U[16 * mi + 4 * q4 + 1]), pack2(U[16 * mi + 4 * q4 + 2], U[16 * mi + 4 * q4 + 3])};
            __builtin_amdgcn_raw_buffer_store_b64(o, r_uT, dofs + (mi * 256 + q4 * 64) * 2, 0, 16);
          }
      } else {
#pragma unroll
        for (int i = 0; i < 64; ++i) {
          int ii = i;
          asm volatile("" : "+v"(ii));
          *(u16*)(qL + ii * 256 + ((ch ^ (ii & 15)) << 4) + e2) = (u16)f2bf(U[i]);
        }
      }
    }
    __syncthreads();
    {
      const int tid = relaunder(tid_);
#pragma unroll
      for (int it = 0; it < 4; ++it) {
        const int idx = tid + 256 * it;
        const int f = idx >> 6, ln = idx & 63, fl = ln & 15, fq = ln >> 4;
        const int mt = f >> 2, ks = f & 3, i = 16 * mt + fl;
        const int c0 = 4 * ks + (fq >> 1), o8 = (fq & 1) * 8;
        const u32x2 lo = *(const u32x2*)(qL + i * 256 + ((c0 ^ (i & 15)) << 4) + o8);
        const u32x2 hi = *(const u32x2*)(qL + i * 256 + (((c0 + 2) ^ (i & 15)) << 4) + o8);
        const u32x4 o = {lo.x, lo.y, hi.x, hi.y};
        __builtin_amdgcn_raw_buffer_store_b128(o, r_w, item * 16384 + idx * 16, 0, 16);
      }
    }
    asm volatile("s_waitcnt vmcnt(0)" ::: "memory");
    __syncthreads();
    if (relaunder(tid_) == 0) __hip_atomic_store(flags + item, 1u, __ATOMIC_RELAXED, __HIP_MEMORY_SCOPE_AGENT);
  }
}

#define RAW_BARRIER() do { asm volatile("s_waitcnt lgkmcnt(0)" ::: "memory"); __builtin_amdgcn_s_barrier(); asm volatile("" ::: "memory"); } while (0)
#define GAS __attribute__((address_space(1)))
#define SCAN_LOAD(item_)                                                                                          \
  do {                                                                                                            \
    const GAS char* wb_ = (const GAS char*)((const char*)w_g + (size_t)(item_) * 16384);                          \
    const GAS char* qb_ = (const GAS char*)((const char*)qd_g + (size_t)(item_) * 16384);                         \
    const GAS char* kb_ = (const GAS char*)((const char*)kT_g + (size_t)(item_) * 16384);                         \
    const GAS char* ab_ = (const GAS char*)((const char*)at_g + (size_t)(item_) * 8192);                          \
    const GAS char* ub_ = (const GAS char*)((const char*)uT_g + (size_t)(item_) * 16384);                         \
    asm volatile("" : "+s"(wb_), "+s"(qb_), "+s"(kb_), "+s"(ab_), "+s"(ub_));                                     \
    _Pragma("unroll") for (int j = 0; j < 4; ++j) {                                                               \
      R[j] = *(const GAS u32x4*)(wb_ + (toff + 4096u * j));                                                       \
      R[4 + j] = *(const GAS u32x4*)(qb_ + (toff + 4096u * j));                                                   \
      R[8 + j] = *(const GAS u32x4*)(kb_ + (toff + 4096u * j));                                                   \
    }                                                                                                             \
    _Pragma("unroll") for (int j = 0; j < 2; ++j) R[12 + j] = *(const GAS u32x4*)(ab_ + (toff + 4096u * j));     \
    _Pragma("unroll") for (int mi = 0; mi < 4; ++mi) un[mi] = *(const GAS u32x2*)(ub_ + (uoff + 512u * mi));     \
    gn = gend_g[item_];                                                                                           \
  } while (0)
DI void delta_scan(const Params& p, char* smem) {
  char* ws = p.ws;
  const u16* qd_g = (const u16*)(ws + OFF_R);
  const u16* kT_g = (const u16*)(ws + OFF_R + 32 * MiB);
  const u16* at_g = (const u16*)(ws + OFF_R + 64 * MiB);
  const u16* uT_g = (const u16*)p.out;
  const u16* w_g = (const u16*)((const char*)p.out + 32 * MiB);
  const float* gend_g = (const float*)(ws + OFF_GEND);
  u16* o_g = (u16*)(ws + OFF_PROJ);
  unsigned* flags = (unsigned*)(ws + OFF_FLAGS);
  const int tid = tidx(), lane = tid & 63, wave = tid >> 6, l15 = lane & 15, quad = lane >> 4;
  char* Lw = smem;
  char* Lq = smem + 16384;
  char* Lk = smem + 32768;
  char* La = smem + 49152;
  char* Lo = smem + 57344;
  for (int unit = blockIdx.x; unit < 32; unit += gridDim.x) {
    const int bh = unit & 15, half = unit >> 4, b = bh >> 3, h = bh & 7;
    const int slice = half * 4 + wave;
    f32x4 S[8];
#pragma unroll
    for (int i = 0; i < 8; ++i) S[i] = (f32x4){0.f, 0.f, 0.f, 0.f};
    const unsigned toff = (unsigned)tid * 16u, uoff = (unsigned)(slice * 256 + lane) * 8u;
    u32x4 R[14];
    u32x2 un[4];
    float gn;
#define SCAN_WAIT(flv_, item_)                                                                                         \
  do {                                                                                                                 \
    unsigned f_ = (flv_), sp_ = 0u;                                                                                    \
    while (f_ == 0u && sp_ < (1u << 24)) { __builtin_amdgcn_s_sleep(2); f_ = __hip_atomic_load(flags + (item_), __ATOMIC_RELAXED, __HIP_MEMORY_SCOPE_AGENT); ++sp_; } \
    __builtin_amdgcn_fence(__ATOMIC_ACQUIRE, "workgroup");           \
  } while (0)
    unsigned fl;
    {
      const int item = (b * 128) * 8 + h;
      SCAN_WAIT(0u, item);
      SCAN_LOAD(item);
      fl = __hip_atomic_load(flags + ((b * 128 + 1) * 8 + h), __ATOMIC_RELAXED, __HIP_MEMORY_SCOPE_AGENT);
    }
    for (int c = 0; c < 128; ++c) {
#pragma unroll
      for (int j = 0; j < 4; ++j) {
        *(u32x4*)(Lw + (tid + 256 * j) * 16) = R[j];
        *(u32x4*)(Lq + (tid + 256 * j) * 16) = R[4 + j];
        *(u32x4*)(Lk + (tid + 256 * j) * 16) = R[8 + j];
      }
#pragma unroll
      for (int j = 0; j < 2; ++j) *(u32x4*)(La + (tid + 256 * j) * 16) = R[12 + j];
      u32x2 uc[4];
#pragma unroll
      for (int mi = 0; mi < 4; ++mi) uc[mi] = un[mi];
      const float gend = gn;
      RAW_BARRIER();
      if (c + 1 < 128) SCAN_WAIT(fl, (b * 128 + c + 1) * 8 + h);
      if (c > 0) {
        const int tokp = b * 8192 + (c - 1) * 64;
#pragma unroll
        for (int k2 = 0; k2 < 2; ++k2) {
          const int idx = tid + 256 * k2, row = idx >> 3, part = idx & 7;
          *(u32x4*)(o_g + (size_t)(tokp + row) * 4096 + h * 128 + half * 64 + part * 8) = *(const u32x4*)(Lo + idx * 16);
        }
      }
      if (c + 1 < 128) {
        const int item = (b * 128 + c + 1) * 8 + h;
        SCAN_LOAD(item);
        fl = (c + 2 < 128) ? __hip_atomic_load(flags + (item + 8), __ATOMIC_RELAXED, __HIP_MEMORY_SCOPE_AGENT) : 1u;
      }
      __builtin_amdgcn_sched_barrier(0);
      bf16x8 bS[4];
#pragma unroll
      for (int ks = 0; ks < 4; ++ks) bS[ks] = pack8(S[2 * ks], S[2 * ks + 1]);
      bf16x8 fr[16];
#pragma unroll
      for (int i = 0; i < 16; ++i) fr[i] = *(const bf16x8*)(Lw + (i * 64 + lane) * 16);
      __builtin_amdgcn_sched_barrier(0);
      f32x4 vn[4];
#pragma unroll
      for (int mi = 0; mi < 4; ++mi) vn[mi] = (f32x4){0.f, 0.f, 0.f, 0.f};
#pragma unroll
      for (int ks = 0; ks < 4; ++ks)
#pragma unroll
        for (int mi = 0; mi < 4; ++mi) vn[mi] = mfma16(fr[mi * 4 + ks], bS[ks], vn[mi]);
      __builtin_amdgcn_sched_barrier(0);
#pragma unroll
      for (int i = 0; i < 16; ++i) fr[i] = *(const bf16x8*)(Lk + (i * 64 + lane) * 16);
#pragma unroll
      for (int mi = 0; mi < 4; ++mi) {
        vn[mi][0] = bflo(uc[mi].x) - vn[mi][0]; vn[mi][1] = bfhi(uc[mi].x) - vn[mi][1];
        vn[mi][2] = bflo(uc[mi].y) - vn[mi][2]; vn[mi][3] = bfhi(uc[mi].y) - vn[mi][3];
      }
      bf16x8 bV[2];
      bV[0] = pack8(vn[0], vn[1]);
      bV[1] = pack8(vn[2], vn[3]);
#pragma unroll
      for (int mt = 0; mt < 8; ++mt) S[mt] = S[mt] * gend;
      __builtin_amdgcn_sched_barrier(0);
#pragma unroll
      for (int ks = 0; ks < 2; ++ks)
#pragma unroll
        for (int mt = 0; mt < 8; ++mt) S[mt] = mfma16(fr[mt * 2 + ks], bV[ks], S[mt]);
      __builtin_amdgcn_sched_barrier(0);
#pragma unroll
      for (int i = 0; i < 16; ++i) fr[i] = *(const bf16x8*)(Lq + (i * 64 + lane) * 16);
      __builtin_amdgcn_sched_barrier(0);
      f32x4 oacc[4];
#pragma unroll
      for (int mi = 0; mi < 4; ++mi) oacc[mi] = (f32x4){0.f, 0.f, 0.f, 0.f};
#pragma unroll
      for (int ks = 0; ks < 4; ++ks)
#pragma unroll
        for (int mi = 0; mi < 4; ++mi) oacc[mi] = mfma16(fr[mi * 4 + ks], bS[ks], oacc[mi]);
      __builtin_amdgcn_sched_barrier(0);
#pragma unroll
      for (int i = 0; i < 8; ++i) fr[i] = *(const bf16x8*)(La + (i * 64 + lane) * 16);
      __builtin_amdgcn_sched_barrier(0);
#pragma unroll
      for (int ks = 0; ks < 2; ++ks)
#pragma unroll
        for (int mi = 0; mi < 4; ++mi) oacc[mi] = mfma16(fr[mi * 2 + ks], bV[ks], oacc[mi]);
      __builtin_amdgcn_sched_barrier(0);
#pragma unroll
      for (int mi = 0; mi < 4; ++mi)
#pragma unroll
        for (int jj = 0; jj < 4; ++jj)
          *(u16*)(Lo + (16 * mi + 4 * quad + jj) * 128 + (wave * 16 + l15) * 2) = (u16)f2bf(oacc[mi][jj]);
      RAW_BARRIER();
    }
    {
      const int tokp = b * 8192 + 127 * 64;
#pragma unroll
      for (int k2 = 0; k2 < 2; ++k2) {
        const int idx = tid + 256 * k2, row = idx >> 3, part = idx & 7;
        *(u32x4*)(o_g + (size_t)(tokp + row) * 4096 + h * 128 + half * 64 + part * 8) = *(const u32x4*)(Lo + idx * 16);
      }
      RAW_BARRIER();
    }
  }
}

#undef SCAN_LOAD
#undef SCAN_WAIT

DI void gate_phase(const Params& p) {
  char* ws = p.ws;
  const u16* proj = (const u16*)(ws + OFF_PROJ);
  u16* y0 = (u16*)(ws + OFF_R + 32 * MiB);
  const int tidg = tidx();
  const int lane = tidg & 63, l15 = lane & 15, quad = lane >> 4;
  const int gw = blockIdx.x * 4 + (tidg >> 6), nw = gridDim.x * 4;
  float wn[8];
#pragma unroll
  for (int e = 0; e < 8; ++e) wn[e] = p.a_o_norm_w[l15 * 8 + e];
  for (int r4 = gw; r4 < 32768; r4 += nw) {
    const int rh = r4 * 4 + quad, tok = rh >> 3, h = rh & 7;
    float o[8], z[8];
    unpack8(*(const u32x4*)(proj + (size_t)tok * 4096 + h * 128 + l15 * 8), o);
    unpack8(*(const u32x4*)(proj + (size_t)tok * 4096 + 3072 + h * 128 + l15 * 8), z);
    float ssq = 0.f;
#pragma unroll
    for (int e = 0; e < 8; ++e) ssq += o[e] * o[e];
    ssq += __shfl_xor(ssq, 1); ssq += __shfl_xor(ssq, 2); ssq += __shfl_xor(ssq, 4); ssq += __shfl_xor(ssq, 8);
    const float rs = rsqrtf(ssq * (1.f / 128.f) + kEps);
#pragma unroll
    for (int e = 0; e < 8; ++e) o[e] = o[e] * rs * wn[e] * silu(z[e]);
    *(u32x4*)(y0 + (size_t)tok * 1024 + h * 128 + l15 * 8) = packf8(o);
  }
}

DI void qknorm_cumsum(const Params& p, char* smem) {
  char* ws = p.ws;
  u16* proj = (u16*)(ws + OFF_PROJ);
  const int tid = tidx(), lane = tid & 63, l15 = lane & 15, quad = lane >> 4;
  const int gw = blockIdx.x * 4 + (tid >> 6), nw = gridDim.x * 4;
  for (int idx = gw; idx < 65536; idx += nw) {
    const int which = idx >> 15, r4 = idx & 32767;
    const int rh = r4 * 4 + quad, tok = rh >> 3, h = rh & 7;
    const float* wv = which ? p.b_k_norm_w : p.b_q_norm_w;
    u16* ptr = proj + (size_t)tok * 4096 + which * 1024 + h * 128 + l15 * 8;
    float v[8];
    unpack8(*(const u32x4*)ptr, v);
    float ssq = 0.f;
#pragma unroll
    for (int e = 0; e < 8; ++e) ssq += v[e] * v[e];
    ssq += __shfl_xor(ssq, 1); ssq += __shfl_xor(ssq, 2); ssq += __shfl_xor(ssq, 4); ssq += __shfl_xor(ssq, 8);
    const float rs = rsqrtf(ssq * (1.f / 128.f) + kEps) * (which ? 1.f : kScale);
#pragma unroll
    for (int e = 0; e < 8; ++e) v[e] = v[e] * rs * wv[l15 * 8 + e];
    *(u32x4*)ptr = packf8(v);
  }
}

DI void attn_phase(const Params& p, char* smem) {
  char* ws = p.ws;
  const u16* proj = (const u16*)(ws + OFF_PROJ);
  const u16* vT = (const u16*)(ws + OFF_R + 32 * MiB);
  const float* fraw = (const float*)(ws + OFF_FRAW);
  u16* y1 = (u16*)(ws + OFF_R + 64 * MiB);
  float* bias_s = (float*)(smem + 65536);
  float* ca_s = bias_s + 128;
  const int tid_ = tidx();
  float mq = 0.f, mk = 0.f;
  for (int i = 0; i < 128; ++i) { mq = fmaxf(mq, fabsf(p.b_q_norm_w[i])); mk = fmaxf(mk, fabsf(p.b_k_norm_w[i])); }
  const float QKB = 128.f * kScale * mq * mk;
  float* mmin_s = (float*)(smem + 66320);

  unsigned* qctr = (unsigned*)(ws + OFF_BAR) + XCD_BAR_WORDS;
  int* qslot = (int*)(smem + 66304);
  int qx = blockIdx.x & 7, qtries = 0;
  while (true) {
    const int tid = relaunder(tid_), lane = tid & 63, wave = tid >> 6, l15 = lane & 15, quad = lane >> 4;
    if (tid == 0) *qslot = (int)atomicAdd(qctr + qx * 16, 1u);
    __syncthreads();
    const int it = *qslot;
    __syncthreads();
    if (it >= 128) { if (++qtries >= 8) break; qx = (qx + 1) & 7; continue; }
    const int qb = 63 - (it & 63);
    const int b = it >> 6, h = b ? ((qx + 4) & 7) : qx, bh = b * 8 + h, i0 = qb * 128;
    const int qrow0 = i0 + 32 * wave;
    const float fb = p.b_f_bias[h];
    bf16x8 bq[2][4];
#pragma unroll
    for (int nq = 0; nq < 2; ++nq)
#pragma unroll
      for (int ks = 0; ks < 4; ++ks)
        bq[nq][ks] = *(const bf16x8*)(proj + (size_t)(b * 8192 + qrow0 + 16 * nq + l15) * 4096 + h * 128 + 32 * ks + 8 * quad);
    f32x4 O[8][2];
#pragma unroll
    for (int dt = 0; dt < 8; ++dt) { O[dt][0] = (f32x4){0.f, 0.f, 0.f, 0.f}; O[dt][1] = (f32x4){0.f, 0.f, 0.f, 0.f}; }
    float mrun[2] = {-1e30f, -1e30f}, lrun[2] = {0.f, 0.f};

    const int kkey = wave * 4 + (lane >> 4);
    const int kch = (lane & 15) ^ (kkey & 15);
    const u16* Kg = proj + (size_t)(b * 8192 + kkey) * 4096 + 1024 + h * 128 + kch * 8;
    const int vd = wave * 8 + (lane >> 3);
    const int vch = (lane & 7) ^ ((((wave & 1) << 2) + (lane >> 4)) & 7);
    const u16* Vg = vT + (size_t)(bh * 128 + vd) * 8192 + vch * 8;
#define ATT_STAGE(buf, j0_)                                                                                                   \
  do {                                                                                                                        \
    _Pragma("unroll") for (int i = 0; i < 4; ++i) {                                                                           \
      __builtin_amdgcn_global_load_lds((const unsigned*)(Kg + (size_t)((j0_) + 16 * i) * 4096),                               \
                                       (unsigned*)(smem + (buf) * 32768 + (i * 4 + wave) * 1024), 16, 0, 0);                  \
      __builtin_amdgcn_global_load_lds((const unsigned*)(Vg + (size_t)(32 * i) * 8192 + (j0_)),                               \
                                       (unsigned*)(smem + (buf) * 32768 + 16384 + (i * 4 + wave) * 1024), 16, 0, 0);          \
    }                                                                                                                         \
  } while (0)
    int j0 = i0 + 64;
    ATT_STAGE(0, j0);
    float carry = 0.f, biasA = 0.f, frn = 0.f;
    if (wave == 0) {
      const float xa = fraw[(size_t)(b * 8192 + i0 + lane) * 16 + h] + fb;
      const float xb2 = fraw[(size_t)(b * 8192 + i0 + 64 + lane) * 16 + h] + fb;
      const float lfA = fminf(xa, 0.f) - log1pf(__expf(-fabsf(xa)));
      const float lfB = fminf(xb2, 0.f) - log1pf(__expf(-fabsf(xb2)));
      float pa = lfA, pb = lfB;
#pragma unroll
      for (int o = 1; o < 64; o <<= 1) {
        const float ta = __shfl_up(pa, o), tb = __shfl_up(pb, o);
        if (lane >= o) { pa += ta; pb += tb; }
      }
      const float lf0 = __shfl(lfA, 0), totA = __shfl(pa, 63);
      biasA = -(pa - lf0) * kLog2e;
      bias_s[lane] = -(totA - lf0 + pb) * kLog2e;
      carry = lf0;
    }
    if (lane == 0) { mmin_s[wave] = -1e30f; mmin_s[4 + wave] = -1e30f; }
    asm volatile("s_waitcnt vmcnt(0)" ::: "memory");
    __syncthreads();
    int cur = 0;
    while (true) {
      const int nj = j0 - 64;
      bool more = nj >= 0;
      if (more && j0 <= i0) {
        const float* mm = mmin_s + cur * 4;
        const float mmin = fminf(fminf(mm[0], mm[1]), fminf(mm[2], mm[3]));
        more = !((QKB + ca_s[cur]) * kLog2e < mmin - 30.f * kLog2e);
      }
      if (more) {
        ATT_STAGE(cur ^ 1, nj);
        if (wave == 0 && nj < i0) frn = fraw[(size_t)(b * 8192 + nj + lane) * 16 + h];
      }
      if (j0 <= qrow0 + 31) {
        const char* Ks = smem + cur * 32768;
        const char* Vs = Ks + 16384;
        const float* cs = bias_s + cur * 64;
        f32x4 s[4][2];
#pragma unroll
        for (int kt = 0; kt < 4; ++kt) { s[kt][0] = (f32x4){0.f, 0.f, 0.f, 0.f}; s[kt][1] = (f32x4){0.f, 0.f, 0.f, 0.f}; }
#pragma unroll
        for (int ks = 0; ks < 4; ++ks)
#pragma unroll
          for (int kt = 0; kt < 4; ++kt) {
            const int kl = 16 * kt + l15;
            const bf16x8 ak = *(const bf16x8*)(Ks + kl * 256 + (((ks * 4 + quad) ^ (kl & 15)) << 4));
            s[kt][0] = mfma16(ak, bq[0][ks], s[kt][0]);
            s[kt][1] = mfma16(ak, bq[1][ks], s[kt][1]);
          }
        const bool diag = (j0 >= i0);
#pragma unroll
        for (int kt = 0; kt < 4; ++kt) {
          const f32x4 bias = *(const f32x4*)(cs + 16 * kt + 4 * quad);
#pragma unroll
          for (int nq = 0; nq < 2; ++nq)
#pragma unroll
            for (int jj = 0; jj < 4; ++jj) {
              float v = s[kt][nq][jj] + bias[jj];
              if (diag) { if (j0 + 16 * kt + 4 * quad + jj > qrow0 + 16 * nq + l15) v = -1e30f; }
              s[kt][nq][jj] = v;
            }
        }
        bf16x8 bP[2][2];
#pragma unroll
        for (int nq = 0; nq < 2; ++nq) {
          float tmax = -1e30f;
#pragma unroll
          for (int kt = 0; kt < 4; ++kt)
#pragma unroll
            for (int jj = 0; jj < 4; ++jj) tmax = fmaxf(tmax, s[kt][nq][jj]);
          tmax = fmaxf(tmax, __shfl_xor(tmax, 16));
          tmax = fmaxf(tmax, __shfl_xor(tmax, 32));
          const float mnew = fmaxf(mrun[nq], tmax);
          const float alpha = __builtin_amdgcn_exp2f(mrun[nq] - mnew);
          const bool grew = mnew > mrun[nq];
          mrun[nq] = mnew;
          float psum = 0.f;
#pragma unroll
          for (int kt = 0; kt < 4; ++kt)
#pragma unroll
            for (int jj = 0; jj < 4; ++jj) { const float pv = __builtin_amdgcn_exp2f(s[kt][nq][jj] - mnew); s[kt][nq][jj] = pv; psum += pv; }
          lrun[nq] = lrun[nq] * alpha + psum;
          if (__builtin_amdgcn_ballot_w64(grew) != 0ull) {
#pragma unroll
            for (int dt = 0; dt < 8; ++dt) O[dt][nq] = O[dt][nq] * alpha;
          }
          bP[0][nq] = pack8(s[0][nq], s[1][nq]);
          bP[1][nq] = pack8(s[2][nq], s[3][nq]);
        }
#pragma unroll
        for (int ks = 0; ks < 2; ++ks)
#pragma unroll
          for (int dt = 0; dt < 8; ++dt) {
            const int d = 16 * dt + l15, sw = (d >> 1) & 7, c0 = 4 * ks + (quad >> 1);
            const u32x2 lo = *(const u32x2*)(Vs + d * 128 + ((c0 ^ sw) << 4) + (quad & 1) * 8);
            const u32x2 hi = *(const u32x2*)(Vs + d * 128 + (((c0 + 2) ^ sw) << 4) + (quad & 1) * 8);
            const bf16x8 av = mk8(lo, hi);
            O[dt][0] = mfma16(av, bP[ks][0], O[dt][0]);
            O[dt][1] = mfma16(av, bP[ks][1], O[dt][1]);
          }
        float wm = fminf(mrun[0], mrun[1]);
#pragma unroll
        for (int o = 1; o < 64; o <<= 1) wm = fminf(wm, __shfl_xor(wm, o));
        if (lane == 0) mmin_s[(cur ^ 1) * 4 + wave] = wm;
      }
      if (more && wave == 0) {
        const int nb = cur ^ 1;
        if (nj == i0) {
          bias_s[nb * 64 + lane] = biasA;
          if (lane == 0) ca_s[nb] = carry;
        } else {
          const float xv = frn + fb;
          const float lf = fminf(xv, 0.f) - log1pf(__expf(-fabsf(xv)));
          float sf = lf;
#pragma unroll
          for (int o = 1; o < 64; o <<= 1) { const float t = __shfl_down(sf, o); if (lane + o < 64) sf += t; }
          bias_s[nb * 64 + lane] = (sf - lf + carry) * kLog2e;
          carry += __shfl(sf, 0);
          if (lane == 0) ca_s[nb] = carry;
        }
      }
      asm volatile("s_waitcnt vmcnt(0)" ::: "memory");
      __syncthreads();
      if (!more) break;
      j0 = nj;
      cur ^= 1;
    }
#undef ATT_STAGE
#pragma unroll
    for (int nq = 0; nq < 2; ++nq) {
      float l = lrun[nq];
      l += __shfl_xor(l, 16);
      l += __shfl_xor(l, 32);
      const float inv = 1.f / l;
      const size_t tok = (size_t)(b * 8192 + qrow0 + 16 * nq + l15);
#pragma unroll
      for (int dt = 0; dt < 8; ++dt) {
        const int d = 16 * dt + 4 * quad;
        const u32x2 z2 = *(const u32x2*)(proj + tok * 4096 + 3072 + h * 128 + d);
        const f32x4 o = O[dt][nq] * inv;
        u32x2 r = {pack2(o[0] * silu(bflo(z2.x)), o[1] * silu(bfhi(z2.x))), pack2(o[2] * silu(bflo(z2.y)), o[3] * silu(bfhi(z2.y)))};
        *(u32x2*)(y1 + tok * 1024 + h * 128 + d) = r;
      }
    }
  }
}

DI void final_norm(const Params& p) {
  const float* ss2 = (const float*)(p.ws + OFF_SS2);
  const int tidf = tidx();
  const int lane = tidf & 63;
  const int gw = blockIdx.x * 4 + (tidf >> 6), nw = gridDim.x * 4;
  const f32x4* w = (const f32x4*)p.final_norm_w;
  f32x4 wv[4];
#pragma unroll
  for (int i = 0; i < 4; ++i) wv[i] = w[lane + 64 * i];
  for (int row = gw; row < 16384; row += 4 * nw) {
    u32x2 r[4][4];
    float rs[4];
#pragma unroll
    for (int k = 0; k < 4; ++k) {
      const int rr = row + k * nw;
      const bool okr = rr < 16384;
      const int rc = okr ? rr : row;
      rs[k] = rsqrtf(ss2[rc] * (1.f / 1024.f) + kEps);
      const u32x2* hsrc = (const u32x2*)((const u16*)(p.ws + OFF_R) + (size_t)rc * 1024);
#pragma unroll
      for (int i = 0; i < 4; ++i) r[k][i] = hsrc[lane + 64 * i];
    }
#pragma unroll
    for (int k = 0; k < 4; ++k) {
      const int rr = row + k * nw;
      if (rr < 16384) {
        f32x4* o = (f32x4*)(p.out + (size_t)rr * 1024);
#pragma unroll
        for (int i = 0; i < 4; ++i) {
          f32x4 v = {bflo(r[k][i].x), bfhi(r[k][i].x), bflo(r[k][i].y), bfhi(r[k][i].y)};
          o[lane + 64 * i] = v * rs[k] * wv[i];
        }
      }
    }
  }
}

__global__ void __launch_bounds__(kThreads, 2) fwd_megakernel(Params p) {
  extern __shared__ __attribute__((aligned(16))) char smem[];
  cg::grid_group grid = cg::this_grid();
  char* ws = p.ws;
  __shared__ uint4 xb_words;
  if (threadIdx.x == 0) xb_words = make_uint4(0u, 0u, 0u, 0u);
  __syncthreads();
  if (p.ws == nullptr) grid.sync();
  XcdBarrier xb = xcd_barrier_post((unsigned*)(ws + OFF_BAR), (volatile LAS unsigned*)&xb_words);
  phase0(p, smem);
  xcd_barrier(xb);
  gemm_phase<1>(p, (const u16*)(ws + OFF_R), (const u16*)(ws + OFF_WTA_IN), 32, smem);
  skinny_gemm<0>(p, (const u16*)(ws + OFF_R), (const u16*)(ws + OFF_WTA_IN) + (size_t)4096 * 1024, (float*)(ws + OFF_BRAW));
  xcd_barrier(xb);
  {
    const bool overlap = gridDim.x >= 128;
    const int G = (int)gridDim.x, hG = G >> 1, bi = (int)blockIdx.x;
    const bool is_scan = overlap && bi < 32, is_idle = overlap && bi >= hG && bi < hG + 32;
    const int pfirst = overlap ? (bi < hG ? 32 : 64) : 0, pn = overlap ? G - 64 : G;
    if (!is_scan && !is_idle) delta_prep(p, smem, pfirst, pn);
    if (!is_scan && !is_idle) phase0b(p, smem, pfirst, pn);
    if (!overlap) xcd_barrier(xb);
    if (!overlap || blockIdx.x < 32) delta_scan(p, smem);
    xcd_barrier(xb);
  }
  gate_phase(p);
  xcd_barrier(xb);
  gemm_phase<2>(p, (const u16*)(ws + OFF_R + 32 * MiB), (const u16*)(ws + OFF_WTA_OUT), 8, smem);
  xcd_barrier(xb);
  gemm_phase<3>(p, (const u16*)(ws + OFF_R), (const u16*)(ws + OFF_WTB_IN), 32, smem);
  skinny_gemm<1>(p, (const u16*)(ws + OFF_R), (const u16*)(ws + OFF_WTB_IN) + (size_t)4096 * 1024, (float*)(ws + OFF_FRAW));
  xcd_barrier(xb);
  attn_phase(p, smem);
  xcd_barrier(xb);
  gemm_phase<4>(p, (const u16*)(ws + OFF_R + 64 * MiB), (const u16*)(ws + OFF_WTB_OUT), 8, smem);
  xcd_barrier(xb);
  final_norm(p);
}

extern "C" void kernel_launch(void* const* d_in, const int* in_sizes, int n_in, void* d_out, int out_size, void* d_ws, size_t ws_size,
                              hipStream_t stream) {
  static int grid_blocks = 0;
  if (!grid_blocks) {
    int dev = 0, cus = 0, per_cu = 0;
    hipGetDevice(&dev);
    hipDeviceGetAttribute(&cus, hipDeviceAttributeMultiprocessorCount, dev);
    hipFuncSetAttribute((const void*)fwd_megakernel, hipFuncAttributeMaxDynamicSharedMemorySize, kLds);
    hipOccupancyMaxActiveBlocksPerMultiprocessor(&per_cu, (const void*)fwd_megakernel, kThreads, kLds);
    if (per_cu < 1) per_cu = 1;
    if (per_cu > 2) per_cu = 2;
    grid_blocks = cus * per_cu;
  }
  Params p{};
  p.x = (const float*)d_in[0]; p.a_norm_w = (const float*)d_in[1]; p.a_w_in = (const float*)d_in[2]; p.a_conv_w = (const float*)d_in[3];
  p.a_A_log = (const float*)d_in[4]; p.a_dt_bias = (const float*)d_in[5]; p.a_o_norm_w = (const float*)d_in[6]; p.a_w_out = (const float*)d_in[7];
  p.b_norm_w = (const float*)d_in[8]; p.b_w_in = (const float*)d_in[9]; p.b_f_bias = (const float*)d_in[10]; p.b_q_norm_w = (const float*)d_in[11];
  p.b_k_norm_w = (const float*)d_in[12]; p.b_w_out = (const float*)d_in[13]; p.final_norm_w = (const float*)d_in[14];
  p.out = (float*)d_out;
  p.ws = (char*)d_ws;
  hipMemsetAsync((char*)d_ws + OFF_BAR, 0, CTL_BYTES, stream);
  void* args[] = {&p};
  hipError_t e = hipLaunchCooperativeKernel((const void*)fwd_megakernel, dim3(grid_blocks), dim3(kThreads), args, kLds, stream);
  if (e != hipSuccess) fprintf(stderr, "cooperative launch failed: %s (grid %d)\n", hipGetErrorString(e), grid_blocks);
}
```

```cpp
#include <hip/hip_runtime.h>
#include <hip/hip_cooperative_groups.h>
#include <cstdio>
namespace cg = cooperative_groups;

typedef unsigned short u16;
typedef __attribute__((ext_vector_type(8))) short bf16x8;
typedef __attribute__((ext_vector_type(4))) float f32x4;
typedef __attribute__((ext_vector_type(4))) unsigned u32x4;
typedef __attribute__((ext_vector_type(2))) unsigned u32x2;
#define DI __device__ __forceinline__

constexpr int kThreads = 256;
constexpr int kLds = 69632;
constexpr float kEps = 1e-6f;
constexpr float kScale = 0.08838834764831845f;
constexpr float kLog2e = 1.4426950408889634f;

constexpr size_t MiB = 1048576;
constexpr size_t OFF_WTA_IN = 0;
constexpr size_t OFF_WTA_OUT = 8650752;
constexpr size_t OFF_WTB_IN = 10747904;
constexpr size_t OFF_WTB_OUT = 19398656;
constexpr size_t OFF_SMALL = 21495808;
constexpr size_t OFF_RS0 = OFF_SMALL;
constexpr size_t OFF_SS1 = OFF_RS0 + 65536;
constexpr size_t OFF_SS2 = OFF_SS1 + 65536;
constexpr size_t OFF_BRAW = OFF_SS2 + 65536;
constexpr size_t OFF_FRAW = OFF_BRAW + 1048576;
constexpr size_t OFF_CCUM = OFF_FRAW + 1048576;
constexpr size_t OFF_GEND = OFF_CCUM + 524288;
constexpr size_t OFF_BAR = OFF_GEND + 8192;
constexpr size_t OFF_FLAGS = OFF_BAR + 13824 + 512;
constexpr size_t CTL_BYTES = 13824 + 512 + 8192;
constexpr size_t OFF_PROJ = OFF_SMALL + 3 * MiB;
constexpr size_t OFF_R = OFF_PROJ + 128 * MiB;

struct Params {
  const float *x, *a_norm_w, *a_w_in, *a_conv_w, *a_A_log, *a_dt_bias, *a_o_norm_w, *a_w_out;
  const float *b_norm_w, *b_w_in, *b_f_bias, *b_q_norm_w, *b_k_norm_w, *b_w_out, *final_norm_w;
  float* out;
  char* ws;
};

typedef __attribute__((ext_vector_type(2))) float f32x2;
typedef __attribute__((ext_vector_type(2))) __bf16 bf16x2_t;
DI unsigned pack2(float a, float b) { f32x2 v = {a, b}; return __builtin_bit_cast(unsigned, __builtin_convertvector(v, bf16x2_t)); }
DI unsigned f2bf(float x) { return pack2(x, 0.f) & 0xffffu; }
DI float bflo(unsigned u) { return __uint_as_float(u << 16); }
DI float bfhi(unsigned u) { return __uint_as_float(u & 0xffff0000u); }
DI f32x4 mfma16(bf16x8 a, bf16x8 b, f32x4 c) { return __builtin_amdgcn_mfma_f32_16x16x32_bf16(a, b, c, 0, 0, 0); }
DI bf16x8 mk8(u32x2 lo, u32x2 hi) { u32x4 v = {lo.x, lo.y, hi.x, hi.y}; return __builtin_bit_cast(bf16x8, v); }
DI bf16x8 pack8(f32x4 a, f32x4 b) { u32x4 v = {pack2(a[0], a[1]), pack2(a[2], a[3]), pack2(b[0], b[1]), pack2(b[2], b[3])}; return __builtin_bit_cast(bf16x8, v); }
DI bf16x8 ld2(const u16* p) { return mk8(*(const u32x2*)p, *(const u32x2*)(p + 16)); }
DI int relaunder(int t) { asm volatile("" : "+v"(t)); return t; }
DI int tidx() { int t = threadIdx.x; asm volatile("" : "+v"(t)); return t; }
DI float silu(float x) { return x / (1.f + __expf(-x)); }
DI void unpack8(u32x4 v, float* f) {
  f[0] = bflo(v.x); f[1] = bfhi(v.x); f[2] = bflo(v.y); f[3] = bfhi(v.y);
  f[4] = bflo(v.z); f[5] = bfhi(v.z); f[6] = bflo(v.w); f[7] = bfhi(v.w);
}
DI u32x4 packf8(const float* f) { u32x4 v = {pack2(f[0], f[1]), pack2(f[2], f[3]), pack2(f[4], f[5]), pack2(f[6], f[7])}; return v; }


#define XB_TMO      128
#define XB_XCNT(j)  (256  + 64 * (j))
#define XB_XSUB(j)  (1280 + 64 * (j))
#define XB_XGEN(j)  (2304 + 64 * (j))
#define XB_TOP      3328
#define XB_TOPGEN   3392
#define XCD_BAR_WORDS 3456
#define XB_SPIN_CAP (1u << 23)
#define LAS __attribute__((address_space(3)))
DI unsigned xb_ld(unsigned* p) { return __hip_atomic_load(p, __ATOMIC_RELAXED, __HIP_MEMORY_SCOPE_AGENT); }
DI unsigned xb_add(unsigned* p, unsigned v) { return __hip_atomic_fetch_add(p, v, __ATOMIC_RELAXED, __HIP_MEMORY_SCOPE_AGENT); }
DI unsigned xb_xcc_id() { return (unsigned)__builtin_amdgcn_s_getreg((3 << 11) | 20) & 0xFu; }
#define XB_SPIN(cond, bar) do { unsigned _sp = 0; while (cond) { __builtin_amdgcn_s_sleep(1); \
    if ((++_sp & 255u) == 0u) { if (xb_ld(&(bar)[XB_TMO])) break; if (_sp > XB_SPIN_CAP) { atomicAdd(&(bar)[XB_TMO], 1u); break; } } } } while (0)
struct XcdBarrier { unsigned* bar; unsigned x; volatile LAS unsigned* st; };
DI XcdBarrier xcd_barrier_post(unsigned* bar, volatile LAS unsigned* st) {
  XcdBarrier b; b.bar = bar; b.x = xb_xcc_id(); b.st = st;
  if (threadIdx.x == 0) (void)xb_add(&bar[XB_XCNT(b.x)], 1u);
  return b;
}
DI void xcd_barrier_complete(unsigned* bar, unsigned x, unsigned& nloc, unsigned& nx) {
  const unsigned G = gridDim.x * gridDim.y * gridDim.z;
  unsigned sum, cnt, mine, sp = 0u;
  for (;;) {
    sum = 0u; cnt = 0u; mine = 0u;
#pragma unroll
    for (unsigned j = 0; j < 16; ++j) { const unsigned c = xb_ld(&bar[XB_XCNT(j)]); sum += c; cnt += (c > 0u) ? 1u : 0u; mine = (j == x) ? c : mine; }
    if (sum == G) break;
    __builtin_amdgcn_s_sleep(1);
    if ((++sp & 255u) == 0u) { if (xb_ld(&bar[XB_TMO])) break; if (sp > XB_SPIN_CAP) { atomicAdd(&bar[XB_TMO], 1u); break; } }
  }
  nloc = mine > 0u ? mine : 1u; nx = cnt > 0u ? cnt : 1u;
}
DI void xcd_barrier(const XcdBarrier& b) {
  asm volatile("s_waitcnt vmcnt(0)" ::: "memory");
  __syncthreads();
  if (threadIdx.x == 0) {
    unsigned* bar = b.bar;
    __builtin_amdgcn_s_waitcnt(0);
    unsigned nloc = b.st[0], nx = b.st[1];
    if (nloc == 0u) { xcd_barrier_complete(bar, b.x, nloc, nx); b.st[0] = nloc; b.st[1] = nx; }
    const unsigned old = xb_add(&bar[XB_XSUB(b.x)], 1u);
    const unsigned gen = old / nloc;
    if (old + 1u == (gen + 1u) * nloc) {
      __builtin_amdgcn_fence(__ATOMIC_RELEASE, "agent");
      asm volatile("s_waitcnt vmcnt(0)" ::: "memory");
      const unsigned og = xb_add(&bar[XB_TOP], 1u);
      const unsigned tg = og / nx;
      if (og + 1u == (tg + 1u) * nx) xb_add(&bar[XB_TOPGEN], 1u);
      else XB_SPIN(xb_ld(&bar[XB_TOPGEN]) == tg, bar);
      __builtin_amdgcn_fence(__ATOMIC_ACQUIRE, "agent");
      xb_add(&bar[XB_XGEN(b.x)], 1u);
      asm volatile("s_waitcnt vmcnt(0)" ::: "memory");
    } else {
      XB_SPIN(xb_ld(&bar[XB_XGEN(b.x)]) == gen, bar);
      __builtin_amdgcn_fence(__ATOMIC_ACQUIRE, "agent");
      asm volatile("s_waitcnt vmcnt(0)" ::: "memory");
    }
  }
  __syncthreads();
}

DI void transpose_tile(const float* __restrict__ W, int N, int Npad, const float* __restrict__ kscale, u16* __restrict__ WT, int tile, char* smem) {
  float(*t)[65] = (float(*)[65])smem;
  const int nt = Npad / 64;
  const int k0 = (tile / nt) * 64, n0 = (tile % nt) * 64;
  const int tid = tidx();
  {
    const int tx = tid & 63, ty = tid >> 6;
#pragma unroll 4
    for (int i = 0; i < 16; ++i) {
      const int k = k0 + ty + 4 * i, n = n0 + tx;
      float v = 0.f;
      if (n < N) { v = W[(size_t)k * N + n]; if (kscale) v *= kscale[k]; }
      t[ty + 4 * i][tx] = v;
    }
  }
  __syncthreads();
  {
    const int kx2 = (tid & 31) * 2, ny0 = tid >> 5;
#pragma unroll 4
    for (int i = 0; i < 8; ++i) {
      const int ny = ny0 + 8 * i;
      *(unsigned*)(WT + (size_t)(n0 + ny) * 1024 + k0 + kx2) = pack2(t[kx2][ny], t[kx2 + 1][ny]);
    }
  }
  __syncthreads();
}

DI void phase0(const Params& p, char* smem) {
  char* ws = p.ws;
  {
    float* ss = (float*)(ws + OFF_SS1);
    for (int i = blockIdx.x * kThreads + tidx(); i < 32768; i += gridDim.x * kThreads) ss[i] = 0.f;
  }
  for (int t = blockIdx.x; t < 1312; t += gridDim.x) {
    if (t < 1056) transpose_tile(p.a_w_in, 4112, 4224, p.a_norm_w, (u16*)(ws + OFF_WTA_IN), t, smem);
    else transpose_tile(p.a_w_out, 1024, 1024, nullptr, (u16*)(ws + OFF_WTA_OUT), t - 1056, smem);
  }
  const int tid0 = tidx();
  const int lane = tid0 & 63;
  const int gw = blockIdx.x * 4 + (tid0 >> 6), nw = gridDim.x * 4;
  u16* xb = (u16*)(ws + OFF_R);
  float* rs0 = (float*)(ws + OFF_RS0);
  for (int row = gw; row < 16384; row += 4 * nw) {
    f32x4 v[4][4];
#pragma unroll
    for (int k = 0; k < 4; ++k) {
      const int rr = row + k * nw;
      const f32x4* xr = (const f32x4*)(p.x + (size_t)(rr < 16384 ? rr : row) * 1024);
#pragma unroll
      for (int i = 0; i < 4; ++i) v[k][i] = __builtin_nontemporal_load(xr + lane + 64 * i);
    }
#pragma unroll
    for (int k = 0; k < 4; ++k) {
      const int rr = row + k * nw;
      float ss = 0.f;
#pragma unroll
      for (int i = 0; i < 4; ++i) ss += v[k][i][0] * v[k][i][0] + v[k][i][1] * v[k][i][1] + v[k][i][2] * v[k][i][2] + v[k][i][3] * v[k][i][3];
#pragma unroll
      for (int o = 32; o >= 1; o >>= 1) ss += __shfl_xor(ss, o);
      if (rr < 16384) {
        u32x2* xo = (u32x2*)(xb + (size_t)rr * 1024);
#pragma unroll
        for (int i = 0; i < 4; ++i) { u32x2 o = {pack2(v[k][i][0], v[k][i][1]), pack2(v[k][i][2], v[k][i][3])}; xo[lane + 64 * i] = o; }
        if (lane == 0) rs0[rr] = rsqrtf(ss * (1.f / 1024.f) + kEps);
      }
    }
  }
}

DI void phase0b(const Params& p, char* smem, int first, int nblk) {
  char* ws = p.ws;
  for (int t = (int)blockIdx.x - first; t < 1312; t += nblk) {
    if (t < 1056) transpose_tile(p.b_w_in, 4104, 4224, p.b_norm_w, (u16*)(ws + OFF_WTB_IN), t, smem);
    else transpose_tile(p.b_w_out, 1024, 1024, nullptr, (u16*)(ws + OFF_WTB_OUT), t - 1056, smem);
  }
}

template <int EPI>
DI void gemm_phase(const Params& p, const u16* __restrict__ A, const u16* __restrict__ Bt, int nTn, char* smem) {
  const int tid = tidx(), lane = tid & 63, wave = tid >> 6;
  const int wr = wave >> 1, wc = wave & 1;
  const int l15 = lane & 15, quad = lane >> 4;
  char* ws = p.ws;
  const int NX = ((gridDim.x & 7) == 0) ? 8 : 1;
  const int xg = blockIdx.x % NX, lb = blockIdx.x / NX, Lb = gridDim.x / NX;
  const int nTnG = nTn >> 3, nSuper = 16 * nTnG;
  const int srow = wave * 8 + (lane >> 3);
  const int sch = (lane & 7) ^ ((((wave & 1) << 2) + (lane >> 4)) & 7);
#define GEMM_TILE(seq_, tm_, tn_, ok_)                                                            \
  do {                                                                                            \
    const int sidx_ = xg + NX * ((seq_) >> 6);                                                    \
    ok_ = sidx_ < nSuper;                                                                         \
    const int tl_ = (seq_) & 63;                                                                  \
    tm_ = (sidx_ / nTnG) * 8 + (tl_ & 7);                                                         \
    tn_ = (sidx_ % nTnG) * 8 + (tl_ >> 3);                                                        \
  } while (0)
#define GEMM_STAGE(buf, kt)                                                                                                   \
  do {                                                                                                                        \
    _Pragma("unroll") for (int i = 0; i < 4; ++i) {                                                                           \
      __builtin_amdgcn_global_load_lds((const unsigned*)(Ag + (size_t)i * 32 * 1024 + (kt) * 64),                             \
                                       (unsigned*)(smem + (buf) * 32768 + (i * 4 + wave) * 1024), 16, 0, 0);                  \
      __builtin_amdgcn_global_load_lds((const unsigned*)(Bg + (size_t)i * 32 * 1024 + (kt) * 64),                             \
                                       (unsigned*)(smem + (buf) * 32768 + 16384 + (i * 4 + wave) * 1024), 16, 0, 0);          \
    }                                                                                                                         \
  } while (0)
  int seq = lb, tm, tn;
  bool ok;
  GEMM_TILE(seq, tm, tn, ok);
  const u16* Ag = A + (size_t)(tm * 128 + srow) * 1024 + sch * 8;
  const u16* Bg = Bt + (size_t)(tn * 128 + srow) * 1024 + sch * 8;
  if (ok) GEMM_STAGE(0, 0);
  while (ok) {
    int tm2, tn2;
    bool ok2;
    GEMM_TILE(seq + Lb, tm2, tn2, ok2);
    f32x4 acc[4][4];
#pragma unroll
    for (int a = 0; a < 4; ++a)
#pragma unroll
      for (int b = 0; b < 4; ++b) acc[a][b] = (f32x4){0.f, 0.f, 0.f, 0.f};
    asm volatile("s_waitcnt vmcnt(0)" ::: "memory");
    __syncthreads();
    for (int kt = 0; kt < 16; ++kt) {
      const int cur = kt & 1;
      if (kt + 1 < 16) GEMM_STAGE(cur ^ 1, kt + 1);
      else if (ok2) {
        Ag = A + (size_t)(tm2 * 128 + srow) * 1024 + sch * 8;
        Bg = Bt + (size_t)(tn2 * 128 + srow) * 1024 + sch * 8;
        GEMM_STAGE(0, 0);
      }
      const char* sa = smem + cur * 32768;
      const char* sb = sa + 16384;
#pragma unroll
      for (int ks = 0; ks < 2; ++ks) {
        bf16x8 fa[4], fb[4];
        const int ch = ks * 4 + quad;
#pragma unroll
        for (int mi = 0; mi < 4; ++mi) {
          const int row = wr * 64 + mi * 16 + l15;
          fa[mi] = *(const bf16x8*)(sa + row * 128 + ((ch ^ ((row >> 1) & 7)) << 4));
        }
#pragma unroll
        for (int ni = 0; ni < 4; ++ni) {
          const int row = wc * 64 + ni * 16 + l15;
          fb[ni] = *(const bf16x8*)(sb + row * 128 + ((ch ^ ((row >> 1) & 7)) << 4));
        }
#pragma unroll
        for (int ni = 0; ni < 4; ++ni)
#pragma unroll
          for (int mi = 0; mi < 4; ++mi) acc[ni][mi] = mfma16(fb[ni], fa[mi], acc[ni][mi]);
      }
      if (kt < 15) {
        asm volatile("s_waitcnt vmcnt(0)" ::: "memory");
        __syncthreads();
      }
    }
    float hnorm[4] = {1.f, 1.f, 1.f, 1.f};
    if constexpr (EPI == 3) {
      if (tn < 16) {
        float* part = (float*)(smem + 65536);
        float ssq[4];
#pragma unroll
        for (int mi = 0; mi < 4; ++mi) {
          const float rs = rsqrtf(((const float*)(ws + OFF_SS1))[tm * 128 + wr * 64 + mi * 16 + l15] * (1.f / 1024.f) + kEps);
          float s = 0.f;
#pragma unroll
          for (int ni = 0; ni < 4; ++ni) { const f32x4 v = acc[ni][mi] * rs; s += v[0] * v[0] + v[1] * v[1] + v[2] * v[2] + v[3] * v[3]; }
          s += __shfl_xor(s, 16);
          s += __shfl_xor(s, 32);
          ssq[mi] = s;
          if (quad == 0) part[(wr * 2 + wc) * 64 + mi * 16 + l15] = s;
        }
        __syncthreads();
#pragma unroll
        for (int mi = 0; mi < 4; ++mi) {
          const float tot = ssq[mi] + part[(wr * 2 + (wc ^ 1)) * 64 + mi * 16 + l15];
          hnorm[mi] = rsqrtf(tot * (1.f / 128.f) + kEps) * (tn < 8 ? kScale * kLog2e : 1.f);
        }
      }
    }
#pragma unroll
    for (int mi = 0; mi < 4; ++mi) {
      const int m = tm * 128 + wr * 64 + mi * 16 + l15;
      if constexpr (EPI == 1) {
        const float rs = ((const float*)(ws + OFF_RS0))[m];
        u16* proj = (u16*)(ws + OFF_PROJ);
        float* braw = (float*)(ws + OFF_BRAW);
#pragma unroll
        for (int ni = 0; ni < 4; ++ni) {
          const int nb = tn * 128 + wc * 64 + ni * 16 + quad * 4;
          f32x4 v = acc[ni][mi] * rs;
          if (nb < 4096) { u32x2 o = {pack2(v[0], v[1]), pack2(v[2], v[3])}; __builtin_nontemporal_store(o, (u32x2*)(proj + (size_t)m * 4096 + nb)); }
          else if (nb < 4112) { *(f32x4*)(braw + (size_t)m * 16 + (nb - 4096)) = v; }
        }
      } else if constexpr (EPI == 2 || EPI == 4) {
        float* ssp = (float*)(ws + (EPI == 2 ? OFF_SS1 : OFF_SS2));
        u16* hb = (u16*)(ws + OFF_R);
        float ssq = 0.f;
#pragma unroll
        for (int ni = 0; ni < 4; ++ni) {
          const int nb = tn * 128 + wc * 64 + ni * 16 + quad * 4;
          f32x4 v;
          if constexpr (EPI == 2) {
            v = acc[ni][mi] + __builtin_nontemporal_load((const f32x4*)(p.x + (size_t)m * 1024 + nb));
            u32x2 o = {pack2(v[0], v[1]), pack2(v[2], v[3])};
            *(u32x2*)(hb + (size_t)m * 1024 + nb) = o;
            v[0] = bflo(o.x); v[1] = bfhi(o.x); v[2] = bflo(o.y); v[3] = bfhi(o.y);
          } else {
            const u32x2 r = *(const u32x2*)(hb + (size_t)m * 1024 + nb);
            v = acc[ni][mi];
            v[0] += bflo(r.x); v[1] += bfhi(r.x); v[2] += bflo(r.y); v[3] += bfhi(r.y);
            const u32x2 o = {pack2(v[0], v[1]), pack2(v[2], v[3])};
            *(u32x2*)(hb + (size_t)m * 1024 + nb) = o;
            v[0] = bflo(o.x); v[1] = bfhi(o.x); v[2] = bflo(o.y); v[3] = bfhi(o.y);
          }
          ssq += v[0] * v[0] + v[1] * v[1] + v[2] * v[2] + v[3] * v[3];
        }
        ssq += __shfl_xor(ssq, 16);
        ssq += __shfl_xor(ssq, 32);
        if (quad == 0) atomicAdd(ssp + m, ssq);
      } else if constexpr (EPI == 3) {
        const float rs = rsqrtf(((const float*)(ws + OFF_SS1))[m] * (1.f / 1024.f) + kEps);
        u16* proj = (u16*)(ws + OFF_PROJ);
        u16* vT = (u16*)(ws + OFF_R + 32 * MiB);
        float* fraw = (float*)(ws + OFF_FRAW);
        float hs = 1.f;
        if (tn < 16) hs = hnorm[mi];
#pragma unroll
        for (int ni = 0; ni < 4; ++ni) {
          const int nb = tn * 128 + wc * 64 + ni * 16 + quad * 4;
          f32x4 v = acc[ni][mi] * rs;
          if (tn < 16) {
            const f32x4 wv = *(const f32x4*)((tn < 8 ? p.b_q_norm_w : p.b_k_norm_w) + (nb & 127));
            v = v * hs * wv;
          }
          if (nb < 4096) {
            if ((nb >> 10) != 2) { u32x2 o = {pack2(v[0], v[1]), pack2(v[2], v[3])}; __builtin_nontemporal_store(o, (u32x2*)(proj + (size_t)m * 4096 + nb)); }
            else {
              const int hd = nb - 2048;
              const int b = m >> 13, t = m & 8191;
              u16* dst = vT + ((size_t)(b * 1024 + hd)) * 8192 + t;
#pragma unroll
              for (int jj = 0; jj < 4; ++jj) dst[(size_t)jj * 8192] = (u16)f2bf(v[jj]);
            }
          } else if (nb < 4104) { *(f32x4*)(fraw + (size_t)m * 16 + (nb - 4096)) = v; }
        }
      }
    }
    seq += Lb; tm = tm2; tn = tn2; ok = ok2;
  }
#undef GEMM_STAGE
#undef GEMM_TILE
}


template <int MODE>
DI void skinny_gemm(const Params& p, const u16* __restrict__ A, const u16* __restrict__ Wt16, float* __restrict__ out) {
  const int tid = tidx(), lane = tid & 63, l15 = lane & 15, quad = lane >> 4;
  const int gw = blockIdx.x * 4 + (tid >> 6), nw = gridDim.x * 4;
  for (int mt = gw; mt < 1024; mt += nw) {
    const int m = mt * 16 + l15;
    const u16* ap = A + (size_t)m * 1024 + quad * 8;
    const u16* bp = Wt16 + (size_t)l15 * 1024 + quad * 8;
    f32x4 acc = {0.f, 0.f, 0.f, 0.f};
#pragma unroll 8
    for (int ks = 0; ks < 32; ++ks) acc = mfma16(*(const bf16x8*)(bp + ks * 32), *(const bf16x8*)(ap + ks * 32), acc);
    float rs;
    if constexpr (MODE == 0) rs = ((const float*)(p.ws + OFF_RS0))[m];
    else rs = rsqrtf(((const float*)(p.ws + OFF_SS1))[m] * (1.f / 1024.f) + kEps);
    *(f32x4*)(out + (size_t)m * 16 + 4 * quad) = acc * rs;
  }
}

DI void delta_prep(const Params& p, char* smem, int first, int nblk) {
  char* ws = p.ws;
  const u16* proj = (const u16*)(ws + OFF_PROJ);
  const float* braw = (const float*)(ws + OFF_BRAW);
  u16* qd_g = (u16*)(ws + OFF_R);
  u16* kT_g = (u16*)(ws + OFF_R + 32 * MiB);
  u16* at_g = (u16*)(ws + OFF_R + 64 * MiB);
  u16* uT_g = (u16*)p.out;
  u16* w_g = (u16*)((char*)p.out + 32 * MiB);
  float* gend_g = (float*)(ws + OFF_GEND);
  char* qL = smem;
  char* kL = smem + 16384;
  char* vL = smem + 32768;
  float* As = (float*)(smem + 49152);
  float* sc = (float*)(smem + 66560);
  float* g_s = sc;
  float* beta_s = sc + 64;
  float* rq_s = sc + 128;
  float* rk_s = sc + 192;
  float* ssq_s = sc + 256;
  float* fu_s = sc + 384;
  float* fw_s = sc + 448;
  const int tid_ = tidx();

  unsigned* flags = (unsigned*)(ws + OFF_FLAGS);
  const __amdgpu_buffer_rsrc_t r_qd = __builtin_amdgcn_make_buffer_rsrc(qd_g, 0, 32 << 20, 0x00020000);
  const __amdgpu_buffer_rsrc_t r_kT = __builtin_amdgcn_make_buffer_rsrc(kT_g, 0, 32 << 20, 0x00020000);
  const __amdgpu_buffer_rsrc_t r_at = __builtin_amdgcn_make_buffer_rsrc(at_g, 0, 16 << 20, 0x00020000);
  const __amdgpu_buffer_rsrc_t r_uT = __builtin_amdgcn_make_buffer_rsrc(uT_g, 0, 32 << 20, 0x00020000);
  const __amdgpu_buffer_rsrc_t r_w = __builtin_amdgcn_make_buffer_rsrc(w_g, 0, 32 << 20, 0x00020000);
  for (int j = (int)blockIdx.x - first; j < 2048; j += nblk) {
    const int c = j >> 4, b = (j >> 3) & 1, h = j & 7;
    const int item = (b * 128 + c) * 8 + h;
    const int tok0 = b * 8192 + c * 64;
    const int tid = relaunder(tid_), lane = tid & 63, wave = tid >> 6, l15 = lane & 15, quad = lane >> 4;
    if (wave == 3) {
      const int row = tok0 + lane;
      const float br = braw[(size_t)row * 16 + h];
      const float ar = braw[(size_t)row * 16 + 8 + h] + p.a_dt_bias[h];
      const float beta = 1.f / (1.f + __expf(-br));
      const float sp = fmaxf(ar, 0.f) + log1pf(__expf(-fabsf(ar)));
      float g = -__expf(p.a_A_log[h]) * sp;
#pragma unroll
      for (int o = 1; o < 64; o <<= 1) { float t = __shfl_up(g, o); if (lane >= o) g += t; }
      g_s[lane] = g;
      beta_s[lane] = beta;
    } else {
      const int sec = wave, cgi = l15, rr = quad;
      const int col = sec * 1024 + h * 128 + cgi * 8;
      float w0[8], w1[8], w2[8], w3[8];
#pragma unroll
      for (int e = 0; e < 8; ++e) {
        w0[e] = p.a_conv_w[0 * 3072 + col + e]; w1[e] = p.a_conv_w[1 * 3072 + col + e];
        w2[e] = p.a_conv_w[2 * 3072 + col + e]; w3[e] = p.a_conv_w[3 * 3072 + col + e];
      }
      const u16* src = proj + (size_t)(tok0 + rr * 16) * 4096 + col;
      float x0[8], x1[8], x2[8], x3[8];
      if (c == 0 && rr == 0) {
#pragma unroll
        for (int e = 0; e < 8; ++e) { x0[e] = 0.f; x1[e] = 0.f; x2[e] = 0.f; }
      } else {
        unpack8(*(const u32x4*)(src - 3 * 4096), x0);
        unpack8(*(const u32x4*)(src - 2 * 4096), x1);
        unpack8(*(const u32x4*)(src - 1 * 4096), x2);
      }
      char* dstL = smem + sec * 16384;
#pragma unroll 4
      for (int r = 0; r < 16; ++r) {
        unpack8(*(const u32x4*)(src + (size_t)r * 4096), x3);
        float y[8];
        float ssq = 0.f;
#pragma unroll
        for (int e = 0; e < 8; ++e) {
          float v = w0[e] * x0[e] + w1[e] * x1[e] + w2[e] * x2[e] + w3[e] * x3[e];
          v = silu(v);
          y[e] = v;
          ssq += v * v;
          x0[e] = x1[e]; x1[e] = x2[e]; x2[e] = x3[e];
        }
        ssq += __shfl_xor(ssq, 1); ssq += __shfl_xor(ssq, 2); ssq += __shfl_xor(ssq, 4); ssq += __shfl_xor(ssq, 8);
        const int row = rr * 16 + r;
        if (sec < 2 && cgi == 0) ssq_s[sec * 64 + row] = ssq;
        *(u32x4*)(dstL + row * 256 + ((cgi ^ (row & 15)) << 4)) = packf8(y);
      }
    }
    __syncthreads();
    if (tid < 64) {
      const float rq = rsqrtf(ssq_s[tid] + kEps), rk = rsqrtf(ssq_s[64 + tid] + kEps);
      const float gi = g_s[tid], g63 = g_s[63];
      const float eg = __expf(gi);
      rq_s[tid] = rq; rk_s[tid] = rk;
      const float be = beta_s[tid];
      fu_s[tid] = be;
      fw_s[tid] = be * rk * eg;
      ssq_s[tid] = rq * kScale * eg;
      ssq_s[64 + tid] = rk * __expf(g63 - gi);
      if (tid == 0) __hip_atomic_store(gend_g + item, __expf(g63), __ATOMIC_RELAXED, __HIP_MEMORY_SCOPE_AGENT);
    }
    __syncthreads();
    {
      const int tid = relaunder(tid_), lane = tid & 63, wave = tid >> 6, l15 = lane & 15, quad = lane >> 4;
      bf16x8 bk[4], bq[4];
      const int rowI = 16 * wave + l15;
#pragma unroll
      for (int ks = 0; ks < 4; ++ks) {
        const int off = rowI * 256 + (((ks * 4 + quad) ^ (rowI & 15)) << 4);
        bk[ks] = *(const bf16x8*)(kL + off);
        bq[ks] = *(const bf16x8*)(qL + off);
      }
      const int i = rowI;
      const float gi = g_s[i], bi = beta_s[i] * rk_s[i], qi = kScale * rq_s[i];
      u32x2 keep = {0u, 0u};
#pragma unroll
      for (int J = 0; J < 4; ++J) {
        f32x4 skk = {0.f, 0.f, 0.f, 0.f}, sqk = {0.f, 0.f, 0.f, 0.f};
        const int rowJ = 16 * J + l15;
#pragma unroll
        for (int ks = 0; ks < 4; ++ks) {
          const bf16x8 ak = *(const bf16x8*)(kL + rowJ * 256 + (((ks * 4 + quad) ^ (rowJ & 15)) << 4));
          skk = mfma16(ak, bk[ks], skk);
          sqk = mfma16(ak, bq[ks], sqk);
        }
        const f32x4 gj4 = *(const f32x4*)(g_s + 16 * J + 4 * quad);
        const f32x4 rk4 = *(const f32x4*)(rk_s + 16 * J + 4 * quad);
        f32x4 a4, t4;
#pragma unroll
        for (int jj = 0; jj < 4; ++jj) {
          const int j = 16 * J + 4 * quad + jj;
          const float dec = (i >= j) ? __expf(gi - gj4[jj]) : 0.f;
          a4[jj] = (i > j) ? bi * rk4[jj] * skk[jj] * dec : 0.f;
          t4[jj] = qi * rk4[jj] * sqk[jj] * dec;
        }
        *(f32x4*)(As + i * 68 + 16 * J + 4 * quad) = a4;
        const u32x2 half = {pack2(t4[0], t4[1]), pack2(t4[2], t4[3])};
        if ((J & 1) == 0) keep = half;
        else {
          const u32x4 fr = {keep.x, keep.y, half.x, half.y};
          __builtin_amdgcn_raw_buffer_store_b128(fr, r_at, item * 8192 + ((wave * 2 + (J >> 1)) * 64 + lane) * 16, 0, 16);
        }
      }
    }
    {
      const int tid = relaunder(tid_);
#pragma unroll
      for (int it = 0; it < 4; ++it) {
        const int idx = tid + 256 * it;
        const int f = idx >> 6, ln = idx & 63, fl = ln & 15, fq = ln >> 4;
        {
          const int mt = f >> 2, ks = f & 3, i = 16 * mt + fl;
          const int c0 = 4 * ks + (fq >> 1), o8 = (fq & 1) * 8;
          const u32x2 lo = *(const u32x2*)(qL + i * 256 + ((c0 ^ (i & 15)) << 4) + o8);
          const u32x2 hi = *(const u32x2*)(qL + i * 256 + (((c0 + 2) ^ (i & 15)) << 4) + o8);
          const float s = ssq_s[i];
          const u32x4 o = {pack2(bflo(lo.x) * s, bfhi(lo.x) * s), pack2(bflo(lo.y) * s, bfhi(lo.y) * s),
                           pack2(bflo(hi.x) * s, bfhi(hi.x) * s), pack2(bflo(hi.y) * s, bfhi(hi.y) * s)};
          __builtin_amdgcn_raw_buffer_store_b128(o, r_qd, item * 16384 + idx * 16, 0, 16);
        }
        {
          const int mt = f >> 1, ks = f & 1, dk = 16 * mt + fl;
          float v[8];
#pragma unroll
          for (int e = 0; e < 8; ++e) {
            const int i = 32 * ks + ((e < 4) ? (4 * fq + e) : (16 + 4 * fq + e - 4));
            const u16 raw = *(const u16*)(kL + i * 256 + (((dk >> 3) ^ (i & 15)) << 4) + (dk & 7) * 2);
            v[e] = __uint_as_float(((unsigned)raw) << 16) * ssq_s[64 + i];
          }
          __builtin_amdgcn_raw_buffer_store_b128(packf8(v), r_kT, item * 16384 + idx * 16, 0, 16);
        }
      }
    }
    __syncthreads();
    {
      float U[64];
      const int tid = relaunder(tid_), wave = tid >> 6;
      const int cc = tid & 127, ch = cc >> 3, e2 = (cc & 7) * 2;
      const char* srcL = (wave < 2) ? vL : kL;
      const float* fr = (wave < 2) ? fu_s : fw_s;
#pragma unroll
      for (int i = 0; i < 64; ++i) {
        int ii = i;
        asm volatile("" : "+v"(ii));
        const u16 raw = *(const u16*)(srcL + ii * 256 + ((ch ^ (ii & 15)) << 4) + e2);
        float acc = __uint_as_float(((unsigned)raw) << 16) * fr[ii];
#pragma unroll
        for (int j = 0; j < i; ++j) acc -= As[i * 68 + j] * U[j];
        U[i] = acc;
      }
      if (wave < 2) {
        const int dofs = item * 16384 + (((cc >> 4) * 4) * 256 + (cc & 15) * 4) * 2;
#pragma unroll
        for (int mi = 0; mi < 4; ++mi)
#pragma unroll
          for (int q4 = 0; q4 < 4; ++q4) {
            const u32x2 o = {pack2(U[16 * mi + 4 * q4], U[16 * mi + 4 * q4 + 1]), pack2(U[16 * mi + 4 * q4 + 2], U[16 * mi + 4 * q4 + 3])};
            __builtin_amdgcn_raw_buffer_store_b64(o, r_uT, dofs + (mi * 256 + q4 * 64) * 2, 0, 16);
          }
      } else {
#pragma unroll
        for (int i = 0; i < 64; ++i) {
          int ii = i;
          asm volatile("" : "+v"(ii));
          *(u16*)(qL + ii * 256 + ((ch ^ (ii & 15)) << 4) + e2) = (u16)f2bf(U[i]);
        }
      }
    }
    __syncthreads();
    {
      const int tid = relaunder(tid_);
#pragma unroll
      for (int it = 0; it < 4; ++it) {
        const int idx = tid + 256 * it;
        const int f = idx >> 6, ln = idx & 63, fl = ln & 15, fq = ln >> 4;
        const int mt = f >> 2, ks = f & 3, i = 16 * mt + fl;
        const int c0 = 4 * ks + (fq >> 1), o8 = (fq & 1) * 8;
        const u32x2 lo = *(const u32x2*)(qL + i * 256 + ((c0 ^ (i & 15)) << 4) + o8);
        const u32x2 hi = *(const u32x2*)(qL + i * 256 + (((c0 + 2) ^ (i & 15)) << 4) + o8);
        const u32x4 o = {lo.x, lo.y, hi.x, hi.y};
        __builtin_amdgcn_raw_buffer_store_b128(o, r_w, item * 16384 + idx * 16, 0, 16);
      }
    }
    asm volatile("s_waitcnt vmcnt(0)" ::: "memory");
    __syncthreads();
    if (relaunder(tid_) == 0) __hip_atomic_store(flags + item, 1u, __ATOMIC_RELAXED, __HIP_MEMORY_SCOPE_AGENT);
  }
}

#define RAW_BARRIER() do { asm volatile("s_waitcnt lgkmcnt(0)" ::: "memory"); __builtin_amdgcn_s_barrier(); asm volatile("" ::: "memory"); } while (0)
#define GAS __attribute__((address_space(1)))
#define SCAN_LOAD(item_)                                                                                          \
  do {                                                                                                            \
    const GAS char* wb_ = (const GAS char*)((const char*)w_g + (size_t)(item_) * 16384);                          \
    const GAS char* qb_ = (const GAS char*)((const char*)qd_g + (size_t)(item_) * 16384);                         \
    const GAS char* kb_ = (const GAS char*)((const char*)kT_g + (size_t)(item_) * 16384);                         \
    const GAS char* ab_ = (const GAS char*)((const char*)at_g + (size_t)(item_) * 8192);                          \
    const GAS char* ub_ = (const GAS char*)((const char*)uT_g + (size_t)(item_) * 16384);                         \
    asm volatile("" : "+s"(wb_), "+s"(qb_), "+s"(kb_), "+s"(ab_), "+s"(ub_));                                     \
    _Pragma("unroll") for (int j = 0; j < 4; ++j) {                                                               \
      R[j] = *(const GAS u32x4*)(wb_ + (toff + 4096u * j));                                                       \
      R[4 + j] = *(const GAS u32x4*)(qb_ + (toff + 4096u * j));                                                   \
      R[8 + j] = *(const GAS u32x4*)(kb_ + (toff + 4096u * j));                                                   \
    }                                                                                                             \
    _Pragma("unroll") for (int j = 0; j < 2; ++j) R[12 + j] = *(const GAS u32x4*)(ab_ + (toff + 4096u * j));     \
    _Pragma("unroll") for (int mi = 0; mi < 4; ++mi) un[mi] = *(const GAS u32x2*)(ub_ + (uoff + 512u * mi));     \
    gn = gend_g[item_];                                                                                           \
  } while (0)
DI void delta_scan(const Params& p, char* smem) {
  char* ws = p.ws;
  const u16* qd_g = (const u16*)(ws + OFF_R);
  const u16* kT_g = (const u16*)(ws + OFF_R + 32 * MiB);
  const u16* at_g = (const u16*)(ws + OFF_R + 64 * MiB);
  const u16* uT_g = (const u16*)p.out;
  const u16* w_g = (const u16*)((const char*)p.out + 32 * MiB);
  const float* gend_g = (const float*)(ws + OFF_GEND);
  u16* o_g = (u16*)(ws + OFF_PROJ);
  unsigned* flags = (unsigned*)(ws + OFF_FLAGS);
  const int tid = tidx(), lane = tid & 63, wave = tid >> 6, l15 = lane & 15, quad = lane >> 4;
  char* Lw = smem;
  char* Lq = smem + 16384;
  char* Lk = smem + 32768;
  char* La = smem + 49152;
  char* Lo = smem + 57344;
  for (int unit = blockIdx.x; unit < 32; unit += gridDim.x) {
    const int bh = unit & 15, half = unit >> 4, b = bh >> 3, h = bh & 7;
    const int slice = half * 4 + wave;
    f32x4 S[8];
#pragma unroll
    for (int i = 0; i < 8; ++i) S[i] = (f32x4){0.f, 0.f, 0.f, 0.f};
    const unsigned toff = (unsigned)tid * 16u, uoff = (unsigned)(slice * 256 + lane) * 8u;
    u32x4 R[14];
    u32x2 un[4];
    float gn;
#define SCAN_WAIT(flv_, item_)                                                                                         \
  do {                                                                                                                 \
    unsigned f_ = (flv_), sp_ = 0u;                                                                                    \
    while (f_ == 0u && sp_ < (1u << 24)) { __builtin_amdgcn_s_sleep(2); f_ = __hip_atomic_load(flags + (item_), __ATOMIC_RELAXED, __HIP_MEMORY_SCOPE_AGENT); ++sp_; } \
    __builtin_amdgcn_fence(__ATOMIC_ACQUIRE, "workgroup");           \
  } while (0)
    unsigned fl;
    {
      const int item = (b * 128) * 8 + h;
      SCAN_WAIT(0u, item);
      SCAN_LOAD(item);
      fl = __hip_atomic_load(flags + ((b * 128 + 1) * 8 + h), __ATOMIC_RELAXED, __HIP_MEMORY_SCOPE_AGENT);
    }
    for (int c = 0; c < 128; ++c) {
#pragma unroll
      for (int j = 0; j < 4; ++j) {
        *(u32x4*)(Lw + (tid + 256 * j) * 16) = R[j];
        *(u32x4*)(Lq + (tid + 256 * j) * 16) = R[4 + j];
        *(u32x4*)(Lk + (tid + 256 * j) * 16) = R[8 + j];
      }
#pragma unroll
      for (int j = 0; j < 2; ++j) *(u32x4*)(La + (tid + 256 * j) * 16) = R[12 + j];
      u32x2 uc[4];
#pragma unroll
      for (int mi = 0; mi < 4; ++mi) uc[mi] = un[mi];
      const float gend = gn;
      RAW_BARRIER();
      if (c + 1 < 128) SCAN_WAIT(fl, (b * 128 + c + 1) * 8 + h);
      if (c > 0) {
        const int tokp = b * 8192 + (c - 1) * 64;
#pragma unroll
        for (int k2 = 0; k2 < 2; ++k2) {
          const int idx = tid + 256 * k2, row = idx >> 3, part = idx & 7;
          *(u32x4*)(o_g + (size_t)(tokp + row) * 4096 + h * 128 + half * 64 + part * 8) = *(const u32x4*)(Lo + idx * 16);
        }
      }
      if (c + 1 < 128) {
        const int item = (b * 128 + c + 1) * 8 + h;
        SCAN_LOAD(item);
        fl = (c + 2 < 128) ? __hip_atomic_load(flags + (item + 8), __ATOMIC_RELAXED, __HIP_MEMORY_SCOPE_AGENT) : 1u;
      }
      __builtin_amdgcn_sched_barrier(0);
      bf16x8 bS[4];
#pragma unroll
      for (int ks = 0; ks < 4; ++ks) bS[ks] = pack8(S[2 * ks], S[2 * ks + 1]);
      bf16x8 fr[16];
#pragma unroll
      for (int i = 0; i < 16; ++i) fr[i] = *(const bf16x8*)(Lw + (i * 64 + lane) * 16);
      __builtin_amdgcn_sched_barrier(0);
      f32x4 vn[4];
#pragma unroll
      for (int mi = 0; mi < 4; ++mi) vn[mi] = (f32x4){0.f, 0.f, 0.f, 0.f};
#pragma unroll
      for (int ks = 0; ks < 4; ++ks)
#pragma unroll
        for (int mi = 0; mi < 4; ++mi) vn[mi] = mfma16(fr[mi * 4 + ks], bS[ks], vn[mi]);
      __builtin_amdgcn_sched_barrier(0);
#pragma unroll
      for (int i = 0; i < 16; ++i) fr[i] = *(const bf16x8*)(Lk + (i * 64 + lane) * 16);
#pragma unroll
      for (int mi = 0; mi < 4; ++mi) {
        vn[mi][0] = bflo(uc[mi].x) - vn[mi][0]; vn[mi][1] = bfhi(uc[mi].x) - vn[mi][1];
        vn[mi][2] = bflo(uc[mi].y) - vn[mi][2]; vn[mi][3] = bfhi(uc[mi].y) - vn[mi][3];
      }
      bf16x8 bV[2];
      bV[0] = pack8(vn[0], vn[1]);
      bV[1] = pack8(vn[2], vn[3]);
#pragma unroll
      for (int mt = 0; mt < 8; ++mt) S[mt] = S[mt] * gend;
      __builtin_amdgcn_sched_barrier(0);
#pragma unroll
      for (int ks = 0; ks < 2; ++ks)
#pragma unroll
        for (int mt = 0; mt < 8; ++mt) S[mt] = mfma16(fr[mt * 2 + ks], bV[ks], S[mt]);
      __builtin_amdgcn_sched_barrier(0);
#pragma unroll
      for (int i = 0; i < 16; ++i) fr[i] = *(const bf16x8*)(Lq + (i * 64 + lane) * 16);
      __builtin_amdgcn_sched_barrier(0);
      f32x4 oacc[4];
#pragma unroll
      for (int mi = 0; mi < 4; ++mi) oacc[mi] = (f32x4){0.f, 0.f, 0.f, 0.f};
#pragma unroll
      for (int ks = 0; ks < 4; ++ks)
#pragma unroll
        for (int mi = 0; mi < 4; ++mi) oacc[mi] = mfma16(fr[mi * 4 + ks], bS[ks], oacc[mi]);
      __builtin_amdgcn_sched_barrier(0);
#pragma unroll
      for (int i = 0; i < 8; ++i) fr[i] = *(const bf16x8*)(La + (i * 64 + lane) * 16);
      __builtin_amdgcn_sched_barrier(0);
#pragma unroll
      for (int ks = 0; ks < 2; ++ks)
#pragma unroll
        for (int mi = 0; mi < 4; ++mi) oacc[mi] = mfma16(fr[mi * 2 + ks], bV[ks], oacc[mi]);
      __builtin_amdgcn_sched_barrier(0);
#pragma unroll
      for (int mi = 0; mi < 4; ++mi)
#pragma unroll
        for (int jj = 0; jj < 4; ++jj)
          *(u16*)(Lo + (16 * mi + 4 * quad + jj) * 128 + (wave * 16 + l15) * 2) = (u16)f2bf(oacc[mi][jj]);
      RAW_BARRIER();
    }
    {
      const int tokp = b * 8192 + 127 * 64;
#pragma unroll
      for (int k2 = 0; k2 < 2; ++k2) {
        const int idx = tid + 256 * k2, row = idx >> 3, part = idx & 7;
        *(u32x4*)(o_g + (size_t)(tokp + row) * 4096 + h * 128 + half * 64 + part * 8) = *(const u32x4*)(Lo + idx * 16);
      }
      RAW_BARRIER();
    }
  }
}

#undef SCAN_LOAD
#undef SCAN_WAIT

DI void gate_phase(const Params& p) {
  char* ws = p.ws;
  const u16* proj = (const u16*)(ws + OFF_PROJ);
  u16* y0 = (u16*)(ws + OFF_R + 32 * MiB);
  const int tidg = tidx();
  const int lane = tidg & 63, l15 = lane & 15, quad = lane >> 4;
  const int gw = blockIdx.x * 4 + (tidg >> 6), nw = gridDim.x * 4;
  float wn[8];
#pragma unroll
  for (int e = 0; e < 8; ++e) wn[e] = p.a_o_norm_w[l15 * 8 + e];
  for (int r4 = gw; r4 < 32768; r4 += nw) {
    const int rh = r4 * 4 + quad, tok = rh >> 3, h = rh & 7;
    float o[8], z[8];
    unpack8(*(const u32x4*)(proj + (size_t)tok * 4096 + h * 128 + l15 * 8), o);
    unpack8(*(const u32x4*)(proj + (size_t)tok * 4096 + 3072 + h * 128 + l15 * 8), z);
    float ssq = 0.f;
#pragma unroll
    for (int e = 0; e < 8; ++e) ssq += o[e] * o[e];
    ssq += __shfl_xor(ssq, 1); ssq += __shfl_xor(ssq, 2); ssq += __shfl_xor(ssq, 4); ssq += __shfl_xor(ssq, 8);
    const float rs = rsqrtf(ssq * (1.f / 128.f) + kEps);
#pragma unroll
    for (int e = 0; e < 8; ++e) o[e] = o[e] * rs * wn[e] * silu(z[e]);
    *(u32x4*)(y0 + (size_t)tok * 1024 + h * 128 + l15 * 8) = packf8(o);
  }
}

DI void qknorm_cumsum(const Params& p, char* smem) {
  char* ws = p.ws;
  u16* proj = (u16*)(ws + OFF_PROJ);
  const int tid = tidx(), lane = tid & 63, l15 = lane & 15, quad = lane >> 4;
  const int gw = blockIdx.x * 4 + (tid >> 6), nw = gridDim.x * 4;
  for (int idx = gw; idx < 65536; idx += nw) {
    const int which = idx >> 15, r4 = idx & 32767;
    const int rh = r4 * 4 + quad, tok = rh >> 3, h = rh & 7;
    const float* wv = which ? p.b_k_norm_w : p.b_q_norm_w;
    u16* ptr = proj + (size_t)tok * 4096 + which * 1024 + h * 128 + l15 * 8;
    float v[8];
    unpack8(*(const u32x4*)ptr, v);
    float ssq = 0.f;
#pragma unroll
    for (int e = 0; e < 8; ++e) ssq += v[e] * v[e];
    ssq += __shfl_xor(ssq, 1); ssq += __shfl_xor(ssq, 2); ssq += __shfl_xor(ssq, 4); ssq += __shfl_xor(ssq, 8);
    const float rs = rsqrtf(ssq * (1.f / 128.f) + kEps) * (which ? 1.f : kScale);
#pragma unroll
    for (int e = 0; e < 8; ++e) v[e] = v[e] * rs * wv[l15 * 8 + e];
    *(u32x4*)ptr = packf8(v);
  }
}

DI void attn_phase(const Params& p, char* smem) {
  char* ws = p.ws;
  const u16* proj = (const u16*)(ws + OFF_PROJ);
  const u16* vT = (const u16*)(ws + OFF_R + 32 * MiB);
  const float* fraw = (const float*)(ws + OFF_FRAW);
  u16* y1 = (u16*)(ws + OFF_R + 64 * MiB);
  float* bias_s = (float*)(smem + 65536);
  float* ca_s = bias_s + 128;
  const int tid_ = tidx();
  float mq = 0.f, mk = 0.f;
  for (int i = 0; i < 128; ++i) { mq = fmaxf(mq, fabsf(p.b_q_norm_w[i])); mk = fmaxf(mk, fabsf(p.b_k_norm_w[i])); }
  const float QKB = 128.f * kScale * mq * mk;
  float* mmin_s = (float*)(smem + 66320);

  unsigned* qctr = (unsigned*)(ws + OFF_BAR) + XCD_BAR_WORDS;
  int* qslot = (int*)(smem + 66304);
  int qx = blockIdx.x & 7, qtries = 0;
  while (true) {
    const int tid = relaunder(tid_), lane = tid & 63, wave = tid >> 6, l15 = lane & 15, quad = lane >> 4;
    if (tid == 0) *qslot = (int)atomicAdd(qctr + qx * 16, 1u);
    __syncthreads();
    const int it = *qslot;
    __syncthreads();
    if (it >= 128) { if (++qtries >= 8) break; qx = (qx + 1) & 7; continue; }
    const int qb = 63 - (it & 63);
    const int b = it >> 6, h = b ? ((qx + 4) & 7) : qx, bh = b * 8 + h, i0 = qb * 128;
    const int qrow0 = i0 + 32 * wave;
    const float fb = p.b_f_bias[h];
    bf16x8 bq[2][4];
#pragma unroll
    for (int nq = 0; nq < 2; ++nq)
#pragma unroll
      for (int ks = 0; ks < 4; ++ks)
        bq[nq][ks] = *(const bf16x8*)(proj + (size_t)(b * 8192 + qrow0 + 16 * nq + l15) * 4096 + h * 128 + 32 * ks + 8 * quad);
    f32x4 O[8][2];
#pragma unroll
    for (int dt = 0; dt < 8; ++dt) { O[dt][0] = (f32x4){0.f, 0.f, 0.f, 0.f}; O[dt][1] = (f32x4){0.f, 0.f, 0.f, 0.f}; }
    float mrun[2] = {-1e30f, -1e30f}, lrun[2] = {0.f, 0.f};

    const int kkey = wave * 4 + (lane >> 4);
    const int kch = (lane & 15) ^ (kkey & 15);
    const u16* Kg = proj + (size_t)(b * 8192 + kkey) * 4096 + 1024 + h * 128 + kch * 8;
    const int vd = wave * 8 + (lane >> 3);
    const int vch = (lane & 7) ^ ((((wave & 1) << 2) + (lane >> 4)) & 7);
    const u16* Vg = vT + (size_t)(bh * 128 + vd) * 8192 + vch * 8;
#define ATT_STAGE(buf, j0_)                                                                                                   \
  do {                                                                                                                        \
    _Pragma("unroll") for (int i = 0; i < 4; ++i) {                                                                           \
      __builtin_amdgcn_global_load_lds((const unsigned*)(Kg + (size_t)((j0_) + 16 * i) * 4096),                               \
                                       (unsigned*)(smem + (buf) * 32768 + (i * 4 + wave) * 1024), 16, 0, 0);                  \
      __builtin_amdgcn_global_load_lds((const unsigned*)(Vg + (size_t)(32 * i) * 8192 + (j0_)),                               \
                                       (unsigned*)(smem + (buf) * 32768 + 16384 + (i * 4 + wave) * 1024), 16, 0, 0);          \
    }                                                                                                                         \
  } while (0)
    int j0 = i0 + 64;
    ATT_STAGE(0, j0);
    float carry = 0.f, biasA = 0.f, frn = 0.f;
    if (wave == 0) {
      const float xa = fraw[(size_t)(b * 8192 + i0 + lane) * 16 + h] + fb;
      const float xb2 = fraw[(size_t)(b * 8192 + i0 + 64 + lane) * 16 + h] + fb;
      const float lfA = fminf(xa, 0.f) - log1pf(__expf(-fabsf(xa)));
      const float lfB = fminf(xb2, 0.f) - log1pf(__expf(-fabsf(xb2)));
      float pa = lfA, pb = lfB;
#pragma unroll
      for (int o = 1; o < 64; o <<= 1) {
        const float ta = __shfl_up(pa, o), tb = __shfl_up(pb, o);
        if (lane >= o) { pa += ta; pb += tb; }
      }
      const float lf0 = __shfl(lfA, 0), totA = __shfl(pa, 63);
      biasA = -(pa - lf0) * kLog2e;
      bias_s[lane] = -(totA - lf0 + pb) * kLog2e;
      carry = lf0;
    }
    if (lane == 0) { mmin_s[wave] = -1e30f; mmin_s[4 + wave] = -1e30f; }
    asm volatile("s_waitcnt vmcnt(0)" ::: "memory");
    __syncthreads();
    int cur = 0;
    while (true) {
      const int nj = j0 - 64;
      bool more = nj >= 0;
      if (more && j0 <= i0) {
        const float* mm = mmin_s + cur * 4;
        const float mmin = fminf(fminf(mm[0], mm[1]), fminf(mm[2], mm[3]));
        more = !((QKB + ca_s[cur]) * kLog2e < mmin - 30.f * kLog2e);
      }
      if (more) {
        ATT_STAGE(cur ^ 1, nj);
        if (wave == 0 && nj < i0) frn = fraw[(size_t)(b * 8192 + nj + lane) * 16 + h];
      }
      if (j0 <= qrow0 + 31) {
        const char* Ks = smem + cur * 32768;
        const char* Vs = Ks + 16384;
        const float* cs = bias_s + cur * 64;
        f32x4 s[4][2];
#pragma unroll
        for (int kt = 0; kt < 4; ++kt) { s[kt][0] = (f32x4){0.f, 0.f, 0.f, 0.f}; s[kt][1] = (f32x4){0.f, 0.f, 0.f, 0.f}; }
#pragma unroll
        for (int ks = 0; ks < 4; ++ks)
#pragma unroll
          for (int kt = 0; kt < 4; ++kt) {
            const int kl = 16 * kt + l15;
            const bf16x8 ak = *(const bf16x8*)(Ks + kl * 256 + (((ks * 4 + quad) ^ (kl & 15)) << 4));
            s[kt][0] = mfma16(ak, bq[0][ks], s[kt][0]);
            s[kt][1] = mfma16(ak, bq[1][ks], s[kt][1]);
          }
        const bool diag = (j0 >= i0);
#pragma unroll
        for (int kt = 0; kt < 4; ++kt) {
          const f32x4 bias = *(const f32x4*)(cs + 16 * kt + 4 * quad);
#pragma unroll
          for (int nq = 0; nq < 2; ++nq)
#pragma unroll
            for (int jj = 0; jj < 4; ++jj) {
              float v = s[kt][nq][jj] + bias[jj];
              if (diag) { if (j0 + 16 * kt + 4 * quad + jj > qrow0 + 16 * nq + l15) v = -1e30f; }
              s[kt][nq][jj] = v;
            }
        }
        bf16x8 bP[2][2];
#pragma unroll
        for (int nq = 0; nq < 2; ++nq) {
          float tmax = -1e30f;
#pragma unroll
          for (int kt = 0; kt < 4; ++kt)
#pragma unroll
            for (int jj = 0; jj < 4; ++jj) tmax = fmaxf(tmax, s[kt][nq][jj]);
          tmax = fmaxf(tmax, __shfl_xor(tmax, 16));
          tmax = fmaxf(tmax, __shfl_xor(tmax, 32));
          const float mnew = fmaxf(mrun[nq], tmax);
          const float alpha = __builtin_amdgcn_exp2f(mrun[nq] - mnew);
          const bool grew = mnew > mrun[nq];
          mrun[nq] = mnew;
          float psum = 0.f;
#pragma unroll
          for (int kt = 0; kt < 4; ++kt)
#pragma unroll
            for (int jj = 0; jj < 4; ++jj) { const float pv = __builtin_amdgcn_exp2f(s[kt][nq][jj] - mnew); s[kt][nq][jj] = pv; psum += pv; }
          lrun[nq] = lrun[nq] * alpha + psum;
          if (__builtin_amdgcn_ballot_w64(grew) != 0ull) {
#pragma unroll
            for (int dt = 0; dt < 8; ++dt) O[dt][nq] = O[dt][nq] * alpha;
          }
          bP[0][nq] = pack8(s[0][nq], s[1][nq]);
          bP[1][nq] = pack8(s[2][nq], s[3][nq]);
        }
#pragma unroll
        for (int ks = 0; ks < 2; ++ks)
#pragma unroll
          for (int dt = 0; dt < 8; ++dt) {
            const int d = 16 * dt + l15, sw = (d >> 1) & 7, c0 = 4 * ks + (quad >> 1);
            const u32x2 lo = *(const u32x2*)(Vs + d * 128 + ((c0 ^ sw) << 4) + (quad & 1) * 8);
            const u32x2 hi = *(const u32x2*)(Vs + d * 128 + (((c0 + 2) ^ sw) << 4) + (quad & 1) * 8);
            const bf16x8 av = mk8(lo, hi);
            O[dt][0] = mfma16(av, bP[ks][0], O[dt][0]);
            O[dt][1] = mfma16(av, bP[ks][1], O[dt][1]);
          }
        float wm = fminf(mrun[0], mrun[1]);
#pragma unroll
        for (int o = 1; o < 64; o <<= 1) wm = fminf(wm, __shfl_xor(wm, o));
        if (lane == 0) mmin_s[(cur ^ 1) * 4 + wave] = wm;
      }
      if (more && wave == 0) {
        const int nb = cur ^ 1;
        if (nj == i0) {
          bias_s[nb * 64 + lane] = biasA;
          if (lane == 0) ca_s[nb] = carry;
        } else {
          const float xv = frn + fb;
          const float lf = fminf(xv, 0.f) - log1pf(__expf(-fabsf(xv)));
          float sf = lf;
#pragma unroll
          for (int o = 1; o < 64; o <<= 1) { const float t = __shfl_down(sf, o); if (lane + o < 64) sf += t; }
          bias_s[nb * 64 + lane] = (sf - lf + carry) * kLog2e;
          carry += __shfl(sf, 0);
          if (lane == 0) ca_s[nb] = carry;
        }
      }
      asm volatile("s_waitcnt vmcnt(0)" ::: "memory");
      __syncthreads();
      if (!more) break;
      j0 = nj;
      cur ^= 1;
    }
#undef ATT_STAGE
#pragma unroll
    for (int nq = 0; nq < 2; ++nq) {
      float l = lrun[nq];
      l += __shfl_xor(l, 16);
      l += __shfl_xor(l, 32);
      const float inv = 1.f / l;
      const size_t tok = (size_t)(b * 8192 + qrow0 + 16 * nq + l15);
#pragma unroll
      for (int dt = 0; dt < 8; ++dt) {
        const int d = 16 * dt + 4 * quad;
        const u32x2 z2 = *(const u32x2*)(proj + tok * 4096 + 3072 + h * 128 + d);
        const f32x4 o = O[dt][nq] * inv;
        u32x2 r = {pack2(o[0] * silu(bflo(z2.x)), o[1] * silu(bfhi(z2.x))), pack2(o[2] * silu(bflo(z2.y)), o[3] * silu(bfhi(z2.y)))};
        *(u32x2*)(y1 + tok * 1024 + h * 128 + d) = r;
      }
    }
  }
}

DI void final_norm(const Params& p) {
  const float* ss2 = (const float*)(p.ws + OFF_SS2);
  const int tidf = tidx();
  const int lane = tidf & 63;
  const int gw = blockIdx.x * 4 + (tidf >> 6), nw = gridDim.x * 4;
  const f32x4* w = (const f32x4*)p.final_norm_w;
  f32x4 wv[4];
#pragma unroll
  for (int i = 0; i < 4; ++i) wv[i] = w[lane + 64 * i];
  for (int row = gw; row < 16384; row += 4 * nw) {
    u32x2 r[4][4];
    float rs[4];
#pragma unroll
    for (int k = 0; k < 4; ++k) {
      const int rr = row + k * nw;
      const bool okr = rr < 16384;
      const int rc = okr ? rr : row;
      rs[k] = rsqrtf(ss2[rc] * (1.f / 1024.f) + kEps);
      const u32x2* hsrc = (const u32x2*)((const u16*)(p.ws + OFF_R) + (size_t)rc * 1024);
#pragma unroll
      for (int i = 0; i < 4; ++i) r[k][i] = hsrc[lane + 64 * i];
    }
#pragma unroll
    for (int k = 0; k < 4; ++k) {
      const int rr = row + k * nw;
      if (rr < 16384) {
        f32x4* o = (f32x4*)(p.out + (size_t)rr * 1024);
#pragma unroll
        for (int i = 0; i < 4; ++i) {
          f32x4 v = {bflo(r[k][i].x), bfhi(r[k][i].x), bflo(r[k][i].y), bfhi(r[k][i].y)};
          __builtin_nontemporal_store(v * rs[k] * wv[i], o + lane + 64 * i);
        }
      }
    }
  }
}

__global__ void __launch_bounds__(kThreads, 2) fwd_megakernel(Params p) {
  extern __shared__ __attribute__((aligned(16))) char smem[];
  cg::grid_group grid = cg::this_grid();
  char* ws = p.ws;
  __shared__ uint4 xb_words;
  if (threadIdx.x == 0) xb_words = make_uint4(0u, 0u, 0u, 0u);
  __syncthreads();
  if (p.ws == nullptr) grid.sync();
  XcdBarrier xb = xcd_barrier_post((unsigned*)(ws + OFF_BAR), (volatile LAS unsigned*)&xb_words);
  phase0(p, smem);
  xcd_barrier(xb);
  gemm_phase<1>(p, (const u16*)(ws + OFF_R), (const u16*)(ws + OFF_WTA_IN), 32, smem);
  skinny_gemm<0>(p, (const u16*)(ws + OFF_R), (const u16*)(ws + OFF_WTA_IN) + (size_t)4096 * 1024, (float*)(ws + OFF_BRAW));
  xcd_barrier(xb);
  {
    const bool overlap = gridDim.x >= 128;
    const int G = (int)gridDim.x, hG = G >> 1, bi = (int)blockIdx.x;
    const bool is_scan = overlap && bi < 32, is_idle = overlap && bi >= hG && bi < hG + 32;
    const int pfirst = overlap ? (bi < hG ? 32 : 64) : 0, pn = overlap ? G - 64 : G;
    if (!is_scan && !is_idle) delta_prep(p, smem, pfirst, pn);
    if (!is_scan && !is_idle) phase0b(p, smem, pfirst, pn);
    if (!overlap) xcd_barrier(xb);
    if (!overlap || blockIdx.x < 32) delta_scan(p, smem);
    xcd_barrier(xb);
  }
  gate_phase(p);
  xcd_barrier(xb);
  gemm_phase<2>(p, (const u16*)(ws + OFF_R + 32 * MiB), (const u16*)(ws + OFF_WTA_OUT), 8, smem);
  xcd_barrier(xb);
  gemm_phase<3>(p, (const u16*)(ws + OFF_R), (const u16*)(ws + OFF_WTB_IN), 32, smem);
  skinny_gemm<1>(p, (const u16*)(ws + OFF_R), (const u16*)(ws + OFF_WTB_IN) + (size_t)4096 * 1024, (float*)(ws + OFF_FRAW));
  xcd_barrier(xb);
  attn_phase(p, smem);
  xcd_barrier(xb);
  gemm_phase<4>(p, (const u16*)(ws + OFF_R + 64 * MiB), (const u16*)(ws + OFF_WTB_OUT), 8, smem);
  xcd_barrier(xb);
  final_norm(p);
}

extern "C" void kernel_launch(void* const* d_in, const int* in_sizes, int n_in, void* d_out, int out_size, void* d_ws, size_t ws_size,
                              hipStream_t stream) {
  static int grid_blocks = 0;
  if (!grid_blocks) {
    int dev = 0, cus = 0, per_cu = 0;
    hipGetDevice(&dev);
    hipDeviceGetAttribute(&cus, hipDeviceAttributeMultiprocessorCount, dev);
    hipFuncSetAttribute((const void*)fwd_megakernel, hipFuncAttributeMaxDynamicSharedMemorySize, kLds);
    hipOccupancyMaxActiveBlocksPerMultiprocessor(&per_cu, (const void*)fwd_megakernel, kThreads, kLds);
    if (per_cu < 1) per_cu = 1;
    if (per_cu > 2) per_cu = 2;
    grid_blocks = cus * per_cu;
  }
  Params p{};
  p.x = (const float*)d_in[0]; p.a_norm_w = (const float*)d_in[1]; p.a_w_in = (const float*)d_in[2]; p.a_conv_w = (const float*)d_in[3];
  p.a_A_log = (const float*)d_in[4]; p.a_dt_bias = (const float*)d_in[5]; p.a_o_norm_w = (const float*)d_in[6]; p.a_w_out = (const float*)d_in[7];
  p.b_norm_w = (const float*)d_in[8]; p.b_w_in = (const float*)d_in[9]; p.b_f_bias = (const float*)d_in[10]; p.b_q_norm_w = (const float*)d_in[11];
  p.b_k_norm_w = (const float*)d_in[12]; p.b_w_out = (const float*)d_in[13]; p.final_norm_w = (const float*)d_in[14];
  p.out = (float*)d_out;
  p.ws = (char*)d_ws;
  hipMemsetAsync((char*)d_ws + OFF_BAR, 0, CTL_BYTES, stream);
  void* args[] = {&p};
  hipError_t e = hipLaunchCooperativeKernel((const void*)fwd_megakernel, dim3(grid_blocks), dim3(kThreads), args, kLds, stream);
  if (e != hipSuccess) fprintf(stderr, "cooperative launch failed: %s (grid %d)\n", hipGetErrorString(e), grid_blocks);
}
```

```cpp
#include <hip/hip_runtime.h>
#include <hip/hip_cooperative_groups.h>
#include <cstdio>
namespace cg = cooperative_groups;

typedef unsigned short u16;
typedef __attribute__((ext_vector_type(8))) short bf16x8;
typedef __attribute__((ext_vector_type(4))) float f32x4;
typedef __attribute__((ext_vector_type(4))) unsigned u32x4;
typedef __attribute__((ext_vector_type(2))) unsigned u32x2;
#define DI __device__ __forceinline__

constexpr int kThreads = 256;
constexpr int kLds = 69632;
constexpr float kEps = 1e-6f;
constexpr float kScale = 0.08838834764831845f;
constexpr float kLog2e = 1.4426950408889634f;

constexpr size_t MiB = 1048576;
constexpr size_t OFF_WTA_IN = 0;
constexpr size_t OFF_WTA_OUT = 8650752;
constexpr size_t OFF_WTB_IN = 10747904;
constexpr size_t OFF_WTB_OUT = 19398656;
constexpr size_t OFF_SMALL = 21495808;
constexpr size_t OFF_RS0 = OFF_SMALL;
constexpr size_t OFF_SS1 = OFF_RS0 + 65536;
constexpr size_t OFF_SS2 = OFF_SS1 + 65536;
constexpr size_t OFF_BRAW = OFF_SS2 + 65536;
constexpr size_t OFF_FRAW = OFF_BRAW + 1048576;
constexpr size_t OFF_CCUM = OFF_FRAW + 1048576;
constexpr size_t OFF_GEND = OFF_CCUM + 524288;
constexpr size_t OFF_BAR = OFF_GEND + 8192;
constexpr size_t OFF_FLAGS = OFF_BAR + 13824 + 512;
constexpr size_t CTL_BYTES = 13824 + 512 + 8192;
constexpr size_t OFF_PROJ = OFF_SMALL + 3 * MiB;
constexpr size_t OFF_R = OFF_PROJ + 128 * MiB;

struct Params {
  const float *x, *a_norm_w, *a_w_in, *a_conv_w, *a_A_log, *a_dt_bias, *a_o_norm_w, *a_w_out;
  const float *b_norm_w, *b_w_in, *b_f_bias, *b_q_norm_w, *b_k_norm_w, *b_w_out, *final_norm_w;
  float* out;
  char* ws;
};

typedef __attribute__((ext_vector_type(2))) float f32x2;
typedef __attribute__((ext_vector_type(2))) __bf16 bf16x2_t;
DI unsigned pack2(float a, float b) { f32x2 v = {a, b}; return __builtin_bit_cast(unsigned, __builtin_convertvector(v, bf16x2_t)); }
DI unsigned f2bf(float x) { return pack2(x, 0.f) & 0xffffu; }
DI float bflo(unsigned u) { return __uint_as_float(u << 16); }
DI float bfhi(unsigned u) { return __uint_as_float(u & 0xffff0000u); }
DI f32x4 mfma16(bf16x8 a, bf16x8 b, f32x4 c) { return __builtin_amdgcn_mfma_f32_16x16x32_bf16(a, b, c, 0, 0, 0); }
DI bf16x8 mk8(u32x2 lo, u32x2 hi) { u32x4 v = {lo.x, lo.y, hi.x, hi.y}; return __builtin_bit_cast(bf16x8, v); }
DI bf16x8 pack8(f32x4 a, f32x4 b) { u32x4 v = {pack2(a[0], a[1]), pack2(a[2], a[3]), pack2(b[0], b[1]), pack2(b[2], b[3])}; return __builtin_bit_cast(bf16x8, v); }
DI bf16x8 ld2(const u16* p) { return mk8(*(const u32x2*)p, *(const u32x2*)(p + 16)); }
DI int relaunder(int t) { asm volatile("" : "+v"(t)); return t; }
DI int tidx() { int t = threadIdx.x; asm volatile("" : "+v"(t)); return t; }
DI float silu(float x) { return x / (1.f + __expf(-x)); }
DI void unpack8(u32x4 v, float* f) {
  f[0] = bflo(v.x); f[1] = bfhi(v.x); f[2] = bflo(v.y); f[3] = bfhi(v.y);
  f[4] = bflo(v.z); f[5] = bfhi(v.z); f[6] = bflo(v.w); f[7] = bfhi(v.w);
}
DI u32x4 packf8(const float* f) { u32x4 v = {pack2(f[0], f[1]), pack2(f[2], f[3]), pack2(f[4], f[5]), pack2(f[6], f[7])}; return v; }


#define XB_TMO      128
#define XB_XCNT(j)  (256  + 64 * (j))
#define XB_XSUB(j)  (1280 + 64 * (j))
#define XB_XGEN(j)  (2304 + 64 * (j))
#define XB_TOP      3328
#define XB_TOPGEN   3392
#define XCD_BAR_WORDS 3456
#define XB_SPIN_CAP (1u << 23)
#define LAS __attribute__((address_space(3)))
DI unsigned xb_ld(unsigned* p) { return __hip_atomic_load(p, __ATOMIC_RELAXED, __HIP_MEMORY_SCOPE_AGENT); }
DI unsigned xb_add(unsigned* p, unsigned v) { return __hip_atomic_fetch_add(p, v, __ATOMIC_RELAXED, __HIP_MEMORY_SCOPE_AGENT); }
DI unsigned xb_xcc_id() { return (unsigned)__builtin_amdgcn_s_getreg((3 << 11) | 20) & 0xFu; }
#define XB_SPIN(cond, bar) do { unsigned _sp = 0; while (cond) { __builtin_amdgcn_s_sleep(1); \
    if ((++_sp & 255u) == 0u) { if (xb_ld(&(bar)[XB_TMO])) break; if (_sp > XB_SPIN_CAP) { atomicAdd(&(bar)[XB_TMO], 1u); break; } } } } while (0)
struct XcdBarrier { unsigned* bar; unsigned x; volatile LAS unsigned* st; };
DI XcdBarrier xcd_barrier_post(unsigned* bar, volatile LAS unsigned* st) {
  XcdBarrier b; b.bar = bar; b.x = xb_xcc_id(); b.st = st;
  if (threadIdx.x == 0) (void)xb_add(&bar[XB_XCNT(b.x)], 1u);
  return b;
}
DI void xcd_barrier_complete(unsigned* bar, unsigned x, unsigned& nloc, unsigned& nx) {
  const unsigned G = gridDim.x * gridDim.y * gridDim.z;
  unsigned sum, cnt, mine, sp = 0u;
  for (;;) {
    sum = 0u; cnt = 0u; mine = 0u;
#pragma unroll
    for (unsigned j = 0; j < 16; ++j) { const unsigned c = xb_ld(&bar[XB_XCNT(j)]); sum += c; cnt += (c > 0u) ? 1u : 0u; mine = (j == x) ? c : mine; }
    if (sum == G) break;
    __builtin_amdgcn_s_sleep(1);
    if ((++sp & 255u) == 0u) { if (xb_ld(&bar[XB_TMO])) break; if (sp > XB_SPIN_CAP) { atomicAdd(&bar[XB_TMO], 1u); break; } }
  }
  nloc = mine > 0u ? mine : 1u; nx = cnt > 0u ? cnt : 1u;
}
DI void xcd_barrier(const XcdBarrier& b) {
  asm volatile("s_waitcnt vmcnt(0)" ::: "memory");
  __syncthreads();
  if (threadIdx.x == 0) {
    unsigned* bar = b.bar;
    __builtin_amdgcn_s_waitcnt(0);
    unsigned nloc = b.st[0], nx = b.st[1];
    if (nloc == 0u) { xcd_barrier_complete(bar, b.x, nloc, nx); b.st[0] = nloc; b.st[1] = nx; }
    const unsigned old = xb_add(&bar[XB_XSUB(b.x)], 1u);
    const unsigned gen = old / nloc;
    if (old + 1u == (gen + 1u) * nloc) {
      __builtin_amdgcn_fence(__ATOMIC_RELEASE, "agent");
      asm volatile("s_waitcnt vmcnt(0)" ::: "memory");
      const unsigned og = xb_add(&bar[XB_TOP], 1u);
      const unsigned tg = og / nx;
      if (og + 1u == (tg + 1u) * nx) xb_add(&bar[XB_TOPGEN], 1u);
      else XB_SPIN(xb_ld(&bar[XB_TOPGEN]) == tg, bar);
      __builtin_amdgcn_fence(__ATOMIC_ACQUIRE, "agent");
      xb_add(&bar[XB_XGEN(b.x)], 1u);
      asm volatile("s_waitcnt vmcnt(0)" ::: "memory");
    } else {
      XB_SPIN(xb_ld(&bar[XB_XGEN(b.x)]) == gen, bar);
      __builtin_amdgcn_fence(__ATOMIC_ACQUIRE, "agent");
      asm volatile("s_waitcnt vmcnt(0)" ::: "memory");
    }
  }
  __syncthreads();
}

DI void transpose_tile(const float* __restrict__ W, int N, int Npad, const float* __restrict__ kscale, u16* __restrict__ WT, int tile, char* smem) {
  float(*t)[65] = (float(*)[65])smem;
  const int nt = Npad / 64;
  const int k0 = (tile / nt) * 64, n0 = (tile % nt) * 64;
  const int tid = tidx();
  {
    const int tx = tid & 63, ty = tid >> 6;
#pragma unroll 4
    for (int i = 0; i < 16; ++i) {
      const int k = k0 + ty + 4 * i, n = n0 + tx;
      float v = 0.f;
      if (n < N) { v = W[(size_t)k * N + n]; if (kscale) v *= kscale[k]; }
      t[ty + 4 * i][tx] = v;
    }
  }
  __syncthreads();
  {
    const int kx2 = (tid & 31) * 2, ny0 = tid >> 5;
#pragma unroll 4
    for (int i = 0; i < 8; ++i) {
      const int ny = ny0 + 8 * i;
      *(unsigned*)(WT + (size_t)(n0 + ny) * 1024 + k0 + kx2) = pack2(t[kx2][ny], t[kx2 + 1][ny]);
    }
  }
  __syncthreads();
}

DI void phase0(const Params& p, char* smem) {
  char* ws = p.ws;
  {
    float* ss = (float*)(ws + OFF_SS1);
    for (int i = blockIdx.x * kThreads + tidx(); i < 32768; i += gridDim.x * kThreads) ss[i] = 0.f;
  }
  for (int t = blockIdx.x; t < 1312; t += gridDim.x) {
    if (t < 1056) transpose_tile(p.a_w_in, 4112, 4224, p.a_norm_w, (u16*)(ws + OFF_WTA_IN), t, smem);
    else transpose_tile(p.a_w_out, 1024, 1024, nullptr, (u16*)(ws + OFF_WTA_OUT), t - 1056, smem);
  }
  const int tid0 = tidx();
  const int lane = tid0 & 63;
  const int gw = blockIdx.x * 4 + (tid0 >> 6), nw = gridDim.x * 4;
  u16* xb = (u16*)(ws + OFF_R);
  float* rs0 = (float*)(ws + OFF_RS0);
  for (int row = gw; row < 16384; row += 4 * nw) {
    f32x4 v[4][4];
#pragma unroll
    for (int k = 0; k < 4; ++k) {
      const int rr = row + k * nw;
      const f32x4* xr = (const f32x4*)(p.x + (size_t)(rr < 16384 ? rr : row) * 1024);
#pragma unroll
      for (int i = 0; i < 4; ++i) v[k][i] = __builtin_nontemporal_load(xr + lane + 64 * i);
    }
#pragma unroll
    for (int k = 0; k < 4; ++k) {
      const int rr = row + k * nw;
      float ss = 0.f;
#pragma unroll
      for (int i = 0; i < 4; ++i) ss += v[k][i][0] * v[k][i][0] + v[k][i][1] * v[k][i][1] + v[k][i][2] * v[k][i][2] + v[k][i][3] * v[k][i][3];
#pragma unroll
      for (int o = 32; o >= 1; o >>= 1) ss += __shfl_xor(ss, o);
      if (rr < 16384) {
        u32x2* xo = (u32x2*)(xb + (size_t)rr * 1024);
#pragma unroll
        for (int i = 0; i < 4; ++i) { u32x2 o = {pack2(v[k][i][0], v[k][i][1]), pack2(v[k][i][2], v[k][i][3])}; xo[lane + 64 * i] = o; }
        if (lane == 0) rs0[rr] = rsqrtf(ss * (1.f / 1024.f) + kEps);
      }
    }
  }
}

DI void phase0b(const Params& p, char* smem, int first, int nblk) {
  char* ws = p.ws;
  for (int t = (int)blockIdx.x - first; t < 1312; t += nblk) {
    if (t < 1056) transpose_tile(p.b_w_in, 4104, 4224, p.b_norm_w, (u16*)(ws + OFF_WTB_IN), t, smem);
    else transpose_tile(p.b_w_out, 1024, 1024, nullptr, (u16*)(ws + OFF_WTB_OUT), t - 1056, smem);
  }
}

template <int EPI>
DI void gemm_phase(const Params& p, const u16* __restrict__ A, const u16* __restrict__ Bt, int nTn, char* smem) {
  const int tid = tidx(), lane = tid & 63, wave = tid >> 6;
  const int wr = wave >> 1, wc = wave & 1;
  const int l15 = lane & 15, quad = lane >> 4;
  char* ws = p.ws;
  const int NX = ((gridDim.x & 7) == 0) ? 8 : 1;
  const int xg = blockIdx.x % NX, lb = blockIdx.x / NX, Lb = gridDim.x / NX;
  const int nTnG = nTn >> 3, nSuper = 16 * nTnG;
  const int srow = wave * 8 + (lane >> 3);
  const int sch = (lane & 7) ^ ((((wave & 1) << 2) + (lane >> 4)) & 7);
#define GEMM_TILE(seq_, tm_, tn_, ok_)                                                            \
  do {                                                                                            \
    const int sidx_ = xg + NX * ((seq_) >> 6);                                                    \
    ok_ = sidx_ < nSuper;                                                                         \
    const int tl_ = (seq_) & 63;                                                                  \
    tm_ = (sidx_ / nTnG) * 8 + (tl_ & 7);                                                         \
    tn_ = (sidx_ % nTnG) * 8 + (tl_ >> 3);                                                        \
  } while (0)
#define GEMM_STAGE(buf, kt)                                                                                                   \
  do {                                                                                                                        \
    _Pragma("unroll") for (int i = 0; i < 4; ++i) {                                                                           \
      __builtin_amdgcn_global_load_lds((const unsigned*)(Ag + (size_t)i * 32 * 1024 + (kt) * 64),                             \
                                       (unsigned*)(smem + (buf) * 32768 + (i * 4 + wave) * 1024), 16, 0, 0);                  \
      __builtin_amdgcn_global_load_lds((const unsigned*)(Bg + (size_t)i * 32 * 1024 + (kt) * 64),                             \
                                       (unsigned*)(smem + (buf) * 32768 + 16384 + (i * 4 + wave) * 1024), 16, 0, 0);          \
    }                                                                                                                         \
  } while (0)
  int seq = lb, tm, tn;
  bool ok;
  GEMM_TILE(seq, tm, tn, ok);
  const u16* Ag = A + (size_t)(tm * 128 + srow) * 1024 + sch * 8;
  const u16* Bg = Bt + (size_t)(tn * 128 + srow) * 1024 + sch * 8;
  if (ok) GEMM_STAGE(0, 0);
  while (ok) {
    int tm2, tn2;
    bool ok2;
    GEMM_TILE(seq + Lb, tm2, tn2, ok2);
    f32x4 acc[4][4];
#pragma unroll
    for (int a = 0; a < 4; ++a)
#pragma unroll
      for (int b = 0; b < 4; ++b) acc[a][b] = (f32x4){0.f, 0.f, 0.f, 0.f};
    asm volatile("s_waitcnt vmcnt(0)" ::: "memory");
    __syncthreads();
    for (int kt = 0; kt < 16; ++kt) {
      const int cur = kt & 1;
      if (kt + 1 < 16) GEMM_STAGE(cur ^ 1, kt + 1);
      else if (ok2) {
        Ag = A + (size_t)(tm2 * 128 + srow) * 1024 + sch * 8;
        Bg = Bt + (size_t)(tn2 * 128 + srow) * 1024 + sch * 8;
        GEMM_STAGE(0, 0);
      }
      const char* sa = smem + cur * 32768;
      const char* sb = sa + 16384;
#pragma unroll
      for (int ks = 0; ks < 2; ++ks) {
        bf16x8 fa[4], fb[4];
        const int ch = ks * 4 + quad;
#pragma unroll
        for (int mi = 0; mi < 4; ++mi) {
          const int row = wr * 64 + mi * 16 + l15;
          fa[mi] = *(const bf16x8*)(sa + row * 128 + ((ch ^ ((row >> 1) & 7)) << 4));
        }
#pragma unroll
        for (int ni = 0; ni < 4; ++ni) {
          const int row = wc * 64 + ni * 16 + l15;
          fb[ni] = *(const bf16x8*)(sb + row * 128 + ((ch ^ ((row >> 1) & 7)) << 4));
        }
#pragma unroll
        for (int ni = 0; ni < 4; ++ni)
#pragma unroll
          for (int mi = 0; mi < 4; ++mi) acc[ni][mi] = mfma16(fb[ni], fa[mi], acc[ni][mi]);
      }
      if (kt < 15) {
        asm volatile("s_waitcnt vmcnt(0)" ::: "memory");
        __syncthreads();
      }
    }
    float hnorm[4] = {1.f, 1.f, 1.f, 1.f};
    if constexpr (EPI == 3) {
      if (tn < 16) {
        float* part = (float*)(smem + 65536);
        float ssq[4];
#pragma unroll
        for (int mi = 0; mi < 4; ++mi) {
          const float rs = rsqrtf(((const float*)(ws + OFF_SS1))[tm * 128 + wr * 64 + mi * 16 + l15] * (1.f / 1024.f) + kEps);
          float s = 0.f;
#pragma unroll
          for (int ni = 0; ni < 4; ++ni) { const f32x4 v = acc[ni][mi] * rs; s += v[0] * v[0] + v[1] * v[1] + v[2] * v[2] + v[3] * v[3]; }
          s += __shfl_xor(s, 16);
          s += __shfl_xor(s, 32);
          ssq[mi] = s;
          if (quad == 0) part[(wr * 2 + wc) * 64 + mi * 16 + l15] = s;
        }
        __syncthreads();
#pragma unroll
        for (int mi = 0; mi < 4; ++mi) {
          const float tot = ssq[mi] + part[(wr * 2 + (wc ^ 1)) * 64 + mi * 16 + l15];
          hnorm[mi] = rsqrtf(tot * (1.f / 128.f) + kEps) * (tn < 8 ? kScale * kLog2e : 1.f);
        }
      }
    }
#pragma unroll
    for (int mi = 0; mi < 4; ++mi) {
      const int m = tm * 128 + wr * 64 + mi * 16 + l15;
      if constexpr (EPI == 1) {
        const float rs = ((const float*)(ws + OFF_RS0))[m];
        u16* proj = (u16*)(ws + OFF_PROJ);
        float* braw = (float*)(ws + OFF_BRAW);
#pragma unroll
        for (int ni = 0; ni < 4; ++ni) {
          const int nb = tn * 128 + wc * 64 + ni * 16 + quad * 4;
          f32x4 v = acc[ni][mi] * rs;
          if (nb < 4096) { u32x2 o = {pack2(v[0], v[1]), pack2(v[2], v[3])}; __builtin_nontemporal_store(o, (u32x2*)(proj + (size_t)m * 4096 + nb)); }
          else if (nb < 4112) { *(f32x4*)(braw + (size_t)m * 16 + (nb - 4096)) = v; }
        }
      } else if constexpr (EPI == 2 || EPI == 4) {
        float* ssp = (float*)(ws + (EPI == 2 ? OFF_SS1 : OFF_SS2));
        u16* hb = (u16*)(ws + OFF_R);
        float ssq = 0.f;
#pragma unroll
        for (int ni = 0; ni < 4; ++ni) {
          const int nb = tn * 128 + wc * 64 + ni * 16 + quad * 4;
          f32x4 v;
          if constexpr (EPI == 2) {
            v = acc[ni][mi] + __builtin_nontemporal_load((const f32x4*)(p.x + (size_t)m * 1024 + nb));
            u32x2 o = {pack2(v[0], v[1]), pack2(v[2], v[3])};
            *(u32x2*)(hb + (size_t)m * 1024 + nb) = o;
            v[0] = bflo(o.x); v[1] = bfhi(o.x); v[2] = bflo(o.y); v[3] = bfhi(o.y);
          } else {
            const u32x2 r = *(const u32x2*)(hb + (size_t)m * 1024 + nb);
            v = acc[ni][mi];
            v[0] += bflo(r.x); v[1] += bfhi(r.x); v[2] += bflo(r.y); v[3] += bfhi(r.y);
            const u32x2 o = {pack2(v[0], v[1]), pack2(v[2], v[3])};
            *(u32x2*)(hb + (size_t)m * 1024 + nb) = o;
            v[0] = bflo(o.x); v[1] = bfhi(o.x); v[2] = bflo(o.y); v[3] = bfhi(o.y);
          }
          ssq += v[0] * v[0] + v[1] * v[1] + v[2] * v[2] + v[3] * v[3];
        }
        ssq += __shfl_xor(ssq, 16);
        ssq += __shfl_xor(ssq, 32);
        if (quad == 0) atomicAdd(ssp + m, ssq);
      } else if constexpr (EPI == 3) {
        const float rs = rsqrtf(((const float*)(ws + OFF_SS1))[m] * (1.f / 1024.f) + kEps);
        u16* proj = (u16*)(ws + OFF_PROJ);
        u16* vT = (u16*)(ws + OFF_R + 32 * MiB);
        float* fraw = (float*)(ws + OFF_FRAW);
        float hs = 1.f;
        if (tn < 16) hs = hnorm[mi];
#pragma unroll
        for (int ni = 0; ni < 4; ++ni) {
          const int nb = tn * 128 + wc * 64 + ni * 16 + quad * 4;
          f32x4 v = acc[ni][mi] * rs;
          if (tn < 16) {
            const f32x4 wv = *(const f32x4*)((tn < 8 ? p.b_q_norm_w : p.b_k_norm_w) + (nb & 127));
            v = v * hs * wv;
          }
          if (nb < 4096) {
            if ((nb >> 10) != 2) { u32x2 o = {pack2(v[0], v[1]), pack2(v[2], v[3])}; __builtin_nontemporal_store(o, (u32x2*)(proj + (size_t)m * 4096 + nb)); }
            else {
              const int hd = nb - 2048;
              const int b = m >> 13, t = m & 8191;
              u16* dst = vT + ((size_t)(b * 1024 + hd)) * 8192 + t;
#pragma unroll
              for (int jj = 0; jj < 4; ++jj) dst[(size_t)jj * 8192] = (u16)f2bf(v[jj]);
            }
          } else if (nb < 4104) { *(f32x4*)(fraw + (size_t)m * 16 + (nb - 4096)) = v; }
        }
      }
    }
    seq += Lb; tm = tm2; tn = tn2; ok = ok2;
  }
#undef GEMM_STAGE
#undef GEMM_TILE
}


template <int MODE>
DI void skinny_gemm(const Params& p, const u16* __restrict__ A, const u16* __restrict__ Wt16, float* __restrict__ out) {
  const int tid = tidx(), lane = tid & 63, l15 = lane & 15, quad = lane >> 4;
  const int gw = blockIdx.x * 4 + (tid >> 6), nw = gridDim.x * 4;
  for (int mt = gw; mt < 1024; mt += nw) {
    const int m = mt * 16 + l15;
    const u16* ap = A + (size_t)m * 1024 + quad * 8;
    const u16* bp = Wt16 + (size_t)l15 * 1024 + quad * 8;
    f32x4 acc = {0.f, 0.f, 0.f, 0.f};
#pragma unroll 8
    for (int ks = 0; ks < 32; ++ks) acc = mfma16(*(const bf16x8*)(bp + ks * 32), *(const bf16x8*)(ap + ks * 32), acc);
    float rs;
    if constexpr (MODE == 0) rs = ((const float*)(p.ws + OFF_RS0))[m];
    else rs = rsqrtf(((const float*)(p.ws + OFF_SS1))[m] * (1.f / 1024.f) + kEps);
    *(f32x4*)(out + (size_t)m * 16 + 4 * quad) = acc * rs;
  }
}

DI void delta_prep(const Params& p, char* smem, int first, int nblk) {
  char* ws = p.ws;
  const u16* proj = (const u16*)(ws + OFF_PROJ);
  const float* braw = (const float*)(ws + OFF_BRAW);
  u16* qd_g = (u16*)(ws + OFF_R);
  u16* kT_g = (u16*)(ws + OFF_R + 32 * MiB);
  u16* at_g = (u16*)(ws + OFF_R + 64 * MiB);
  u16* uT_g = (u16*)p.out;
  u16* w_g = (u16*)((char*)p.out + 32 * MiB);
  float* gend_g = (float*)(ws + OFF_GEND);
  char* qL = smem;
  char* kL = smem + 16384;
  char* vL = smem + 32768;
  float* As = (float*)(smem + 49152);
  float* sc = (float*)(smem + 66560);
  float* g_s = sc;
  float* beta_s = sc + 64;
  float* rq_s = sc + 128;
  float* rk_s = sc + 192;
  float* ssq_s = sc + 256;
  float* fu_s = sc + 384;
  float* fw_s = sc + 448;
  const int tid_ = tidx();

  unsigned* flags = (unsigned*)(ws + OFF_FLAGS);
  const __amdgpu_buffer_rsrc_t r_qd = __builtin_amdgcn_make_buffer_rsrc(qd_g, 0, 32 << 20, 0x00020000);
  const __amdgpu_buffer_rsrc_t r_kT = __builtin_amdgcn_make_buffer_rsrc(kT_g, 0, 32 << 20, 0x00020000);
  const __amdgpu_buffer_rsrc_t r_at = __builtin_amdgcn_make_buffer_rsrc(at_g, 0, 16 << 20, 0x00020000);
  const __amdgpu_buffer_rsrc_t r_uT = __builtin_amdgcn_make_buffer_rsrc(uT_g, 0, 32 << 20, 0x00020000);
  const __amdgpu_buffer_rsrc_t r_w = __builtin_amdgcn_make_buffer_rsrc(w_g, 0, 32 << 20, 0x00020000);
  if (nblk >= 256 && ((int)blockIdx.x - first) >= (nblk >> 1)) {
    for (int i = 0; i < 7; ++i) __builtin_amdgcn_s_sleep(127);
  }
  for (int j = (int)blockIdx.x - first; j < 2048; j += nblk) {
    const int c = j >> 4, b = (j >> 3) & 1, h = j & 7;
    const int item = (b * 128 + c) * 8 + h;
    const int tok0 = b * 8192 + c * 64;
    const int tid = relaunder(tid_), lane = tid & 63, wave = tid >> 6, l15 = lane & 15, quad = lane >> 4;
    if (wave == 3) {
      const int row = tok0 + lane;
      const float br = braw[(size_t)row * 16 + h];
      const float ar = braw[(size_t)row * 16 + 8 + h] + p.a_dt_bias[h];
      const float beta = 1.f / (1.f + __expf(-br));
      const float sp = fmaxf(ar, 0.f) + log1pf(__expf(-fabsf(ar)));
      float g = -__expf(p.a_A_log[h]) * sp;
#pragma unroll
      for (int o = 1; o < 64; o <<= 1) { float t = __shfl_up(g, o); if (lane >= o) g += t; }
      g_s[lane] = g;
      beta_s[lane] = beta;
    } else {
      const int sec = wave, cgi = l15, rr = quad;
      const int col = sec * 1024 + h * 128 + cgi * 8;
      float w0[8], w1[8], w2[8], w3[8];
#pragma unroll
      for (int e = 0; e < 8; ++e) {
        w0[e] = p.a_conv_w[0 * 3072 + col + e]; w1[e] = p.a_conv_w[1 * 3072 + col + e];
        w2[e] = p.a_conv_w[2 * 3072 + col + e]; w3[e] = p.a_conv_w[3 * 3072 + col + e];
      }
      const u16* src = proj + (size_t)(tok0 + rr * 16) * 4096 + col;
      float x0[8], x1[8], x2[8], x3[8];
      if (c == 0 && rr == 0) {
#pragma unroll
        for (int e = 0; e < 8; ++e) { x0[e] = 0.f; x1[e] = 0.f; x2[e] = 0.f; }
      } else {
        unpack8(*(const u32x4*)(src - 3 * 4096), x0);
        unpack8(*(const u32x4*)(src - 2 * 4096), x1);
        unpack8(*(const u32x4*)(src - 1 * 4096), x2);
      }
      char* dstL = smem + sec * 16384;
#pragma unroll 4
      for (int r = 0; r < 16; ++r) {
        unpack8(*(const u32x4*)(src + (size_t)r * 4096), x3);
        float y[8];
        float ssq = 0.f;
#pragma unroll
        for (int e = 0; e < 8; ++e) {
          float v = w0[e] * x0[e] + w1[e] * x1[e] + w2[e] * x2[e] + w3[e] * x3[e];
          v = silu(v);
          y[e] = v;
          ssq += v * v;
          x0[e] = x1[e]; x1[e] = x2[e]; x2[e] = x3[e];
        }
        ssq += __shfl_xor(ssq, 1); ssq += __shfl_xor(ssq, 2); ssq += __shfl_xor(ssq, 4); ssq += __shfl_xor(ssq, 8);
        const int row = rr * 16 + r;
        if (sec < 2 && cgi == 0) ssq_s[sec * 64 + row] = ssq;
        *(u32x4*)(dstL + row * 256 + ((cgi ^ (row & 15)) << 4)) = packf8(y);
      }
    }
    __syncthreads();
    if (tid < 64) {
      const float rq = rsqrtf(ssq_s[tid] + kEps), rk = rsqrtf(ssq_s[64 + tid] + kEps);
      const float gi = g_s[tid], g63 = g_s[63];
      const float eg = __expf(gi);
      rq_s[tid] = rq; rk_s[tid] = rk;
      const float be = beta_s[tid];
      fu_s[tid] = be;
      fw_s[tid] = be * rk * eg;
      ssq_s[tid] = rq * kScale * eg;
      ssq_s[64 + tid] = rk * __expf(g63 - gi);
      if (tid == 0) __hip_atomic_store(gend_g + item, __expf(g63), __ATOMIC_RELAXED, __HIP_MEMORY_SCOPE_AGENT);
    }
    __syncthreads();
    {
      const int tid = relaunder(tid_), lane = tid & 63, wave = tid >> 6, l15 = lane & 15, quad = lane >> 4;
      bf16x8 bk[4], bq[4];
      const int rowI = 16 * wave + l15;
#pragma unroll
      for (int ks = 0; ks < 4; ++ks) {
        const int off = rowI * 256 + (((ks * 4 + quad) ^ (rowI & 15)) << 4);
        bk[ks] = *(const bf16x8*)(kL + off);
        bq[ks] = *(const bf16x8*)(qL + off);
      }
      const int i = rowI;
      const float gi = g_s[i], bi = beta_s[i] * rk_s[i], qi = kScale * rq_s[i];
      u32x2 keep = {0u, 0u};
#pragma unroll
      for (int J = 0; J < 4; ++J) {
        f32x4 skk = {0.f, 0.f, 0.f, 0.f}, sqk = {0.f, 0.f, 0.f, 0.f};
        const int rowJ = 16 * J + l15;
#pragma unroll
        for (int ks = 0; ks < 4; ++ks) {
          const bf16x8 ak = *(const bf16x8*)(kL + rowJ * 256 + (((ks * 4 + quad) ^ (rowJ & 15)) << 4));
          skk = mfma16(ak, bk[ks], skk);
          sqk = mfma16(ak, bq[ks], sqk);
        }
        const f32x4 gj4 = *(const f32x4*)(g_s + 16 * J + 4 * quad);
        const f32x4 rk4 = *(const f32x4*)(rk_s + 16 * J + 4 * quad);
        f32x4 a4, t4;
#pragma unroll
        for (int jj = 0; jj < 4; ++jj) {
          const int j = 16 * J + 4 * quad + jj;
          const float dec = (i >= j) ? __expf(gi - gj4[jj]) : 0.f;
          a4[jj] = (i > j) ? bi * rk4[jj] * skk[jj] * dec : 0.f;
          t4[jj] = qi * rk4[jj] * sqk[jj] * dec;
        }
        *(f32x4*)(As + i * 68 + 16 * J + 4 * quad) = a4;
        const u32x2 half = {pack2(t4[0], t4[1]), pack2(t4[2], t4[3])};
        if ((J & 1) == 0) keep = half;
        else {
          const u32x4 fr = {keep.x, keep.y, half.x, half.y};
          __builtin_amdgcn_raw_buffer_store_b128(fr, r_at, item * 8192 + ((wave * 2 + (J >> 1)) * 64 + lane) * 16, 0, 16);
        }
      }
    }
    {
      const int tid = relaunder(tid_);
#pragma unroll
      for (int it = 0; it < 4; ++it) {
        const int idx = tid + 256 * it;
        const int f = idx >> 6, ln = idx & 63, fl = ln & 15, fq = ln >> 4;
        {
          const int mt = f >> 2, ks = f & 3, i = 16 * mt + fl;
          const int c0 = 4 * ks + (fq >> 1), o8 = (fq & 1) * 8;
          const u32x2 lo = *(const u32x2*)(qL + i * 256 + ((c0 ^ (i & 15)) << 4) + o8);
          const u32x2 hi = *(const u32x2*)(qL + i * 256 + (((c0 + 2) ^ (i & 15)) << 4) + o8);
          const float s = ssq_s[i];
          const u32x4 o = {pack2(bflo(lo.x) * s, bfhi(lo.x) * s), pack2(bflo(lo.y) * s, bfhi(lo.y) * s),
                           pack2(bflo(hi.x) * s, bfhi(hi.x) * s), pack2(bflo(hi.y) * s, bfhi(hi.y) * s)};
          __builtin_amdgcn_raw_buffer_store_b128(o, r_qd, item * 16384 + idx * 16, 0, 16);
        }
        {
          const int mt = f >> 1, ks = f & 1, dk = 16 * mt + fl;
          float v[8];
#pragma unroll
          for (int e = 0; e < 8; ++e) {
            const int i = 32 * ks + ((e < 4) ? (4 * fq + e) : (16 + 4 * fq + e - 4));
            const u16 raw = *(const u16*)(kL + i * 256 + (((dk >> 3) ^ (i & 15)) << 4) + (dk & 7) * 2);
            v[e] = __uint_as_float(((unsigned)raw) << 16) * ssq_s[64 + i];
          }
          __builtin_amdgcn_raw_buffer_store_b128(packf8(v), r_kT, item * 16384 + idx * 16, 0, 16);
        }
      }
    }
    __syncthreads();
    {
      float U[64];
      const int tid = relaunder(tid_), wave = tid >> 6;
      const int cc = tid & 127, ch = cc >> 3, e2 = (cc & 7) * 2;
      const char* srcL = (wave < 2) ? vL : kL;
      const float* fr = (wave < 2) ? fu_s : fw_s;
#pragma unroll
      for (int i = 0; i < 64; ++i) {
        int ii = i;
        asm volatile("" : "+v"(ii));
        const u16 raw = *(const u16*)(srcL + ii * 256 + ((ch ^ (ii & 15)) << 4) + e2);
        float acc = __uint_as_float(((unsigned)raw) << 16) * fr[ii];
#pragma unroll
        for (int j = 0; j < i; ++j) acc -= As[i * 68 + j] * U[j];
        U[i] = acc;
      }
      if (wave < 2) {
        const int dofs = item * 16384 + (((cc >> 4) * 4) * 256 + (cc & 15) * 4) * 2;
#pragma unroll
        for (int mi = 0; mi < 4; ++mi)
#pragma unroll
          for (int q4 = 0; q4 < 4; ++q4) {
            const u32x2 o = {pack2(U[16 * mi + 4 * q4], U[16 * mi + 4 * q4 + 1]), pack2(U[16 * mi + 4 * q4 + 2], U[16 * mi + 4 * q4 + 3])};
            __builtin_amdgcn_raw_buffer_store_b64(o, r_uT, dofs + (mi * 256 + q4 * 64) * 2, 0, 16);
          }
      } else {
#pragma unroll
        for (int i = 0; i < 64; ++i) {
          int ii = i;
          asm volatile("" : "+v"(ii));
          *(u16*)(qL + ii * 256 + ((ch ^ (ii & 15)) << 4) + e2) = (u16)f2bf(U[i]);
        }
      }
    }
    __syncthreads();
    {
      const int tid = relaunder(tid_);
#pragma unroll
      for (int it = 0; it < 4; ++it) {
        const int idx = tid + 256 * it;
        const int f = idx >> 6, ln = idx & 63, fl = ln & 15, fq = ln >> 4;
        const int mt = f >> 2, ks = f & 3, i = 16 * mt + fl;
        const int c0 = 4 * ks + (fq >> 1), o8 = (fq & 1) * 8;
        const u32x2 lo = *(const u32x2*)(qL + i * 256 + ((c0 ^ (i & 15)) << 4) + o8);
        const u32x2 hi = *(const u32x2*)(qL + i * 256 + (((c0 + 2) ^ (i & 15)) << 4) + o8);
        const u32x4 o = {lo.x, lo.y, hi.x, hi.y};
        __builtin_amdgcn_raw_buffer_store_b128(o, r_w, item * 16384 + idx * 16, 0, 16);
      }
    }
    asm volatile("s_waitcnt vmcnt(0)" ::: "memory");
    __syncthreads();
    if (relaunder(tid_) == 0) __hip_atomic_store(flags + item, 1u, __ATOMIC_RELAXED, __HIP_MEMORY_SCOPE_AGENT);
  }
}

#define RAW_BARRIER() do { asm volatile("s_waitcnt lgkmcnt(0)" ::: "memory"); __builtin_amdgcn_s_barrier(); asm volatile("" ::: "memory"); } while (0)
#define GAS __attribute__((address_space(1)))
#define SCAN_LOAD(item_)                                                                                          \
  do {                                                                                                            \
    const GAS char* wb_ = (const GAS char*)((const char*)w_g + (size_t)(item_) * 16384);                          \
    const GAS char* qb_ = (const GAS char*)((const char*)qd_g + (size_t)(item_) * 16384);                         \
    const GAS char* kb_ = (const GAS char*)((const char*)kT_g + (size_t)(item_) * 16384);                         \
    const GAS char* ab_ = (const GAS char*)((const char*)at_g + (size_t)(item_) * 8192);                          \
    const GAS char* ub_ = (const GAS char*)((const char*)uT_g + (size_t)(item_) * 16384);                         \
    asm volatile("" : "+s"(wb_), "+s"(qb_), "+s"(kb_), "+s"(ab_), "+s"(ub_));                                     \
    _Pragma("unroll") for (int j = 0; j < 4; ++j) {                                                               \
      R[j] = *(const GAS u32x4*)(wb_ + (toff + 4096u * j));                                                       \
      R[4 + j] = *(const GAS u32x4*)(qb_ + (toff + 4096u * j));                                                   \
      R[8 + j] = *(const GAS u32x4*)(kb_ + (toff + 4096u * j));                                                   \
    }                                                                                                             \
    _Pragma("unroll") for (int j = 0; j < 2; ++j) R[12 + j] = *(const GAS u32x4*)(ab_ + (toff + 4096u * j));     \
    _Pragma("unroll") for (int mi = 0; mi < 4; ++mi) un[mi] = *(const GAS u32x2*)(ub_ + (uoff + 512u * mi));     \
    gn = gend_g[item_];                                                                                           \
  } while (0)
DI void delta_scan(const Params& p, char* smem) {
  char* ws = p.ws;
  const u16* qd_g = (const u16*)(ws + OFF_R);
  const u16* kT_g = (const u16*)(ws + OFF_R + 32 * MiB);
  const u16* at_g = (const u16*)(ws + OFF_R + 64 * MiB);
  const u16* uT_g = (const u16*)p.out;
  const u16* w_g = (const u16*)((const char*)p.out + 32 * MiB);
  const float* gend_g = (const float*)(ws + OFF_GEND);
  u16* o_g = (u16*)(ws + OFF_PROJ);
  unsigned* flags = (unsigned*)(ws + OFF_FLAGS);
  const int tid = tidx(), lane = tid & 63, wave = tid >> 6, l15 = lane & 15, quad = lane >> 4;
  char* Lw = smem;
  char* Lq = smem + 16384;
  char* Lk = smem + 32768;
  char* La = smem + 49152;
  char* Lo = smem + 57344;
  for (int unit = blockIdx.x; unit < 32; unit += gridDim.x) {
    const int bh = unit & 15, half = unit >> 4, b = bh >> 3, h = bh & 7;
    const int slice = half * 4 + wave;
    f32x4 S[8];
#pragma unroll
    for (int i = 0; i < 8; ++i) S[i] = (f32x4){0.f, 0.f, 0.f, 0.f};
    const unsigned toff = (unsigned)tid * 16u, uoff = (unsigned)(slice * 256 + lane) * 8u;
    u32x4 R[14];
    u32x2 un[4];
    float gn;
#define SCAN_WAIT(flv_, item_)                                                                                         \
  do {                                                                                                                 \
    unsigned f_ = (flv_), sp_ = 0u;                                                                                    \
    while (f_ == 0u && sp_ < (1u << 24)) { __builtin_amdgcn_s_sleep(2); f_ = __hip_atomic_load(flags + (item_), __ATOMIC_RELAXED, __HIP_MEMORY_SCOPE_AGENT); ++sp_; } \
    __builtin_amdgcn_fence(__ATOMIC_ACQUIRE, "workgroup");           \
  } while (0)
    unsigned fl;
    {
      const int item = (b * 128) * 8 + h;
      SCAN_WAIT(0u, item);
      SCAN_LOAD(item);
      fl = __hip_atomic_load(flags + ((b * 128 + 1) * 8 + h), __ATOMIC_RELAXED, __HIP_MEMORY_SCOPE_AGENT);
    }
    for (int c = 0; c < 128; ++c) {
#pragma unroll
      for (int j = 0; j < 4; ++j) {
        *(u32x4*)(Lw + (tid + 256 * j) * 16) = R[j];
        *(u32x4*)(Lq + (tid + 256 * j) * 16) = R[4 + j];
        *(u32x4*)(Lk + (tid + 256 * j) * 16) = R[8 + j];
      }
#pragma unroll
      for (int j = 0; j < 2; ++j) *(u32x4*)(La + (tid + 256 * j) * 16) = R[12 + j];
      u32x2 uc[4];
#pragma unroll
      for (int mi = 0; mi < 4; ++mi) uc[mi] = un[mi];
      const float gend = gn;
      RAW_BARRIER();
      if (c + 1 < 128) SCAN_WAIT(fl, (b * 128 + c + 1) * 8 + h);
      if (c > 0) {
        const int tokp = b * 8192 + (c - 1) * 64;
#pragma unroll
        for (int k2 = 0; k2 < 2; ++k2) {
          const int idx = tid + 256 * k2, row = idx >> 3, part = idx & 7;
          *(u32x4*)(o_g + (size_t)(tokp + row) * 4096 + h * 128 + half * 64 + part * 8) = *(const u32x4*)(Lo + idx * 16);
        }
      }
      if (c + 1 < 128) {
        const int item = (b * 128 + c + 1) * 8 + h;
        SCAN_LOAD(item);
        fl = (c + 2 < 128) ? __hip_atomic_load(flags + (item + 8), __ATOMIC_RELAXED, __HIP_MEMORY_SCOPE_AGENT) : 1u;
      }
      __builtin_amdgcn_sched_barrier(0);
      bf16x8 bS[4];
#pragma unroll
      for (int ks = 0; ks < 4; ++ks) bS[ks] = pack8(S[2 * ks], S[2 * ks + 1]);
      bf16x8 fr[16];
#pragma unroll
      for (int i = 0; i < 16; ++i) fr[i] = *(const bf16x8*)(Lw + (i * 64 + lane) * 16);
      __builtin_amdgcn_sched_barrier(0);
      f32x4 vn[4];
#pragma unroll
      for (int mi = 0; mi < 4; ++mi) vn[mi] = (f32x4){0.f, 0.f, 0.f, 0.f};
#pragma unroll
      for (int ks = 0; ks < 4; ++ks)
#pragma unroll
        for (int mi = 0; mi < 4; ++mi) vn[mi] = mfma16(fr[mi * 4 + ks], bS[ks], vn[mi]);
      __builtin_amdgcn_sched_barrier(0);
#pragma unroll
      for (int i = 0; i < 16; ++i) fr[i] = *(const bf16x8*)(Lk + (i * 64 + lane) * 16);
#pragma unroll
      for (int mi = 0; mi < 4; ++mi) {
        vn[mi][0] = bflo(uc[mi].x) - vn[mi][0]; vn[mi][1] = bfhi(uc[mi].x) - vn[mi][1];
        vn[mi][2] = bflo(uc[mi].y) - vn[mi][2]; vn[mi][3] = bfhi(uc[mi].y) - vn[mi][3];
      }
      bf16x8 bV[2];
      bV[0] = pack8(vn[0], vn[1]);
      bV[1] = pack8(vn[2], vn[3]);
#pragma unroll
      for (int mt = 0; mt < 8; ++mt) S[mt] = S[mt] * gend;
      __builtin_amdgcn_sched_barrier(0);
#pragma unroll
      for (int ks = 0; ks < 2; ++ks)
#pragma unroll
        for (int mt = 0; mt < 8; ++mt) S[mt] = mfma16(fr[mt * 2 + ks], bV[ks], S[mt]);
      __builtin_amdgcn_sched_barrier(0);
#pragma unroll
      for (int i = 0; i < 16; ++i) fr[i] = *(const bf16x8*)(Lq + (i * 64 + lane) * 16);
      __builtin_amdgcn_sched_barrier(0);
      f32x4 oacc[4];
#pragma unroll
      for (int mi = 0; mi < 4; ++mi) oacc[mi] = (f32x4){0.f, 0.f, 0.f, 0.f};
#pragma unroll
      for (int ks = 0; ks < 4; ++ks)
#pragma unroll
        for (int mi = 0; mi < 4; ++mi) oacc[mi] = mfma16(fr[mi * 4 + ks], bS[ks], oacc[mi]);
      __builtin_amdgcn_sched_barrier(0);
#pragma unroll
      for (int i = 0; i < 8; ++i) fr[i] = *(const bf16x8*)(La + (i * 64 + lane) * 16);
      __builtin_amdgcn_sched_barrier(0);
#pragma unroll
      for (int ks = 0; ks < 2; ++ks)
#pragma unroll
        for (int mi = 0; mi < 4; ++mi) oacc[mi] = mfma16(fr[mi * 2 + ks], bV[ks], oacc[mi]);
      __builtin_amdgcn_sched_barrier(0);
#pragma unroll
      for (int mi = 0; mi < 4; ++mi)
#pragma unroll
        for (int jj = 0; jj < 4; ++jj)
          *(u16*)(Lo + (16 * mi + 4 * quad + jj) * 128 + (wave * 16 + l15) * 2) = (u16)f2bf(oacc[mi][jj]);
      RAW_BARRIER();
    }
    {
      const int tokp = b * 8192 + 127 * 64;
#pragma unroll
      for (int k2 = 0; k2 < 2; ++k2) {
        const int idx = tid + 256 * k2, row = idx >> 3, part = idx & 7;
        *(u32x4*)(o_g + (size_t)(tokp + row) * 4096 + h * 128 + half * 64 + part * 8) = *(const u32x4*)(Lo + idx * 16);
      }
      RAW_BARRIER();
    }
  }
}

#undef SCAN_LOAD
#undef SCAN_WAIT

DI void gate_phase(const Params& p) {
  char* ws = p.ws;
  const u16* proj = (const u16*)(ws + OFF_PROJ);
  u16* y0 = (u16*)(ws + OFF_R + 32 * MiB);
  const int tidg = tidx();
  const int lane = tidg & 63, l15 = lane & 15, quad = lane >> 4;
  const int gw = blockIdx.x * 4 + (tidg >> 6), nw = gridDim.x * 4;
  float wn[8];
#pragma unroll
  for (int e = 0; e < 8; ++e) wn[e] = p.a_o_norm_w[l15 * 8 + e];
  for (int r4 = gw; r4 < 32768; r4 += nw) {
    const int rh = r4 * 4 + quad, tok = rh >> 3, h = rh & 7;
    float o[8], z[8];
    unpack8(*(const u32x4*)(proj + (size_t)tok * 4096 + h * 128 + l15 * 8), o);
    unpack8(*(const u32x4*)(proj + (size_t)tok * 4096 + 3072 + h * 128 + l15 * 8), z);
    float ssq = 0.f;
#pragma unroll
    for (int e = 0; e < 8; ++e) ssq += o[e] * o[e];
    ssq += __shfl_xor(ssq, 1); ssq += __shfl_xor(ssq, 2); ssq += __shfl_xor(ssq, 4); ssq += __shfl_xor(ssq, 8);
    const float rs = rsqrtf(ssq * (1.f / 128.f) + kEps);
#pragma unroll
    for (int e = 0; e < 8; ++e) o[e] = o[e] * rs * wn[e] * silu(z[e]);
    *(u32x4*)(y0 + (size_t)tok * 1024 + h * 128 + l15 * 8) = packf8(o);
  }
}

DI void qknorm_cumsum(const Params& p, char* smem) {
  char* ws = p.ws;
  u16* proj = (u16*)(ws + OFF_PROJ);
  const int tid = tidx(), lane = tid & 63, l15 = lane & 15, quad = lane >> 4;
  const int gw = blockIdx.x * 4 + (tid >> 6), nw = gridDim.x * 4;
  for (int idx = gw; idx < 65536; idx += nw) {
    const int which = idx >> 15, r4 = idx & 32767;
    const int rh = r4 * 4 + quad, tok = rh >> 3, h = rh & 7;
    const float* wv = which ? p.b_k_norm_w : p.b_q_norm_w;
    u16* ptr = proj + (size_t)tok * 4096 + which * 1024 + h * 128 + l15 * 8;
    float v[8];
    unpack8(*(const u32x4*)ptr, v);
    float ssq = 0.f;
#pragma unroll
    for (int e = 0; e < 8; ++e) ssq += v[e] * v[e];
    ssq += __shfl_xor(ssq, 1); ssq += __shfl_xor(ssq, 2); ssq += __shfl_xor(ssq, 4); ssq += __shfl_xor(ssq, 8);
    const float rs = rsqrtf(ssq * (1.f / 128.f) + kEps) * (which ? 1.f : kScale);
#pragma unroll
    for (int e = 0; e < 8; ++e) v[e] = v[e] * rs * wv[l15 * 8 + e];
    *(u32x4*)ptr = packf8(v);
  }
}

DI void attn_phase(const Params& p, char* smem) {
  char* ws = p.ws;
  const u16* proj = (const u16*)(ws + OFF_PROJ);
  const u16* vT = (const u16*)(ws + OFF_R + 32 * MiB);
  const float* fraw = (const float*)(ws + OFF_FRAW);
  u16* y1 = (u16*)(ws + OFF_R + 64 * MiB);
  float* bias_s = (float*)(smem + 65536);
  float* ca_s = bias_s + 128;
  const int tid_ = tidx();
  float mq = 0.f, mk = 0.f;
  for (int i = 0; i < 128; ++i) { mq = fmaxf(mq, fabsf(p.b_q_norm_w[i])); mk = fmaxf(mk, fabsf(p.b_k_norm_w[i])); }
  const float QKB = 128.f * kScale * mq * mk;
  float* mmin_s = (float*)(smem + 66320);

  unsigned* qctr = (unsigned*)(ws + OFF_BAR) + XCD_BAR_WORDS;
  int* qslot = (int*)(smem + 66304);
  int qx = blockIdx.x & 7, qtries = 0;
  while (true) {
    const int tid = relaunder(tid_), lane = tid & 63, wave = tid >> 6, l15 = lane & 15, quad = lane >> 4;
    if (tid == 0) *qslot = (int)atomicAdd(qctr + qx * 16, 1u);
    __syncthreads();
    const int it = *qslot;
    __syncthreads();
    if (it >= 128) { if (++qtries >= 8) break; qx = (qx + 1) & 7; continue; }
    const int qb = 63 - (it & 63);
    const int b = it >> 6, h = b ? ((qx + 4) & 7) : qx, bh = b * 8 + h, i0 = qb * 128;
    const int qrow0 = i0 + 32 * wave;
    const float fb = p.b_f_bias[h];
    bf16x8 bq[2][4];
#pragma unroll
    for (int nq = 0; nq < 2; ++nq)
#pragma unroll
      for (int ks = 0; ks < 4; ++ks)
        bq[nq][ks] = *(const bf16x8*)(proj + (size_t)(b * 8192 + qrow0 + 16 * nq + l15) * 4096 + h * 128 + 32 * ks + 8 * quad);
    f32x4 O[8][2];
#pragma unroll
    for (int dt = 0; dt < 8; ++dt) { O[dt][0] = (f32x4){0.f, 0.f, 0.f, 0.f}; O[dt][1] = (f32x4){0.f, 0.f, 0.f, 0.f}; }
    float mrun[2] = {-1e30f, -1e30f}, lrun[2] = {0.f, 0.f};

    const int kkey = wave * 4 + (lane >> 4);
    const int kch = (lane & 15) ^ (kkey & 15);
    const u16* Kg = proj + (size_t)(b * 8192 + kkey) * 4096 + 1024 + h * 128 + kch * 8;
    const int vd = wave * 8 + (lane >> 3);
    const int vch = (lane & 7) ^ ((((wave & 1) << 2) + (lane >> 4)) & 7);
    const u16* Vg = vT + (size_t)(bh * 128 + vd) * 8192 + vch * 8;
#define ATT_STAGE(buf, j0_)                                                                                                   \
  do {                                                                                                                        \
    _Pragma("unroll") for (int i = 0; i < 4; ++i) {                                                                           \
      __builtin_amdgcn_global_load_lds((const unsigned*)(Kg + (size_t)((j0_) + 16 * i) * 4096),                               \
                                       (unsigned*)(smem + (buf) * 32768 + (i * 4 + wave) * 1024), 16, 0, 0);                  \
      __builtin_amdgcn_global_load_lds((const unsigned*)(Vg + (size_t)(32 * i) * 8192 + (j0_)),                               \
                                       (unsigned*)(smem + (buf) * 32768 + 16384 + (i * 4 + wave) * 1024), 16, 0, 0);          \
    }                                                                                                                         \
  } while (0)
    int j0 = i0 + 64;
    ATT_STAGE(0, j0);
    float carry = 0.f, biasA = 0.f, frn = 0.f;
    if (wave == 0) {
      const float xa = fraw[(size_t)(b * 8192 + i0 + lane) * 16 + h] + fb;
      const float xb2 = fraw[(size_t)(b * 8192 + i0 + 64 + lane) * 16 + h] + fb;
      const float lfA = fminf(xa, 0.f) - log1pf(__expf(-fabsf(xa)));
      const float lfB = fminf(xb2, 0.f) - log1pf(__expf(-fabsf(xb2)));
      float pa = lfA, pb = lfB;
#pragma unroll
      for (int o = 1; o < 64; o <<= 1) {
        const float ta = __shfl_up(pa, o), tb = __shfl_up(pb, o);
        if (lane >= o) { pa += ta; pb += tb; }
      }
      const float lf0 = __shfl(lfA, 0), totA = __shfl(pa, 63);
      biasA = -(pa - lf0) * kLog2e;
      bias_s[lane] = -(totA - lf0 + pb) * kLog2e;
      carry = lf0;
    }
    if (lane == 0) { mmin_s[wave] = -1e30f; mmin_s[4 + wave] = -1e30f; }
    asm volatile("s_waitcnt vmcnt(0)" ::: "memory");
    __syncthreads();
    int cur = 0;
    while (true) {
      const int nj = j0 - 64;
      bool more = nj >= 0;
      if (more && j0 <= i0) {
        const float* mm = mmin_s + cur * 4;
        const float mmin = fminf(fminf(mm[0], mm[1]), fminf(mm[2], mm[3]));
        more = !((QKB + ca_s[cur]) * kLog2e < mmin - 30.f * kLog2e);
      }
      if (more) {
        ATT_STAGE(cur ^ 1, nj);
        if (wave == 0 && nj < i0) frn = fraw[(size_t)(b * 8192 + nj + lane) * 16 + h];
      }
      if (j0 <= qrow0 + 31) {
        const char* Ks = smem + cur * 32768;
        const char* Vs = Ks + 16384;
        const float* cs = bias_s + cur * 64;
        f32x4 s[4][2];
#pragma unroll
        for (int kt = 0; kt < 4; ++kt) { s[kt][0] = (f32x4){0.f, 0.f, 0.f, 0.f}; s[kt][1] = (f32x4){0.f, 0.f, 0.f, 0.f}; }
#pragma unroll
        for (int ks = 0; ks < 4; ++ks)
#pragma unroll
          for (int kt = 0; kt < 4; ++kt) {
            const int kl = 16 * kt + l15;
            const bf16x8 ak = *(const bf16x8*)(Ks + kl * 256 + (((ks * 4 + quad) ^ (kl & 15)) << 4));
            s[kt][0] = mfma16(ak, bq[0][ks], s[kt][0]);
            s[kt][1] = mfma16(ak, bq[1][ks], s[kt][1]);
          }
        const bool diag = (j0 >= i0);
#pragma unroll
        for (int kt = 0; kt < 4; ++kt) {
          const f32x4 bias = *(const f32x4*)(cs + 16 * kt + 4 * quad);
#pragma unroll
          for (int nq = 0; nq < 2; ++nq)
#pragma unroll
            for (int jj = 0; jj < 4; ++jj) {
              float v = s[kt][nq][jj] + bias[jj];
              if (diag) { if (j0 + 16 * kt + 4 * quad + jj > qrow0 + 16 * nq + l15) v = -1e30f; }
              s[kt][nq][jj] = v;
            }
        }
        bf16x8 bP[2][2];
#pragma unroll
        for (int nq = 0; nq < 2; ++nq) {
          float tmax = -1e30f;
#pragma unroll
          for (int kt = 0; kt < 4; ++kt)
#pragma unroll
            for (int jj = 0; jj < 4; ++jj) tmax = fmaxf(tmax, s[kt][nq][jj]);
          tmax = fmaxf(tmax, __shfl_xor(tmax, 16));
          tmax = fmaxf(tmax, __shfl_xor(tmax, 32));
          const float mnew = fmaxf(mrun[nq], tmax);
          const float alpha = __builtin_amdgcn_exp2f(mrun[nq] - mnew);
          const bool grew = mnew > mrun[nq];
          mrun[nq] = mnew;
          float psum = 0.f;
#pragma unroll
          for (int kt = 0; kt < 4; ++kt)
#pragma unroll
            for (int jj = 0; jj < 4; ++jj) { const float pv = __builtin_amdgcn_exp2f(s[kt][nq][jj] - mnew); s[kt][nq][jj] = pv; psum += pv; }
          lrun[nq] = lrun[nq] * alpha + psum;
          if (__builtin_amdgcn_ballot_w64(grew) != 0ull) {
#pragma unroll
            for (int dt = 0; dt < 8; ++dt) O[dt][nq] = O[dt][nq] * alpha;
          }
          bP[0][nq] = pack8(s[0][nq], s[1][nq]);
          bP[1][nq] = pack8(s[2][nq], s[3][nq]);
        }
#pragma unroll
        for (int ks = 0; ks < 2; ++ks)
#pragma unroll
          for (int dt = 0; dt < 8; ++dt) {
            const int d = 16 * dt + l15, sw = (d >> 1) & 7, c0 = 4 * ks + (quad >> 1);
            const u32x2 lo = *(const u32x2*)(Vs + d * 128 + ((c0 ^ sw) << 4) + (quad & 1) * 8);
            const u32x2 hi = *(const u32x2*)(Vs + d * 128 + (((c0 + 2) ^ sw) << 4) + (quad & 1) * 8);
            const bf16x8 av = mk8(lo, hi);
            O[dt][0] = mfma16(av, bP[ks][0], O[dt][0]);
            O[dt][1] = mfma16(av, bP[ks][1], O[dt][1]);
          }
        float wm = fminf(mrun[0], mrun[1]);
#pragma unroll
        for (int o = 1; o < 64; o <<= 1) wm = fminf(wm, __shfl_xor(wm, o));
        if (lane == 0) mmin_s[(cur ^ 1) * 4 + wave] = wm;
      }
      if (more && wave == 0) {
        const int nb = cur ^ 1;
        if (nj == i0) {
          bias_s[nb * 64 + lane] = biasA;
          if (lane == 0) ca_s[nb] = carry;
        } else {
          const float xv = frn + fb;
          const float lf = fminf(xv, 0.f) - log1pf(__expf(-fabsf(xv)));
          float sf = lf;
#pragma unroll
          for (int o = 1; o < 64; o <<= 1) { const float t = __shfl_down(sf, o); if (lane + o < 64) sf += t; }
          bias_s[nb * 64 + lane] = (sf - lf + carry) * kLog2e;
          carry += __shfl(sf, 0);
          if (lane == 0) ca_s[nb] = carry;
        }
      }
      asm volatile("s_waitcnt vmcnt(0)" ::: "memory");
      __syncthreads();
      if (!more) break;
      j0 = nj;
      cur ^= 1;
    }
#undef ATT_STAGE
#pragma unroll
    for (int nq = 0; nq < 2; ++nq) {
      float l = lrun[nq];
      l += __shfl_xor(l, 16);
      l += __shfl_xor(l, 32);
      const float inv = 1.f / l;
      const size_t tok = (size_t)(b * 8192 + qrow0 + 16 * nq + l15);
#pragma unroll
      for (int dt = 0; dt < 8; ++dt) {
        const int d = 16 * dt + 4 * quad;
        const u32x2 z2 = *(const u32x2*)(proj + tok * 4096 + 3072 + h * 128 + d);
        const f32x4 o = O[dt][nq] * inv;
        u32x2 r = {pack2(o[0] * silu(bflo(z2.x)), o[1] * silu(bfhi(z2.x))), pack2(o[2] * silu(bflo(z2.y)), o[3] * silu(bfhi(z2.y)))};
        *(u32x2*)(y1 + tok * 1024 + h * 128 + d) = r;
      }
    }
  }
}

DI void final_norm(const Params& p) {
  const float* ss2 = (const float*)(p.ws + OFF_SS2);
  const int tidf = tidx();
  const int lane = tidf & 63;
  const int gw = blockIdx.x * 4 + (tidf >> 6), nw = gridDim.x * 4;
  const f32x4* w = (const f32x4*)p.final_norm_w;
  f32x4 wv[4];
#pragma unroll
  for (int i = 0; i < 4; ++i) wv[i] = w[lane + 64 * i];
  for (int row = gw; row < 16384; row += 4 * nw) {
    u32x2 r[4][4];
    float rs[4];
#pragma unroll
    for (int k = 0; k < 4; ++k) {
      const int rr = row + k * nw;
      const bool okr = rr < 16384;
      const int rc = okr ? rr : row;
      rs[k] = rsqrtf(ss2[rc] * (1.f / 1024.f) + kEps);
      const u32x2* hsrc = (const u32x2*)((const u16*)(p.ws + OFF_R) + (size_t)rc * 1024);
#pragma unroll
      for (int i = 0; i < 4; ++i) r[k][i] = hsrc[lane + 64 * i];
    }
#pragma unroll
    for (int k = 0; k < 4; ++k) {
      const int rr = row + k * nw;
      if (rr < 16384) {
        f32x4* o = (f32x4*)(p.out + (size_t)rr * 1024);
#pragma unroll
        for (int i = 0; i < 4; ++i) {
          f32x4 v = {bflo(r[k][i].x), bfhi(r[k][i].x), bflo(r[k][i].y), bfhi(r[k][i].y)};
          __builtin_nontemporal_store(v * rs[k] * wv[i], o + lane + 64 * i);
        }
      }
    }
  }
}

__global__ void __launch_bounds__(kThreads, 2) fwd_megakernel(Params p) {
  extern __shared__ __attribute__((aligned(16))) char smem[];
  cg::grid_group grid = cg::this_grid();
  char* ws = p.ws;
  __shared__ uint4 xb_words;
  if (threadIdx.x == 0) xb_words = make_uint4(0u, 0u, 0u, 0u);
  __syncthreads();
  if (p.ws == nullptr) grid.sync();
  XcdBarrier xb = xcd_barrier_post((unsigned*)(ws + OFF_BAR), (volatile LAS unsigned*)&xb_words);
  phase0(p, smem);
  xcd_barrier(xb);
  gemm_phase<1>(p, (const u16*)(ws + OFF_R), (const u16*)(ws + OFF_WTA_IN), 32, smem);
  skinny_gemm<0>(p, (const u16*)(ws + OFF_R), (const u16*)(ws + OFF_WTA_IN) + (size_t)4096 * 1024, (float*)(ws + OFF_BRAW));
  xcd_barrier(xb);
  {
    const bool overlap = gridDim.x >= 128;
    const int G = (int)gridDim.x, hG = G >> 1, bi = (int)blockIdx.x;
    const bool is_scan = overlap && bi < 32, is_idle = overlap && bi >= hG && bi < hG + 32;
    const int pfirst = overlap ? (bi < hG ? 32 : 64) : 0, pn = overlap ? G - 64 : G;
    if (!is_scan && !is_idle) delta_prep(p, smem, pfirst, pn);
    if (!is_scan && !is_idle) phase0b(p, smem, pfirst, pn);
    if (!overlap) xcd_barrier(xb);
    if (!overlap || blockIdx.x < 32) delta_scan(p, smem);
    xcd_barrier(xb);
  }
  gate_phase(p);
  xcd_barrier(xb);
  gemm_phase<2>(p, (const u16*)(ws + OFF_R + 32 * MiB), (const u16*)(ws + OFF_WTA_OUT), 8, smem);
  xcd_barrier(xb);
  gemm_phase<3>(p, (const u16*)(ws + OFF_R), (const u16*)(ws + OFF_WTB_IN), 32, smem);
  skinny_gemm<1>(p, (const u16*)(ws + OFF_R), (const u16*)(ws + OFF_WTB_IN) + (size_t)4096 * 1024, (float*)(ws + OFF_FRAW));
  xcd_barrier(xb);
  attn_phase(p, smem);
  xcd_barrier(xb);
  gemm_phase<4>(p, (const u16*)(ws + OFF_R + 64 * MiB), (const u16*)(ws + OFF_WTB_OUT), 8, smem);
  xcd_barrier(xb);
  final_norm(p);
}

extern "C" void kernel_launch(void* const* d_in, const int* in_sizes, int n_in, void* d_out, int out_size, void* d_ws, size_t ws_size,
                              hipStream_t stream) {
  static int grid_blocks = 0;
  if (!grid_blocks) {
    int dev = 0, cus = 0, per_cu = 0;
    hipGetDevice(&dev);
    hipDeviceGetAttribute(&cus, hipDeviceAttributeMultiprocessorCount, dev);
    hipFuncSetAttribute((const void*)fwd_megakernel, hipFuncAttributeMaxDynamicSharedMemorySize, kLds);
    hipOccupancyMaxActiveBlocksPerMultiprocessor(&per_cu, (const void*)fwd_megakernel, kThreads, kLds);
    if (per_cu < 1) per_cu = 1;
    if (per_cu > 2) per_cu = 2;
    grid_blocks = cus * per_cu;
  }
  Params p{};
  p.x = (const float*)d_in[0]; p.a_norm_w = (const float*)d_in[1]; p.a_w_in = (const float*)d_in[2]; p.a_conv_w = (const float*)d_in[3];
  p.a_A_log = (const float*)d_in[4]; p.a_dt_bias = (const float*)d_in[5]; p.a_o_norm_w = (const float*)d_in[6]; p.a_w_out = (const float*)d_in[7];
  p.b_norm_w = (const float*)d_in[8]; p.b_w_in = (const float*)d_in[9]; p.b_f_bias = (const float*)d_in[10]; p.b_q_norm_w = (const float*)d_in[11];
  p.b_k_norm_w = (const float*)d_in[12]; p.b_w_out = (const float*)d_in[13]; p.final_norm_w = (const float*)d_in[14];
  p.out = (float*)d_out;
  p.ws = (char*)d_ws;
  hipMemsetAsync((char*)d_ws + OFF_BAR, 0, CTL_BYTES, stream);
  void* args[] = {&p};
  hipError_t e = hipLaunchCooperativeKernel((const void*)fwd_megakernel, dim3(grid_blocks), dim3(kThreads), args, kLds, stream);
  if (e != hipSuccess) fprintf(stderr, "cooperative launch failed: %s (grid %d)\n", hipGetErrorString(e), grid_blocks);
}
```

```cpp
#include <hip/hip_runtime.h>
#include <hip/hip_cooperative_groups.h>
#include <cstdio>
namespace cg = cooperative_groups;

typedef unsigned short u16;
typedef __attribute__((ext_vector_type(8))) short bf16x8;
typedef __attribute__((ext_vector_type(4))) float f32x4;
typedef __attribute__((ext_vector_type(4))) unsigned u32x4;
typedef __attribute__((ext_vector_type(2))) unsigned u32x2;
#define DI __device__ __forceinline__

constexpr int kThreads = 256;
constexpr int kLds = 69632;
constexpr float kEps = 1e-6f;
constexpr float kScale = 0.08838834764831845f;
constexpr float kLog2e = 1.4426950408889634f;

constexpr size_t MiB = 1048576;
constexpr size_t OFF_WTA_IN = 0;
constexpr size_t OFF_WTA_OUT = 8650752;
constexpr size_t OFF_WTB_IN = 10747904;
constexpr size_t OFF_WTB_OUT = 19398656;
constexpr size_t OFF_SMALL = 21495808;
constexpr size_t OFF_RS0 = OFF_SMALL;
constexpr size_t OFF_SS1 = OFF_RS0 + 65536;
constexpr size_t OFF_SS2 = OFF_SS1 + 65536;
constexpr size_t OFF_BRAW = OFF_SS2 + 65536;
constexpr size_t OFF_FRAW = OFF_BRAW + 1048576;
constexpr size_t OFF_CCUM = OFF_FRAW + 1048576;
constexpr size_t OFF_GEND = OFF_CCUM + 524288;
constexpr size_t OFF_BAR = OFF_GEND + 8192;
constexpr size_t OFF_FLAGS = OFF_BAR + 13824 + 512;
constexpr size_t CTL_BYTES = 13824 + 512 + 8192;
constexpr size_t OFF_PROJ = OFF_SMALL + 3 * MiB;
constexpr size_t OFF_R = OFF_PROJ + 128 * MiB;

struct Params {
  const float *x, *a_norm_w, *a_w_in, *a_conv_w, *a_A_log, *a_dt_bias, *a_o_norm_w, *a_w_out;
  const float *b_norm_w, *b_w_in, *b_f_bias, *b_q_norm_w, *b_k_norm_w, *b_w_out, *final_norm_w;
  float* out;
  char* ws;
};

typedef __attribute__((ext_vector_type(2))) float f32x2;
typedef __attribute__((ext_vector_type(2))) __bf16 bf16x2_t;
DI unsigned pack2(float a, float b) { f32x2 v = {a, b}; return __builtin_bit_cast(unsigned, __builtin_convertvector(v, bf16x2_t)); }
DI unsigned f2bf(float x) { return pack2(x, 0.f) & 0xffffu; }
DI float bflo(unsigned u) { return __uint_as_float(u << 16); }
DI float bfhi(unsigned u) { return __uint_as_float(u & 0xffff0000u); }
DI f32x4 mfma16(bf16x8 a, bf16x8 b, f32x4 c) { return __builtin_amdgcn_mfma_f32_16x16x32_bf16(a, b, c, 0, 0, 0); }
DI bf16x8 mk8(u32x2 lo, u32x2 hi) { u32x4 v = {lo.x, lo.y, hi.x, hi.y}; return __builtin_bit_cast(bf16x8, v); }
DI bf16x8 pack8(f32x4 a, f32x4 b) { u32x4 v = {pack2(a[0], a[1]), pack2(a[2], a[3]), pack2(b[0], b[1]), pack2(b[2], b[3])}; return __builtin_bit_cast(bf16x8, v); }
DI bf16x8 ld2(const u16* p) { return mk8(*(const u32x2*)p, *(const u32x2*)(p + 16)); }
DI int relaunder(int t) { asm volatile("" : "+v"(t)); return t; }
DI int tidx() { int t = threadIdx.x; asm volatile("" : "+v"(t)); return t; }
DI float silu(float x) { return x / (1.f + __expf(-x)); }
DI void unpack8(u32x4 v, float* f) {
  f[0] = bflo(v.x); f[1] = bfhi(v.x); f[2] = bflo(v.y); f[3] = bfhi(v.y);
  f[4] = bflo(v.z); f[5] = bfhi(v.z); f[6] = bflo(v.w); f[7] = bfhi(v.w);
}
DI u32x4 packf8(const float* f) { u32x4 v = {pack2(f[0], f[1]), pack2(f[2], f[3]), pack2(f[4], f[5]), pack2(f[6], f[7])}; return v; }


#define XB_TMO      128
#define XB_XCNT(j)  (256  + 64 * (j))
#define XB_XSUB(j)  (1280 + 64 * (j))
#define XB_XGEN(j)  (2304 + 64 * (j))
#define XB_TOP      3328
#define XB_TOPGEN   3392
#define XCD_BAR_WORDS 3456
#define XB_SPIN_CAP (1u << 23)
#define LAS __attribute__((address_space(3)))
DI unsigned xb_ld(unsigned* p) { return __hip_atomic_load(p, __ATOMIC_RELAXED, __HIP_MEMORY_SCOPE_AGENT); }
DI unsigned xb_add(unsigned* p, unsigned v) { return __hip_atomic_fetch_add(p, v, __ATOMIC_RELAXED, __HIP_MEMORY_SCOPE_AGENT); }
DI unsigned xb_xcc_id() { return (unsigned)__builtin_amdgcn_s_getreg((3 << 11) | 20) & 0xFu; }
#define XB_SPIN(cond, bar) do { unsigned _sp = 0; while (cond) { __builtin_amdgcn_s_sleep(1); \
    if ((++_sp & 255u) == 0u) { if (xb_ld(&(bar)[XB_TMO])) break; if (_sp > XB_SPIN_CAP) { atomicAdd(&(bar)[XB_TMO], 1u); break; } } } } while (0)
struct XcdBarrier { unsigned* bar; unsigned x; volatile LAS unsigned* st; };
DI XcdBarrier xcd_barrier_post(unsigned* bar, volatile LAS unsigned* st) {
  XcdBarrier b; b.bar = bar; b.x = xb_xcc_id(); b.st = st;
  if (threadIdx.x == 0) (void)xb_add(&bar[XB_XCNT(b.x)], 1u);
  return b;
}
DI void xcd_barrier_complete(unsigned* bar, unsigned x, unsigned& nloc, unsigned& nx) {
  const unsigned G = gridDim.x * gridDim.y * gridDim.z;
  unsigned sum, cnt, mine, sp = 0u;
  for (;;) {
    sum = 0u; cnt = 0u; mine = 0u;
#pragma unroll
    for (unsigned j = 0; j < 16; ++j) { const unsigned c = xb_ld(&bar[XB_XCNT(j)]); sum += c; cnt += (c > 0u) ? 1u : 0u; mine = (j == x) ? c : mine; }
    if (sum == G) break;
    __builtin_amdgcn_s_sleep(1);
    if ((++sp & 255u) == 0u) { if (xb_ld(&bar[XB_TMO])) break; if (sp > XB_SPIN_CAP) { atomicAdd(&bar[XB_TMO], 1u); break; } }
  }
  nloc = mine > 0u ? mine : 1u; nx = cnt > 0u ? cnt : 1u;
}
DI void xcd_barrier(const XcdBarrier& b) {
  asm volatile("s_waitcnt vmcnt(0)" ::: "memory");
  __syncthreads();
  if (threadIdx.x == 0) {
    unsigned* bar = b.bar;
    __builtin_amdgcn_s_waitcnt(0);
    unsigned nloc = b.st[0], nx = b.st[1];
    if (nloc == 0u) { xcd_barrier_complete(bar, b.x, nloc, nx); b.st[0] = nloc; b.st[1] = nx; }
    const unsigned old = xb_add(&bar[XB_XSUB(b.x)], 1u);
    const unsigned gen = old / nloc;
    if (old + 1u == (gen + 1u) * nloc) {
      __builtin_amdgcn_fence(__ATOMIC_RELEASE, "agent");
      asm volatile("s_waitcnt vmcnt(0)" ::: "memory");
      const unsigned og = xb_add(&bar[XB_TOP], 1u);
      const unsigned tg = og / nx;
      if (og + 1u == (tg + 1u) * nx) xb_add(&bar[XB_TOPGEN], 1u);
      else XB_SPIN(xb_ld(&bar[XB_TOPGEN]) == tg, bar);
      __builtin_amdgcn_fence(__ATOMIC_ACQUIRE, "agent");
      xb_add(&bar[XB_XGEN(b.x)], 1u);
      asm volatile("s_waitcnt vmcnt(0)" ::: "memory");
    } else {
      XB_SPIN(xb_ld(&bar[XB_XGEN(b.x)]) == gen, bar);
      __builtin_amdgcn_fence(__ATOMIC_ACQUIRE, "agent");
      asm volatile("s_waitcnt vmcnt(0)" ::: "memory");
    }
  }
  __syncthreads();
}

DI void transpose_tile(const float* __restrict__ W, int N, int Npad, const float* __restrict__ kscale, u16* __restrict__ WT, int tile, char* smem) {
  float(*t)[65] = (float(*)[65])smem;
  const int nt = Npad / 64;
  const int k0 = (tile / nt) * 64, n0 = (tile % nt) * 64;
  const int tid = tidx();
  {
    const int tx = tid & 63, ty = tid >> 6;
#pragma unroll 4
    for (int i = 0; i < 16; ++i) {
      const int k = k0 + ty + 4 * i, n = n0 + tx;
      float v = 0.f;
      if (n < N) { v = W[(size_t)k * N + n]; if (kscale) v *= kscale[k]; }
      t[ty + 4 * i][tx] = v;
    }
  }
  __syncthreads();
  {
    const int kx2 = (tid & 31) * 2, ny0 = tid >> 5;
#pragma unroll 4
    for (int i = 0; i < 8; ++i) {
      const int ny = ny0 + 8 * i;
      *(unsigned*)(WT + (size_t)(n0 + ny) * 1024 + k0 + kx2) = pack2(t[kx2][ny], t[kx2 + 1][ny]);
    }
  }
  __syncthreads();
}

DI void phase0(const Params& p, char* smem) {
  char* ws = p.ws;
  {
    float* ss = (float*)(ws + OFF_SS1);
    for (int i = blockIdx.x * kThreads + tidx(); i < 32768; i += gridDim.x * kThreads) ss[i] = 0.f;
  }
  for (int t = blockIdx.x; t < 1312; t += gridDim.x) {
    if (t < 1056) transpose_tile(p.a_w_in, 4112, 4224, p.a_norm_w, (u16*)(ws + OFF_WTA_IN), t, smem);
    else transpose_tile(p.a_w_out, 1024, 1024, nullptr, (u16*)(ws + OFF_WTA_OUT), t - 1056, smem);
  }
  const int tid0 = tidx();
  const int lane = tid0 & 63;
  const int gw = blockIdx.x * 4 + (tid0 >> 6), nw = gridDim.x * 4;
  u16* xb = (u16*)(ws + OFF_R);
  float* rs0 = (float*)(ws + OFF_RS0);
  for (int row = gw; row < 16384; row += 4 * nw) {
    f32x4 v[4][4];
#pragma unroll
    for (int k = 0; k < 4; ++k) {
      const int rr = row + k * nw;
      const f32x4* xr = (const f32x4*)(p.x + (size_t)(rr < 16384 ? rr : row) * 1024);
#pragma unroll
      for (int i = 0; i < 4; ++i) v[k][i] = __builtin_nontemporal_load(xr + lane + 64 * i);
    }
#pragma unroll
    for (int k = 0; k < 4; ++k) {
      const int rr = row + k * nw;
      float ss = 0.f;
#pragma unroll
      for (int i = 0; i < 4; ++i) ss += v[k][i][0] * v[k][i][0] + v[k][i][1] * v[k][i][1] + v[k][i][2] * v[k][i][2] + v[k][i][3] * v[k][i][3];
#pragma unroll
      for (int o = 32; o >= 1; o >>= 1) ss += __shfl_xor(ss, o);
      if (rr < 16384) {
        u32x2* xo = (u32x2*)(xb + (size_t)rr * 1024);
#pragma unroll
        for (int i = 0; i < 4; ++i) { u32x2 o = {pack2(v[k][i][0], v[k][i][1]), pack2(v[k][i][2], v[k][i][3])}; xo[lane + 64 * i] = o; }
        if (lane == 0) rs0[rr] = rsqrtf(ss * (1.f / 1024.f) + kEps);
      }
    }
  }
}

DI void phase0b(const Params& p, char* smem, int first, int nblk) {
  char* ws = p.ws;
  for (int t = (int)blockIdx.x - first; t < 1312; t += nblk) {
    if (t < 1056) transpose_tile(p.b_w_in, 4104, 4224, p.b_norm_w, (u16*)(ws + OFF_WTB_IN), t, smem);
    else transpose_tile(p.b_w_out, 1024, 1024, nullptr, (u16*)(ws + OFF_WTB_OUT), t - 1056, smem);
  }
}

template <int EPI>
DI void gemm_phase(const Params& p, const u16* __restrict__ A, const u16* __restrict__ Bt, int nTn, char* smem) {
  const int tid = tidx(), lane = tid & 63, wave = tid >> 6;
  const int wr = wave >> 1, wc = wave & 1;
  const int l15 = lane & 15, quad = lane >> 4;
  char* ws = p.ws;
  const int NX = ((gridDim.x & 7) == 0) ? 8 : 1;
  const int xg = blockIdx.x % NX, lb = blockIdx.x / NX, Lb = gridDim.x / NX;
  const int nTnG = nTn >> 3, nSuper = 16 * nTnG;
  const int srow = wave * 8 + (lane >> 3);
  const int sch = (lane & 7) ^ ((((wave & 1) << 2) + (lane >> 4)) & 7);
#define GEMM_TILE(seq_, tm_, tn_, ok_)                                                            \
  do {                                                                                            \
    const int sidx_ = xg + NX * ((seq_) >> 6);                                                    \
    ok_ = sidx_ < nSuper;                                                                         \
    const int tl_ = (seq_) & 63;                                                                  \
    tm_ = (sidx_ / nTnG) * 8 + (tl_ & 7);                                                         \
    tn_ = (sidx_ % nTnG) * 8 + (tl_ >> 3);                                                        \
  } while (0)
#define GEMM_STAGE(buf, kt)                                                                                                   \
  do {                                                                                                                        \
    _Pragma("unroll") for (int i = 0; i < 4; ++i) {                                                                           \
      __builtin_amdgcn_global_load_lds((const unsigned*)(Ag + (size_t)i * 32 * 1024 + (kt) * 64),                             \
                                       (unsigned*)(smem + (buf) * 32768 + (i * 4 + wave) * 1024), 16, 0, 0);                  \
      __builtin_amdgcn_global_load_lds((const unsigned*)(Bg + (size_t)i * 32 * 1024 + (kt) * 64),                             \
                                       (unsigned*)(smem + (buf) * 32768 + 16384 + (i * 4 + wave) * 1024), 16, 0, 0);          \
    }                                                                                                                         \
  } while (0)
  int seq = lb, tm, tn;
  bool ok;
  GEMM_TILE(seq, tm, tn, ok);
  const u16* Ag = A + (size_t)(tm * 128 + srow) * 1024 + sch * 8;
  const u16* Bg = Bt + (size_t)(tn * 128 + srow) * 1024 + sch * 8;
  if (ok) GEMM_STAGE(0, 0);
  while (ok) {
    int tm2, tn2;
    bool ok2;
    GEMM_TILE(seq + Lb, tm2, tn2, ok2);
    f32x4 acc[4][4];
#pragma unroll
    for (int a = 0; a < 4; ++a)
#pragma unroll
      for (int b = 0; b < 4; ++b) acc[a][b] = (f32x4){0.f, 0.f, 0.f, 0.f};
    asm volatile("s_waitcnt vmcnt(0)" ::: "memory");
    __syncthreads();
#pragma unroll 2
    for (int kt = 0; kt < 16; ++kt) {
      const int cur = kt & 1;
      if (kt + 1 < 16) GEMM_STAGE(cur ^ 1, kt + 1);
      else if (ok2) {
        Ag = A + (size_t)(tm2 * 128 + srow) * 1024 + sch * 8;
        Bg = Bt + (size_t)(tn2 * 128 + srow) * 1024 + sch * 8;
        GEMM_STAGE(0, 0);
      }
      const char* sa = smem + cur * 32768;
      const char* sb = sa + 16384;
#pragma unroll
      for (int ks = 0; ks < 2; ++ks) {
        bf16x8 fa[4], fb[4];
        const int ch = ks * 4 + quad;
#pragma unroll
        for (int mi = 0; mi < 4; ++mi) {
          const int row = wr * 64 + mi * 16 + l15;
          fa[mi] = *(const bf16x8*)(sa + row * 128 + ((ch ^ ((row >> 1) & 7)) << 4));
        }
#pragma unroll
        for (int ni = 0; ni < 4; ++ni) {
          const int row = wc * 64 + ni * 16 + l15;
          fb[ni] = *(const bf16x8*)(sb + row * 128 + ((ch ^ ((row >> 1) & 7)) << 4));
        }
#pragma unroll
        for (int ni = 0; ni < 4; ++ni)
#pragma unroll
          for (int mi = 0; mi < 4; ++mi) acc[ni][mi] = mfma16(fb[ni], fa[mi], acc[ni][mi]);
      }
      if (kt < 15) {
        asm volatile("s_waitcnt vmcnt(0)" ::: "memory");
        __syncthreads();
      }
    }
    float hnorm[4] = {1.f, 1.f, 1.f, 1.f};
    if constexpr (EPI == 3) {
      if (tn < 16) {
        float* part = (float*)(smem + 65536);
        float ssq[4];
#pragma unroll
        for (int mi = 0; mi < 4; ++mi) {
          const float rs = rsqrtf(((const float*)(ws + OFF_SS1))[tm * 128 + wr * 64 + mi * 16 + l15] * (1.f / 1024.f) + kEps);
          float s = 0.f;
#pragma unroll
          for (int ni = 0; ni < 4; ++ni) { const f32x4 v = acc[ni][mi] * rs; s += v[0] * v[0] + v[1] * v[1] + v[2] * v[2] + v[3] * v[3]; }
          s += __shfl_xor(s, 16);
          s += __shfl_xor(s, 32);
          ssq[mi] = s;
          if (quad == 0) part[(wr * 2 + wc) * 64 + mi * 16 + l15] = s;
        }
        __syncthreads();
#pragma unroll
        for (int mi = 0; mi < 4; ++mi) {
          const float tot = ssq[mi] + part[(wr * 2 + (wc ^ 1)) * 64 + mi * 16 + l15];
          hnorm[mi] = rsqrtf(tot * (1.f / 128.f) + kEps) * (tn < 8 ? kScale * kLog2e : 1.f);
        }
      }
    }
#pragma unroll
    for (int mi = 0; mi < 4; ++mi) {
      const int m = tm * 128 + wr * 64 + mi * 16 + l15;
      if constexpr (EPI == 1) {
        const float rs = ((const float*)(ws + OFF_RS0))[m];
        u16* proj = (u16*)(ws + OFF_PROJ);
        float* braw = (float*)(ws + OFF_BRAW);
#pragma unroll
        for (int ni = 0; ni < 4; ++ni) {
          const int nb = tn * 128 + wc * 64 + ni * 16 + quad * 4;
          f32x4 v = acc[ni][mi] * rs;
          if (nb < 4096) { u32x2 o = {pack2(v[0], v[1]), pack2(v[2], v[3])}; __builtin_nontemporal_store(o, (u32x2*)(proj + (size_t)m * 4096 + nb)); }
          else if (nb < 4112) { *(f32x4*)(braw + (size_t)m * 16 + (nb - 4096)) = v; }
        }
      } else if constexpr (EPI == 2 || EPI == 4) {
        float* ssp = (float*)(ws + (EPI == 2 ? OFF_SS1 : OFF_SS2));
        u16* hb = (u16*)(ws + OFF_R);
        float ssq = 0.f;
#pragma unroll
        for (int ni = 0; ni < 4; ++ni) {
          const int nb = tn * 128 + wc * 64 + ni * 16 + quad * 4;
          f32x4 v;
          if constexpr (EPI == 2) {
            v = acc[ni][mi] + __builtin_nontemporal_load((const f32x4*)(p.x + (size_t)m * 1024 + nb));
            u32x2 o = {pack2(v[0], v[1]), pack2(v[2], v[3])};
            *(u32x2*)(hb + (size_t)m * 1024 + nb) = o;
            v[0] = bflo(o.x); v[1] = bfhi(o.x); v[2] = bflo(o.y); v[3] = bfhi(o.y);
          } else {
            const u32x2 r = *(const u32x2*)(hb + (size_t)m * 1024 + nb);
            v = acc[ni][mi];
            v[0] += bflo(r.x); v[1] += bfhi(r.x); v[2] += bflo(r.y); v[3] += bfhi(r.y);
            const u32x2 o = {pack2(v[0], v[1]), pack2(v[2], v[3])};
            *(u32x2*)(hb + (size_t)m * 1024 + nb) = o;
            v[0] = bflo(o.x); v[1] = bfhi(o.x); v[2] = bflo(o.y); v[3] = bfhi(o.y);
          }
          ssq += v[0] * v[0] + v[1] * v[1] + v[2] * v[2] + v[3] * v[3];
        }
        ssq += __shfl_xor(ssq, 16);
        ssq += __shfl_xor(ssq, 32);
        if (quad == 0) atomicAdd(ssp + m, ssq);
      } else if constexpr (EPI == 3) {
        const float rs = rsqrtf(((const float*)(ws + OFF_SS1))[m] * (1.f / 1024.f) + kEps);
        u16* proj = (u16*)(ws + OFF_PROJ);
        u16* vT = (u16*)(ws + OFF_R + 32 * MiB);
        float* fraw = (float*)(ws + OFF_FRAW);
        float hs = 1.f;
        if (tn < 16) hs = hnorm[mi];
#pragma unroll
        for (int ni = 0; ni < 4; ++ni) {
          const int nb = tn * 128 + wc * 64 + ni * 16 + quad * 4;
          f32x4 v = acc[ni][mi] * rs;
          if (tn < 16) {
            const f32x4 wv = *(const f32x4*)((tn < 8 ? p.b_q_norm_w : p.b_k_norm_w) + (nb & 127));
            v = v * hs * wv;
          }
          if (nb < 4096) {
            if ((nb >> 10) != 2) { u32x2 o = {pack2(v[0], v[1]), pack2(v[2], v[3])}; __builtin_nontemporal_store(o, (u32x2*)(proj + (size_t)m * 4096 + nb)); }
            else {
              const int hd = nb - 2048;
              const int b = m >> 13, t = m & 8191;
              u16* dst = vT + ((size_t)(b * 1024 + hd)) * 8192 + t;
#pragma unroll
              for (int jj = 0; jj < 4; ++jj) dst[(size_t)jj * 8192] = (u16)f2bf(v[jj]);
            }
          } else if (nb < 4104) { *(f32x4*)(fraw + (size_t)m * 16 + (nb - 4096)) = v; }
        }
      }
    }
    seq += Lb; tm = tm2; tn = tn2; ok = ok2;
  }
#undef GEMM_STAGE
#undef GEMM_TILE
}


template <int MODE>
DI void skinny_gemm(const Params& p, const u16* __restrict__ A, const u16* __restrict__ Wt16, float* __restrict__ out) {
  const int tid = tidx(), lane = tid & 63, l15 = lane & 15, quad = lane >> 4;
  const int gw = blockIdx.x * 4 + (tid >> 6), nw = gridDim.x * 4;
  for (int mt = gw; mt < 1024; mt += nw) {
    const int m = mt * 16 + l15;
    const u16* ap = A + (size_t)m * 1024 + quad * 8;
    const u16* bp = Wt16 + (size_t)l15 * 1024 + quad * 8;
    f32x4 acc = {0.f, 0.f, 0.f, 0.f};
#pragma unroll 8
    for (int ks = 0; ks < 32; ++ks) acc = mfma16(*(const bf16x8*)(bp + ks * 32), *(const bf16x8*)(ap + ks * 32), acc);
    float rs;
    if constexpr (MODE == 0) rs = ((const float*)(p.ws + OFF_RS0))[m];
    else rs = rsqrtf(((const float*)(p.ws + OFF_SS1))[m] * (1.f / 1024.f) + kEps);
    *(f32x4*)(out + (size_t)m * 16 + 4 * quad) = acc * rs;
  }
}

DI void delta_prep(const Params& p, char* smem, int first, int nblk) {
  char* ws = p.ws;
  const u16* proj = (const u16*)(ws + OFF_PROJ);
  const float* braw = (const float*)(ws + OFF_BRAW);
  u16* qd_g = (u16*)(ws + OFF_R);
  u16* kT_g = (u16*)(ws + OFF_R + 32 * MiB);
  u16* at_g = (u16*)(ws + OFF_R + 64 * MiB);
  u16* uT_g = (u16*)p.out;
  u16* w_g = (u16*)((char*)p.out + 32 * MiB);
  float* gend_g = (float*)(ws + OFF_GEND);
  char* qL = smem;
  char* kL = smem + 16384;
  char* vL = smem + 32768;
  float* As = (float*)(smem + 49152);
  float* sc = (float*)(smem + 66560);
  float* g_s = sc;
  float* beta_s = sc + 64;
  float* rq_s = sc + 128;
  float* rk_s = sc + 192;
  float* ssq_s = sc + 256;
  float* fu_s = sc + 384;
  float* fw_s = sc + 448;
  const int tid_ = tidx();

  unsigned* flags = (unsigned*)(ws + OFF_FLAGS);
  const __amdgpu_buffer_rsrc_t r_qd = __builtin_amdgcn_make_buffer_rsrc(qd_g, 0, 32 << 20, 0x00020000);
  const __amdgpu_buffer_rsrc_t r_kT = __builtin_amdgcn_make_buffer_rsrc(kT_g, 0, 32 << 20, 0x00020000);
  const __amdgpu_buffer_rsrc_t r_at = __builtin_amdgcn_make_buffer_rsrc(at_g, 0, 16 << 20, 0x00020000);
  const __amdgpu_buffer_rsrc_t r_uT = __builtin_amdgcn_make_buffer_rsrc(uT_g, 0, 32 << 20, 0x00020000);
  const __amdgpu_buffer_rsrc_t r_w = __builtin_amdgcn_make_buffer_rsrc(w_g, 0, 32 << 20, 0x00020000);
  if (nblk >= 256 && ((int)blockIdx.x - first) >= (nblk >> 1)) {
    for (int i = 0; i < 7; ++i) __builtin_amdgcn_s_sleep(127);
  }
  for (int j = (int)blockIdx.x - first; j < 2048; j += nblk) {
    const int c = j >> 4, b = (j >> 3) & 1, h = j & 7;
    const int item = (b * 128 + c) * 8 + h;
    const int tok0 = b * 8192 + c * 64;
    const int tid = relaunder(tid_), lane = tid & 63, wave = tid >> 6, l15 = lane & 15, quad = lane >> 4;
    if (wave == 3) {
      const int row = tok0 + lane;
      const float br = braw[(size_t)row * 16 + h];
      const float ar = braw[(size_t)row * 16 + 8 + h] + p.a_dt_bias[h];
      const float beta = 1.f / (1.f + __expf(-br));
      const float sp = fmaxf(ar, 0.f) + log1pf(__expf(-fabsf(ar)));
      float g = -__expf(p.a_A_log[h]) * sp;
#pragma unroll
      for (int o = 1; o < 64; o <<= 1) { float t = __shfl_up(g, o); if (lane >= o) g += t; }
      g_s[lane] = g;
      beta_s[lane] = beta;
    } else {
      const int sec = wave, cgi = l15, rr = quad;
      const int col = sec * 1024 + h * 128 + cgi * 8;
      float w0[8], w1[8], w2[8], w3[8];
#pragma unroll
      for (int e = 0; e < 8; ++e) {
        w0[e] = p.a_conv_w[0 * 3072 + col + e]; w1[e] = p.a_conv_w[1 * 3072 + col + e];
        w2[e] = p.a_conv_w[2 * 3072 + col + e]; w3[e] = p.a_conv_w[3 * 3072 + col + e];
      }
      const u16* src = proj + (size_t)(tok0 + rr * 16) * 4096 + col;
      float x0[8], x1[8], x2[8], x3[8];
      if (c == 0 && rr == 0) {
#pragma unroll
        for (int e = 0; e < 8; ++e) { x0[e] = 0.f; x1[e] = 0.f; x2[e] = 0.f; }
      } else {
        unpack8(*(const u32x4*)(src - 3 * 4096), x0);
        unpack8(*(const u32x4*)(src - 2 * 4096), x1);
        unpack8(*(const u32x4*)(src - 1 * 4096), x2);
      }
      char* dstL = smem + sec * 16384;
#pragma unroll 4
      for (int r = 0; r < 16; ++r) {
        unpack8(*(const u32x4*)(src + (size_t)r * 4096), x3);
        float y[8];
        float ssq = 0.f;
#pragma unroll
        for (int e = 0; e < 8; ++e) {
          float v = w0[e] * x0[e] + w1[e] * x1[e] + w2[e] * x2[e] + w3[e] * x3[e];
          v = silu(v);
          y[e] = v;
          ssq += v * v;
          x0[e] = x1[e]; x1[e] = x2[e]; x2[e] = x3[e];
        }
        ssq += __shfl_xor(ssq, 1); ssq += __shfl_xor(ssq, 2); ssq += __shfl_xor(ssq, 4); ssq += __shfl_xor(ssq, 8);
        const int row = rr * 16 + r;
        if (sec < 2 && cgi == 0) ssq_s[sec * 64 + row] = ssq;
        *(u32x4*)(dstL + row * 256 + ((cgi ^ (row & 15)) << 4)) = packf8(y);
      }
    }
    __syncthreads();
    if (tid < 64) {
      const float rq = rsqrtf(ssq_s[tid] + kEps), rk = rsqrtf(ssq_s[64 + tid] + kEps);
      const float gi = g_s[tid], g63 = g_s[63];
      const float eg = __expf(gi);
      rq_s[tid] = rq; rk_s[tid] = rk;
      const float be = beta_s[tid];
      fu_s[tid] = be;
      fw_s[tid] = be * rk * eg;
      ssq_s[tid] = rq * kScale * eg;
      ssq_s[64 + tid] = rk * __expf(g63 - gi);
      if (tid == 0) __hip_atomic_store(gend_g + item, __expf(g63), __ATOMIC_RELAXED, __HIP_MEMORY_SCOPE_AGENT);
    }
    __syncthreads();
    {
      const int tid = relaunder(tid_), lane = tid & 63, wave = tid >> 6, l15 = lane & 15, quad = lane >> 4;
      bf16x8 bk[4], bq[4];
      const int rowI = 16 * wave + l15;
#pragma unroll
      for (int ks = 0; ks < 4; ++ks) {
        const int off = rowI * 256 + (((ks * 4 + quad) ^ (rowI & 15)) << 4);
        bk[ks] = *(const bf16x8*)(kL + off);
        bq[ks] = *(const bf16x8*)(qL + off);
      }
      const int i = rowI;
      const float gi = g_s[i], bi = beta_s[i] * rk_s[i], qi = kScale * rq_s[i];
      u32x2 keep = {0u, 0u};
#pragma unroll
      for (int J = 0; J < 4; ++J) {
        f32x4 skk = {0.f, 0.f, 0.f, 0.f}, sqk = {0.f, 0.f, 0.f, 0.f};
        const int rowJ = 16 * J + l15;
#pragma unroll
        for (int ks = 0; ks < 4; ++ks) {
          const bf16x8 ak = *(const bf16x8*)(kL + rowJ * 256 + (((ks * 4 + quad) ^ (rowJ & 15)) << 4));
          skk = mfma16(ak, bk[ks], skk);
          sqk = mfma16(ak, bq[ks], sqk);
        }
        const f32x4 gj4 = *(const f32x4*)(g_s + 16 * J + 4 * quad);
        const f32x4 rk4 = *(const f32x4*)(rk_s + 16 * J + 4 * quad);
        f32x4 a4, t4;
#pragma unroll
        for (int jj = 0; jj < 4; ++jj) {
          const int j = 16 * J + 4 * quad + jj;
          const float dec = (i >= j) ? __expf(gi - gj4[jj]) : 0.f;
          a4[jj] = (i > j) ? bi * rk4[jj] * skk[jj] * dec : 0.f;
          t4[jj] = qi * rk4[jj] * sqk[jj] * dec;
        }
        *(f32x4*)(As + i * 68 + 16 * J + 4 * quad) = a4;
        const u32x2 half = {pack2(t4[0], t4[1]), pack2(t4[2], t4[3])};
        if ((J & 1) == 0) keep = half;
        else {
          const u32x4 fr = {keep.x, keep.y, half.x, half.y};
          __builtin_amdgcn_raw_buffer_store_b128(fr, r_at, item * 8192 + ((wave * 2 + (J >> 1)) * 64 + lane) * 16, 0, 16);
        }
      }
    }
    {
      const int tid = relaunder(tid_);
#pragma unroll
      for (int it = 0; it < 4; ++it) {
        const int idx = tid + 256 * it;
        const int f = idx >> 6, ln = idx & 63, fl = ln & 15, fq = ln >> 4;
        {
          const int mt = f >> 2, ks = f & 3, i = 16 * mt + fl;
          const int c0 = 4 * ks + (fq >> 1), o8 = (fq & 1) * 8;
          const u32x2 lo = *(const u32x2*)(qL + i * 256 + ((c0 ^ (i & 15)) << 4) + o8);
          const u32x2 hi = *(const u32x2*)(qL + i * 256 + (((c0 + 2) ^ (i & 15)) << 4) + o8);
          const float s = ssq_s[i];
          const u32x4 o = {pack2(bflo(lo.x) * s, bfhi(lo.x) * s), pack2(bflo(lo.y) * s, bfhi(lo.y) * s),
                           pack2(bflo(hi.x) * s, bfhi(hi.x) * s), pack2(bflo(hi.y) * s, bfhi(hi.y) * s)};
          __builtin_amdgcn_raw_buffer_store_b128(o, r_qd, item * 16384 + idx * 16, 0, 16);
        }
        {
          const int mt = f >> 1, ks = f & 1, dk = 16 * mt + fl;
          float v[8];
#pragma unroll
          for (int e = 0; e < 8; ++e) {
            const int i = 32 * ks + ((e < 4) ? (4 * fq + e) : (16 + 4 * fq + e - 4));
            const u16 raw = *(const u16*)(kL + i * 256 + (((dk >> 3) ^ (i & 15)) << 4) + (dk & 7) * 2);
            v[e] = __uint_as_float(((unsigned)raw) << 16) * ssq_s[64 + i];
          }
          __builtin_amdgcn_raw_buffer_store_b128(packf8(v), r_kT, item * 16384 + idx * 16, 0, 16);
        }
      }
    }
    __syncthreads();
    {
      float U[64];
      const int tid = relaunder(tid_), wave = tid >> 6;
      const int cc = tid & 127, ch = cc >> 3, e2 = (cc & 7) * 2;
      const char* srcL = (wave < 2) ? vL : kL;
      const float* fr = (wave < 2) ? fu_s : fw_s;
#pragma unroll
      for (int i = 0; i < 64; ++i) {
        int ii = i;
        asm volatile("" : "+v"(ii));
        const u16 raw = *(const u16*)(srcL + ii * 256 + ((ch ^ (ii & 15)) << 4) + e2);
        float acc = __uint_as_float(((unsigned)raw) << 16) * fr[ii];
#pragma unroll
        for (int j = 0; j < i; ++j) acc -= As[i * 68 + j] * U[j];
        U[i] = acc;
      }
      if (wave < 2) {
        const int dofs = item * 16384 + (((cc >> 4) * 4) * 256 + (cc & 15) * 4) * 2;
#pragma unroll
        for (int mi = 0; mi < 4; ++mi)
#pragma unroll
          for (int q4 = 0; q4 < 4; ++q4) {
            const u32x2 o = {pack2(U[16 * mi + 4 * q4], U[16 * mi + 4 * q4 + 1]), pack2(U[16 * mi + 4 * q4 + 2], U[16 * mi + 4 * q4 + 3])};
            __builtin_amdgcn_raw_buffer_store_b64(o, r_uT, dofs + (mi * 256 + q4 * 64) * 2, 0, 16);
          }
      } else {
#pragma unroll
        for (int i = 0; i < 64; ++i) {
          int ii = i;
          asm volatile("" : "+v"(ii));
          *(u16*)(qL + ii * 256 + ((ch ^ (ii & 15)) << 4) + e2) = (u16)f2bf(U[i]);
        }
      }
    }
    __syncthreads();
    {
      const int tid = relaunder(tid_);
#pragma unroll
      for (int it = 0; it < 4; ++it) {
        const int idx = tid + 256 * it;
        const int f = idx >> 6, ln = idx & 63, fl = ln & 15, fq = ln >> 4;
        const int mt = f >> 2, ks = f & 3, i = 16 * mt + fl;
        const int c0 = 4 * ks + (fq >> 1), o8 = (fq & 1) * 8;
        const u32x2 lo = *(const u32x2*)(qL + i * 256 + ((c0 ^ (i & 15)) << 4) + o8);
        const u32x2 hi = *(const u32x2*)(qL + i * 256 + (((c0 + 2) ^ (i & 15)) << 4) + o8);
        const u32x4 o = {lo.x, lo.y, hi.x, hi.y};
        __builtin_amdgcn_raw_buffer_store_b128(o, r_w, item * 16384 + idx * 16, 0, 16);
      }
    }
    asm volatile("s_waitcnt vmcnt(0)" ::: "memory");
    __syncthreads();
    if (relaunder(tid_) == 0) __hip_atomic_store(flags + item, 1u, __ATOMIC_RELAXED, __HIP_MEMORY_SCOPE_AGENT);
  }
}

#define RAW_BARRIER() do { asm volatile("s_waitcnt lgkmcnt(0)" ::: "memory"); __builtin_amdgcn_s_barrier(); asm volatile("" ::: "memory"); } while (0)
#define GAS __attribute__((address_space(1)))
#define SCAN_LOAD(item_)                                                                                          \
  do {                                                                                                            \
    const GAS char* wb_ = (const GAS char*)((const char*)w_g + (size_t)(item_) * 16384);                          \
    const GAS char* qb_ = (const GAS char*)((const char*)qd_g + (size_t)(item_) * 16384);                         \
    const GAS char* kb_ = (const GAS char*)((const char*)kT_g + (size_t)(item_) * 16384);                         \
    const GAS char* ab_ = (const GAS char*)((const char*)at_g + (size_t)(item_) * 8192);                          \
    const GAS char* ub_ = (const GAS char*)((const char*)uT_g + (size_t)(item_) * 16384);                         \
    asm volatile("" : "+s"(wb_), "+s"(qb_), "+s"(kb_), "+s"(ab_), "+s"(ub_));                                     \
    _Pragma("unroll") for (int j = 0; j < 4; ++j) {                                                               \
      R[j] = *(const GAS u32x4*)(wb_ + (toff + 4096u * j));                                                       \
      R[4 + j] = *(const GAS u32x4*)(qb_ + (toff + 4096u * j));                                                   \
      R[8 + j] = *(const GAS u32x4*)(kb_ + (toff + 4096u * j));                                                   \
    }                                                                                                             \
    _Pragma("unroll") for (int j = 0; j < 2; ++j) R[12 + j] = *(const GAS u32x4*)(ab_ + (toff + 4096u * j));     \
    _Pragma("unroll") for (int mi = 0; mi < 4; ++mi) un[mi] = *(const GAS u32x2*)(ub_ + (uoff + 512u * mi));     \
    gn = gend_g[item_];                                                                                           \
  } while (0)
DI void delta_scan(const Params& p, char* smem) {
  char* ws = p.ws;
  const u16* qd_g = (const u16*)(ws + OFF_R);
  const u16* kT_g = (const u16*)(ws + OFF_R + 32 * MiB);
  const u16* at_g = (const u16*)(ws + OFF_R + 64 * MiB);
  const u16* uT_g = (const u16*)p.out;
  const u16* w_g = (const u16*)((const char*)p.out + 32 * MiB);
  const float* gend_g = (const float*)(ws + OFF_GEND);
  u16* o_g = (u16*)(ws + OFF_PROJ);
  unsigned* flags = (unsigned*)(ws + OFF_FLAGS);
  const int tid = tidx(), lane = tid & 63, wave = tid >> 6, l15 = lane & 15, quad = lane >> 4;
  char* Lw = smem;
  char* Lq = smem + 16384;
  char* Lk = smem + 32768;
  char* La = smem + 49152;
  char* Lo = smem + 57344;
  for (int unit = blockIdx.x; unit < 32; unit += gridDim.x) {
    const int bh = unit & 15, half = unit >> 4, b = bh >> 3, h = bh & 7;
    const int slice = half * 4 + wave;
    f32x4 S[8];
#pragma unroll
    for (int i = 0; i < 8; ++i) S[i] = (f32x4){0.f, 0.f, 0.f, 0.f};
    const unsigned toff = (unsigned)tid * 16u, uoff = (unsigned)(slice * 256 + lane) * 8u;
    u32x4 R[14];
    u32x2 un[4];
    float gn;
#define SCAN_WAIT(flv_, item_)                                                                                         \
  do {                                                                                                                 \
    unsigned f_ = (flv_), sp_ = 0u;                                                                                    \
    while (f_ == 0u && sp_ < (1u << 24)) { __builtin_amdgcn_s_sleep(2); f_ = __hip_atomic_load(flags + (item_), __ATOMIC_RELAXED, __HIP_MEMORY_SCOPE_AGENT); ++sp_; } \
    __builtin_amdgcn_fence(__ATOMIC_ACQUIRE, "workgroup");           \
  } while (0)
    unsigned fl;
    {
      const int item = (b * 128) * 8 + h;
      SCAN_WAIT(0u, item);
      SCAN_LOAD(item);
      fl = __hip_atomic_load(flags + ((b * 128 + 1) * 8 + h), __ATOMIC_RELAXED, __HIP_MEMORY_SCOPE_AGENT);
    }
    for (int c = 0; c < 128; ++c) {
#pragma unroll
      for (int j = 0; j < 4; ++j) {
        *(u32x4*)(Lw + (tid + 256 * j) * 16) = R[j];
        *(u32x4*)(Lq + (tid + 256 * j) * 16) = R[4 + j];
        *(u32x4*)(Lk + (tid + 256 * j) * 16) = R[8 + j];
      }
#pragma unroll
      for (int j = 0; j < 2; ++j) *(u32x4*)(La + (tid + 256 * j) * 16) = R[12 + j];
      u32x2 uc[4];
#pragma unroll
      for (int mi = 0; mi < 4; ++mi) uc[mi] = un[mi];
      const float gend = gn;
      RAW_BARRIER();
      if (c + 1 < 128) SCAN_WAIT(fl, (b * 128 + c + 1) * 8 + h);
      if (c > 0) {
        const int tokp = b * 8192 + (c - 1) * 64;
#pragma unroll
        for (int k2 = 0; k2 < 2; ++k2) {
          const int idx = tid + 256 * k2, row = idx >> 3, part = idx & 7;
          *(u32x4*)(o_g + (size_t)(tokp + row) * 4096 + h * 128 + half * 64 + part * 8) = *(const u32x4*)(Lo + idx * 16);
        }
      }
      if (c + 1 < 128) {
        const int item = (b * 128 + c + 1) * 8 + h;
        SCAN_LOAD(item);
        fl = (c + 2 < 128) ? __hip_atomic_load(flags + (item + 8), __ATOMIC_RELAXED, __HIP_MEMORY_SCOPE_AGENT) : 1u;
      }
      __builtin_amdgcn_sched_barrier(0);
      bf16x8 bS[4];
#pragma unroll
      for (int ks = 0; ks < 4; ++ks) bS[ks] = pack8(S[2 * ks], S[2 * ks + 1]);
      bf16x8 fr[16];
#pragma unroll
      for (int i = 0; i < 16; ++i) fr[i] = *(const bf16x8*)(Lw + (i * 64 + lane) * 16);
      __builtin_amdgcn_sched_barrier(0);
      f32x4 vn[4];
#pragma unroll
      for (int mi = 0; mi < 4; ++mi) vn[mi] = (f32x4){0.f, 0.f, 0.f, 0.f};
#pragma unroll
      for (int ks = 0; ks < 4; ++ks)
#pragma unroll
        for (int mi = 0; mi < 4; ++mi) vn[mi] = mfma16(fr[mi * 4 + ks], bS[ks], vn[mi]);
      __builtin_amdgcn_sched_barrier(0);
#pragma unroll
      for (int i = 0; i < 16; ++i) fr[i] = *(const bf16x8*)(Lk + (i * 64 + lane) * 16);
#pragma unroll
      for (int mi = 0; mi < 4; ++mi) {
        vn[mi][0] = bflo(uc[mi].x) - vn[mi][0]; vn[mi][1] = bfhi(uc[mi].x) - vn[mi][1];
        vn[mi][2] = bflo(uc[mi].y) - vn[mi][2]; vn[mi][3] = bfhi(uc[mi].y) - vn[mi][3];
      }
      bf16x8 bV[2];
      bV[0] = pack8(vn[0], vn[1]);
      bV[1] = pack8(vn[2], vn[3]);
#pragma unroll
      for (int mt = 0; mt < 8; ++mt) S[mt] = S[mt] * gend;
      __builtin_amdgcn_sched_barrier(0);
#pragma unroll
      for (int ks = 0; ks < 2; ++ks)
#pragma unroll
        for (int mt = 0; mt < 8; ++mt) S[mt] = mfma16(fr[mt * 2 + ks], bV[ks], S[mt]);
      __builtin_amdgcn_sched_barrier(0);
#pragma unroll
      for (int i = 0; i < 16; ++i) fr[i] = *(const bf16x8*)(Lq + (i * 64 + lane) * 16);
      __builtin_amdgcn_sched_barrier(0);
      f32x4 oacc[4];
#pragma unroll
      for (int mi = 0; mi < 4; ++mi) oacc[mi] = (f32x4){0.f, 0.f, 0.f, 0.f};
#pragma unroll
      for (int ks = 0; ks < 4; ++ks)
#pragma unroll
        for (int mi = 0; mi < 4; ++mi) oacc[mi] = mfma16(fr[mi * 4 + ks], bS[ks], oacc[mi]);
      __builtin_amdgcn_sched_barrier(0);
#pragma unroll
      for (int i = 0; i < 8; ++i) fr[i] = *(const bf16x8*)(La + (i * 64 + lane) * 16);
      __builtin_amdgcn_sched_barrier(0);
#pragma unroll
      for (int ks = 0; ks < 2; ++ks)
#pragma unroll
        for (int mi = 0; mi < 4; ++mi) oacc[mi] = mfma16(fr[mi * 2 + ks], bV[ks], oacc[mi]);
      __builtin_amdgcn_sched_barrier(0);
#pragma unroll
      for (int mi = 0; mi < 4; ++mi)
#pragma unroll
        for (int jj = 0; jj < 4; ++jj)
          *(u16*)(Lo + (16 * mi + 4 * quad + jj) * 128 + (wave * 16 + l15) * 2) = (u16)f2bf(oacc[mi][jj]);
      RAW_BARRIER();
    }
    {
      const int tokp = b * 8192 + 127 * 64;
#pragma unroll
      for (int k2 = 0; k2 < 2; ++k2) {
        const int idx = tid + 256 * k2, row = idx >> 3, part = idx & 7;
        *(u32x4*)(o_g + (size_t)(tokp + row) * 4096 + h * 128 + half * 64 + part * 8) = *(const u32x4*)(Lo + idx * 16);
      }
      RAW_BARRIER();
    }
  }
}

#undef SCAN_LOAD
#undef SCAN_WAIT

DI void gate_phase(const Params& p) {
  char* ws = p.ws;
  const u16* proj = (const u16*)(ws + OFF_PROJ);
  u16* y0 = (u16*)(ws + OFF_R + 32 * MiB);
  const int tidg = tidx();
  const int lane = tidg & 63, l15 = lane & 15, quad = lane >> 4;
  const int gw = blockIdx.x * 4 + (tidg >> 6), nw = gridDim.x * 4;
  float wn[8];
#pragma unroll
  for (int e = 0; e < 8; ++e) wn[e] = p.a_o_norm_w[l15 * 8 + e];
  for (int r4 = gw; r4 < 32768; r4 += nw) {
    const int rh = r4 * 4 + quad, tok = rh >> 3, h = rh & 7;
    float o[8], z[8];
    unpack8(*(const u32x4*)(proj + (size_t)tok * 4096 + h * 128 + l15 * 8), o);
    unpack8(*(const u32x4*)(proj + (size_t)tok * 4096 + 3072 + h * 128 + l15 * 8), z);
    float ssq = 0.f;
#pragma unroll
    for (int e = 0; e < 8; ++e) ssq += o[e] * o[e];
    ssq += __shfl_xor(ssq, 1); ssq += __shfl_xor(ssq, 2); ssq += __shfl_xor(ssq, 4); ssq += __shfl_xor(ssq, 8);
    const float rs = rsqrtf(ssq * (1.f / 128.f) + kEps);
#pragma unroll
    for (int e = 0; e < 8; ++e) o[e] = o[e] * rs * wn[e] * silu(z[e]);
    *(u32x4*)(y0 + (size_t)tok * 1024 + h * 128 + l15 * 8) = packf8(o);
  }
}

DI void qknorm_cumsum(const Params& p, char* smem) {
  char* ws = p.ws;
  u16* proj = (u16*)(ws + OFF_PROJ);
  const int tid = tidx(), lane = tid & 63, l15 = lane & 15, quad = lane >> 4;
  const int gw = blockIdx.x * 4 + (tid >> 6), nw = gridDim.x * 4;
  for (int idx = gw; idx < 65536; idx += nw) {
    const int which = idx >> 15, r4 = idx & 32767;
    const int rh = r4 * 4 + quad, tok = rh >> 3, h = rh & 7;
    const float* wv = which ? p.b_k_norm_w : p.b_q_norm_w;
    u16* ptr = proj + (size_t)tok * 4096 + which * 1024 + h * 128 + l15 * 8;
    float v[8];
    unpack8(*(const u32x4*)ptr, v);
    float ssq = 0.f;
#pragma unroll
    for (int e = 0; e < 8; ++e) ssq += v[e] * v[e];
    ssq += __shfl_xor(ssq, 1); ssq += __shfl_xor(ssq, 2); ssq += __shfl_xor(ssq, 4); ssq += __shfl_xor(ssq, 8);
    const float rs = rsqrtf(ssq * (1.f / 128.f) + kEps) * (which ? 1.f : kScale);
#pragma unroll
    for (int e = 0; e < 8; ++e) v[e] = v[e] * rs * wv[l15 * 8 + e];
    *(u32x4*)ptr = packf8(v);
  }
}

DI void attn_phase(const Params& p, char* smem) {
  char* ws = p.ws;
  const u16* proj = (const u16*)(ws + OFF_PROJ);
  const u16* vT = (const u16*)(ws + OFF_R + 32 * MiB);
  const float* fraw = (const float*)(ws + OFF_FRAW);
  u16* y1 = (u16*)(ws + OFF_R + 64 * MiB);
  float* bias_s = (float*)(smem + 65536);
  float* ca_s = bias_s + 128;
  const int tid_ = tidx();
  float mq = 0.f, mk = 0.f;
  for (int i = 0; i < 128; ++i) { mq = fmaxf(mq, fabsf(p.b_q_norm_w[i])); mk = fmaxf(mk, fabsf(p.b_k_norm_w[i])); }
  const float QKB = 128.f * kScale * mq * mk;
  float* mmin_s = (float*)(smem + 66320);

  unsigned* qctr = (unsigned*)(ws + OFF_BAR) + XCD_BAR_WORDS;
  int* qslot = (int*)(smem + 66304);
  int qx = blockIdx.x & 7, qtries = 0;
  while (true) {
    const int tid = relaunder(tid_), lane = tid & 63, wave = tid >> 6, l15 = lane & 15, quad = lane >> 4;
    if (tid == 0) *qslot = (int)atomicAdd(qctr + qx * 16, 1u);
    __syncthreads();
    const int it = *qslot;
    __syncthreads();
    if (it >= 128) { if (++qtries >= 8) break; qx = (qx + 1) & 7; continue; }
    const int qb = 63 - (it & 63);
    const int b = it >> 6, h = b ? ((qx + 4) & 7) : qx, bh = b * 8 + h, i0 = qb * 128;
    const int qrow0 = i0 + 32 * wave;
    const float fb = p.b_f_bias[h];
    bf16x8 bq[2][4];
#pragma unroll
    for (int nq = 0; nq < 2; ++nq)
#pragma unroll
      for (int ks = 0; ks < 4; ++ks)
        bq[nq][ks] = *(const bf16x8*)(proj + (size_t)(b * 8192 + qrow0 + 16 * nq + l15) * 4096 + h * 128 + 32 * ks + 8 * quad);
    f32x4 O[8][2];
#pragma unroll
    for (int dt = 0; dt < 8; ++dt) { O[dt][0] = (f32x4){0.f, 0.f, 0.f, 0.f}; O[dt][1] = (f32x4){0.f, 0.f, 0.f, 0.f}; }
    float mrun[2] = {-1e30f, -1e30f}, lrun[2] = {0.f, 0.f};

    const int kkey = wave * 4 + (lane >> 4);
    const int kch = (lane & 15) ^ (kkey & 15);
    const u16* Kg = proj + (size_t)(b * 8192 + kkey) * 4096 + 1024 + h * 128 + kch * 8;
    const int vd = wave * 8 + (lane >> 3);
    const int vch = (lane & 7) ^ ((((wave & 1) << 2) + (lane >> 4)) & 7);
    const u16* Vg = vT + (size_t)(bh * 128 + vd) * 8192 + vch * 8;
#define ATT_STAGE(buf, j0_)                                                                                                   \
  do {                                                                                                                        \
    _Pragma("unroll") for (int i = 0; i < 4; ++i) {                                                                           \
      __builtin_amdgcn_global_load_lds((const unsigned*)(Kg + (size_t)((j0_) + 16 * i) * 4096),                               \
                                       (unsigned*)(smem + (buf) * 32768 + (i * 4 + wave) * 1024), 16, 0, 0);                  \
      __builtin_amdgcn_global_load_lds((const unsigned*)(Vg + (size_t)(32 * i) * 8192 + (j0_)),                               \
                                       (unsigned*)(smem + (buf) * 32768 + 16384 + (i * 4 + wave) * 1024), 16, 0, 0);          \
    }                                                                                                                         \
  } while (0)
    int j0 = i0 + 64;
    ATT_STAGE(0, j0);
    float carry = 0.f, biasA = 0.f, frn = 0.f;
    if (wave == 0) {
      const float xa = fraw[(size_t)(b * 8192 + i0 + lane) * 16 + h] + fb;
      const float xb2 = fraw[(size_t)(b * 8192 + i0 + 64 + lane) * 16 + h] + fb;
      const float lfA = fminf(xa, 0.f) - log1pf(__expf(-fabsf(xa)));
      const float lfB = fminf(xb2, 0.f) - log1pf(__expf(-fabsf(xb2)));
      float pa = lfA, pb = lfB;
#pragma unroll
      for (int o = 1; o < 64; o <<= 1) {
        const float ta = __shfl_up(pa, o), tb = __shfl_up(pb, o);
        if (lane >= o) { pa += ta; pb += tb; }
      }
      const float lf0 = __shfl(lfA, 0), totA = __shfl(pa, 63);
      biasA = -(pa - lf0) * kLog2e;
      bias_s[lane] = -(totA - lf0 + pb) * kLog2e;
      carry = lf0;
    }
    if (lane == 0) { mmin_s[wave] = -1e30f; mmin_s[4 + wave] = -1e30f; }
    asm volatile("s_waitcnt vmcnt(0)" ::: "memory");
    __syncthreads();
    int cur = 0;
    while (true) {
      const int nj = j0 - 64;
      bool more = nj >= 0;
      if (more && j0 <= i0) {
        const float* mm = mmin_s + cur * 4;
        const float mmin = fminf(fminf(mm[0], mm[1]), fminf(mm[2], mm[3]));
        more = !((QKB + ca_s[cur]) * kLog2e < mmin - 30.f * kLog2e);
      }
      if (more) {
        ATT_STAGE(cur ^ 1, nj);
        if (wave == 0 && nj < i0) frn = fraw[(size_t)(b * 8192 + nj + lane) * 16 + h];
      }
      if (j0 <= qrow0 + 31) {
        const char* Ks = smem + cur * 32768;
        const char* Vs = Ks + 16384;
        const float* cs = bias_s + cur * 64;
        f32x4 s[4][2];
#pragma unroll
        for (int kt = 0; kt < 4; ++kt) { s[kt][0] = (f32x4){0.f, 0.f, 0.f, 0.f}; s[kt][1] = (f32x4){0.f, 0.f, 0.f, 0.f}; }
#pragma unroll
        for (int ks = 0; ks < 4; ++ks)
#pragma unroll
          for (int kt = 0; kt < 4; ++kt) {
            const int kl = 16 * kt + l15;
            const bf16x8 ak = *(const bf16x8*)(Ks + kl * 256 + (((ks * 4 + quad) ^ (kl & 15)) << 4));
            s[kt][0] = mfma16(ak, bq[0][ks], s[kt][0]);
            s[kt][1] = mfma16(ak, bq[1][ks], s[kt][1]);
          }
        const bool diag = (j0 >= i0);
#pragma unroll
        for (int kt = 0; kt < 4; ++kt) {
          const f32x4 bias = *(const f32x4*)(cs + 16 * kt + 4 * quad);
#pragma unroll
          for (int nq = 0; nq < 2; ++nq)
#pragma unroll
            for (int jj = 0; jj < 4; ++jj) {
              float v = s[kt][nq][jj] + bias[jj];
              if (diag) { if (j0 + 16 * kt + 4 * quad + jj > qrow0 + 16 * nq + l15) v = -1e30f; }
              s[kt][nq][jj] = v;
            }
        }
        bf16x8 bP[2][2];
#pragma unroll
        for (int nq = 0; nq < 2; ++nq) {
          float tmax = -1e30f;
#pragma unroll
          for (int kt = 0; kt < 4; ++kt)
#pragma unroll
            for (int jj = 0; jj < 4; ++jj) tmax = fmaxf(tmax, s[kt][nq][jj]);
          tmax = fmaxf(tmax, __shfl_xor(tmax, 16));
          tmax = fmaxf(tmax, __shfl_xor(tmax, 32));
          const float mnew = fmaxf(mrun[nq], tmax);
          const float alpha = __builtin_amdgcn_exp2f(mrun[nq] - mnew);
          const bool grew = mnew > mrun[nq];
          mrun[nq] = mnew;
          float psum = 0.f;
#pragma unroll
          for (int kt = 0; kt < 4; ++kt)
#pragma unroll
            for (int jj = 0; jj < 4; ++jj) { const float pv = __builtin_amdgcn_exp2f(s[kt][nq][jj] - mnew); s[kt][nq][jj] = pv; psum += pv; }
          lrun[nq] = lrun[nq] * alpha + psum;
          if (__builtin_amdgcn_ballot_w64(grew) != 0ull) {
#pragma unroll
            for (int dt = 0; dt < 8; ++dt) O[dt][nq] = O[dt][nq] * alpha;
          }
          bP[0][nq] = pack8(s[0][nq], s[1][nq]);
          bP[1][nq] = pack8(s[2][nq], s[3][nq]);
        }
#pragma unroll
        for (int ks = 0; ks < 2; ++ks)
#pragma unroll
          for (int dt = 0; dt < 8; ++dt) {
            const int d = 16 * dt + l15, sw = (d >> 1) & 7, c0 = 4 * ks + (quad >> 1);
            const u32x2 lo = *(const u32x2*)(Vs + d * 128 + ((c0 ^ sw) << 4) + (quad & 1) * 8);
            const u32x2 hi = *(const u32x2*)(Vs + d * 128 + (((c0 + 2) ^ sw) << 4) + (quad & 1) * 8);
            const bf16x8 av = mk8(lo, hi);
            O[dt][0] = mfma16(av, bP[ks][0], O[dt][0]);
            O[dt][1] = mfma16(av, bP[ks][1], O[dt][1]);
          }
        float wm = fminf(mrun[0], mrun[1]);
#pragma unroll
        for (int o = 1; o < 64; o <<= 1) wm = fminf(wm, __shfl_xor(wm, o));
        if (lane == 0) mmin_s[(cur ^ 1) * 4 + wave] = wm;
      }
      if (more && wave == 0) {
        const int nb = cur ^ 1;
        if (nj == i0) {
          bias_s[nb * 64 + lane] = biasA;
          if (lane == 0) ca_s[nb] = carry;
        } else {
          const float xv = frn + fb;
          const float lf = fminf(xv, 0.f) - log1pf(__expf(-fabsf(xv)));
          float sf = lf;
#pragma unroll
          for (int o = 1; o < 64; o <<= 1) { const float t = __shfl_down(sf, o); if (lane + o < 64) sf += t; }
          bias_s[nb * 64 + lane] = (sf - lf + carry) * kLog2e;
          carry += __shfl(sf, 0);
          if (lane == 0) ca_s[nb] = carry;
        }
      }
      asm volatile("s_waitcnt vmcnt(0)" ::: "memory");
      __syncthreads();
      if (!more) break;
      j0 = nj;
      cur ^= 1;
    }
#undef ATT_STAGE
#pragma unroll
    for (int nq = 0; nq < 2; ++nq) {
      float l = lrun[nq];
      l += __shfl_xor(l, 16);
      l += __shfl_xor(l, 32);
      const float inv = 1.f / l;
      const size_t tok = (size_t)(b * 8192 + qrow0 + 16 * nq + l15);
#pragma unroll
      for (int dt = 0; dt < 8; ++dt) {
        const int d = 16 * dt + 4 * quad;
        const u32x2 z2 = *(const u32x2*)(proj + tok * 4096 + 3072 + h * 128 + d);
        const f32x4 o = O[dt][nq] * inv;
        u32x2 r = {pack2(o[0] * silu(bflo(z2.x)), o[1] * silu(bfhi(z2.x))), pack2(o[2] * silu(bflo(z2.y)), o[3] * silu(bfhi(z2.y)))};
        *(u32x2*)(y1 + tok * 1024 + h * 128 + d) = r;
      }
    }
  }
}

DI void final_norm(const Params& p) {
  const float* ss2 = (const float*)(p.ws + OFF_SS2);
  const int tidf = tidx();
  const int lane = tidf & 63;
  const int gw = blockIdx.x * 4 + (tidf >> 6), nw = gridDim.x * 4;
  const f32x4* w = (const f32x4*)p.final_norm_w;
  f32x4 wv[4];
#pragma unroll
  for (int i = 0; i < 4; ++i) wv[i] = w[lane + 64 * i];
  for (int row = gw; row < 16384; row += 4 * nw) {
    u32x2 r[4][4];
    float rs[4];
#pragma unroll
    for (int k = 0; k < 4; ++k) {
      const int rr = row + k * nw;
      const bool okr = rr < 16384;
      const int rc = okr ? rr : row;
      rs[k] = rsqrtf(ss2[rc] * (1.f / 1024.f) + kEps);
      const u32x2* hsrc = (const u32x2*)((const u16*)(p.ws + OFF_R) + (size_t)rc * 1024);
#pragma unroll
      for (int i = 0; i < 4; ++i) r[k][i] = hsrc[lane + 64 * i];
    }
#pragma unroll
    for (int k = 0; k < 4; ++k) {
      const int rr = row + k * nw;
      if (rr < 16384) {
        f32x4* o = (f32x4*)(p.out + (size_t)rr * 1024);
#pragma unroll
        for (int i = 0; i < 4; ++i) {
          f32x4 v = {bflo(r[k][i].x), bfhi(r[k][i].x), bflo(r[k][i].y), bfhi(r[k][i].y)};
          __builtin_nontemporal_store(v * rs[k] * wv[i], o + lane + 64 * i);
        }
      }
    }
  }
}

__global__ void __launch_bounds__(kThreads, 2) fwd_megakernel(Params p) {
  extern __shared__ __attribute__((aligned(16))) char smem[];
  cg::grid_group grid = cg::this_grid();
  char* ws = p.ws;
  __shared__ uint4 xb_words;
  if (threadIdx.x == 0) xb_words = make_uint4(0u, 0u, 0u, 0u);
  __syncthreads();
  if (p.ws == nullptr) grid.sync();
  XcdBarrier xb = xcd_barrier_post((unsigned*)(ws + OFF_BAR), (volatile LAS unsigned*)&xb_words);
  phase0(p, smem);
  xcd_barrier(xb);
  gemm_phase<1>(p, (const u16*)(ws + OFF_R), (const u16*)(ws + OFF_WTA_IN), 32, smem);
  skinny_gemm<0>(p, (const u16*)(ws + OFF_R), (const u16*)(ws + OFF_WTA_IN) + (size_t)4096 * 1024, (float*)(ws + OFF_BRAW));
  xcd_barrier(xb);
  {
    const bool overlap = gridDim.x >= 128;
    const int G = (int)gridDim.x, hG = G >> 1, bi = (int)blockIdx.x;
    const bool is_scan = overlap && bi < 32, is_idle = overlap && bi >= hG && bi < hG + 32;
    const int pfirst = overlap ? (bi < hG ? 32 : 64) : 0, pn = overlap ? G - 64 : G;
    if (!is_scan && !is_idle) delta_prep(p, smem, pfirst, pn);
    if (!is_scan && !is_idle) phase0b(p, smem, pfirst, pn);
    if (!overlap) xcd_barrier(xb);
    if (!overlap || blockIdx.x < 32) delta_scan(p, smem);
    xcd_barrier(xb);
  }
  gate_phase(p);
  xcd_barrier(xb);
  gemm_phase<2>(p, (const u16*)(ws + OFF_R + 32 * MiB), (const u16*)(ws + OFF_WTA_OUT), 8, smem);
  xcd_barrier(xb);
  gemm_phase<3>(p, (const u16*)(ws + OFF_R), (const u16*)(ws + OFF_WTB_IN), 32, smem);
  skinny_gemm<1>(p, (const u16*)(ws + OFF_R), (const u16*)(ws + OFF_WTB_IN) + (size_t)4096 * 1024, (float*)(ws + OFF_FRAW));
  xcd_barrier(xb);
  attn_phase(p, smem);
  xcd_barrier(xb);
  gemm_phase<4>(p, (const u16*)(ws + OFF_R + 64 * MiB), (const u16*)(ws + OFF_WTB_OUT), 8, smem);
  xcd_barrier(xb);
  final_norm(p);
}

extern "C" void kernel_launch(void* const* d_in, const int* in_sizes, int n_in, void* d_out, int out_size, void* d_ws, size_t ws_size,
                              hipStream_t stream) {
  static int grid_blocks = 0;
  if (!grid_blocks) {
    int dev = 0, cus = 0, per_cu = 0;
    hipGetDevice(&dev);
    hipDeviceGetAttribute(&cus, hipDeviceAttributeMultiprocessorCount, dev);
    hipFuncSetAttribute((const void*)fwd_megakernel, hipFuncAttributeMaxDynamicSharedMemorySize, kLds);
    hipOccupancyMaxActiveBlocksPerMultiprocessor(&per_cu, (const void*)fwd_megakernel, kThreads, kLds);
    if (per_cu < 1) per_cu = 1;
    if (per_cu > 2) per_cu = 2;
    grid_blocks = cus * per_cu;
  }
  Params p{};
  p.x = (const float*)d_in[0]; p.a_norm_w = (const float*)d_in[1]; p.a_w_in = (const float*)d_in[2]; p.a_conv_w = (const float*)d_in[3];
  p.a_A_log = (const float*)d_in[4]; p.a_dt_bias = (const float*)d_in[5]; p.a_o_norm_w = (const float*)d_in[6]; p.a_w_out = (const float*)d_in[7];
  p.b_norm_w = (const float*)d_in[8]; p.b_w_in = (const float*)d_in[9]; p.b_f_bias = (const float*)d_in[10]; p.b_q_norm_w = (const float*)d_in[11];
  p.b_k_norm_w = (const float*)d_in[12]; p.b_w_out = (const float*)d_in[13]; p.final_norm_w = (const float*)d_in[14];
  p.out = (float*)d_out;
  p.ws = (char*)d_ws;
  hipMemsetAsync((char*)d_ws + OFF_BAR, 0, CTL_BYTES, stream);
  void* args[] = {&p};
  hipError_t e = hipLaunchCooperativeKernel((const void*)fwd_megakernel, dim3(grid_blocks), dim3(kThreads), args, kLds, stream);
  if (e != hipSuccess) fprintf(stderr, "cooperative launch failed: %s (grid %d)\n", hipGetErrorString(e), grid_blocks);
}
```

```cpp
#include <hip/hip_runtime.h>
#include <hip/hip_cooperative_groups.h>
#include <cstdio>
namespace cg = cooperative_groups;

typedef unsigned short u16;
typedef __attribute__((ext_vector_type(8))) short bf16x8;
typedef __attribute__((ext_vector_type(4))) float f32x4;
typedef __attribute__((ext_vector_type(4))) unsigned u32x4;
typedef __attribute__((ext_vector_type(2))) unsigned u32x2;
#define DI __device__ __forceinline__

constexpr int kThreads = 256;
constexpr int kLds = 69632;
constexpr float kEps = 1e-6f;
constexpr float kScale = 0.08838834764831845f;
constexpr float kLog2e = 1.4426950408889634f;

constexpr size_t MiB = 1048576;
constexpr size_t OFF_WTA_IN = 0;
constexpr size_t OFF_WTA_OUT = 8650752;
constexpr size_t OFF_WTB_IN = 10747904;
constexpr size_t OFF_WTB_OUT = 19398656;
constexpr size_t OFF_SMALL = 21495808;
constexpr size_t OFF_RS0 = OFF_SMALL;
constexpr size_t OFF_SS1 = OFF_RS0 + 65536;
constexpr size_t OFF_SS2 = OFF_SS1 + 65536;
constexpr size_t OFF_BRAW = OFF_SS2 + 65536;
constexpr size_t OFF_FRAW = OFF_BRAW + 1048576;
constexpr size_t OFF_CCUM = OFF_FRAW + 1048576;
constexpr size_t OFF_GEND = OFF_CCUM + 524288;
constexpr size_t OFF_BAR = OFF_GEND + 8192;
constexpr size_t OFF_FLAGS = OFF_BAR + 13824 + 512;
constexpr size_t CTL_BYTES = 13824 + 512 + 8192;
constexpr size_t OFF_PROJ = OFF_SMALL + 3 * MiB;
constexpr size_t OFF_R = OFF_PROJ + 128 * MiB;

struct Params {
  const float *x, *a_norm_w, *a_w_in, *a_conv_w, *a_A_log, *a_dt_bias, *a_o_norm_w, *a_w_out;
  const float *b_norm_w, *b_w_in, *b_f_bias, *b_q_norm_w, *b_k_norm_w, *b_w_out, *final_norm_w;
  float* out;
  char* ws;
};

typedef __attribute__((ext_vector_type(2))) float f32x2;
typedef __attribute__((ext_vector_type(2))) __bf16 bf16x2_t;
DI unsigned pack2(float a, float b) { f32x2 v = {a, b}; return __builtin_bit_cast(unsigned, __builtin_convertvector(v, bf16x2_t)); }
DI unsigned f2bf(float x) { return pack2(x, 0.f) & 0xffffu; }
DI float bflo(unsigned u) { return __uint_as_float(u << 16); }
DI float bfhi(unsigned u) { return __uint_as_float(u & 0xffff0000u); }
DI f32x4 mfma16(bf16x8 a, bf16x8 b, f32x4 c) { return __builtin_amdgcn_mfma_f32_16x16x32_bf16(a, b, c, 0, 0, 0); }
DI bf16x8 mk8(u32x2 lo, u32x2 hi) { u32x4 v = {lo.x, lo.y, hi.x, hi.y}; return __builtin_bit_cast(bf16x8, v); }
DI bf16x8 pack8(f32x4 a, f32x4 b) { u32x4 v = {pack2(a[0], a[1]), pack2(a[2], a[3]), pack2(b[0], b[1]), pack2(b[2], b[3])}; return __builtin_bit_cast(bf16x8, v); }
DI bf16x8 ld2(const u16* p) { return mk8(*(const u32x2*)p, *(const u32x2*)(p + 16)); }
DI int relaunder(int t) { asm volatile("" : "+v"(t)); return t; }
DI int tidx() { int t = threadIdx.x; asm volatile("" : "+v"(t)); return t; }
DI float silu(float x) { return x / (1.f + __expf(-x)); }
DI void unpack8(u32x4 v, float* f) {
  f[0] = bflo(v.x); f[1] = bfhi(v.x); f[2] = bflo(v.y); f[3] = bfhi(v.y);
  f[4] = bflo(v.z); f[5] = bfhi(v.z); f[6] = bflo(v.w); f[7] = bfhi(v.w);
}
DI u32x4 packf8(const float* f) { u32x4 v = {pack2(f[0], f[1]), pack2(f[2], f[3]), pack2(f[4], f[5]), pack2(f[6], f[7])}; return v; }


#define XB_TMO      128
#define XB_XCNT(j)  (256  + 64 * (j))
#define XB_XSUB(j)  (1280 + 64 * (j))
#define XB_XGEN(j)  (2304 + 64 * (j))
#define XB_TOP      3328
#define XB_TOPGEN   3392
#define XCD_BAR_WORDS 3456
#define XB_SPIN_CAP (1u << 23)
#define LAS __attribute__((address_space(3)))
DI unsigned xb_ld(unsigned* p) { return __hip_atomic_load(p, __ATOMIC_RELAXED, __HIP_MEMORY_SCOPE_AGENT); }
DI unsigned xb_add(unsigned* p, unsigned v) { return __hip_atomic_fetch_add(p, v, __ATOMIC_RELAXED, __HIP_MEMORY_SCOPE_AGENT); }
DI unsigned xb_xcc_id() { return (unsigned)__builtin_amdgcn_s_getreg((3 << 11) | 20) & 0xFu; }
#define XB_SPIN(cond, bar) do { unsigned _sp = 0; while (cond) { __builtin_amdgcn_s_sleep(1); \
    if ((++_sp & 255u) == 0u) { if (xb_ld(&(bar)[XB_TMO])) break; if (_sp > XB_SPIN_CAP) { atomicAdd(&(bar)[XB_TMO], 1u); break; } } } } while (0)
struct XcdBarrier { unsigned* bar; unsigned x; volatile LAS unsigned* st; };
DI XcdBarrier xcd_barrier_post(unsigned* bar, volatile LAS unsigned* st) {
  XcdBarrier b; b.bar = bar; b.x = xb_xcc_id(); b.st = st;
  if (threadIdx.x == 0) (void)xb_add(&bar[XB_XCNT(b.x)], 1u);
  return b;
}
DI void xcd_barrier_complete(unsigned* bar, unsigned x, unsigned& nloc, unsigned& nx) {
  const unsigned G = gridDim.x * gridDim.y * gridDim.z;
  unsigned sum, cnt, mine, sp = 0u;
  for (;;) {
    sum = 0u; cnt = 0u; mine = 0u;
#pragma unroll
    for (unsigned j = 0; j < 16; ++j) { const unsigned c = xb_ld(&bar[XB_XCNT(j)]); sum += c; cnt += (c > 0u) ? 1u : 0u; mine = (j == x) ? c : mine; }
    if (sum == G) break;
    __builtin_amdgcn_s_sleep(1);
    if ((++sp & 255u) == 0u) { if (xb_ld(&bar[XB_TMO])) break; if (sp > XB_SPIN_CAP) { atomicAdd(&bar[XB_TMO], 1u); break; } }
  }
  nloc = mine > 0u ? mine : 1u; nx = cnt > 0u ? cnt : 1u;
}
DI void xcd_barrier(const XcdBarrier& b) {
  asm volatile("s_waitcnt vmcnt(0)" ::: "memory");
  __syncthreads();
  if (threadIdx.x == 0) {
    unsigned* bar = b.bar;
    __builtin_amdgcn_s_waitcnt(0);
    unsigned nloc = b.st[0], nx = b.st[1];
    if (nloc == 0u) { xcd_barrier_complete(bar, b.x, nloc, nx); b.st[0] = nloc; b.st[1] = nx; }
    const unsigned old = xb_add(&bar[XB_XSUB(b.x)], 1u);
    const unsigned gen = old / nloc;
    if (old + 1u == (gen + 1u) * nloc) {
      __builtin_amdgcn_fence(__ATOMIC_RELEASE, "agent");
      asm volatile("s_waitcnt vmcnt(0)" ::: "memory");
      const unsigned og = xb_add(&bar[XB_TOP], 1u);
      const unsigned tg = og / nx;
      if (og + 1u == (tg + 1u) * nx) xb_add(&bar[XB_TOPGEN], 1u);
      else XB_SPIN(xb_ld(&bar[XB_TOPGEN]) == tg, bar);
      __builtin_amdgcn_fence(__ATOMIC_ACQUIRE, "agent");
      xb_add(&bar[XB_XGEN(b.x)], 1u);
      asm volatile("s_waitcnt vmcnt(0)" ::: "memory");
    } else {
      XB_SPIN(xb_ld(&bar[XB_XGEN(b.x)]) == gen, bar);
      __builtin_amdgcn_fence(__ATOMIC_ACQUIRE, "agent");
      asm volatile("s_waitcnt vmcnt(0)" ::: "memory");
    }
  }
  __syncthreads();
}

DI void transpose_tile(const float* __restrict__ W, int N, int Npad, const float* __restrict__ kscale, u16* __restrict__ WT, int tile, char* smem) {
  float(*t)[65] = (float(*)[65])smem;
  const int nt = Npad / 64;
  const int k0 = (tile / nt) * 64, n0 = (tile % nt) * 64;
  const int tid = tidx();
  {
    const int tx = tid & 63, ty = tid >> 6;
#pragma unroll 4
    for (int i = 0; i < 16; ++i) {
      const int k = k0 + ty + 4 * i, n = n0 + tx;
      float v = 0.f;
      if (n < N) { v = W[(size_t)k * N + n]; if (kscale) v *= kscale[k]; }
      t[ty + 4 * i][tx] = v;
    }
  }
  __syncthreads();
  {
    const int kx2 = (tid & 31) * 2, ny0 = tid >> 5;
#pragma unroll 4
    for (int i = 0; i < 8; ++i) {
      const int ny = ny0 + 8 * i;
      *(unsigned*)(WT + (size_t)(n0 + ny) * 1024 + k0 + kx2) = pack2(t[kx2][ny], t[kx2 + 1][ny]);
    }
  }
  __syncthreads();
}

DI void phase0(const Params& p, char* smem) {
  char* ws = p.ws;
  {
    float* ss = (float*)(ws + OFF_SS1);
    for (int i = blockIdx.x * kThreads + tidx(); i < 32768; i += gridDim.x * kThreads) ss[i] = 0.f;
  }
  for (int t = blockIdx.x; t < 1312; t += gridDim.x) {
    if (t < 1056) transpose_tile(p.a_w_in, 4112, 4224, p.a_norm_w, (u16*)(ws + OFF_WTA_IN), t, smem);
    else transpose_tile(p.a_w_out, 1024, 1024, nullptr, (u16*)(ws + OFF_WTA_OUT), t - 1056, smem);
  }
  const int tid0 = tidx();
  const int lane = tid0 & 63;
  const int gw = blockIdx.x * 4 + (tid0 >> 6), nw = gridDim.x * 4;
  u16* xb = (u16*)(ws + OFF_R);
  float* rs0 = (float*)(ws + OFF_RS0);
  for (int row = gw; row < 16384; row += 4 * nw) {
    f32x4 v[4][4];
#pragma unroll
    for (int k = 0; k < 4; ++k) {
      const int rr = row + k * nw;
      const f32x4* xr = (const f32x4*)(p.x + (size_t)(rr < 16384 ? rr : row) * 1024);
#pragma unroll
      for (int i = 0; i < 4; ++i) v[k][i] = __builtin_nontemporal_load(xr + lane + 64 * i);
    }
#pragma unroll
    for (int k = 0; k < 4; ++k) {
      const int rr = row + k * nw;
      float ss = 0.f;
#pragma unroll
      for (int i = 0; i < 4; ++i) ss += v[k][i][0] * v[k][i][0] + v[k][i][1] * v[k][i][1] + v[k][i][2] * v[k][i][2] + v[k][i][3] * v[k][i][3];
#pragma unroll
      for (int o = 32; o >= 1; o >>= 1) ss += __shfl_xor(ss, o);
      if (rr < 16384) {
        u32x2* xo = (u32x2*)(xb + (size_t)rr * 1024);
#pragma unroll
        for (int i = 0; i < 4; ++i) { u32x2 o = {pack2(v[k][i][0], v[k][i][1]), pack2(v[k][i][2], v[k][i][3])}; xo[lane + 64 * i] = o; }
        if (lane == 0) rs0[rr] = rsqrtf(ss * (1.f / 1024.f) + kEps);
      }
    }
  }
}

DI void phase0b(const Params& p, char* smem, int first, int nblk) {
  char* ws = p.ws;
  for (int t = (int)blockIdx.x - first; t < 1312; t += nblk) {
    if (t < 1056) transpose_tile(p.b_w_in, 4104, 4224, p.b_norm_w, (u16*)(ws + OFF_WTB_IN), t, smem);
    else transpose_tile(p.b_w_out, 1024, 1024, nullptr, (u16*)(ws + OFF_WTB_OUT), t - 1056, smem);
  }
}

template <int EPI>
DI void gemm_phase(const Params& p, const u16* __restrict__ A, const u16* __restrict__ Bt, int nTn, char* smem) {
  const int tid = tidx(), lane = tid & 63, wave = tid >> 6;
  const int wr = wave >> 1, wc = wave & 1;
  const int l15 = lane & 15, quad = lane >> 4;
  char* ws = p.ws;
  const int NX = ((gridDim.x & 7) == 0) ? 8 : 1;
  const int xg = blockIdx.x % NX, lb = blockIdx.x / NX, Lb = gridDim.x / NX;
  const int nTnG = nTn >> 3, nSuper = 16 * nTnG;
  const int srow = wave * 8 + (lane >> 3);
  const int sch = (lane & 7) ^ ((((wave & 1) << 2) + (lane >> 4)) & 7);
#define GEMM_TILE(seq_, tm_, tn_, ok_)                                                            \
  do {                                                                                            \
    const int sidx_ = xg + NX * ((seq_) >> 6);                                                    \
    ok_ = sidx_ < nSuper;                                                                         \
    const int tl_ = (seq_) & 63;                                                                  \
    tm_ = (sidx_ / nTnG) * 8 + (tl_ & 7);                                                         \
    tn_ = (sidx_ % nTnG) * 8 + (tl_ >> 3);                                                        \
  } while (0)
#define GEMM_STAGE(buf, kt)                                                                                                   \
  do {                                                                                                                        \
    _Pragma("unroll") for (int i = 0; i < 4; ++i) {                                                                           \
      __builtin_amdgcn_global_load_lds((const unsigned*)(Ag + (size_t)i * 32 * 1024 + (kt) * 64),                             \
                                       (unsigned*)(smem + (buf) * 32768 + (i * 4 + wave) * 1024), 16, 0, 0);                  \
      __builtin_amdgcn_global_load_lds((const unsigned*)(Bg + (size_t)i * 32 * 1024 + (kt) * 64),                             \
                                       (unsigned*)(smem + (buf) * 32768 + 16384 + (i * 4 + wave) * 1024), 16, 0, 0);          \
    }                                                                                                                         \
  } while (0)
  int seq = lb, tm, tn;
  bool ok;
  GEMM_TILE(seq, tm, tn, ok);
  const u16* Ag = A + (size_t)(tm * 128 + srow) * 1024 + sch * 8;
  const u16* Bg = Bt + (size_t)(tn * 128 + srow) * 1024 + sch * 8;
  if (ok) GEMM_STAGE(0, 0);
  while (ok) {
    int tm2, tn2;
    bool ok2;
    GEMM_TILE(seq + Lb, tm2, tn2, ok2);
    f32x4 acc[4][4];
#pragma unroll
    for (int a = 0; a < 4; ++a)
#pragma unroll
      for (int b = 0; b < 4; ++b) acc[a][b] = (f32x4){0.f, 0.f, 0.f, 0.f};
    asm volatile("s_waitcnt vmcnt(0)" ::: "memory");
    __syncthreads();
#pragma unroll 2
    for (int kt = 0; kt < 16; ++kt) {
      const int cur = kt & 1;
      if (kt + 1 < 16) GEMM_STAGE(cur ^ 1, kt + 1);
      else if (ok2) {
        Ag = A + (size_t)(tm2 * 128 + srow) * 1024 + sch * 8;
        Bg = Bt + (size_t)(tn2 * 128 + srow) * 1024 + sch * 8;
        GEMM_STAGE(0, 0);
      }
      const char* sa = smem + cur * 32768;
      const char* sb = sa + 16384;
#pragma unroll
      for (int ks = 0; ks < 2; ++ks) {
        bf16x8 fa[4], fb[4];
        const int ch = ks * 4 + quad;
#pragma unroll
        for (int mi = 0; mi < 4; ++mi) {
          const int row = wr * 64 + mi * 16 + l15;
          fa[mi] = *(const bf16x8*)(sa + row * 128 + ((ch ^ ((row >> 1) & 7)) << 4));
        }
#pragma unroll
        for (int ni = 0; ni < 4; ++ni) {
          const int row = wc * 64 + ni * 16 + l15;
          fb[ni] = *(const bf16x8*)(sb + row * 128 + ((ch ^ ((row >> 1) & 7)) << 4));
        }
#pragma unroll
        for (int ni = 0; ni < 4; ++ni)
#pragma unroll
          for (int mi = 0; mi < 4; ++mi) acc[ni][mi] = mfma16(fb[ni], fa[mi], acc[ni][mi]);
      }
      if (kt < 15) {
        asm volatile("s_waitcnt vmcnt(0)" ::: "memory");
        __syncthreads();
      }
    }
    float hnorm[4] = {1.f, 1.f, 1.f, 1.f};
    if constexpr (EPI == 3) {
      if (tn < 16) {
        float* part = (float*)(smem + 65536);
        float ssq[4];
#pragma unroll
        for (int mi = 0; mi < 4; ++mi) {
          const float rs = rsqrtf(((const float*)(ws + OFF_SS1))[tm * 128 + wr * 64 + mi * 16 + l15] * (1.f / 1024.f) + kEps);
          float s = 0.f;
#pragma unroll
          for (int ni = 0; ni < 4; ++ni) { const f32x4 v = acc[ni][mi] * rs; s += v[0] * v[0] + v[1] * v[1] + v[2] * v[2] + v[3] * v[3]; }
          s += __shfl_xor(s, 16);
          s += __shfl_xor(s, 32);
          ssq[mi] = s;
          if (quad == 0) part[(wr * 2 + wc) * 64 + mi * 16 + l15] = s;
        }
        __syncthreads();
#pragma unroll
        for (int mi = 0; mi < 4; ++mi) {
          const float tot = ssq[mi] + part[(wr * 2 + (wc ^ 1)) * 64 + mi * 16 + l15];
          hnorm[mi] = rsqrtf(tot * (1.f / 128.f) + kEps) * (tn < 8 ? kScale * kLog2e : 1.f);
        }
      }
    }
#pragma unroll
    for (int mi = 0; mi < 4; ++mi) {
      const int m = tm * 128 + wr * 64 + mi * 16 + l15;
      if constexpr (EPI == 1) {
        const float rs = ((const float*)(ws + OFF_RS0))[m];
        u16* proj = (u16*)(ws + OFF_PROJ);
        float* braw = (float*)(ws + OFF_BRAW);
#pragma unroll
        for (int ni = 0; ni < 4; ++ni) {
          const int nb = tn * 128 + wc * 64 + ni * 16 + quad * 4;
          f32x4 v = acc[ni][mi] * rs;
          if (nb < 4096) { u32x2 o = {pack2(v[0], v[1]), pack2(v[2], v[3])}; __builtin_nontemporal_store(o, (u32x2*)(proj + (size_t)m * 4096 + nb)); }
          else if (nb < 4112) { *(f32x4*)(braw + (size_t)m * 16 + (nb - 4096)) = v; }
        }
      } else if constexpr (EPI == 2 || EPI == 4) {
        float* ssp = (float*)(ws + (EPI == 2 ? OFF_SS1 : OFF_SS2));
        u16* hb = (u16*)(ws + OFF_R);
        float ssq = 0.f;
#pragma unroll
        for (int ni = 0; ni < 4; ++ni) {
          const int nb = tn * 128 + wc * 64 + ni * 16 + quad * 4;
          f32x4 v;
          if constexpr (EPI == 2) {
            v = acc[ni][mi] + __builtin_nontemporal_load((const f32x4*)(p.x + (size_t)m * 1024 + nb));
            u32x2 o = {pack2(v[0], v[1]), pack2(v[2], v[3])};
            *(u32x2*)(hb + (size_t)m * 1024 + nb) = o;
            v[0] = bflo(o.x); v[1] = bfhi(o.x); v[2] = bflo(o.y); v[3] = bfhi(o.y);
          } else {
            const u32x2 r = *(const u32x2*)(hb + (size_t)m * 1024 + nb);
            v = acc[ni][mi];
            v[0] += bflo(r.x); v[1] += bfhi(r.x); v[2] += bflo(r.y); v[3] += bfhi(r.y);
            const u32x2 o = {pack2(v[0], v[1]), pack2(v[2], v[3])};
            *(u32x2*)(hb + (size_t)m * 1024 + nb) = o;
            v[0] = bflo(o.x); v[1] = bfhi(o.x); v[2] = bflo(o.y); v[3] = bfhi(o.y);
          }
          ssq += v[0] * v[0] + v[1] * v[1] + v[2] * v[2] + v[3] * v[3];
        }
        ssq += __shfl_xor(ssq, 16);
        ssq += __shfl_xor(ssq, 32);
        if (quad == 0) atomicAdd(ssp + m, ssq);
      } else if constexpr (EPI == 3) {
        const float rs = rsqrtf(((const float*)(ws + OFF_SS1))[m] * (1.f / 1024.f) + kEps);
        u16* proj = (u16*)(ws + OFF_PROJ);
        u16* vT = (u16*)(ws + OFF_R + 32 * MiB);
        float* fraw = (float*)(ws + OFF_FRAW);
        float hs = 1.f;
        if (tn < 16) hs = hnorm[mi];
#pragma unroll
        for (int ni = 0; ni < 4; ++ni) {
          const int nb = tn * 128 + wc * 64 + ni * 16 + quad * 4;
          f32x4 v = acc[ni][mi] * rs;
          if (tn < 16) {
            const f32x4 wv = *(const f32x4*)((tn < 8 ? p.b_q_norm_w : p.b_k_norm_w) + (nb & 127));
            v = v * hs * wv;
          }
          if (nb < 4096) {
            if ((nb >> 10) != 2) { u32x2 o = {pack2(v[0], v[1]), pack2(v[2], v[3])}; __builtin_nontemporal_store(o, (u32x2*)(proj + (size_t)m * 4096 + nb)); }
            else {
              const int hd = nb - 2048;
              const int b = m >> 13, t = m & 8191;
              u16* dst = vT + ((size_t)(b * 1024 + hd)) * 8192 + t;
#pragma unroll
              for (int jj = 0; jj < 4; ++jj) dst[(size_t)jj * 8192] = (u16)f2bf(v[jj]);
            }
          } else if (nb < 4104) { *(f32x4*)(fraw + (size_t)m * 16 + (nb - 4096)) = v; }
        }
      }
    }
    seq += Lb; tm = tm2; tn = tn2; ok = ok2;
  }
#undef GEMM_STAGE
#undef GEMM_TILE
}


template <int MODE>
DI void skinny_gemm(const Params& p, const u16* __restrict__ A, const u16* __restrict__ Wt16, float* __restrict__ out) {
  const int tid = tidx(), lane = tid & 63, l15 = lane & 15, quad = lane >> 4;
  const int gw = blockIdx.x * 4 + (tid >> 6), nw = gridDim.x * 4;
  for (int mt = gw; mt < 1024; mt += nw) {
    const int m = mt * 16 + l15;
    const u16* ap = A + (size_t)m * 1024 + quad * 8;
    const u16* bp = Wt16 + (size_t)l15 * 1024 + quad * 8;
    f32x4 acc = {0.f, 0.f, 0.f, 0.f};
#pragma unroll 8
    for (int ks = 0; ks < 32; ++ks) acc = mfma16(*(const bf16x8*)(bp + ks * 32), *(const bf16x8*)(ap + ks * 32), acc);
    float rs;
    if constexpr (MODE == 0) rs = ((const float*)(p.ws + OFF_RS0))[m];
    else rs = rsqrtf(((const float*)(p.ws + OFF_SS1))[m] * (1.f / 1024.f) + kEps);
    *(f32x4*)(out + (size_t)m * 16 + 4 * quad) = acc * rs;
  }
}

DI void delta_prep(const Params& p, char* smem, int first, int nblk) {
  char* ws = p.ws;
  const u16* proj = (const u16*)(ws + OFF_PROJ);
  const float* braw = (const float*)(ws + OFF_BRAW);
  u16* qd_g = (u16*)(ws + OFF_R);
  u16* kT_g = (u16*)(ws + OFF_R + 32 * MiB);
  u16* at_g = (u16*)(ws + OFF_R + 64 * MiB);
  u16* uT_g = (u16*)p.out;
  u16* w_g = (u16*)((char*)p.out + 32 * MiB);
  float* gend_g = (float*)(ws + OFF_GEND);
  char* qL = smem;
  char* kL = smem + 16384;
  char* vL = smem + 32768;
  float* As = (float*)(smem + 49152);
  float* sc = (float*)(smem + 66560);
  float* g_s = sc;
  float* beta_s = sc + 64;
  float* rq_s = sc + 128;
  float* rk_s = sc + 192;
  float* ssq_s = sc + 256;
  float* fu_s = sc + 384;
  float* fw_s = sc + 448;
  const int tid_ = tidx();

  unsigned* flags = (unsigned*)(ws + OFF_FLAGS);
  const __amdgpu_buffer_rsrc_t r_qd = __builtin_amdgcn_make_buffer_rsrc(qd_g, 0, 32 << 20, 0x00020000);
  const __amdgpu_buffer_rsrc_t r_kT = __builtin_amdgcn_make_buffer_rsrc(kT_g, 0, 32 << 20, 0x00020000);
  const __amdgpu_buffer_rsrc_t r_at = __builtin_amdgcn_make_buffer_rsrc(at_g, 0, 16 << 20, 0x00020000);
  const __amdgpu_buffer_rsrc_t r_uT = __builtin_amdgcn_make_buffer_rsrc(uT_g, 0, 32 << 20, 0x00020000);
  const __amdgpu_buffer_rsrc_t r_w = __builtin_amdgcn_make_buffer_rsrc(w_g, 0, 32 << 20, 0x00020000);
  if (nblk >= 256 && ((int)blockIdx.x - first) >= (nblk >> 1)) {
    for (int i = 0; i < 7; ++i) __builtin_amdgcn_s_sleep(127);
  }
  for (int j = (int)blockIdx.x - first; j < 2048; j += nblk) {
    const int c = j >> 4, b = (j >> 3) & 1, h = j & 7;
    const int item = (b * 128 + c) * 8 + h;
    const int tok0 = b * 8192 + c * 64;
    const int tid = relaunder(tid_), lane = tid & 63, wave = tid >> 6, l15 = lane & 15, quad = lane >> 4;
    if (wave == 3) {
      const int row = tok0 + lane;
      const float br = braw[(size_t)row * 16 + h];
      const float ar = braw[(size_t)row * 16 + 8 + h] + p.a_dt_bias[h];
      const float beta = 1.f / (1.f + __expf(-br));
      const float sp = fmaxf(ar, 0.f) + log1pf(__expf(-fabsf(ar)));
      float g = -__expf(p.a_A_log[h]) * sp;
#pragma unroll
      for (int o = 1; o < 64; o <<= 1) { float t = __shfl_up(g, o); if (lane >= o) g += t; }
      g_s[lane] = g;
      beta_s[lane] = beta;
    } else {
      const int sec = wave, cgi = l15, rr = quad;
      const int col = sec * 1024 + h * 128 + cgi * 8;
      float w0[8], w1[8], w2[8], w3[8];
#pragma unroll
      for (int e = 0; e < 8; ++e) {
        w0[e] = p.a_conv_w[0 * 3072 + col + e]; w1[e] = p.a_conv_w[1 * 3072 + col + e];
        w2[e] = p.a_conv_w[2 * 3072 + col + e]; w3[e] = p.a_conv_w[3 * 3072 + col + e];
      }
      const u16* src = proj + (size_t)(tok0 + rr * 16) * 4096 + col;
      float x0[8], x1[8], x2[8], x3[8];
      if (c == 0 && rr == 0) {
#pragma unroll
        for (int e = 0; e < 8; ++e) { x0[e] = 0.f; x1[e] = 0.f; x2[e] = 0.f; }
      } else {
        unpack8(*(const u32x4*)(src - 3 * 4096), x0);
        unpack8(*(const u32x4*)(src - 2 * 4096), x1);
        unpack8(*(const u32x4*)(src - 1 * 4096), x2);
      }
      char* dstL = smem + sec * 16384;
#pragma unroll 4
      for (int r = 0; r < 16; ++r) {
        unpack8(*(const u32x4*)(src + (size_t)r * 4096), x3);
        float y[8];
        float ssq = 0.f;
#pragma unroll
        for (int e = 0; e < 8; ++e) {
          float v = w0[e] * x0[e] + w1[e] * x1[e] + w2[e] * x2[e] + w3[e] * x3[e];
          v = silu(v);
          y[e] = v;
          ssq += v * v;
          x0[e] = x1[e]; x1[e] = x2[e]; x2[e] = x3[e];
        }
        ssq += __shfl_xor(ssq, 1); ssq += __shfl_xor(ssq, 2); ssq += __shfl_xor(ssq, 4); ssq += __shfl_xor(ssq, 8);
        const int row = rr * 16 + r;
        if (sec < 2 && cgi == 0) ssq_s[sec * 64 + row] = ssq;
        *(u32x4*)(dstL + row * 256 + ((cgi ^ (row & 15)) << 4)) = packf8(y);
      }
    }
    __syncthreads();
    if (tid < 64) {
      const float rq = rsqrtf(ssq_s[tid] + kEps), rk = rsqrtf(ssq_s[64 + tid] + kEps);
      const float gi = g_s[tid], g63 = g_s[63];
      const float eg = __expf(gi);
      rq_s[tid] = rq; rk_s[tid] = rk;
      const float be = beta_s[tid];
      fu_s[tid] = be;
      fw_s[tid] = be * rk * eg;
      ssq_s[tid] = rq * kScale * eg;
      ssq_s[64 + tid] = rk * __expf(g63 - gi);
      if (tid == 0) __hip_atomic_store(gend_g + item, __expf(g63), __ATOMIC_RELAXED, __HIP_MEMORY_SCOPE_AGENT);
    }
    __syncthreads();
    {
      const int tid = relaunder(tid_), lane = tid & 63, wave = tid >> 6, l15 = lane & 15, quad = lane >> 4;
      bf16x8 bk[4], bq[4];
      const int rowI = 16 * wave + l15;
#pragma unroll
      for (int ks = 0; ks < 4; ++ks) {
        const int off = rowI * 256 + (((ks * 4 + quad) ^ (rowI & 15)) << 4);
        bk[ks] = *(const bf16x8*)(kL + off);
        bq[ks] = *(const bf16x8*)(qL + off);
      }
      const int i = rowI;
      const float gi = g_s[i], bi = beta_s[i] * rk_s[i], qi = kScale * rq_s[i];
      u32x2 keep = {0u, 0u};
#pragma unroll
      for (int J = 0; J < 4; ++J) {
        f32x4 skk = {0.f, 0.f, 0.f, 0.f}, sqk = {0.f, 0.f, 0.f, 0.f};
        const int rowJ = 16 * J + l15;
#pragma unroll
        for (int ks = 0; ks < 4; ++ks) {
          const bf16x8 ak = *(const bf16x8*)(kL + rowJ * 256 + (((ks * 4 + quad) ^ (rowJ & 15)) << 4));
          skk = mfma16(ak, bk[ks], skk);
          sqk = mfma16(ak, bq[ks], sqk);
        }
        const f32x4 gj4 = *(const f32x4*)(g_s + 16 * J + 4 * quad);
        const f32x4 rk4 = *(const f32x4*)(rk_s + 16 * J + 4 * quad);
        f32x4 a4, t4;
#pragma unroll
        for (int jj = 0; jj < 4; ++jj) {
          const int j = 16 * J + 4 * quad + jj;
          const float dec = (i >= j) ? __expf(gi - gj4[jj]) : 0.f;
          a4[jj] = (i > j) ? bi * rk4[jj] * skk[jj] * dec : 0.f;
          t4[jj] = qi * rk4[jj] * sqk[jj] * dec;
        }
        *(f32x4*)(As + i * 68 + 16 * J + 4 * quad) = a4;
        const u32x2 half = {pack2(t4[0], t4[1]), pack2(t4[2], t4[3])};
        if ((J & 1) == 0) keep = half;
        else {
          const u32x4 fr = {keep.x, keep.y, half.x, half.y};
          __builtin_amdgcn_raw_buffer_store_b128(fr, r_at, item * 8192 + ((wave * 2 + (J >> 1)) * 64 + lane) * 16, 0, 16);
        }
      }
    }
    {
      const int tid = relaunder(tid_);
#pragma unroll
      for (int it = 0; it < 4; ++it) {
        const int idx = tid + 256 * it;
        const int f = idx >> 6, ln = idx & 63, fl = ln & 15, fq = ln >> 4;
        {
          const int mt = f >> 2, ks = f & 3, i = 16 * mt + fl;
          const int c0 = 4 * ks + (fq >> 1), o8 = (fq & 1) * 8;
          const u32x2 lo = *(const u32x2*)(qL + i * 256 + ((c0 ^ (i & 15)) << 4) + o8);
          const u32x2 hi = *(const u32x2*)(qL + i * 256 + (((c0 + 2) ^ (i & 15)) << 4) + o8);
          const float s = ssq_s[i];
          const u32x4 o = {pack2(bflo(lo.x) * s, bfhi(lo.x) * s), pack2(bflo(lo.y) * s, bfhi(lo.y) * s),
                           pack2(bflo(hi.x) * s, bfhi(hi.x) * s), pack2(bflo(hi.y) * s, bfhi(hi.y) * s)};
          __builtin_amdgcn_raw_buffer_store_b128(o, r_qd, item * 16384 + idx * 16, 0, 16);
        }
        {
          const int mt = f >> 1, ks = f & 1, dk = 16 * mt + fl;
          float v[8];
#pragma unroll
          for (int e = 0; e < 8; ++e) {
            const int i = 32 * ks + ((e < 4) ? (4 * fq + e) : (16 + 4 * fq + e - 4));
            const u16 raw = *(const u16*)(kL + i * 256 + (((dk >> 3) ^ (i & 15)) << 4) + (dk & 7) * 2);
            v[e] = __uint_as_float(((unsigned)raw) << 16) * ssq_s[64 + i];
          }
          __builtin_amdgcn_raw_buffer_store_b128(packf8(v), r_kT, item * 16384 + idx * 16, 0, 16);
        }
      }
    }
    __syncthreads();
    {
      float U[64];
      const int tid = relaunder(tid_), wave = tid >> 6;
      const int cc = tid & 127, ch = cc >> 3, e2 = (cc & 7) * 2;
      const char* srcL = (wave < 2) ? vL : kL;
      const float* fr = (wave < 2) ? fu_s : fw_s;
#pragma unroll
      for (int i = 0; i < 64; ++i) {
        int ii = i;
        asm volatile("" : "+v"(ii));
        const u16 raw = *(const u16*)(srcL + ii * 256 + ((ch ^ (ii & 15)) << 4) + e2);
        float acc = __uint_as_float(((unsigned)raw) << 16) * fr[ii];
#pragma unroll
        for (int j = 0; j < i; ++j) acc -= As[i * 68 + j] * U[j];
        U[i] = acc;
      }
      if (wave < 2) {
        const int dofs = item * 16384 + (((cc >> 4) * 4) * 256 + (cc & 15) * 4) * 2;
#pragma unroll
        for (int mi = 0; mi < 4; ++mi)
#pragma unroll
          for (int q4 = 0; q4 < 4; ++q4) {
            const u32x2 o = {pack2(U[16 * mi + 4 * q4], U[16 * mi + 4 * q4 + 1]), pack2(U[16 * mi + 4 * q4 + 2], U[16 * mi + 4 * q4 + 3])};
            __builtin_amdgcn_raw_buffer_store_b64(o, r_uT, dofs + (mi * 256 + q4 * 64) * 2, 0, 16);
          }
      } else {
#pragma unroll
        for (int i = 0; i < 64; ++i) {
          int ii = i;
          asm volatile("" : "+v"(ii));
          *(u16*)(qL + ii * 256 + ((ch ^ (ii & 15)) << 4) + e2) = (u16)f2bf(U[i]);
        }
      }
    }
    __syncthreads();
    {
      const int tid = relaunder(tid_);
#pragma unroll
      for (int it = 0; it < 4; ++it) {
        const int idx = tid + 256 * it;
        const int f = idx >> 6, ln = idx & 63, fl = ln & 15, fq = ln >> 4;
        const int mt = f >> 2, ks = f & 3, i = 16 * mt + fl;
        const int c0 = 4 * ks + (fq >> 1), o8 = (fq & 1) * 8;
        const u32x2 lo = *(const u32x2*)(qL + i * 256 + ((c0 ^ (i & 15)) << 4) + o8);
        const u32x2 hi = *(const u32x2*)(qL + i * 256 + (((c0 + 2) ^ (i & 15)) << 4) + o8);
        const u32x4 o = {lo.x, lo.y, hi.x, hi.y};
        __builtin_amdgcn_raw_buffer_store_b128(o, r_w, item * 16384 + idx * 16, 0, 16);
      }
    }
    asm volatile("s_waitcnt vmcnt(0)" ::: "memory");
    __syncthreads();
    if (relaunder(tid_) == 0) __hip_atomic_store(flags + item, 1u, __ATOMIC_RELAXED, __HIP_MEMORY_SCOPE_AGENT);
  }
}

#define RAW_BARRIER() do { asm volatile("s_waitcnt lgkmcnt(0)" ::: "memory"); __builtin_amdgcn_s_barrier(); asm volatile("" ::: "memory"); } while (0)
#define GAS __attribute__((address_space(1)))
#define SCAN_LOAD(item_)                                                                                          \
  do {                                                                                                            \
    const GAS char* wb_ = (const GAS char*)((const char*)w_g + (size_t)(item_) * 16384);                          \
    const GAS char* qb_ = (const GAS char*)((const char*)qd_g + (size_t)(item_) * 16384);                         \
    const GAS char* kb_ = (const GAS char*)((const char*)kT_g + (size_t)(item_) * 16384);                         \
    const GAS char* ab_ = (const GAS char*)((const char*)at_g + (size_t)(item_) * 8192);                          \
    const GAS char* ub_ = (const GAS char*)((const char*)uT_g + (size_t)(item_) * 16384);                         \
    asm volatile("" : "+s"(wb_), "+s"(qb_), "+s"(kb_), "+s"(ab_), "+s"(ub_));                                     \
    _Pragma("unroll") for (int j = 0; j < 4; ++j) {                                                               \
      R[j] = *(const GAS u32x4*)(wb_ + (toff + 4096u * j));                                                       \
      R[4 + j] = *(const GAS u32x4*)(qb_ + (toff + 4096u * j));                                                   \
      R[8 + j] = *(const GAS u32x4*)(kb_ + (toff + 4096u * j));                                                   \
    }                                                                                                             \
    _Pragma("unroll") for (int j = 0; j < 2; ++j) R[12 + j] = *(const GAS u32x4*)(ab_ + (toff + 4096u * j));     \
    _Pragma("unroll") for (int mi = 0; mi < 4; ++mi) un[mi] = *(const GAS u32x2*)(ub_ + (uoff + 512u * mi));     \
    gn = gend_g[item_];                                                                                           \
  } while (0)
DI void delta_scan(const Params& p, char* smem) {
  char* ws = p.ws;
  const u16* qd_g = (const u16*)(ws + OFF_R);
  const u16* kT_g = (const u16*)(ws + OFF_R + 32 * MiB);
  const u16* at_g = (const u16*)(ws + OFF_R + 64 * MiB);
  const u16* uT_g = (const u16*)p.out;
  const u16* w_g = (const u16*)((const char*)p.out + 32 * MiB);
  const float* gend_g = (const float*)(ws + OFF_GEND);
  u16* o_g = (u16*)(ws + OFF_PROJ);
  unsigned* flags = (unsigned*)(ws + OFF_FLAGS);
  const int tid = tidx(), lane = tid & 63, wave = tid >> 6, l15 = lane & 15, quad = lane >> 4;
  char* Lw = smem;
  char* Lq = smem + 16384;
  char* Lk = smem + 32768;
  char* La = smem + 49152;
  char* Lo = smem + 57344;
  for (int unit = blockIdx.x; unit < 32; unit += gridDim.x) {
    const int bh = unit & 15, half = unit >> 4, b = bh >> 3, h = bh & 7;
    const int slice = half * 4 + wave;
    f32x4 S[8];
#pragma unroll
    for (int i = 0; i < 8; ++i) S[i] = (f32x4){0.f, 0.f, 0.f, 0.f};
    const unsigned toff = (unsigned)tid * 16u, uoff = (unsigned)(slice * 256 + lane) * 8u;
    u32x4 R[14];
    u32x2 un[4];
    float gn;
#define SCAN_WAIT(flv_, item_)                                                                                         \
  do {                                                                                                                 \
    unsigned f_ = (flv_), sp_ = 0u;                                                                                    \
    while (f_ == 0u && sp_ < (1u << 24)) { __builtin_amdgcn_s_sleep(2); f_ = __hip_atomic_load(flags + (item_), __ATOMIC_RELAXED, __HIP_MEMORY_SCOPE_AGENT); ++sp_; } \
    __builtin_amdgcn_fence(__ATOMIC_ACQUIRE, "workgroup");           \
  } while (0)
    unsigned fl;
    {
      const int item = (b * 128) * 8 + h;
      SCAN_WAIT(0u, item);
      SCAN_LOAD(item);
      fl = __hip_atomic_load(flags + ((b * 128 + 1) * 8 + h), __ATOMIC_RELAXED, __HIP_MEMORY_SCOPE_AGENT);
    }
    for (int c = 0; c < 128; ++c) {
#pragma unroll
      for (int j = 0; j < 4; ++j) {
        *(u32x4*)(Lw + (tid + 256 * j) * 16) = R[j];
        *(u32x4*)(Lq + (tid + 256 * j) * 16) = R[4 + j];
        *(u32x4*)(Lk + (tid + 256 * j) * 16) = R[8 + j];
      }
#pragma unroll
      for (int j = 0; j < 2; ++j) *(u32x4*)(La + (tid + 256 * j) * 16) = R[12 + j];
      u32x2 uc[4];
#pragma unroll
      for (int mi = 0; mi < 4; ++mi) uc[mi] = un[mi];
      const float gend = gn;
      RAW_BARRIER();
      if (c + 1 < 128) SCAN_WAIT(fl, (b * 128 + c + 1) * 8 + h);
      if (c > 0) {
        const int tokp = b * 8192 + (c - 1) * 64;
#pragma unroll
        for (int k2 = 0; k2 < 2; ++k2) {
          const int idx = tid + 256 * k2, row = idx >> 3, part = idx & 7;
          *(u32x4*)(o_g + (size_t)(tokp + row) * 4096 + h * 128 + half * 64 + part * 8) = *(const u32x4*)(Lo + idx * 16);
        }
      }
      if (c + 1 < 128) {
        const int item = (b * 128 + c + 1) * 8 + h;
        SCAN_LOAD(item);
        fl = (c + 2 < 128) ? __hip_atomic_load(flags + (item + 8), __ATOMIC_RELAXED, __HIP_MEMORY_SCOPE_AGENT) : 1u;
      }
      __builtin_amdgcn_sched_barrier(0);
      bf16x8 bS[4];
#pragma unroll
      for (int ks = 0; ks < 4; ++ks) bS[ks] = pack8(S[2 * ks], S[2 * ks + 1]);
      bf16x8 fr[16];
#pragma unroll
      for (int i = 0; i < 16; ++i) fr[i] = *(const bf16x8*)(Lw + (i * 64 + lane) * 16);
      __builtin_amdgcn_sched_barrier(0);
      f32x4 vn[4];
#pragma unroll
      for (int mi = 0; mi < 4; ++mi) vn[mi] = (f32x4){0.f, 0.f, 0.f, 0.f};
#pragma unroll
      for (int ks = 0; ks < 4; ++ks)
#pragma unroll
        for (int mi = 0; mi < 4; ++mi) vn[mi] = mfma16(fr[mi * 4 + ks], bS[ks], vn[mi]);
      __builtin_amdgcn_sched_barrier(0);
#pragma unroll
      for (int i = 0; i < 16; ++i) fr[i] = *(const bf16x8*)(Lk + (i * 64 + lane) * 16);
#pragma unroll
      for (int mi = 0; mi < 4; ++mi) {
        vn[mi][0] = bflo(uc[mi].x) - vn[mi][0]; vn[mi][1] = bfhi(uc[mi].x) - vn[mi][1];
        vn[mi][2] = bflo(uc[mi].y) - vn[mi][2]; vn[mi][3] = bfhi(uc[mi].y) - vn[mi][3];
      }
      bf16x8 bV[2];
      bV[0] = pack8(vn[0], vn[1]);
      bV[1] = pack8(vn[2], vn[3]);
#pragma unroll
      for (int mt = 0; mt < 8; ++mt) S[mt] = S[mt] * gend;
      __builtin_amdgcn_sched_barrier(0);
#pragma unroll
      for (int ks = 0; ks < 2; ++ks)
#pragma unroll
        for (int mt = 0; mt < 8; ++mt) S[mt] = mfma16(fr[mt * 2 + ks], bV[ks], S[mt]);
      __builtin_amdgcn_sched_barrier(0);
#pragma unroll
      for (int i = 0; i < 16; ++i) fr[i] = *(const bf16x8*)(Lq + (i * 64 + lane) * 16);
      __builtin_amdgcn_sched_barrier(0);
      f32x4 oacc[4];
#pragma unroll
      for (int mi = 0; mi < 4; ++mi) oacc[mi] = (f32x4){0.f, 0.f, 0.f, 0.f};
#pragma unroll
      for (int ks = 0; ks < 4; ++ks)
#pragma unroll
        for (int mi = 0; mi < 4; ++mi) oacc[mi] = mfma16(fr[mi * 4 + ks], bS[ks], oacc[mi]);
      __builtin_amdgcn_sched_barrier(0);
#pragma unroll
      for (int i = 0; i < 8; ++i) fr[i] = *(const bf16x8*)(La + (i * 64 + lane) * 16);
      __builtin_amdgcn_sched_barrier(0);
#pragma unroll
      for (int ks = 0; ks < 2; ++ks)
#pragma unroll
        for (int mi = 0; mi < 4; ++mi) oacc[mi] = mfma16(fr[mi * 2 + ks], bV[ks], oacc[mi]);
      __builtin_amdgcn_sched_barrier(0);
#pragma unroll
      for (int mi = 0; mi < 4; ++mi)
#pragma unroll
        for (int jj = 0; jj < 4; ++jj)
          *(u16*)(Lo + (16 * mi + 4 * quad + jj) * 128 + (wave * 16 + l15) * 2) = (u16)f2bf(oacc[mi][jj]);
      RAW_BARRIER();
    }
    {
      const int tokp = b * 8192 + 127 * 64;
#pragma unroll
      for (int k2 = 0; k2 < 2; ++k2) {
        const int idx = tid + 256 * k2, row = idx >> 3, part = idx & 7;
        *(u32x4*)(o_g + (size_t)(tokp + row) * 4096 + h * 128 + half * 64 + part * 8) = *(const u32x4*)(Lo + idx * 16);
      }
      RAW_BARRIER();
    }
  }
}

#undef SCAN_LOAD
#undef SCAN_WAIT

DI void gate_phase(const Params& p) {
  char* ws = p.ws;
  const u16* proj = (const u16*)(ws + OFF_PROJ);
  u16* y0 = (u16*)(ws + OFF_R + 32 * MiB);
  const int tidg = tidx();
  const int lane = tidg & 63, l15 = lane & 15, quad = lane >> 4;
  const int gw = blockIdx.x * 4 + (tidg >> 6), nw = gridDim.x * 4;
  float wn[8];
#pragma unroll
  for (int e = 0; e < 8; ++e) wn[e] = p.a_o_norm_w[l15 * 8 + e];
  for (int r4 = gw; r4 < 32768; r4 += nw) {
    const int rh = r4 * 4 + quad, tok = rh >> 3, h = rh & 7;
    float o[8], z[8];
    unpack8(*(const u32x4*)(proj + (size_t)tok * 4096 + h * 128 + l15 * 8), o);
    unpack8(*(const u32x4*)(proj + (size_t)tok * 4096 + 3072 + h * 128 + l15 * 8), z);
    float ssq = 0.f;
#pragma unroll
    for (int e = 0; e < 8; ++e) ssq += o[e] * o[e];
    ssq += __shfl_xor(ssq, 1); ssq += __shfl_xor(ssq, 2); ssq += __shfl_xor(ssq, 4); ssq += __shfl_xor(ssq, 8);
    const float rs = rsqrtf(ssq * (1.f / 128.f) + kEps);
#pragma unroll
    for (int e = 0; e < 8; ++e) o[e] = o[e] * rs * wn[e] * silu(z[e]);
    *(u32x4*)(y0 + (size_t)tok * 1024 + h * 128 + l15 * 8) = packf8(o);
  }
}

DI void qknorm_cumsum(const Params& p, char* smem) {
  char* ws = p.ws;
  u16* proj = (u16*)(ws + OFF_PROJ);
  const int tid = tidx(), lane = tid & 63, l15 = lane & 15, quad = lane >> 4;
  const int gw = blockIdx.x * 4 + (tid >> 6), nw = gridDim.x * 4;
  for (int idx = gw; idx < 65536; idx += nw) {
    const int which = idx >> 15, r4 = idx & 32767;
    const int rh = r4 * 4 + quad, tok = rh >> 3, h = rh & 7;
    const float* wv = which ? p.b_k_norm_w : p.b_q_norm_w;
    u16* ptr = proj + (size_t)tok * 4096 + which * 1024 + h * 128 + l15 * 8;
    float v[8];
    unpack8(*(const u32x4*)ptr, v);
    float ssq = 0.f;
#pragma unroll
    for (int e = 0; e < 8; ++e) ssq += v[e] * v[e];
    ssq += __shfl_xor(ssq, 1); ssq += __shfl_xor(ssq, 2); ssq += __shfl_xor(ssq, 4); ssq += __shfl_xor(ssq, 8);
    const float rs = rsqrtf(ssq * (1.f / 128.f) + kEps) * (which ? 1.f : kScale);
#pragma unroll
    for (int e = 0; e < 8; ++e) v[e] = v[e] * rs * wv[l15 * 8 + e];
    *(u32x4*)ptr = packf8(v);
  }
}

DI void attn_phase(const Params& p, char* smem) {
  char* ws = p.ws;
  const u16* proj = (const u16*)(ws + OFF_PROJ);
  const u16* vT = (const u16*)(ws + OFF_R + 32 * MiB);
  const float* fraw = (const float*)(ws + OFF_FRAW);
  u16* y1 = (u16*)(ws + OFF_R + 64 * MiB);
  float* bias_s = (float*)(smem + 65536);
  float* ca_s = bias_s + 128;
  const int tid_ = tidx();
  float mq = 0.f, mk = 0.f;
  for (int i = 0; i < 128; ++i) { mq = fmaxf(mq, fabsf(p.b_q_norm_w[i])); mk = fmaxf(mk, fabsf(p.b_k_norm_w[i])); }
  const float QKB = 128.f * kScale * mq * mk;
  float* mmin_s = (float*)(smem + 66320);

  unsigned* qctr = (unsigned*)(ws + OFF_BAR) + XCD_BAR_WORDS;
  int* qslot = (int*)(smem + 66304);
  int qx = blockIdx.x & 7, qtries = 0;
  while (true) {
    const int tid = relaunder(tid_), lane = tid & 63, wave = tid >> 6, l15 = lane & 15, quad = lane >> 4;
    if (tid == 0) *qslot = (int)atomicAdd(qctr + qx * 16, 1u);
    __syncthreads();
    const int it = *qslot;
    __syncthreads();
    if (it >= 128) { if (++qtries >= 8) break; qx = (qx + 1) & 7; continue; }
    const int qb = 63 - (it & 63);
    const int b = it >> 6, h = b ? ((qx + 4) & 7) : qx, bh = b * 8 + h, i0 = qb * 128;
    const int qrow0 = i0 + 32 * wave;
    const float fb = p.b_f_bias[h];
    bf16x8 bq[2][4];
#pragma unroll
    for (int nq = 0; nq < 2; ++nq)
#pragma unroll
      for (int ks = 0; ks < 4; ++ks)
        bq[nq][ks] = *(const bf16x8*)(proj + (size_t)(b * 8192 + qrow0 + 16 * nq + l15) * 4096 + h * 128 + 32 * ks + 8 * quad);
    f32x4 O[8][2];
#pragma unroll
    for (int dt = 0; dt < 8; ++dt) { O[dt][0] = (f32x4){0.f, 0.f, 0.f, 0.f}; O[dt][1] = (f32x4){0.f, 0.f, 0.f, 0.f}; }
    float mrun[2] = {-1e30f, -1e30f}, lrun[2] = {0.f, 0.f};

    const int kkey = wave * 4 + (lane >> 4);
    const int kch = (lane & 15) ^ (kkey & 15);
    const u16* Kg = proj + (size_t)(b * 8192 + kkey) * 4096 + 1024 + h * 128 + kch * 8;
    const int vd = wave * 8 + (lane >> 3);
    const int vch = (lane & 7) ^ ((((wave & 1) << 2) + (lane >> 4)) & 7);
    const u16* Vg = vT + (size_t)(bh * 128 + vd) * 8192 + vch * 8;
#define ATT_STAGE(buf, j0_)                                                                                                   \
  do {                                                                                                                        \
    _Pragma("unroll") for (int i = 0; i < 4; ++i) {                                                                           \
      __builtin_amdgcn_global_load_lds((const unsigned*)(Kg + (size_t)((j0_) + 16 * i) * 4096),                               \
                                       (unsigned*)(smem + (buf) * 32768 + (i * 4 + wave) * 1024), 16, 0, 0);                  \
      __builtin_amdgcn_global_load_lds((const unsigned*)(Vg + (size_t)(32 * i) * 8192 + (j0_)),                               \
                                       (unsigned*)(smem + (buf) * 32768 + 16384 + (i * 4 + wave) * 1024), 16, 0, 0);          \
    }                                                                                                                         \
  } while (0)
    int j0 = i0 + 64;
    ATT_STAGE(0, j0);
    float carry = 0.f, biasA = 0.f, frn = 0.f;
    if (wave == 0) {
      const float xa = fraw[(size_t)(b * 8192 + i0 + lane) * 16 + h] + fb;
      const float xb2 = fraw[(size_t)(b * 8192 + i0 + 64 + lane) * 16 + h] + fb;
      const float lfA = fminf(xa, 0.f) - log1pf(__expf(-fabsf(xa)));
      const float lfB = fminf(xb2, 0.f) - log1pf(__expf(-fabsf(xb2)));
      float pa = lfA, pb = lfB;
#pragma unroll
      for (int o = 1; o < 64; o <<= 1) {
        const float ta = __shfl_up(pa, o), tb = __shfl_up(pb, o);
        if (lane >= o) { pa += ta; pb += tb; }
      }
      const float lf0 = __shfl(lfA, 0), totA = __shfl(pa, 63);
      biasA = -(pa - lf0) * kLog2e;
      bias_s[lane] = -(totA - lf0 + pb) * kLog2e;
      carry = lf0;
    }
    if (lane == 0) { mmin_s[wave] = -1e30f; mmin_s[4 + wave] = -1e30f; }
    asm volatile("s_waitcnt vmcnt(0)" ::: "memory");
    __syncthreads();
    auto att_tile = [&](const int cur) __attribute__((always_inline)) -> bool {
      const int nj = j0 - 64;
      bool more = nj >= 0;
      if (more && j0 <= i0) {
        const float* mm = mmin_s + cur * 4;
        const float mmin = fminf(fminf(mm[0], mm[1]), fminf(mm[2], mm[3]));
        more = !((QKB + ca_s[cur]) * kLog2e < mmin - 30.f * kLog2e);
      }
      if (more) {
        ATT_STAGE(cur ^ 1, nj);
        if (wave == 0 && nj < i0) frn = fraw[(size_t)(b * 8192 + nj + lane) * 16 + h];
      }
      if (j0 <= qrow0 + 31) {
        const char* Ks = smem + cur * 32768;
        const char* Vs = Ks + 16384;
        const float* cs = bias_s + cur * 64;
        f32x4 s[4][2];
#pragma unroll
        for (int kt = 0; kt < 4; ++kt) { s[kt][0] = (f32x4){0.f, 0.f, 0.f, 0.f}; s[kt][1] = (f32x4){0.f, 0.f, 0.f, 0.f}; }
#pragma unroll
        for (int ks = 0; ks < 4; ++ks)
#pragma unroll
          for (int kt = 0; kt < 4; ++kt) {
            const int kl = 16 * kt + l15;
            const bf16x8 ak = *(const bf16x8*)(Ks + kl * 256 + (((ks * 4 + quad) ^ (kl & 15)) << 4));
            s[kt][0] = mfma16(ak, bq[0][ks], s[kt][0]);
            s[kt][1] = mfma16(ak, bq[1][ks], s[kt][1]);
          }
        const bool diag = (j0 >= i0);
#pragma unroll
        for (int kt = 0; kt < 4; ++kt) {
          const f32x4 bias = *(const f32x4*)(cs + 16 * kt + 4 * quad);
#pragma unroll
          for (int nq = 0; nq < 2; ++nq)
#pragma unroll
            for (int jj = 0; jj < 4; ++jj) {
              float v = s[kt][nq][jj] + bias[jj];
              if (diag) { if (j0 + 16 * kt + 4 * quad + jj > qrow0 + 16 * nq + l15) v = -1e30f; }
              s[kt][nq][jj] = v;
            }
        }
        bf16x8 bP[2][2];
#pragma unroll
        for (int nq = 0; nq < 2; ++nq) {
          float tmax = -1e30f;
#pragma unroll
          for (int kt = 0; kt < 4; ++kt)
#pragma unroll
            for (int jj = 0; jj < 4; ++jj) tmax = fmaxf(tmax, s[kt][nq][jj]);
          tmax = fmaxf(tmax, __shfl_xor(tmax, 16));
          tmax = fmaxf(tmax, __shfl_xor(tmax, 32));
          const float mnew = fmaxf(mrun[nq], tmax);
          const float alpha = __builtin_amdgcn_exp2f(mrun[nq] - mnew);
          const bool grew = mnew > mrun[nq];
          mrun[nq] = mnew;
          float psum = 0.f;
#pragma unroll
          for (int kt = 0; kt < 4; ++kt)
#pragma unroll
            for (int jj = 0; jj < 4; ++jj) { const float pv = __builtin_amdgcn_exp2f(s[kt][nq][jj] - mnew); s[kt][nq][jj] = pv; psum += pv; }
          lrun[nq] = lrun[nq] * alpha + psum;
          if (__builtin_amdgcn_ballot_w64(grew) != 0ull) {
#pragma unroll
            for (int dt = 0; dt < 8; ++dt) O[dt][nq] = O[dt][nq] * alpha;
          }
          bP[0][nq] = pack8(s[0][nq], s[1][nq]);
          bP[1][nq] = pack8(s[2][nq], s[3][nq]);
        }
#pragma unroll
        for (int ks = 0; ks < 2; ++ks)
#pragma unroll
          for (int dt = 0; dt < 8; ++dt) {
            const int d = 16 * dt + l15, sw = (d >> 1) & 7, c0 = 4 * ks + (quad >> 1);
            const u32x2 lo = *(const u32x2*)(Vs + d * 128 + ((c0 ^ sw) << 4) + (quad & 1) * 8);
            const u32x2 hi = *(const u32x2*)(Vs + d * 128 + (((c0 + 2) ^ sw) << 4) + (quad & 1) * 8);
            const bf16x8 av = mk8(lo, hi);
            O[dt][0] = mfma16(av, bP[ks][0], O[dt][0]);
            O[dt][1] = mfma16(av, bP[ks][1], O[dt][1]);
          }
        float wm = fminf(mrun[0], mrun[1]);
#pragma unroll
        for (int o = 1; o < 64; o <<= 1) wm = fminf(wm, __shfl_xor(wm, o));
        if (lane == 0) mmin_s[(cur ^ 1) * 4 + wave] = wm;
      }
      if (more && wave == 0) {
        const int nb = cur ^ 1;
        if (nj == i0) {
          bias_s[nb * 64 + lane] = biasA;
          if (lane == 0) ca_s[nb] = carry;
        } else {
          const float xv = frn + fb;
          const float lf = fminf(xv, 0.f) - log1pf(__expf(-fabsf(xv)));
          float sf = lf;
#pragma unroll
          for (int o = 1; o < 64; o <<= 1) { const float t = __shfl_down(sf, o); if (lane + o < 64) sf += t; }
          bias_s[nb * 64 + lane] = (sf - lf + carry) * kLog2e;
          carry += __shfl(sf, 0);
          if (lane == 0) ca_s[nb] = carry;
        }
      }
      asm volatile("s_waitcnt vmcnt(0)" ::: "memory");
      __syncthreads();
      if (!more) return false;
      j0 = nj;
      return true;
    };
    while (true) {
      if (!att_tile(0)) break;
      if (!att_tile(1)) break;
    }
#undef ATT_STAGE
#pragma unroll
    for (int nq = 0; nq < 2; ++nq) {
      float l = lrun[nq];
      l += __shfl_xor(l, 16);
      l += __shfl_xor(l, 32);
      const float inv = 1.f / l;
      const size_t tok = (size_t)(b * 8192 + qrow0 + 16 * nq + l15);
#pragma unroll
      for (int dt = 0; dt < 8; ++dt) {
        const int d = 16 * dt + 4 * quad;
        const u32x2 z2 = *(const u32x2*)(proj + tok * 4096 + 3072 + h * 128 + d);
        const f32x4 o = O[dt][nq] * inv;
        u32x2 r = {pack2(o[0] * silu(bflo(z2.x)), o[1] * silu(bfhi(z2.x))), pack2(o[2] * silu(bflo(z2.y)), o[3] * silu(bfhi(z2.y)))};
        *(u32x2*)(y1 + tok * 1024 + h * 128 + d) = r;
      }
    }
  }
}

DI void final_norm(const Params& p) {
  const float* ss2 = (const float*)(p.ws + OFF_SS2);
  const int tidf = tidx();
  const int lane = tidf & 63;
  const int gw = blockIdx.x * 4 + (tidf >> 6), nw = gridDim.x * 4;
  const f32x4* w = (const f32x4*)p.final_norm_w;
  f32x4 wv[4];
#pragma unroll
  for (int i = 0; i < 4; ++i) wv[i] = w[lane + 64 * i];
  for (int row = gw; row < 16384; row += 4 * nw) {
    u32x2 r[4][4];
    float rs[4];
#pragma unroll
    for (int k = 0; k < 4; ++k) {
      const int rr = row + k * nw;
      const bool okr = rr < 16384;
      const int rc = okr ? rr : row;
      rs[k] = rsqrtf(ss2[rc] * (1.f / 1024.f) + kEps);
      const u32x2* hsrc = (const u32x2*)((const u16*)(p.ws + OFF_R) + (size_t)rc * 1024);
#pragma unroll
      for (int i = 0; i < 4; ++i) r[k][i] = hsrc[lane + 64 * i];
    }
#pragma unroll
    for (int k = 0; k < 4; ++k) {
      const int rr = row + k * nw;
      if (rr < 16384) {
        f32x4* o = (f32x4*)(p.out + (size_t)rr * 1024);
#pragma unroll
        for (int i = 0; i < 4; ++i) {
          f32x4 v = {bflo(r[k][i].x), bfhi(r[k][i].x), bflo(r[k][i].y), bfhi(r[k][i].y)};
          __builtin_nontemporal_store(v * rs[k] * wv[i], o + lane + 64 * i);
        }
      }
    }
  }
}

__global__ void __launch_bounds__(kThreads, 2) fwd_megakernel(Params p) {
  extern __shared__ __attribute__((aligned(16))) char smem[];
  cg::grid_group grid = cg::this_grid();
  char* ws = p.ws;
  __shared__ uint4 xb_words;
  if (threadIdx.x == 0) xb_words = make_uint4(0u, 0u, 0u, 0u);
  __syncthreads();
  if (p.ws == nullptr) grid.sync();
  XcdBarrier xb = xcd_barrier_post((unsigned*)(ws + OFF_BAR), (volatile LAS unsigned*)&xb_words);
  phase0(p, smem);
  xcd_barrier(xb);
  gemm_phase<1>(p, (const u16*)(ws + OFF_R), (const u16*)(ws + OFF_WTA_IN), 32, smem);
  skinny_gemm<0>(p, (const u16*)(ws + OFF_R), (const u16*)(ws + OFF_WTA_IN) + (size_t)4096 * 1024, (float*)(ws + OFF_BRAW));
  xcd_barrier(xb);
  {
    const bool overlap = gridDim.x >= 128;
    const int G = (int)gridDim.x, hG = G >> 1, bi = (int)blockIdx.x;
    const bool is_scan = overlap && bi < 32, is_idle = overlap && bi >= hG && bi < hG + 32;
    const int pfirst = overlap ? (bi < hG ? 32 : 64) : 0, pn = overlap ? G - 64 : G;
    if (!is_scan && !is_idle) delta_prep(p, smem, pfirst, pn);
    if (!is_scan && !is_idle) phase0b(p, smem, pfirst, pn);
    if (!overlap) xcd_barrier(xb);
    if (!overlap || blockIdx.x < 32) delta_scan(p, smem);
    xcd_barrier(xb);
  }
  gate_phase(p);
  xcd_barrier(xb);
  gemm_phase<2>(p, (const u16*)(ws + OFF_R + 32 * MiB), (const u16*)(ws + OFF_WTA_OUT), 8, smem);
  xcd_barrier(xb);
  gemm_phase<3>(p, (const u16*)(ws + OFF_R), (const u16*)(ws + OFF_WTB_IN), 32, smem);
  skinny_gemm<1>(p, (const u16*)(ws + OFF_R), (const u16*)(ws + OFF_WTB_IN) + (size_t)4096 * 1024, (float*)(ws + OFF_FRAW));
  xcd_barrier(xb);
  attn_phase(p, smem);
  xcd_barrier(xb);
  gemm_phase<4>(p, (const u16*)(ws + OFF_R + 64 * MiB), (const u16*)(ws + OFF_WTB_OUT), 8, smem);
  xcd_barrier(xb);
  final_norm(p);
}

extern "C" void kernel_launch(void* const* d_in, const int* in_sizes, int n_in, void* d_out, int out_size, void* d_ws, size_t ws_size,
                              hipStream_t stream) {
  static int grid_blocks = 0;
  if (!grid_blocks) {
    int dev = 0, cus = 0, per_cu = 0;
    hipGetDevice(&dev);
    hipDeviceGetAttribute(&cus, hipDeviceAttributeMultiprocessorCount, dev);
    hipFuncSetAttribute((const void*)fwd_megakernel, hipFuncAttributeMaxDynamicSharedMemorySize, kLds);
    hipOccupancyMaxActiveBlocksPerMultiprocessor(&per_cu, (const void*)fwd_megakernel, kThreads, kLds);
    if (per_cu < 1) per_cu = 1;
    if (per_cu > 2) per_cu = 2;
    grid_blocks = cus * per_cu;
  }
  Params p{};
  p.x = (const float*)d_in[0]; p.a_norm_w = (const float*)d_in[1]; p.a_w_in = (const float*)d_in[2]; p.a_conv_w = (const float*)d_in[3];
  p.a_A_log = (const float*)d_in[4]; p.a_dt_bias = (const float*)d_in[5]; p.a_o_norm_w = (const float*)d_in[6]; p.a_w_out = (const float*)d_in[7];
  p.b_norm_w = (const float*)d_in[8]; p.b_w_in = (const float*)d_in[9]; p.b_f_bias = (const float*)d_in[10]; p.b_q_norm_w = (const float*)d_in[11];
  p.b_k_norm_w = (const float*)d_in[12]; p.b_w_out = (const float*)d_in[13]; p.final_norm_w = (const float*)d_in[14];
  p.out = (float*)d_out;
  p.ws = (char*)d_ws;
  hipMemsetAsync((char*)d_ws + OFF_BAR, 0, CTL_BYTES, stream);
  void* args[] = {&p};
  hipError_t e = hipLaunchCooperativeKernel((const void*)fwd_megakernel, dim3(grid_blocks), dim3(kThreads), args, kLds, stream);
  if (e != hipSuccess) fprintf(stderr, "cooperative launch failed: %s (grid %d)\n", hipGetErrorString(e), grid_blocks);
}
```

```cpp
#include <hip/hip_runtime.h>
#include <hip/hip_cooperative_groups.h>
#include <cstdio>
namespace cg = cooperative_groups;

typedef unsigned short u16;
typedef __attribute__((ext_vector_type(8))) short bf16x8;
typedef __attribute__((ext_vector_type(4))) float f32x4;
typedef __attribute__((ext_vector_type(4))) unsigned u32x4;
typedef __attribute__((ext_vector_type(2))) unsigned u32x2;
#define DI __device__ __forceinline__

constexpr int kThreads = 256;
constexpr int kLds = 69632;
constexpr float kEps = 1e-6f;
constexpr float kScale = 0.08838834764831845f;
constexpr float kLog2e = 1.4426950408889634f;

constexpr size_t MiB = 1048576;
constexpr size_t OFF_WTA_IN = 0;
constexpr size_t OFF_WTA_OUT = 8650752;
constexpr size_t OFF_WTB_IN = 10747904;
constexpr size_t OFF_WTB_OUT = 19398656;
constexpr size_t OFF_SMALL = 21495808;
constexpr size_t OFF_RS0 = OFF_SMALL;
constexpr size_t OFF_SS1 = OFF_RS0 + 65536;
constexpr size_t OFF_SS2 = OFF_SS1 + 65536;
constexpr size_t OFF_BRAW = OFF_SS2 + 65536;
constexpr size_t OFF_FRAW = OFF_BRAW + 1048576;
constexpr size_t OFF_CCUM = OFF_FRAW + 1048576;
constexpr size_t OFF_GEND = OFF_CCUM + 524288;
constexpr size_t OFF_BAR = OFF_GEND + 8192;
constexpr size_t OFF_FLAGS = OFF_BAR + 13824 + 512;
constexpr size_t CTL_BYTES = 13824 + 512 + 8192;
constexpr size_t OFF_PROJ = OFF_SMALL + 3 * MiB;
constexpr size_t OFF_R = OFF_PROJ + 128 * MiB;

struct Params {
  const float *x, *a_norm_w, *a_w_in, *a_conv_w, *a_A_log, *a_dt_bias, *a_o_norm_w, *a_w_out;
  const float *b_norm_w, *b_w_in, *b_f_bias, *b_q_norm_w, *b_k_norm_w, *b_w_out, *final_norm_w;
  float* out;
  char* ws;
};

typedef __attribute__((ext_vector_type(2))) float f32x2;
typedef __attribute__((ext_vector_type(2))) __bf16 bf16x2_t;
DI unsigned pack2(float a, float b) { f32x2 v = {a, b}; return __builtin_bit_cast(unsigned, __builtin_convertvector(v, bf16x2_t)); }
DI unsigned f2bf(float x) { return pack2(x, 0.f) & 0xffffu; }
DI float bflo(unsigned u) { return __uint_as_float(u << 16); }
DI float bfhi(unsigned u) { return __uint_as_float(u & 0xffff0000u); }
DI f32x4 mfma16(bf16x8 a, bf16x8 b, f32x4 c) { return __builtin_amdgcn_mfma_f32_16x16x32_bf16(a, b, c, 0, 0, 0); }
DI bf16x8 mk8(u32x2 lo, u32x2 hi) { u32x4 v = {lo.x, lo.y, hi.x, hi.y}; return __builtin_bit_cast(bf16x8, v); }
DI bf16x8 pack8(f32x4 a, f32x4 b) { u32x4 v = {pack2(a[0], a[1]), pack2(a[2], a[3]), pack2(b[0], b[1]), pack2(b[2], b[3])}; return __builtin_bit_cast(bf16x8, v); }
DI bf16x8 ld2(const u16* p) { return mk8(*(const u32x2*)p, *(const u32x2*)(p + 16)); }
DI int relaunder(int t) { asm volatile("" : "+v"(t)); return t; }
DI int tidx() { int t = threadIdx.x; asm volatile("" : "+v"(t)); return t; }
DI float silu(float x) { return x / (1.f + __expf(-x)); }
DI void unpack8(u32x4 v, float* f) {
  f[0] = bflo(v.x); f[1] = bfhi(v.x); f[2] = bflo(v.y); f[3] = bfhi(v.y);
  f[4] = bflo(v.z); f[5] = bfhi(v.z); f[6] = bflo(v.w); f[7] = bfhi(v.w);
}
DI u32x4 packf8(const float* f) { u32x4 v = {pack2(f[0], f[1]), pack2(f[2], f[3]), pack2(f[4], f[5]), pack2(f[6], f[7])}; return v; }


#define XB_TMO      128
#define XB_XCNT(j)  (256  + 64 * (j))
#define XB_XSUB(j)  (1280 + 64 * (j))
#define XB_XGEN(j)  (2304 + 64 * (j))
#define XB_TOP      3328
#define XB_TOPGEN   3392
#define XCD_BAR_WORDS 3456
#define XB_SPIN_CAP (1u << 23)
#define LAS __attribute__((address_space(3)))
DI unsigned xb_ld(unsigned* p) { return __hip_atomic_load(p, __ATOMIC_RELAXED, __HIP_MEMORY_SCOPE_AGENT); }
DI unsigned xb_add(unsigned* p, unsigned v) { return __hip_atomic_fetch_add(p, v, __ATOMIC_RELAXED, __HIP_MEMORY_SCOPE_AGENT); }
DI unsigned xb_xcc_id() { return (unsigned)__builtin_amdgcn_s_getreg((3 << 11) | 20) & 0xFu; }
#define XB_SPIN(cond, bar) do { unsigned _sp = 0; while (cond) { __builtin_amdgcn_s_sleep(1); \
    if ((++_sp & 255u) == 0u) { if (xb_ld(&(bar)[XB_TMO])) break; if (_sp > XB_SPIN_CAP) { atomicAdd(&(bar)[XB_TMO], 1u); break; } } } } while (0)
struct XcdBarrier { unsigned* bar; unsigned x; volatile LAS unsigned* st; };
DI XcdBarrier xcd_barrier_post(unsigned* bar, volatile LAS unsigned* st) {
  XcdBarrier b; b.bar = bar; b.x = xb_xcc_id(); b.st = st;
  if (threadIdx.x == 0) (void)xb_add(&bar[XB_XCNT(b.x)], 1u);
  return b;
}
DI void xcd_barrier_complete(unsigned* bar, unsigned x, unsigned& nloc, unsigned& nx) {
  const unsigned G = gridDim.x * gridDim.y * gridDim.z;
  unsigned sum, cnt, mine, sp = 0u;
  for (;;) {
    sum = 0u; cnt = 0u; mine = 0u;
#pragma unroll
    for (unsigned j = 0; j < 16; ++j) { const unsigned c = xb_ld(&bar[XB_XCNT(j)]); sum += c; cnt += (c > 0u) ? 1u : 0u; mine = (j == x) ? c : mine; }
    if (sum == G) break;
    __builtin_amdgcn_s_sleep(1);
    if ((++sp & 255u) == 0u) { if (xb_ld(&bar[XB_TMO])) break; if (sp > XB_SPIN_CAP) { atomicAdd(&bar[XB_TMO], 1u); break; } }
  }
  nloc = mine > 0u ? mine : 1u; nx = cnt > 0u ? cnt : 1u;
}
DI void xcd_barrier(const XcdBarrier& b) {
  asm volatile("s_waitcnt vmcnt(0)" ::: "memory");
  __syncthreads();
  if (threadIdx.x == 0) {
    unsigned* bar = b.bar;
    __builtin_amdgcn_s_waitcnt(0);
    unsigned nloc = b.st[0], nx = b.st[1];
    if (nloc == 0u) { xcd_barrier_complete(bar, b.x, nloc, nx); b.st[0] = nloc; b.st[1] = nx; }
    const unsigned old = xb_add(&bar[XB_XSUB(b.x)], 1u);
    const unsigned gen = old / nloc;
    if (old + 1u == (gen + 1u) * nloc) {
      __builtin_amdgcn_fence(__ATOMIC_RELEASE, "agent");
      asm volatile("s_waitcnt vmcnt(0)" ::: "memory");
      const unsigned og = xb_add(&bar[XB_TOP], 1u);
      const unsigned tg = og / nx;
      if (og + 1u == (tg + 1u) * nx) xb_add(&bar[XB_TOPGEN], 1u);
      else XB_SPIN(xb_ld(&bar[XB_TOPGEN]) == tg, bar);
      __builtin_amdgcn_fence(__ATOMIC_ACQUIRE, "agent");
      xb_add(&bar[XB_XGEN(b.x)], 1u);
      asm volatile("s_waitcnt vmcnt(0)" ::: "memory");
    } else {
      XB_SPIN(xb_ld(&bar[XB_XGEN(b.x)]) == gen, bar);
      __builtin_amdgcn_fence(__ATOMIC_ACQUIRE, "agent");
      asm volatile("s_waitcnt vmcnt(0)" ::: "memory");
    }
  }
  __syncthreads();
}

DI void transpose_tile(const float* __restrict__ W, int N, int Npad, const float* __restrict__ kscale, u16* __restrict__ WT, int tile, char* smem) {
  float(*t)[65] = (float(*)[65])smem;
  const int nt = Npad / 64;
  const int k0 = (tile / nt) * 64, n0 = (tile % nt) * 64;
  const int tid = tidx();
  {
    const int tx = tid & 63, ty = tid >> 6;
#pragma unroll 4
    for (int i = 0; i < 16; ++i) {
      const int k = k0 + ty + 4 * i, n = n0 + tx;
      float v = 0.f;
      if (n < N) { v = W[(size_t)k * N + n]; if (kscale) v *= kscale[k]; }
      t[ty + 4 * i][tx] = v;
    }
  }
  __syncthreads();
  {
    const int kx2 = (tid & 31) * 2, ny0 = tid >> 5;
#pragma unroll 4
    for (int i = 0; i < 8; ++i) {
      const int ny = ny0 + 8 * i;
      *(unsigned*)(WT + (size_t)(n0 + ny) * 1024 + k0 + kx2) = pack2(t[kx2][ny], t[kx2 + 1][ny]);
    }
  }
  __syncthreads();
}

DI void phase0(const Params& p, char* smem) {
  char* ws = p.ws;
  {
    float* ss = (float*)(ws + OFF_SS1);
    for (int i = blockIdx.x * kThreads + tidx(); i < 32768; i += gridDim.x * kThreads) ss[i] = 0.f;
  }
  for (int t = blockIdx.x; t < 1312; t += gridDim.x) {
    if (t < 1056) transpose_tile(p.a_w_in, 4112, 4224, p.a_norm_w, (u16*)(ws + OFF_WTA_IN), t, smem);
    else transpose_tile(p.a_w_out, 1024, 1024, nullptr, (u16*)(ws + OFF_WTA_OUT), t - 1056, smem);
  }
  const int tid0 = tidx();
  const int lane = tid0 & 63;
  const int gw = blockIdx.x * 4 + (tid0 >> 6), nw = gridDim.x * 4;
  u16* xb = (u16*)(ws + OFF_R);
  float* rs0 = (float*)(ws + OFF_RS0);
  for (int row = gw; row < 16384; row += 4 * nw) {
    f32x4 v[4][4];
#pragma unroll
    for (int k = 0; k < 4; ++k) {
      const int rr = row + k * nw;
      const f32x4* xr = (const f32x4*)(p.x + (size_t)(rr < 16384 ? rr : row) * 1024);
#pragma unroll
      for (int i = 0; i < 4; ++i) v[k][i] = __builtin_nontemporal_load(xr + lane + 64 * i);
    }
#pragma unroll
    for (int k = 0; k < 4; ++k) {
      const int rr = row + k * nw;
      float ss = 0.f;
#pragma unroll
      for (int i = 0; i < 4; ++i) ss += v[k][i][0] * v[k][i][0] + v[k][i][1] * v[k][i][1] + v[k][i][2] * v[k][i][2] + v[k][i][3] * v[k][i][3];
#pragma unroll
      for (int o = 32; o >= 1; o >>= 1) ss += __shfl_xor(ss, o);
      if (rr < 16384) {
        u32x2* xo = (u32x2*)(xb + (size_t)rr * 1024);
#pragma unroll
        for (int i = 0; i < 4; ++i) { u32x2 o = {pack2(v[k][i][0], v[k][i][1]), pack2(v[k][i][2], v[k][i][3])}; xo[lane + 64 * i] = o; }
        if (lane == 0) rs0[rr] = rsqrtf(ss * (1.f / 1024.f) + kEps);
      }
    }
  }
}

DI void phase0b(const Params& p, char* smem, int first, int nblk) {
  char* ws = p.ws;
  for (int t = (int)blockIdx.x - first; t < 1312; t += nblk) {
    if (t < 1056) transpose_tile(p.b_w_in, 4104, 4224, p.b_norm_w, (u16*)(ws + OFF_WTB_IN), t, smem);
    else transpose_tile(p.b_w_out, 1024, 1024, nullptr, (u16*)(ws + OFF_WTB_OUT), t - 1056, smem);
  }
}

template <int EPI>
DI void gemm_phase(const Params& p, const u16* __restrict__ A, const u16* __restrict__ Bt, int nTn, char* smem) {
  const int tid = tidx(), lane = tid & 63, wave = tid >> 6;
  const int wr = wave >> 1, wc = wave & 1;
  const int l15 = lane & 15, quad = lane >> 4;
  char* ws = p.ws;
  const int NX = ((gridDim.x & 7) == 0) ? 8 : 1;
  const int xg = blockIdx.x % NX, lb = blockIdx.x / NX, Lb = gridDim.x / NX;
  const int nTnG = nTn >> 3, nSuper = 16 * nTnG;
  const int srow = wave * 8 + (lane >> 3);
  const int sch = (lane & 7) ^ ((((wave & 1) << 2) + (lane >> 4)) & 7);
#define GEMM_TILE(seq_, tm_, tn_, ok_)                                                            \
  do {                                                                                            \
    const int sidx_ = xg + NX * ((seq_) >> 6);                                                    \
    ok_ = sidx_ < nSuper;                                                                         \
    const int tl_ = (seq_) & 63;                                                                  \
    tm_ = (sidx_ / nTnG) * 8 + (tl_ & 7);                                                         \
    tn_ = (sidx_ % nTnG) * 8 + (tl_ >> 3);                                                        \
  } while (0)
#define GEMM_STAGE(buf, kt)                                                                                                   \
  do {                                                                                                                        \
    _Pragma("unroll") for (int i = 0; i < 4; ++i) {                                                                           \
      __builtin_amdgcn_global_load_lds((const unsigned*)(Ag + (size_t)i * 32 * 1024 + (kt) * 64),                             \
                                       (unsigned*)(smem + (buf) * 32768 + (i * 4 + wave) * 1024), 16, 0, 0);                  \
      __builtin_amdgcn_global_load_lds((const unsigned*)(Bg + (size_t)i * 32 * 1024 + (kt) * 64),                             \
                                       (unsigned*)(smem + (buf) * 32768 + 16384 + (i * 4 + wave) * 1024), 16, 0, 0);          \
    }                                                                                                                         \
  } while (0)
  int seq = lb, tm, tn;
  bool ok;
  GEMM_TILE(seq, tm, tn, ok);
  const u16* Ag = A + (size_t)(tm * 128 + srow) * 1024 + sch * 8;
  const u16* Bg = Bt + (size_t)(tn * 128 + srow) * 1024 + sch * 8;
  if (ok) GEMM_STAGE(0, 0);
  while (ok) {
    int tm2, tn2;
    bool ok2;
    GEMM_TILE(seq + Lb, tm2, tn2, ok2);
    f32x4 acc[4][4];
#pragma unroll
    for (int a = 0; a < 4; ++a)
#pragma unroll
      for (int b = 0; b < 4; ++b) acc[a][b] = (f32x4){0.f, 0.f, 0.f, 0.f};
    asm volatile("s_waitcnt vmcnt(0)" ::: "memory");
    __syncthreads();
#pragma unroll 2
    for (int kt = 0; kt < 16; ++kt) {
      const int cur = kt & 1;
      if (kt + 1 < 16) GEMM_STAGE(cur ^ 1, kt + 1);
      else if (ok2) {
        Ag = A + (size_t)(tm2 * 128 + srow) * 1024 + sch * 8;
        Bg = Bt + (size_t)(tn2 * 128 + srow) * 1024 + sch * 8;
        GEMM_STAGE(0, 0);
      }
      const char* sa = smem + cur * 32768;
      const char* sb = sa + 16384;
#pragma unroll
      for (int ks = 0; ks < 2; ++ks) {
        bf16x8 fa[4], fb[4];
        const int ch = ks * 4 + quad;
#pragma unroll
        for (int mi = 0; mi < 4; ++mi) {
          const int row = wr * 64 + mi * 16 + l15;
          fa[mi] = *(const bf16x8*)(sa + row * 128 + ((ch ^ ((row >> 1) & 7)) << 4));
        }
#pragma unroll
        for (int ni = 0; ni < 4; ++ni) {
          const int row = wc * 64 + ni * 16 + l15;
          fb[ni] = *(const bf16x8*)(sb + row * 128 + ((ch ^ ((row >> 1) & 7)) << 4));
        }
#pragma unroll
        for (int ni = 0; ni < 4; ++ni)
#pragma unroll
          for (int mi = 0; mi < 4; ++mi) acc[ni][mi] = mfma16(fb[ni], fa[mi], acc[ni][mi]);
      }
      if (kt < 15) {
        asm volatile("s_waitcnt vmcnt(0)" ::: "memory");
        __syncthreads();
      }
    }
    float hnorm[4] = {1.f, 1.f, 1.f, 1.f};
    if constexpr (EPI == 3) {
      if (tn < 16) {
        float* part = (float*)(smem + 65536);
        float ssq[4];
#pragma unroll
        for (int mi = 0; mi < 4; ++mi) {
          const float rs = rsqrtf(((const float*)(ws + OFF_SS1))[tm * 128 + wr * 64 + mi * 16 + l15] * (1.f / 1024.f) + kEps);
          float s = 0.f;
#pragma unroll
          for (int ni = 0; ni < 4; ++ni) { const f32x4 v = acc[ni][mi] * rs; s += v[0] * v[0] + v[1] * v[1] + v[2] * v[2] + v[3] * v[3]; }
          s += __shfl_xor(s, 16);
          s += __shfl_xor(s, 32);
          ssq[mi] = s;
          if (quad == 0) part[(wr * 2 + wc) * 64 + mi * 16 + l15] = s;
        }
        __syncthreads();
#pragma unroll
        for (int mi = 0; mi < 4; ++mi) {
          const float tot = ssq[mi] + part[(wr * 2 + (wc ^ 1)) * 64 + mi * 16 + l15];
          hnorm[mi] = rsqrtf(tot * (1.f / 128.f) + kEps) * (tn < 8 ? kScale * kLog2e : 1.f);
        }
      }
    }
#pragma unroll
    for (int mi = 0; mi < 4; ++mi) {
      const int m = tm * 128 + wr * 64 + mi * 16 + l15;
      if constexpr (EPI == 1) {
        const float rs = ((const float*)(ws + OFF_RS0))[m];
        u16* proj = (u16*)(ws + OFF_PROJ);
        float* braw = (float*)(ws + OFF_BRAW);
#pragma unroll
        for (int ni = 0; ni < 4; ++ni) {
          const int nb = tn * 128 + wc * 64 + ni * 16 + quad * 4;
          f32x4 v = acc[ni][mi] * rs;
          if (nb < 4096) { u32x2 o = {pack2(v[0], v[1]), pack2(v[2], v[3])}; __builtin_nontemporal_store(o, (u32x2*)(proj + (size_t)m * 4096 + nb)); }
          else if (nb < 4112) { *(f32x4*)(braw + (size_t)m * 16 + (nb - 4096)) = v; }
        }
      } else if constexpr (EPI == 2 || EPI == 4) {
        float* ssp = (float*)(ws + (EPI == 2 ? OFF_SS1 : OFF_SS2));
        u16* hb = (u16*)(ws + OFF_R);
        float ssq = 0.f;
#pragma unroll
        for (int ni = 0; ni < 4; ++ni) {
          const int nb = tn * 128 + wc * 64 + ni * 16 + quad * 4;
          f32x4 v;
          if constexpr (EPI == 2) {
            v = acc[ni][mi] + __builtin_nontemporal_load((const f32x4*)(p.x + (size_t)m * 1024 + nb));
            u32x2 o = {pack2(v[0], v[1]), pack2(v[2], v[3])};
            *(u32x2*)(hb + (size_t)m * 1024 + nb) = o;
            v[0] = bflo(o.x); v[1] = bfhi(o.x); v[2] = bflo(o.y); v[3] = bfhi(o.y);
          } else {
            const u32x2 r = *(const u32x2*)(hb + (size_t)m * 1024 + nb);
            v = acc[ni][mi];
            v[0] += bflo(r.x); v[1] += bfhi(r.x); v[2] += bflo(r.y); v[3] += bfhi(r.y);
            const u32x2 o = {pack2(v[0], v[1]), pack2(v[2], v[3])};
            *(u32x2*)(hb + (size_t)m * 1024 + nb) = o;
            v[0] = bflo(o.x); v[1] = bfhi(o.x); v[2] = bflo(o.y); v[3] = bfhi(o.y);
          }
          ssq += v[0] * v[0] + v[1] * v[1] + v[2] * v[2] + v[3] * v[3];
        }
        ssq += __shfl_xor(ssq, 16);
        ssq += __shfl_xor(ssq, 32);
        if (quad == 0) atomicAdd(ssp + m, ssq);
      } else if constexpr (EPI == 3) {
        const float rs = rsqrtf(((const float*)(ws + OFF_SS1))[m] * (1.f / 1024.f) + kEps);
        u16* proj = (u16*)(ws + OFF_PROJ);
        u16* vT = (u16*)(ws + OFF_R + 32 * MiB);
        float* fraw = (float*)(ws + OFF_FRAW);
        float hs = 1.f;
        if (tn < 16) hs = hnorm[mi];
#pragma unroll
        for (int ni = 0; ni < 4; ++ni) {
          const int nb = tn * 128 + wc * 64 + ni * 16 + quad * 4;
          f32x4 v = acc[ni][mi] * rs;
          if (tn < 16) {
            const f32x4 wv = *(const f32x4*)((tn < 8 ? p.b_q_norm_w : p.b_k_norm_w) + (nb & 127));
            v = v * hs * wv;
          }
          if (nb < 4096) {
            if ((nb >> 10) != 2) { u32x2 o = {pack2(v[0], v[1]), pack2(v[2], v[3])}; __builtin_nontemporal_store(o, (u32x2*)(proj + (size_t)m * 4096 + nb)); }
            else {
              const int hd = nb - 2048;
              const int b = m >> 13, t = m & 8191;
              u16* dst = vT + ((size_t)(b * 1024 + hd)) * 8192 + t;
#pragma unroll
              for (int jj = 0; jj < 4; ++jj) dst[(size_t)jj * 8192] = (u16)f2bf(v[jj]);
            }
          } else if (nb < 4104) { *(f32x4*)(fraw + (size_t)m * 16 + (nb - 4096)) = v; }
        }
      }
    }
    seq += Lb; tm = tm2; tn = tn2; ok = ok2;
  }
#undef GEMM_STAGE
#undef GEMM_TILE
}


template <int MODE>
DI void skinny_gemm(const Params& p, const u16* __restrict__ A, const u16* __restrict__ Wt16, float* __restrict__ out) {
  const int tid = tidx(), lane = tid & 63, l15 = lane & 15, quad = lane >> 4;
  const int gw = blockIdx.x * 4 + (tid >> 6), nw = gridDim.x * 4;
  for (int mt = gw; mt < 1024; mt += nw) {
    const int m = mt * 16 + l15;
    const u16* ap = A + (size_t)m * 1024 + quad * 8;
    const u16* bp = Wt16 + (size_t)l15 * 1024 + quad * 8;
    f32x4 acc = {0.f, 0.f, 0.f, 0.f};
#pragma unroll 8
    for (int ks = 0; ks < 32; ++ks) acc = mfma16(*(const bf16x8*)(bp + ks * 32), *(const bf16x8*)(ap + ks * 32), acc);
    float rs;
    if constexpr (MODE == 0) rs = ((const float*)(p.ws + OFF_RS0))[m];
    else rs = rsqrtf(((const float*)(p.ws + OFF_SS1))[m] * (1.f / 1024.f) + kEps);
    *(f32x4*)(out + (size_t)m * 16 + 4 * quad) = acc * rs;
  }
}

DI void delta_prep(const Params& p, char* smem, int first, int nblk) {
  char* ws = p.ws;
  const u16* proj = (const u16*)(ws + OFF_PROJ);
  const float* braw = (const float*)(ws + OFF_BRAW);
  u16* qd_g = (u16*)(ws + OFF_R);
  u16* kT_g = (u16*)(ws + OFF_R + 32 * MiB);
  u16* at_g = (u16*)(ws + OFF_R + 64 * MiB);
  u16* uT_g = (u16*)p.out;
  u16* w_g = (u16*)((char*)p.out + 32 * MiB);
  float* gend_g = (float*)(ws + OFF_GEND);
  char* qL = smem;
  char* kL = smem + 16384;
  char* vL = smem + 32768;
  float* As = (float*)(smem + 49152);
  float* sc = (float*)(smem + 66560);
  float* g_s = sc;
  float* beta_s = sc + 64;
  float* rq_s = sc + 128;
  float* rk_s = sc + 192;
  float* ssq_s = sc + 256;
  float* fu_s = sc + 384;
  float* fw_s = sc + 448;
  const int tid_ = tidx();

  unsigned* flags = (unsigned*)(ws + OFF_FLAGS);
  const __amdgpu_buffer_rsrc_t r_qd = __builtin_amdgcn_make_buffer_rsrc(qd_g, 0, 32 << 20, 0x00020000);
  const __amdgpu_buffer_rsrc_t r_kT = __builtin_amdgcn_make_buffer_rsrc(kT_g, 0, 32 << 20, 0x00020000);
  const __amdgpu_buffer_rsrc_t r_at = __builtin_amdgcn_make_buffer_rsrc(at_g, 0, 16 << 20, 0x00020000);
  const __amdgpu_buffer_rsrc_t r_uT = __builtin_amdgcn_make_buffer_rsrc(uT_g, 0, 32 << 20, 0x00020000);
  const __amdgpu_buffer_rsrc_t r_w = __builtin_amdgcn_make_buffer_rsrc(w_g, 0, 32 << 20, 0x00020000);
  if (nblk >= 256 && ((int)blockIdx.x - first) >= (nblk >> 1)) {
    for (int i = 0; i < 7; ++i) __builtin_amdgcn_s_sleep(127);
  }
  for (int j = (int)blockIdx.x - first; j < 2048; j += nblk) {
    const int c = j >> 4, b = (j >> 3) & 1, h = j & 7;
    const int item = (b * 128 + c) * 8 + h;
    const int tok0 = b * 8192 + c * 64;
    const int tid = relaunder(tid_), lane = tid & 63, wave = tid >> 6, l15 = lane & 15, quad = lane >> 4;
    if (wave == 3) {
      const int row = tok0 + lane;
      const float br = braw[(size_t)row * 16 + h];
      const float ar = braw[(size_t)row * 16 + 8 + h] + p.a_dt_bias[h];
      const float beta = 1.f / (1.f + __expf(-br));
      const float sp = fmaxf(ar, 0.f) + log1pf(__expf(-fabsf(ar)));
      float g = -__expf(p.a_A_log[h]) * sp;
#pragma unroll
      for (int o = 1; o < 64; o <<= 1) { float t = __shfl_up(g, o); if (lane >= o) g += t; }
      g_s[lane] = g;
      beta_s[lane] = beta;
    } else {
      const int sec = wave, cgi = l15, rr = quad;
      const int col = sec * 1024 + h * 128 + cgi * 8;
      float w0[8], w1[8], w2[8], w3[8];
#pragma unroll
      for (int e = 0; e < 8; ++e) {
        w0[e] = p.a_conv_w[0 * 3072 + col + e]; w1[e] = p.a_conv_w[1 * 3072 + col + e];
        w2[e] = p.a_conv_w[2 * 3072 + col + e]; w3[e] = p.a_conv_w[3 * 3072 + col + e];
      }
      const u16* src = proj + (size_t)(tok0 + rr * 16) * 4096 + col;
      float x0[8], x1[8], x2[8], x3[8];
      if (c == 0 && rr == 0) {
#pragma unroll
        for (int e = 0; e < 8; ++e) { x0[e] = 0.f; x1[e] = 0.f; x2[e] = 0.f; }
      } else {
        unpack8(*(const u32x4*)(src - 3 * 4096), x0);
        unpack8(*(const u32x4*)(src - 2 * 4096), x1);
        unpack8(*(const u32x4*)(src - 1 * 4096), x2);
      }
      char* dstL = smem + sec * 16384;
#pragma unroll 4
      for (int r = 0; r < 16; ++r) {
        unpack8(*(const u32x4*)(src + (size_t)r * 4096), x3);
        float y[8];
        float ssq = 0.f;
#pragma unroll
        for (int e = 0; e < 8; ++e) {
          float v = w0[e] * x0[e] + w1[e] * x1[e] + w2[e] * x2[e] + w3[e] * x3[e];
          v = silu(v);
          y[e] = v;
          ssq += v * v;
          x0[e] = x1[e]; x1[e] = x2[e]; x2[e] = x3[e];
        }
        ssq += __shfl_xor(ssq, 1); ssq += __shfl_xor(ssq, 2); ssq += __shfl_xor(ssq, 4); ssq += __shfl_xor(ssq, 8);
        const int row = rr * 16 + r;
        if (sec < 2 && cgi == 0) ssq_s[sec * 64 + row] = ssq;
        *(u32x4*)(dstL + row * 256 + ((cgi ^ (row & 15)) << 4)) = packf8(y);
      }
    }
    __syncthreads();
    if (tid < 64) {
      const float rq = rsqrtf(ssq_s[tid] + kEps), rk = rsqrtf(ssq_s[64 + tid] + kEps);
      const float gi = g_s[tid], g63 = g_s[63];
      const float eg = __expf(gi);
      rq_s[tid] = rq; rk_s[tid] = rk;
      const float be = beta_s[tid];
      fu_s[tid] = be;
      fw_s[tid] = be * rk * eg;
      ssq_s[tid] = rq * kScale * eg;
      ssq_s[64 + tid] = rk * __expf(g63 - gi);
      if (tid == 0) __hip_atomic_store(gend_g + item, __expf(g63), __ATOMIC_RELAXED, __HIP_MEMORY_SCOPE_AGENT);
    }
    __syncthreads();
    {
      const int tid = relaunder(tid_), lane = tid & 63, wave = tid >> 6, l15 = lane & 15, quad = lane >> 4;
      bf16x8 bk[4], bq[4];
      const int rowI = 16 * wave + l15;
#pragma unroll
      for (int ks = 0; ks < 4; ++ks) {
        const int off = rowI * 256 + (((ks * 4 + quad) ^ (rowI & 15)) << 4);
        bk[ks] = *(const bf16x8*)(kL + off);
        bq[ks] = *(const bf16x8*)(qL + off);
      }
      const int i = rowI;
      const float gi = g_s[i], bi = beta_s[i] * rk_s[i], qi = kScale * rq_s[i];
      u32x2 keep = {0u, 0u};
#pragma unroll
      for (int J = 0; J < 4; ++J) {
        f32x4 skk = {0.f, 0.f, 0.f, 0.f}, sqk = {0.f, 0.f, 0.f, 0.f};
        const int rowJ = 16 * J + l15;
#pragma unroll
        for (int ks = 0; ks < 4; ++ks) {
          const bf16x8 ak = *(const bf16x8*)(kL + rowJ * 256 + (((ks * 4 + quad) ^ (rowJ & 15)) << 4));
          skk = mfma16(ak, bk[ks], skk);
          sqk = mfma16(ak, bq[ks], sqk);
        }
        const f32x4 gj4 = *(const f32x4*)(g_s + 16 * J + 4 * quad);
        const f32x4 rk4 = *(const f32x4*)(rk_s + 16 * J + 4 * quad);
        f32x4 a4, t4;
#pragma unroll
        for (int jj = 0; jj < 4; ++jj) {
          const int j = 16 * J + 4 * quad + jj;
          const float dec = (i >= j) ? __expf(gi - gj4[jj]) : 0.f;
          a4[jj] = (i > j) ? bi * rk4[jj] * skk[jj] * dec : 0.f;
          t4[jj] = qi * rk4[jj] * sqk[jj] * dec;
        }
        *(f32x4*)(As + i * 68 + 16 * J + 4 * quad) = a4;
        const u32x2 half = {pack2(t4[0], t4[1]), pack2(t4[2], t4[3])};
        if ((J & 1) == 0) keep = half;
        else {
          const u32x4 fr = {keep.x, keep.y, half.x, half.y};
          __builtin_amdgcn_raw_buffer_store_b128(fr, r_at, item * 8192 + ((wave * 2 + (J >> 1)) * 64 + lane) * 16, 0, 16);
        }
      }
    }
    {
      const int tid = relaunder(tid_);
#pragma unroll
      for (int it = 0; it < 4; ++it) {
        const int idx = tid + 256 * it;
        const int f = idx >> 6, ln = idx & 63, fl = ln & 15, fq = ln >> 4;
        {
          const int mt = f >> 2, ks = f & 3, i = 16 * mt + fl;
          const int c0 = 4 * ks + (fq >> 1), o8 = (fq & 1) * 8;
          const u32x2 lo = *(const u32x2*)(qL + i * 256 + ((c0 ^ (i & 15)) << 4) + o8);
          const u32x2 hi = *(const u32x2*)(qL + i * 256 + (((c0 + 2) ^ (i & 15)) << 4) + o8);
          const float s = ssq_s[i];
          const u32x4 o = {pack2(bflo(lo.x) * s, bfhi(lo.x) * s), pack2(bflo(lo.y) * s, bfhi(lo.y) * s),
                           pack2(bflo(hi.x) * s, bfhi(hi.x) * s), pack2(bflo(hi.y) * s, bfhi(hi.y) * s)};
          __builtin_amdgcn_raw_buffer_store_b128(o, r_qd, item * 16384 + idx * 16, 0, 16);
        }
        {
          const int mt = f >> 1, ks = f & 1, dk = 16 * mt + fl;
          float v[8];
#pragma unroll
          for (int e = 0; e < 8; ++e) {
            const int i = 32 * ks + ((e < 4) ? (4 * fq + e) : (16 + 4 * fq + e - 4));
            const u16 raw = *(const u16*)(kL + i * 256 + (((dk >> 3) ^ (i & 15)) << 4) + (dk & 7) * 2);
            v[e] = __uint_as_float(((unsigned)raw) << 16) * ssq_s[64 + i];
          }
          __builtin_amdgcn_raw_buffer_store_b128(packf8(v), r_kT, item * 16384 + idx * 16, 0, 16);
        }
      }
    }
    __syncthreads();
    {
      float U[64];
      const int tid = relaunder(tid_), wave = tid >> 6;
      const int cc = tid & 127, ch = cc >> 3, e2 = (cc & 7) * 2;
      const char* srcL = (wave < 2) ? vL : kL;
      const float* fr = (wave < 2) ? fu_s : fw_s;
#pragma unroll
      for (int i = 0; i < 64; ++i) {
        int ii = i;
        asm volatile("" : "+v"(ii));
        const u16 raw = *(const u16*)(srcL + ii * 256 + ((ch ^ (ii & 15)) << 4) + e2);
        float acc = __uint_as_float(((unsigned)raw) << 16) * fr[ii];
#pragma unroll
        for (int j = 0; j < i; ++j) acc -= As[i * 68 + j] * U[j];
        U[i] = acc;
      }
      if (wave < 2) {
        const int dofs = item * 16384 + (((cc >> 4) * 4) * 256 + (cc & 15) * 4) * 2;
#pragma unroll
        for (int mi = 0; mi < 4; ++mi)
#pragma unroll
          for (int q4 = 0; q4 < 4; ++q4) {
            const u32x2 o = {pack2(U[16 * mi + 4 * q4], U[16 * mi + 4 * q4 + 1]), pack2(U[16 * mi + 4 * q4 + 2], U[16 * mi + 4 * q4 + 3])};
            __builtin_amdgcn_raw_buffer_store_b64(o, r_uT, dofs + (mi * 256 + q4 * 64) * 2, 0, 16);
          }
      } else {
#pragma unroll
        for (int i = 0; i < 64; ++i) {
          int ii = i;
          asm volatile("" : "+v"(ii));
          *(u16*)(qL + ii * 256 + ((ch ^ (ii & 15)) << 4) + e2) = (u16)f2bf(U[i]);
        }
      }
    }
    __syncthreads();
    {
      const int tid = relaunder(tid_);
#pragma unroll
      for (int it = 0; it < 4; ++it) {
        const int idx = tid + 256 * it;
        const int f = idx >> 6, ln = idx & 63, fl = ln & 15, fq = ln >> 4;
        const int mt = f >> 2, ks = f & 3, i = 16 * mt + fl;
        const int c0 = 4 * ks + (fq >> 1), o8 = (fq & 1) * 8;
        const u32x2 lo = *(const u32x2*)(qL + i * 256 + ((c0 ^ (i & 15)) << 4) + o8);
        const u32x2 hi = *(const u32x2*)(qL + i * 256 + (((c0 + 2) ^ (i & 15)) << 4) + o8);
        const u32x4 o = {lo.x, lo.y, hi.x, hi.y};
        __builtin_amdgcn_raw_buffer_store_b128(o, r_w, item * 16384 + idx * 16, 0, 16);
      }
    }
    asm volatile("s_waitcnt vmcnt(0)" ::: "memory");
    __syncthreads();
    if (relaunder(tid_) == 0) __hip_atomic_store(flags + item, 1u, __ATOMIC_RELAXED, __HIP_MEMORY_SCOPE_AGENT);
  }
}

#define RAW_BARRIER() do { asm volatile("s_waitcnt lgkmcnt(0)" ::: "memory"); __builtin_amdgcn_s_barrier(); asm volatile("" ::: "memory"); } while (0)
#define GAS __attribute__((address_space(1)))
#define SCAN_LOAD(item_)                                                                                          \
  do {                                                                                                            \
    const GAS char* wb_ = (const GAS char*)((const char*)w_g + (size_t)(item_) * 16384);                          \
    const GAS char* qb_ = (const GAS char*)((const char*)qd_g + (size_t)(item_) * 16384);                         \
    const GAS char* kb_ = (const GAS char*)((const char*)kT_g + (size_t)(item_) * 16384);                         \
    const GAS char* ab_ = (const GAS char*)((const char*)at_g + (size_t)(item_) * 8192);                          \
    const GAS char* ub_ = (const GAS char*)((const char*)uT_g + (size_t)(item_) * 16384);                         \
    asm volatile("" : "+s"(wb_), "+s"(qb_), "+s"(kb_), "+s"(ab_), "+s"(ub_));                                     \
    _Pragma("unroll") for (int j = 0; j < 4; ++j) {                                                               \
      R[j] = *(const GAS u32x4*)(wb_ + (toff + 4096u * j));                                                       \
      R[4 + j] = *(const GAS u32x4*)(qb_ + (toff + 4096u * j));                                                   \
      R[8 + j] = *(const GAS u32x4*)(kb_ + (toff + 4096u * j));                                                   \
    }                                                                                                             \
    _Pragma("unroll") for (int j = 0; j < 2; ++j) R[12 + j] = *(const GAS u32x4*)(ab_ + (toff + 4096u * j));     \
    _Pragma("unroll") for (int mi = 0; mi < 4; ++mi) un[mi] = *(const GAS u32x2*)(ub_ + (uoff + 512u * mi));     \
    gn = gend_g[item_];                                                                                           \
  } while (0)
DI void delta_scan(const Params& p, char* smem) {
  char* ws = p.ws;
  const u16* qd_g = (const u16*)(ws + OFF_R);
  const u16* kT_g = (const u16*)(ws + OFF_R + 32 * MiB);
  const u16* at_g = (const u16*)(ws + OFF_R + 64 * MiB);
  const u16* uT_g = (const u16*)p.out;
  const u16* w_g = (const u16*)((const char*)p.out + 32 * MiB);
  const float* gend_g = (const float*)(ws + OFF_GEND);
  u16* o_g = (u16*)(ws + OFF_PROJ);
  unsigned* flags = (unsigned*)(ws + OFF_FLAGS);
  const int tid = tidx(), lane = tid & 63, wave = tid >> 6, l15 = lane & 15, quad = lane >> 4;
  char* Lw = smem;
  char* Lq = smem + 16384;
  char* Lk = smem + 32768;
  char* La = smem + 49152;
  char* Lo = smem + 57344;
  for (int unit = blockIdx.x; unit < 32; unit += gridDim.x) {
    const int bh = unit & 15, half = unit >> 4, b = bh >> 3, h = bh & 7;
    const int slice = half * 4 + wave;
    f32x4 S[8];
#pragma unroll
    for (int i = 0; i < 8; ++i) S[i] = (f32x4){0.f, 0.f, 0.f, 0.f};
    const unsigned toff = (unsigned)tid * 16u, uoff = (unsigned)(slice * 256 + lane) * 8u;
    u32x4 R[14];
    u32x2 un[4];
    float gn;
#define SCAN_WAIT(flv_, item_)                                                                                         \
  do {                                                                                                                 \
    unsigned f_ = (flv_), sp_ = 0u;                                                                                    \
    while (f_ == 0u && sp_ < (1u << 24)) { __builtin_amdgcn_s_sleep(2); f_ = __hip_atomic_load(flags + (item_), __ATOMIC_RELAXED, __HIP_MEMORY_SCOPE_AGENT); ++sp_; } \
    __builtin_amdgcn_fence(__ATOMIC_ACQUIRE, "workgroup");           \
  } while (0)
    unsigned fl;
    {
      const int item = (b * 128) * 8 + h;
      SCAN_WAIT(0u, item);
      SCAN_LOAD(item);
      fl = __hip_atomic_load(flags + ((b * 128 + 1) * 8 + h), __ATOMIC_RELAXED, __HIP_MEMORY_SCOPE_AGENT);
    }
    for (int c = 0; c < 128; ++c) {
#pragma unroll
      for (int j = 0; j < 4; ++j) {
        *(u32x4*)(Lw + (tid + 256 * j) * 16) = R[j];
        *(u32x4*)(Lq + (tid + 256 * j) * 16) = R[4 + j];
        *(u32x4*)(Lk + (tid + 256 * j) * 16) = R[8 + j];
      }
#pragma unroll
      for (int j = 0; j < 2; ++j) *(u32x4*)(La + (tid + 256 * j) * 16) = R[12 + j];
      u32x2 uc[4];
#pragma unroll
      for (int mi = 0; mi < 4; ++mi) uc[mi] = un[mi];
      const float gend = gn;
      RAW_BARRIER();
      if (c + 1 < 128) SCAN_WAIT(fl, (b * 128 + c + 1) * 8 + h);
      if (c > 0) {
        const int tokp = b * 8192 + (c - 1) * 64;
#pragma unroll
        for (int k2 = 0; k2 < 2; ++k2) {
          const int idx = tid + 256 * k2, row = idx >> 3, part = idx & 7;
          *(u32x4*)(o_g + (size_t)(tokp + row) * 4096 + h * 128 + half * 64 + part * 8) = *(const u32x4*)(Lo + idx * 16);
        }
      }
      if (c + 1 < 128) {
        const int item = (b * 128 + c + 1) * 8 + h;
        SCAN_LOAD(item);
        fl = (c + 2 < 128) ? __hip_atomic_load(flags + (item + 8), __ATOMIC_RELAXED, __HIP_MEMORY_SCOPE_AGENT) : 1u;
      }
      __builtin_amdgcn_sched_barrier(0);
      bf16x8 bS[4];
#pragma unroll
      for (int ks = 0; ks < 4; ++ks) bS[ks] = pack8(S[2 * ks], S[2 * ks + 1]);
      bf16x8 fr[16];
#pragma unroll
      for (int i = 0; i < 16; ++i) fr[i] = *(const bf16x8*)(Lw + (i * 64 + lane) * 16);
      __builtin_amdgcn_sched_barrier(0);
      f32x4 vn[4];
#pragma unroll
      for (int mi = 0; mi < 4; ++mi) vn[mi] = (f32x4){0.f, 0.f, 0.f, 0.f};
#pragma unroll
      for (int ks = 0; ks < 4; ++ks)
#pragma unroll
        for (int mi = 0; mi < 4; ++mi) vn[mi] = mfma16(fr[mi * 4 + ks], bS[ks], vn[mi]);
      __builtin_amdgcn_sched_barrier(0);
#pragma unroll
      for (int i = 0; i < 16; ++i) fr[i] = *(const bf16x8*)(Lk + (i * 64 + lane) * 16);
#pragma unroll
      for (int mi = 0; mi < 4; ++mi) {
        vn[mi][0] = bflo(uc[mi].x) - vn[mi][0]; vn[mi][1] = bfhi(uc[mi].x) - vn[mi][1];
        vn[mi][2] = bflo(uc[mi].y) - vn[mi][2]; vn[mi][3] = bfhi(uc[mi].y) - vn[mi][3];
      }
      bf16x8 bV[2];
      bV[0] = pack8(vn[0], vn[1]);
      bV[1] = pack8(vn[2], vn[3]);
#pragma unroll
      for (int mt = 0; mt < 8; ++mt) S[mt] = S[mt] * gend;
      __builtin_amdgcn_sched_barrier(0);
#pragma unroll
      for (int ks = 0; ks < 2; ++ks)
#pragma unroll
        for (int mt = 0; mt < 8; ++mt) S[mt] = mfma16(fr[mt * 2 + ks], bV[ks], S[mt]);
      __builtin_amdgcn_sched_barrier(0);
#pragma unroll
      for (int i = 0; i < 16; ++i) fr[i] = *(const bf16x8*)(Lq + (i * 64 + lane) * 16);
      __builtin_amdgcn_sched_barrier(0);
      f32x4 oacc[4];
#pragma unroll
      for (int mi = 0; mi < 4; ++mi) oacc[mi] = (f32x4){0.f, 0.f, 0.f, 0.f};
#pragma unroll
      for (int ks = 0; ks < 4; ++ks)
#pragma unroll
        for (int mi = 0; mi < 4; ++mi) oacc[mi] = mfma16(fr[mi * 4 + ks], bS[ks], oacc[mi]);
      __builtin_amdgcn_sched_barrier(0);
#pragma unroll
      for (int i = 0; i < 8; ++i) fr[i] = *(const bf16x8*)(La + (i * 64 + lane) * 16);
      __builtin_amdgcn_sched_barrier(0);
#pragma unroll
      for (int ks = 0; ks < 2; ++ks)
#pragma unroll
        for (int mi = 0; mi < 4; ++mi) oacc[mi] = mfma16(fr[mi * 2 + ks], bV[ks], oacc[mi]);
      __builtin_amdgcn_sched_barrier(0);
#pragma unroll
      for (int mi = 0; mi < 4; ++mi)
#pragma unroll
        for (int jj = 0; jj < 4; ++jj)
          *(u16*)(Lo + (16 * mi + 4 * quad + jj) * 128 + (wave * 16 + l15) * 2) = (u16)f2bf(oacc[mi][jj]);
      RAW_BARRIER();
    }
    {
      const int tokp = b * 8192 + 127 * 64;
#pragma unroll
      for (int k2 = 0; k2 < 2; ++k2) {
        const int idx = tid + 256 * k2, row = idx >> 3, part = idx & 7;
        *(u32x4*)(o_g + (size_t)(tokp + row) * 4096 + h * 128 + half * 64 + part * 8) = *(const u32x4*)(Lo + idx * 16);
      }
      RAW_BARRIER();
    }
  }
}

#undef SCAN_LOAD
#undef SCAN_WAIT

DI void gate_phase(const Params& p) {
  char* ws = p.ws;
  const u16* proj = (const u16*)(ws + OFF_PROJ);
  u16* y0 = (u16*)(ws + OFF_R + 32 * MiB);
  const int tidg = tidx();
  const int lane = tidg & 63, l15 = lane & 15, quad = lane >> 4;
  const int gw = blockIdx.x * 4 + (tidg >> 6), nw = gridDim.x * 4;
  float wn[8];
#pragma unroll
  for (int e = 0; e < 8; ++e) wn[e] = p.a_o_norm_w[l15 * 8 + e];
  for (int r4 = gw; r4 < 32768; r4 += nw) {
    const int rh = r4 * 4 + quad, tok = rh >> 3, h = rh & 7;
    float o[8], z[8];
    unpack8(*(const u32x4*)(proj + (size_t)tok * 4096 + h * 128 + l15 * 8), o);
    unpack8(*(const u32x4*)(proj + (size_t)tok * 4096 + 3072 + h * 128 + l15 * 8), z);
    float ssq = 0.f;
#pragma unroll
    for (int e = 0; e < 8; ++e) ssq += o[e] * o[e];
    ssq += __shfl_xor(ssq, 1); ssq += __shfl_xor(ssq, 2); ssq += __shfl_xor(ssq, 4); ssq += __shfl_xor(ssq, 8);
    const float rs = rsqrtf(ssq * (1.f / 128.f) + kEps);
#pragma unroll
    for (int e = 0; e < 8; ++e) o[e] = o[e] * rs * wn[e] * silu(z[e]);
    *(u32x4*)(y0 + (size_t)tok * 1024 + h * 128 + l15 * 8) = packf8(o);
  }
}

DI void qknorm_cumsum(const Params& p, char* smem) {
  char* ws = p.ws;
  u16* proj = (u16*)(ws + OFF_PROJ);
  const int tid = tidx(), lane = tid & 63, l15 = lane & 15, quad = lane >> 4;
  const int gw = blockIdx.x * 4 + (tid >> 6), nw = gridDim.x * 4;
  for (int idx = gw; idx < 65536; idx += nw) {
    const int which = idx >> 15, r4 = idx & 32767;
    const int rh = r4 * 4 + quad, tok = rh >> 3, h = rh & 7;
    const float* wv = which ? p.b_k_norm_w : p.b_q_norm_w;
    u16* ptr = proj + (size_t)tok * 4096 + which * 1024 + h * 128 + l15 * 8;
    float v[8];
    unpack8(*(const u32x4*)ptr, v);
    float ssq = 0.f;
#pragma unroll
    for (int e = 0; e < 8; ++e) ssq += v[e] * v[e];
    ssq += __shfl_xor(ssq, 1); ssq += __shfl_xor(ssq, 2); ssq += __shfl_xor(ssq, 4); ssq += __shfl_xor(ssq, 8);
    const float rs = rsqrtf(ssq * (1.f / 128.f) + kEps) * (which ? 1.f : kScale);
#pragma unroll
    for (int e = 0; e < 8; ++e) v[e] = v[e] * rs * wv[l15 * 8 + e];
    *(u32x4*)ptr = packf8(v);
  }
}

DI void attn_phase(const Params& p, char* smem) {
  char* ws = p.ws;
  const u16* proj = (const u16*)(ws + OFF_PROJ);
  const u16* vT = (const u16*)(ws + OFF_R + 32 * MiB);
  const float* fraw = (const float*)(ws + OFF_FRAW);
  u16* y1 = (u16*)(ws + OFF_R + 64 * MiB);
  float* bias_s = (float*)(smem + 65536);
  float* ca_s = bias_s + 128;
  const int tid_ = tidx();
  float mq = 0.f, mk = 0.f;
  for (int i = 0; i < 128; ++i) { mq = fmaxf(mq, fabsf(p.b_q_norm_w[i])); mk = fmaxf(mk, fabsf(p.b_k_norm_w[i])); }
  const float QKB = 128.f * kScale * mq * mk;
  float* mmin_s = (float*)(smem + 66320);

  unsigned* qctr = (unsigned*)(ws + OFF_BAR) + XCD_BAR_WORDS;
  int* qslot = (int*)(smem + 66304);
  int qx = blockIdx.x & 7, qtries = 0;
  while (true) {
    const int tid = relaunder(tid_), lane = tid & 63, wave = tid >> 6, l15 = lane & 15, quad = lane >> 4;
    if (tid == 0) *qslot = (int)atomicAdd(qctr + qx * 16, 1u);
    __syncthreads();
    const int it = *qslot;
    __syncthreads();
    if (it >= 128) { if (++qtries >= 8) break; qx = (qx + 1) & 7; continue; }
    const int qb = 63 - (it & 63);
    const int b = it >> 6, h = b ? ((qx + 4) & 7) : qx, bh = b * 8 + h, i0 = qb * 128;
    const int qrow0 = i0 + 32 * wave;
    const float fb = p.b_f_bias[h];
    bf16x8 bq[2][4];
#pragma unroll
    for (int nq = 0; nq < 2; ++nq)
#pragma unroll
      for (int ks = 0; ks < 4; ++ks)
        bq[nq][ks] = *(const bf16x8*)(proj + (size_t)(b * 8192 + qrow0 + 16 * nq + l15) * 4096 + h * 128 + 32 * ks + 8 * quad);
    f32x4 O[8][2];
#pragma unroll
    for (int dt = 0; dt < 8; ++dt) { O[dt][0] = (f32x4){0.f, 0.f, 0.f, 0.f}; O[dt][1] = (f32x4){0.f, 0.f, 0.f, 0.f}; }
    float mrun[2] = {-1e30f, -1e30f}, lrun[2] = {0.f, 0.f};

    const int kkey = wave * 4 + (lane >> 4);
    const int kch = (lane & 15) ^ (kkey & 15);
    const u16* Kg = proj + (size_t)(b * 8192 + kkey) * 4096 + 1024 + h * 128 + kch * 8;
    const int vd = wave * 8 + (lane >> 3);
    const int vch = (lane & 7) ^ ((((wave & 1) << 2) + (lane >> 4)) & 7);
    const u16* Vg = vT + (size_t)(bh * 128 + vd) * 8192 + vch * 8;
#define ATT_STAGE(buf, j0_)                                                                                                   \
  do {                                                                                                                        \
    _Pragma("unroll") for (int i = 0; i < 4; ++i) {                                                                           \
      __builtin_amdgcn_global_load_lds((const unsigned*)(Kg + (size_t)((j0_) + 16 * i) * 4096),                               \
                                       (unsigned*)(smem + (buf) * 32768 + (i * 4 + wave) * 1024), 16, 0, 0);                  \
      __builtin_amdgcn_global_load_lds((const unsigned*)(Vg + (size_t)(32 * i) * 8192 + (j0_)),                               \
                                       (unsigned*)(smem + (buf) * 32768 + 16384 + (i * 4 + wave) * 1024), 16, 0, 0);          \
    }                                                                                                                         \
  } while (0)
    int j0 = i0 + 64;
    ATT_STAGE(0, j0);
    float carry = 0.f, biasA = 0.f, frn = 0.f;
    if (wave == 0) {
      const float xa = fraw[(size_t)(b * 8192 + i0 + lane) * 16 + h] + fb;
      const float xb2 = fraw[(size_t)(b * 8192 + i0 + 64 + lane) * 16 + h] + fb;
      const float lfA = fminf(xa, 0.f) - log1pf(__expf(-fabsf(xa)));
      const float lfB = fminf(xb2, 0.f) - log1pf(__expf(-fabsf(xb2)));
      float pa = lfA, pb = lfB;
#pragma unroll
      for (int o = 1; o < 64; o <<= 1) {
        const float ta = __shfl_up(pa, o), tb = __shfl_up(pb, o);
        if (lane >= o) { pa += ta; pb += tb; }
      }
      const float lf0 = __shfl(lfA, 0), totA = __shfl(pa, 63);
      biasA = -(pa - lf0) * kLog2e;
      bias_s[lane] = -(totA - lf0 + pb) * kLog2e;
      carry = lf0;
    }
    if (lane == 0) { mmin_s[wave] = -1e30f; mmin_s[4 + wave] = -1e30f; }
    asm volatile("s_waitcnt vmcnt(0)" ::: "memory");
    __syncthreads();
    auto att_tile = [&](const int cur, const bool diag) __attribute__((always_inline)) -> bool {
      const int nj = j0 - 64;
      bool more = nj >= 0;
      if (more && j0 <= i0) {
        const float* mm = mmin_s + cur * 4;
        const float mmin = fminf(fminf(mm[0], mm[1]), fminf(mm[2], mm[3]));
        more = !((QKB + ca_s[cur]) * kLog2e < mmin - 30.f * kLog2e);
      }
      if (more) {
        ATT_STAGE(cur ^ 1, nj);
        if (wave == 0 && nj < i0) frn = fraw[(size_t)(b * 8192 + nj + lane) * 16 + h];
      }
      if (j0 <= qrow0 + 31) {
        const char* Ks = smem + cur * 32768;
        const char* Vs = Ks + 16384;
        const float* cs = bias_s + cur * 64;
        f32x4 s[4][2];
#pragma unroll
        for (int kt = 0; kt < 4; ++kt) { s[kt][0] = (f32x4){0.f, 0.f, 0.f, 0.f}; s[kt][1] = (f32x4){0.f, 0.f, 0.f, 0.f}; }
#pragma unroll
        for (int ks = 0; ks < 4; ++ks)
#pragma unroll
          for (int kt = 0; kt < 4; ++kt) {
            const int kl = 16 * kt + l15;
            const bf16x8 ak = *(const bf16x8*)(Ks + kl * 256 + (((ks * 4 + quad) ^ (kl & 15)) << 4));
            s[kt][0] = mfma16(ak, bq[0][ks], s[kt][0]);
            s[kt][1] = mfma16(ak, bq[1][ks], s[kt][1]);
          }
#pragma unroll
        for (int kt = 0; kt < 4; ++kt) {
          const f32x4 bias = *(const f32x4*)(cs + 16 * kt + 4 * quad);
#pragma unroll
          for (int nq = 0; nq < 2; ++nq)
#pragma unroll
            for (int jj = 0; jj < 4; ++jj) {
              float v = s[kt][nq][jj] + bias[jj];
              if (diag) { if (j0 + 16 * kt + 4 * quad + jj > qrow0 + 16 * nq + l15) v = -1e30f; }
              s[kt][nq][jj] = v;
            }
        }
        bf16x8 bP[2][2];
#pragma unroll
        for (int nq = 0; nq < 2; ++nq) {
          float tmax = -1e30f;
#pragma unroll
          for (int kt = 0; kt < 4; ++kt)
#pragma unroll
            for (int jj = 0; jj < 4; ++jj) tmax = fmaxf(tmax, s[kt][nq][jj]);
          tmax = fmaxf(tmax, __shfl_xor(tmax, 16));
          tmax = fmaxf(tmax, __shfl_xor(tmax, 32));
          const float mnew = fmaxf(mrun[nq], tmax);
          const float alpha = __builtin_amdgcn_exp2f(mrun[nq] - mnew);
          const bool grew = mnew > mrun[nq];
          mrun[nq] = mnew;
          float psum = 0.f;
#pragma unroll
          for (int kt = 0; kt < 4; ++kt)
#pragma unroll
            for (int jj = 0; jj < 4; ++jj) { const float pv = __builtin_amdgcn_exp2f(s[kt][nq][jj] - mnew); s[kt][nq][jj] = pv; psum += pv; }
          lrun[nq] = lrun[nq] * alpha + psum;
          if (__builtin_amdgcn_ballot_w64(grew) != 0ull) {
#pragma unroll
            for (int dt = 0; dt < 8; ++dt) O[dt][nq] = O[dt][nq] * alpha;
          }
          bP[0][nq] = pack8(s[0][nq], s[1][nq]);
          bP[1][nq] = pack8(s[2][nq], s[3][nq]);
        }
#pragma unroll
        for (int ks = 0; ks < 2; ++ks)
#pragma unroll
          for (int dt = 0; dt < 8; ++dt) {
            const int d = 16 * dt + l15, sw = (d >> 1) & 7, c0 = 4 * ks + (quad >> 1);
            const u32x2 lo = *(const u32x2*)(Vs + d * 128 + ((c0 ^ sw) << 4) + (quad & 1) * 8);
            const u32x2 hi = *(const u32x2*)(Vs + d * 128 + (((c0 + 2) ^ sw) << 4) + (quad & 1) * 8);
            const bf16x8 av = mk8(lo, hi);
            O[dt][0] = mfma16(av, bP[ks][0], O[dt][0]);
            O[dt][1] = mfma16(av, bP[ks][1], O[dt][1]);
          }
        float wm = fminf(mrun[0], mrun[1]);
#pragma unroll
        for (int o = 1; o < 64; o <<= 1) wm = fminf(wm, __shfl_xor(wm, o));
        if (lane == 0) mmin_s[(cur ^ 1) * 4 + wave] = wm;
      }
      if (more && wave == 0) {
        const int nb = cur ^ 1;
        if (nj == i0) {
          bias_s[nb * 64 + lane] = biasA;
          if (lane == 0) ca_s[nb] = carry;
        } else {
          const float xv = frn + fb;
          const float lf = fminf(xv, 0.f) - log1pf(__expf(-fabsf(xv)));
          float sf = lf;
#pragma unroll
          for (int o = 1; o < 64; o <<= 1) { const float t = __shfl_down(sf, o); if (lane + o < 64) sf += t; }
          bias_s[nb * 64 + lane] = (sf - lf + carry) * kLog2e;
          carry += __shfl(sf, 0);
          if (lane == 0) ca_s[nb] = carry;
        }
      }
      asm volatile("s_waitcnt vmcnt(0)" ::: "memory");
      __syncthreads();
      if (!more) return false;
      j0 = nj;
      return true;
    };
    if (att_tile(0, true) && att_tile(1, true)) {
      while (true) {
        if (!att_tile(0, false)) break;
        if (!att_tile(1, false)) break;
      }
    }
#undef ATT_STAGE
#pragma unroll
    for (int nq = 0; nq < 2; ++nq) {
      float l = lrun[nq];
      l += __shfl_xor(l, 16);
      l += __shfl_xor(l, 32);
      const float inv = 1.f / l;
      const size_t tok = (size_t)(b * 8192 + qrow0 + 16 * nq + l15);
#pragma unroll
      for (int dt = 0; dt < 8; ++dt) {
        const int d = 16 * dt + 4 * quad;
        const u32x2 z2 = *(const u32x2*)(proj + tok * 4096 + 3072 + h * 128 + d);
        const f32x4 o = O[dt][nq] * inv;
        u32x2 r = {pack2(o[0] * silu(bflo(z2.x)), o[1] * silu(bfhi(z2.x))), pack2(o[2] * silu(bflo(z2.y)), o[3] * silu(bfhi(z2.y)))};
        *(u32x2*)(y1 + tok * 1024 + h * 128 + d) = r;
      }
    }
  }
}

DI void final_norm(const Params& p) {
  const float* ss2 = (const float*)(p.ws + OFF_SS2);
  const int tidf = tidx();
  const int lane = tidf & 63;
  const int gw = blockIdx.x * 4 + (tidf >> 6), nw = gridDim.x * 4;
  const f32x4* w = (const f32x4*)p.final_norm_w;
  f32x4 wv[4];
#pragma unroll
  for (int i = 0; i < 4; ++i) wv[i] = w[lane + 64 * i];
  for (int row = gw; row < 16384; row += 4 * nw) {
    u32x2 r[4][4];
    float rs[4];
#pragma unroll
    for (int k = 0; k < 4; ++k) {
      const int rr = row + k * nw;
      const bool okr = rr < 16384;
      const int rc = okr ? rr : row;
      rs[k] = rsqrtf(ss2[rc] * (1.f / 1024.f) + kEps);
      const u32x2* hsrc = (const u32x2*)((const u16*)(p.ws + OFF_R) + (size_t)rc * 1024);
#pragma unroll
      for (int i = 0; i < 4; ++i) r[k][i] = hsrc[lane + 64 * i];
    }
#pragma unroll
    for (int k = 0; k < 4; ++k) {
      const int rr = row + k * nw;
      if (rr < 16384) {
        f32x4* o = (f32x4*)(p.out + (size_t)rr * 1024);
#pragma unroll
        for (int i = 0; i < 4; ++i) {
          f32x4 v = {bflo(r[k][i].x), bfhi(r[k][i].x), bflo(r[k][i].y), bfhi(r[k][i].y)};
          __builtin_nontemporal_store(v * rs[k] * wv[i], o + lane + 64 * i);
        }
      }
    }
  }
}

__global__ void __launch_bounds__(kThreads, 2) fwd_megakernel(Params p) {
  extern __shared__ __attribute__((aligned(16))) char smem[];
  cg::grid_group grid = cg::this_grid();
  char* ws = p.ws;
  __shared__ uint4 xb_words;
  if (threadIdx.x == 0) xb_words = make_uint4(0u, 0u, 0u, 0u);
  __syncthreads();
  if (p.ws == nullptr) grid.sync();
  XcdBarrier xb = xcd_barrier_post((unsigned*)(ws + OFF_BAR), (volatile LAS unsigned*)&xb_words);
  phase0(p, smem);
  xcd_barrier(xb);
  gemm_phase<1>(p, (const u16*)(ws + OFF_R), (const u16*)(ws + OFF_WTA_IN), 32, smem);
  skinny_gemm<0>(p, (const u16*)(ws + OFF_R), (const u16*)(ws + OFF_WTA_IN) + (size_t)4096 * 1024, (float*)(ws + OFF_BRAW));
  xcd_barrier(xb);
  {
    const bool overlap = gridDim.x >= 128;
    const int G = (int)gridDim.x, hG = G >> 1, bi = (int)blockIdx.x;
    const bool is_scan = overlap && bi < 32, is_idle = overlap && bi >= hG && bi < hG + 32;
    const int pfirst = overlap ? (bi < hG ? 32 : 64) : 0, pn = overlap ? G - 64 : G;
    if (!is_scan && !is_idle) delta_prep(p, smem, pfirst, pn);
    if (!is_scan && !is_idle) phase0b(p, smem, pfirst, pn);
    if (!overlap) xcd_barrier(xb);
    if (!overlap || blockIdx.x < 32) delta_scan(p, smem);
    xcd_barrier(xb);
  }
  gate_phase(p);
  xcd_barrier(xb);
  gemm_phase<2>(p, (const u16*)(ws + OFF_R + 32 * MiB), (const u16*)(ws + OFF_WTA_OUT), 8, smem);
  xcd_barrier(xb);
  gemm_phase<3>(p, (const u16*)(ws + OFF_R), (const u16*)(ws + OFF_WTB_IN), 32, smem);
  skinny_gemm<1>(p, (const u16*)(ws + OFF_R), (const u16*)(ws + OFF_WTB_IN) + (size_t)4096 * 1024, (float*)(ws + OFF_FRAW));
  xcd_barrier(xb);
  attn_phase(p, smem);
  xcd_barrier(xb);
  gemm_phase<4>(p, (const u16*)(ws + OFF_R + 64 * MiB), (const u16*)(ws + OFF_WTB_OUT), 8, smem);
  xcd_barrier(xb);
  final_norm(p);
}

extern "C" void kernel_launch(void* const* d_in, const int* in_sizes, int n_in, void* d_out, int out_size, void* d_ws, size_t ws_size,
                              hipStream_t stream) {
  static int grid_blocks = 0;
  if (!grid_blocks) {
    int dev = 0, cus = 0, per_cu = 0;
    hipGetDevice(&dev);
    hipDeviceGetAttribute(&cus, hipDeviceAttributeMultiprocessorCount, dev);
    hipFuncSetAttribute((const void*)fwd_megakernel, hipFuncAttributeMaxDynamicSharedMemorySize, kLds);
    hipOccupancyMaxActiveBlocksPerMultiprocessor(&per_cu, (const void*)fwd_megakernel, kThreads, kLds);
    if (per_cu < 1) per_cu = 1;
    if (per_cu > 2) per_cu = 2;
    grid_blocks = cus * per_cu;
  }
  Params p{};
  p.x = (const float*)d_in[0]; p.a_norm_w = (const float*)d_in[1]; p.a_w_in = (const float*)d_in[2]; p.a_conv_w = (const float*)d_in[3];
  p.a_A_log = (const float*)d_in[4]; p.a_dt_bias = (const float*)d_in[5]; p.a_o_norm_w = (const float*)d_in[6]; p.a_w_out = (const float*)d_in[7];
  p.b_norm_w = (const float*)d_in[8]; p.b_w_in = (const float*)d_in[9]; p.b_f_bias = (const float*)d_in[10]; p.b_q_norm_w = (const float*)d_in[11];
  p.b_k_norm_w = (const float*)d_in[12]; p.b_w_out = (const float*)d_in[13]; p.final_norm_w = (const float*)d_in[14];
  p.out = (float*)d_out;
  p.ws = (char*)d_ws;
  hipMemsetAsync((char*)d_ws + OFF_BAR, 0, CTL_BYTES, stream);
  void* args[] = {&p};
  hipError_t e = hipLaunchCooperativeKernel((const void*)fwd_megakernel, dim3(grid_blocks), dim3(kThreads), args, kLds, stream);
  if (e != hipSuccess) fprintf(stderr, "cooperative launch failed: %s (grid %d)\n", hipGetErrorString(e), grid_blocks);
}
```

```cpp
#include <hip/hip_runtime.h>
#include <hip/hip_cooperative_groups.h>
#include <cstdio>
namespace cg = cooperative_groups;

typedef unsigned short u16;
typedef __attribute__((ext_vector_type(8))) short bf16x8;
typedef __attribute__((ext_vector_type(4))) float f32x4;
typedef __attribute__((ext_vector_type(4))) unsigned u32x4;
typedef __attribute__((ext_vector_type(2))) unsigned u32x2;
#define DI __device__ __forceinline__

constexpr int kThreads = 256;
constexpr int kLds = 69632;
constexpr float kEps = 1e-6f;
constexpr float kScale = 0.08838834764831845f;
constexpr float kLog2e = 1.4426950408889634f;

constexpr size_t MiB = 1048576;
constexpr size_t OFF_WTA_IN = 0;
constexpr size_t OFF_WTA_OUT = 8650752;
constexpr size_t OFF_WTB_IN = 10747904;
constexpr size_t OFF_WTB_OUT = 19398656;
constexpr size_t OFF_SMALL = 21495808;
constexpr size_t OFF_RS0 = OFF_SMALL;
constexpr size_t OFF_SS1 = OFF_RS0 + 65536;
constexpr size_t OFF_SS2 = OFF_SS1 + 65536;
constexpr size_t OFF_BRAW = OFF_SS2 + 65536;
constexpr size_t OFF_FRAW = OFF_BRAW + 1048576;
constexpr size_t OFF_CCUM = OFF_FRAW + 1048576;
constexpr size_t OFF_GEND = OFF_CCUM + 524288;
constexpr size_t OFF_BAR = OFF_GEND + 8192;
constexpr size_t OFF_FLAGS = OFF_BAR + 13824 + 512;
constexpr size_t CTL_BYTES = 13824 + 512 + 8192;
constexpr size_t OFF_PROJ = OFF_SMALL + 3 * MiB;
constexpr size_t OFF_R = OFF_PROJ + 128 * MiB;

struct Params {
  const float *x, *a_norm_w, *a_w_in, *a_conv_w, *a_A_log, *a_dt_bias, *a_o_norm_w, *a_w_out;
  const float *b_norm_w, *b_w_in, *b_f_bias, *b_q_norm_w, *b_k_norm_w, *b_w_out, *final_norm_w;
  float* out;
  char* ws;
};

typedef __attribute__((ext_vector_type(2))) float f32x2;
typedef __attribute__((ext_vector_type(2))) __bf16 bf16x2_t;
DI unsigned pack2(float a, float b) { f32x2 v = {a, b}; return __builtin_bit_cast(unsigned, __builtin_convertvector(v, bf16x2_t)); }
DI unsigned f2bf(float x) { return pack2(x, 0.f) & 0xffffu; }
DI float bflo(unsigned u) { return __uint_as_float(u << 16); }
DI float bfhi(unsigned u) { return __uint_as_float(u & 0xffff0000u); }
DI f32x4 mfma16(bf16x8 a, bf16x8 b, f32x4 c) { return __builtin_amdgcn_mfma_f32_16x16x32_bf16(a, b, c, 0, 0, 0); }
DI bf16x8 mk8(u32x2 lo, u32x2 hi) { u32x4 v = {lo.x, lo.y, hi.x, hi.y}; return __builtin_bit_cast(bf16x8, v); }
DI bf16x8 pack8(f32x4 a, f32x4 b) { u32x4 v = {pack2(a[0], a[1]), pack2(a[2], a[3]), pack2(b[0], b[1]), pack2(b[2], b[3])}; return __builtin_bit_cast(bf16x8, v); }
DI bf16x8 ld2(const u16* p) { return mk8(*(const u32x2*)p, *(const u32x2*)(p + 16)); }
DI int relaunder(int t) { asm volatile("" : "+v"(t)); return t; }
DI int tidx() { int t = threadIdx.x; asm volatile("" : "+v"(t)); return t; }
DI float silu(float x) { return x / (1.f + __expf(-x)); }
DI void unpack8(u32x4 v, float* f) {
  f[0] = bflo(v.x); f[1] = bfhi(v.x); f[2] = bflo(v.y); f[3] = bfhi(v.y);
  f[4] = bflo(v.z); f[5] = bfhi(v.z); f[6] = bflo(v.w); f[7] = bfhi(v.w);
}
DI u32x4 packf8(const float* f) { u32x4 v = {pack2(f[0], f[1]), pack2(f[2], f[3]), pack2(f[4], f[5]), pack2(f[6], f[7])}; return v; }


#define XB_TMO      128
#define XB_XCNT(j)  (256  + 64 * (j))
#define XB_XSUB(j)  (1280 + 64 * (j))
#define XB_XGEN(j)  (2304 + 64 * (j))
#define XB_TOP      3328
#define XB_TOPGEN   3392
#define XCD_BAR_WORDS 3456
#define XB_SPIN_CAP (1u << 23)
#define LAS __attribute__((address_space(3)))
DI unsigned xb_ld(unsigned* p) { return __hip_atomic_load(p, __ATOMIC_RELAXED, __HIP_MEMORY_SCOPE_AGENT); }
DI unsigned xb_add(unsigned* p, unsigned v) { return __hip_atomic_fetch_add(p, v, __ATOMIC_RELAXED, __HIP_MEMORY_SCOPE_AGENT); }
DI unsigned xb_xcc_id() { return (unsigned)__builtin_amdgcn_s_getreg((3 << 11) | 20) & 0xFu; }
#define XB_SPIN(cond, bar) do { unsigned _sp = 0; while (cond) { __builtin_amdgcn_s_sleep(1); \
    if ((++_sp & 255u) == 0u) { if (xb_ld(&(bar)[XB_TMO])) break; if (_sp > XB_SPIN_CAP) { atomicAdd(&(bar)[XB_TMO], 1u); break; } } } } while (0)
struct XcdBarrier { unsigned* bar; unsigned x; volatile LAS unsigned* st; };
DI XcdBarrier xcd_barrier_post(unsigned* bar, volatile LAS unsigned* st) {
  XcdBarrier b; b.bar = bar; b.x = xb_xcc_id(); b.st = st;
  if (threadIdx.x == 0) (void)xb_add(&bar[XB_XCNT(b.x)], 1u);
  return b;
}
DI void xcd_barrier_complete(unsigned* bar, unsigned x, unsigned& nloc, unsigned& nx) {
  const unsigned G = gridDim.x * gridDim.y * gridDim.z;
  unsigned sum, cnt, mine, sp = 0u;
  for (;;) {
    sum = 0u; cnt = 0u; mine = 0u;
#pragma unroll
    for (unsigned j = 0; j < 16; ++j) { const unsigned c = xb_ld(&bar[XB_XCNT(j)]); sum += c; cnt += (c > 0u) ? 1u : 0u; mine = (j == x) ? c : mine; }
    if (sum == G) break;
    __builtin_amdgcn_s_sleep(1);
    if ((++sp & 255u) == 0u) { if (xb_ld(&bar[XB_TMO])) break; if (sp > XB_SPIN_CAP) { atomicAdd(&bar[XB_TMO], 1u); break; } }
  }
  nloc = mine > 0u ? mine : 1u; nx = cnt > 0u ? cnt : 1u;
}
DI void xcd_barrier(const XcdBarrier& b) {
  asm volatile("s_waitcnt vmcnt(0)" ::: "memory");
  __syncthreads();
  if (threadIdx.x == 0) {
    unsigned* bar = b.bar;
    __builtin_amdgcn_s_waitcnt(0);
    unsigned nloc = b.st[0], nx = b.st[1];
    if (nloc == 0u) { xcd_barrier_complete(bar, b.x, nloc, nx); b.st[0] = nloc; b.st[1] = nx; }
    const unsigned old = xb_add(&bar[XB_XSUB(b.x)], 1u);
    const unsigned gen = old / nloc;
    if (old + 1u == (gen + 1u) * nloc) {
      __builtin_amdgcn_fence(__ATOMIC_RELEASE, "agent");
      asm volatile("s_waitcnt vmcnt(0)" ::: "memory");
      const unsigned og = xb_add(&bar[XB_TOP], 1u);
      const unsigned tg = og / nx;
      if (og + 1u == (tg + 1u) * nx) xb_add(&bar[XB_TOPGEN], 1u);
      else XB_SPIN(xb_ld(&bar[XB_TOPGEN]) == tg, bar);
      __builtin_amdgcn_fence(__ATOMIC_ACQUIRE, "agent");
      xb_add(&bar[XB_XGEN(b.x)], 1u);
      asm volatile("s_waitcnt vmcnt(0)" ::: "memory");
    } else {
      XB_SPIN(xb_ld(&bar[XB_XGEN(b.x)]) == gen, bar);
      __builtin_amdgcn_fence(__ATOMIC_ACQUIRE, "agent");
      asm volatile("s_waitcnt vmcnt(0)" ::: "memory");
    }
  }
  __syncthreads();
}

DI void transpose_tile(const float* __restrict__ W, int N, int Npad, const float* __restrict__ kscale, u16* __restrict__ WT, int tile, char* smem) {
  float(*t)[65] = (float(*)[65])smem;
  const int nt = Npad / 64;
  const int k0 = (tile / nt) * 64, n0 = (tile % nt) * 64;
  const int tid = tidx();
  {
    const int tx = tid & 63, ty = tid >> 6;
#pragma unroll 4
    for (int i = 0; i < 16; ++i) {
      const int k = k0 + ty + 4 * i, n = n0 + tx;
      float v = 0.f;
      if (n < N) { v = W[(size_t)k * N + n]; if (kscale) v *= kscale[k]; }
      t[ty + 4 * i][tx] = v;
    }
  }
  __syncthreads();
  {
    const int kx2 = (tid & 31) * 2, ny0 = tid >> 5;
#pragma unroll 4
    for (int i = 0; i < 8; ++i) {
      const int ny = ny0 + 8 * i;
      *(unsigned*)(WT + (size_t)(n0 + ny) * 1024 + k0 + kx2) = pack2(t[kx2][ny], t[kx2 + 1][ny]);
    }
  }
  __syncthreads();
}

DI void phase0(const Params& p, char* smem) {
  char* ws = p.ws;
  {
    float* ss = (float*)(ws + OFF_SS1);
    for (int i = blockIdx.x * kThreads + tidx(); i < 32768; i += gridDim.x * kThreads) ss[i] = 0.f;
  }
  for (int t = blockIdx.x; t < 1312; t += gridDim.x) {
    if (t < 1056) transpose_tile(p.a_w_in, 4112, 4224, p.a_norm_w, (u16*)(ws + OFF_WTA_IN), t, smem);
    else transpose_tile(p.a_w_out, 1024, 1024, nullptr, (u16*)(ws + OFF_WTA_OUT), t - 1056, smem);
  }
  const int tid0 = tidx();
  const int lane = tid0 & 63;
  const int gw = blockIdx.x * 4 + (tid0 >> 6), nw = gridDim.x * 4;
  u16* xb = (u16*)(ws + OFF_R);
  float* rs0 = (float*)(ws + OFF_RS0);
  for (int row = gw; row < 16384; row += 4 * nw) {
    f32x4 v[4][4];
#pragma unroll
    for (int k = 0; k < 4; ++k) {
      const int rr = row + k * nw;
      const f32x4* xr = (const f32x4*)(p.x + (size_t)(rr < 16384 ? rr : row) * 1024);
#pragma unroll
      for (int i = 0; i < 4; ++i) v[k][i] = __builtin_nontemporal_load(xr + lane + 64 * i);
    }
#pragma unroll
    for (int k = 0; k < 4; ++k) {
      const int rr = row + k * nw;
      float ss = 0.f;
#pragma unroll
      for (int i = 0; i < 4; ++i) ss += v[k][i][0] * v[k][i][0] + v[k][i][1] * v[k][i][1] + v[k][i][2] * v[k][i][2] + v[k][i][3] * v[k][i][3];
#pragma unroll
      for (int o = 32; o >= 1; o >>= 1) ss += __shfl_xor(ss, o);
      if (rr < 16384) {
        u32x2* xo = (u32x2*)(xb + (size_t)rr * 1024);
#pragma unroll
        for (int i = 0; i < 4; ++i) { u32x2 o = {pack2(v[k][i][0], v[k][i][1]), pack2(v[k][i][2], v[k][i][3])}; xo[lane + 64 * i] = o; }
        if (lane == 0) rs0[rr] = rsqrtf(ss * (1.f / 1024.f) + kEps);
      }
    }
  }
}

DI void phase0b(const Params& p, char* smem, int first, int nblk) {
  char* ws = p.ws;
  for (int t = (int)blockIdx.x - first; t < 1312; t += nblk) {
    if (t < 1056) transpose_tile(p.b_w_in, 4104, 4224, p.b_norm_w, (u16*)(ws + OFF_WTB_IN), t, smem);
    else transpose_tile(p.b_w_out, 1024, 1024, nullptr, (u16*)(ws + OFF_WTB_OUT), t - 1056, smem);
  }
}

template <int EPI>
DI void gemm_phase(const Params& p, const u16* __restrict__ A, const u16* __restrict__ Bt, int nTn, char* smem) {
  const int tid = tidx(), lane = tid & 63, wave = tid >> 6;
  const int wr = wave >> 1, wc = wave & 1;
  const int l15 = lane & 15, quad = lane >> 4;
  char* ws = p.ws;
  const int NX = ((gridDim.x & 7) == 0) ? 8 : 1;
  const int xg = blockIdx.x % NX, lb = blockIdx.x / NX, Lb = gridDim.x / NX;
  const int nTnG = nTn >> 3, nSuper = 16 * nTnG;
  const int srow = wave * 8 + (lane >> 3);
  const int sch = (lane & 7) ^ ((((wave & 1) << 2) + (lane >> 4)) & 7);
#define GEMM_TILE(seq_, tm_, tn_, ok_)                                                            \
  do {                                                                                            \
    const int sidx_ = xg + NX * ((seq_) >> 6);                                                    \
    ok_ = sidx_ < nSuper;                                                                         \
    const int tl_ = (seq_) & 63;                                                                  \
    tm_ = (sidx_ / nTnG) * 8 + (tl_ & 7);                                                         \
    tn_ = (sidx_ % nTnG) * 8 + (tl_ >> 3);                                                        \
  } while (0)
#define GEMM_STAGE(buf, kt)                                                                                                   \
  do {                                                                                                                        \
    _Pragma("unroll") for (int i = 0; i < 4; ++i) {                                                                           \
      __builtin_amdgcn_global_load_lds((const unsigned*)(Ag + (size_t)i * 32 * 1024 + (kt) * 64),                             \
                                       (unsigned*)(smem + (buf) * 32768 + (i * 4 + wave) * 1024), 16, 0, 0);                  \
      __builtin_amdgcn_global_load_lds((const unsigned*)(Bg + (size_t)i * 32 * 1024 + (kt) * 64),                             \
                                       (unsigned*)(smem + (buf) * 32768 + 16384 + (i * 4 + wave) * 1024), 16, 0, 0);          \
    }                                                                                                                         \
  } while (0)
  int seq = lb, tm, tn;
  bool ok;
  GEMM_TILE(seq, tm, tn, ok);
  const u16* Ag = A + (size_t)(tm * 128 + srow) * 1024 + sch * 8;
  const u16* Bg = Bt + (size_t)(tn * 128 + srow) * 1024 + sch * 8;
  if (ok) GEMM_STAGE(0, 0);
  while (ok) {
    int tm2, tn2;
    bool ok2;
    GEMM_TILE(seq + Lb, tm2, tn2, ok2);
    f32x4 acc[4][4];
#pragma unroll
    for (int a = 0; a < 4; ++a)
#pragma unroll
      for (int b = 0; b < 4; ++b) acc[a][b] = (f32x4){0.f, 0.f, 0.f, 0.f};
    asm volatile("s_waitcnt vmcnt(0)" ::: "memory");
    __syncthreads();
#pragma unroll 2
    for (int kt = 0; kt < 16; ++kt) {
      const int cur = kt & 1;
      if (kt + 1 < 16) GEMM_STAGE(cur ^ 1, kt + 1);
      else if (ok2) {
        Ag = A + (size_t)(tm2 * 128 + srow) * 1024 + sch * 8;
        Bg = Bt + (size_t)(tn2 * 128 + srow) * 1024 + sch * 8;
        GEMM_STAGE(0, 0);
      }
      const char* sa = smem + cur * 32768;
      const char* sb = sa + 16384;
#pragma unroll
      for (int ks = 0; ks < 2; ++ks) {
        bf16x8 fa[4], fb[4];
        const int ch = ks * 4 + quad;
#pragma unroll
        for (int mi = 0; mi < 4; ++mi) {
          const int row = wr * 64 + mi * 16 + l15;
          fa[mi] = *(const bf16x8*)(sa + row * 128 + ((ch ^ ((row >> 1) & 7)) << 4));
        }
#pragma unroll
        for (int ni = 0; ni < 4; ++ni) {
          const int row = wc * 64 + ni * 16 + l15;
          fb[ni] = *(const bf16x8*)(sb + row * 128 + ((ch ^ ((row >> 1) & 7)) << 4));
        }
#pragma unroll
        for (int ni = 0; ni < 4; ++ni)
#pragma unroll
          for (int mi = 0; mi < 4; ++mi) acc[ni][mi] = mfma16(fb[ni], fa[mi], acc[ni][mi]);
      }
      if (kt < 15) {
        asm volatile("s_waitcnt vmcnt(0)" ::: "memory");
        __syncthreads();
      }
    }
    float hnorm[4] = {1.f, 1.f, 1.f, 1.f};
    if constexpr (EPI == 3) {
      if (tn < 16) {
        float* part = (float*)(smem + 65536);
        float ssq[4];
#pragma unroll
        for (int mi = 0; mi < 4; ++mi) {
          const float rs = rsqrtf(((const float*)(ws + OFF_SS1))[tm * 128 + wr * 64 + mi * 16 + l15] * (1.f / 1024.f) + kEps);
          float s = 0.f;
#pragma unroll
          for (int ni = 0; ni < 4; ++ni) { const f32x4 v = acc[ni][mi] * rs; s += v[0] * v[0] + v[1] * v[1] + v[2] * v[2] + v[3] * v[3]; }
          s += __shfl_xor(s, 16);
          s += __shfl_xor(s, 32);
          ssq[mi] = s;
          if (quad == 0) part[(wr * 2 + wc) * 64 + mi * 16 + l15] = s;
        }
        __syncthreads();
#pragma unroll
        for (int mi = 0; mi < 4; ++mi) {
          const float tot = ssq[mi] + part[(wr * 2 + (wc ^ 1)) * 64 + mi * 16 + l15];
          hnorm[mi] = rsqrtf(tot * (1.f / 128.f) + kEps) * (tn < 8 ? kScale * kLog2e : 1.f);
        }
      }
    }
#pragma unroll
    for (int mi = 0; mi < 4; ++mi) {
      const int m = tm * 128 + wr * 64 + mi * 16 + l15;
      if constexpr (EPI == 1) {
        const float rs = ((const float*)(ws + OFF_RS0))[m];
        u16* proj = (u16*)(ws + OFF_PROJ);
        float* braw = (float*)(ws + OFF_BRAW);
#pragma unroll
        for (int ni = 0; ni < 4; ++ni) {
          const int nb = tn * 128 + wc * 64 + ni * 16 + quad * 4;
          f32x4 v = acc[ni][mi] * rs;
          if (nb < 4096) { u32x2 o = {pack2(v[0], v[1]), pack2(v[2], v[3])}; __builtin_nontemporal_store(o, (u32x2*)(proj + (size_t)m * 4096 + nb)); }
          else if (nb < 4112) { *(f32x4*)(braw + (size_t)m * 16 + (nb - 4096)) = v; }
        }
      } else if constexpr (EPI == 2 || EPI == 4) {
        float* ssp = (float*)(ws + (EPI == 2 ? OFF_SS1 : OFF_SS2));
        u16* hb = (u16*)(ws + OFF_R);
        float ssq = 0.f;
#pragma unroll
        for (int ni = 0; ni < 4; ++ni) {
          const int nb = tn * 128 + wc * 64 + ni * 16 + quad * 4;
          f32x4 v;
          if constexpr (EPI == 2) {
            v = acc[ni][mi] + __builtin_nontemporal_load((const f32x4*)(p.x + (size_t)m * 1024 + nb));
            u32x2 o = {pack2(v[0], v[1]), pack2(v[2], v[3])};
            *(u32x2*)(hb + (size_t)m * 1024 + nb) = o;
            v[0] = bflo(o.x); v[1] = bfhi(o.x); v[2] = bflo(o.y); v[3] = bfhi(o.y);
          } else {
            const u32x2 r = *(const u32x2*)(hb + (size_t)m * 1024 + nb);
            v = acc[ni][mi];
            v[0] += bflo(r.x); v[1] += bfhi(r.x); v[2] += bflo(r.y); v[3] += bfhi(r.y);
            const u32x2 o = {pack2(v[0], v[1]), pack2(v[2], v[3])};
            *(u32x2*)(hb + (size_t)m * 1024 + nb) = o;
            v[0] = bflo(o.x); v[1] = bfhi(o.x); v[2] = bflo(o.y); v[3] = bfhi(o.y);
          }
          ssq += v[0] * v[0] + v[1] * v[1] + v[2] * v[2] + v[3] * v[3];
        }
        ssq += __shfl_xor(ssq, 16);
        ssq += __shfl_xor(ssq, 32);
        if (quad == 0) atomicAdd(ssp + m, ssq);
      } else if constexpr (EPI == 3) {
        const float rs = rsqrtf(((const float*)(ws + OFF_SS1))[m] * (1.f / 1024.f) + kEps);
        u16* proj = (u16*)(ws + OFF_PROJ);
        u16* vT = (u16*)(ws + OFF_R + 32 * MiB);
        float* fraw = (float*)(ws + OFF_FRAW);
        float hs = 1.f;
        if (tn < 16) hs = hnorm[mi];
#pragma unroll
        for (int ni = 0; ni < 4; ++ni) {
          const int nb = tn * 128 + wc * 64 + ni * 16 + quad * 4;
          f32x4 v = acc[ni][mi] * rs;
          if (tn < 16) {
            const f32x4 wv = *(const f32x4*)((tn < 8 ? p.b_q_norm_w : p.b_k_norm_w) + (nb & 127));
            v = v * hs * wv;
          }
          if (nb < 4096) {
            if ((nb >> 10) != 2) { u32x2 o = {pack2(v[0], v[1]), pack2(v[2], v[3])}; __builtin_nontemporal_store(o, (u32x2*)(proj + (size_t)m * 4096 + nb)); }
            else {
              const int hd = nb - 2048;
              const int b = m >> 13, t = m & 8191;
              u16* dst = vT + ((size_t)(b * 1024 + hd)) * 8192 + t;
#pragma unroll
              for (int jj = 0; jj < 4; ++jj) dst[(size_t)jj * 8192] = (u16)f2bf(v[jj]);
            }
          } else if (nb < 4104) { *(f32x4*)(fraw + (size_t)m * 16 + (nb - 4096)) = v; }
        }
      }
    }
    seq += Lb; tm = tm2; tn = tn2; ok = ok2;
  }
#undef GEMM_STAGE
#undef GEMM_TILE
}


template <int MODE>
DI void skinny_gemm(const Params& p, const u16* __restrict__ A, const u16* __restrict__ Wt16, float* __restrict__ out) {
  const int tid = tidx(), lane = tid & 63, l15 = lane & 15, quad = lane >> 4;
  const int gw = blockIdx.x * 4 + (tid >> 6), nw = gridDim.x * 4;
  for (int mt = gw; mt < 1024; mt += nw) {
    const int m = mt * 16 + l15;
    const u16* ap = A + (size_t)m * 1024 + quad * 8;
    const u16* bp = Wt16 + (size_t)l15 * 1024 + quad * 8;
    f32x4 acc = {0.f, 0.f, 0.f, 0.f};
#pragma unroll 8
    for (int ks = 0; ks < 32; ++ks) acc = mfma16(*(const bf16x8*)(bp + ks * 32), *(const bf16x8*)(ap + ks * 32), acc);
    float rs;
    if constexpr (MODE == 0) rs = ((const float*)(p.ws + OFF_RS0))[m];
    else rs = rsqrtf(((const float*)(p.ws + OFF_SS1))[m] * (1.f / 1024.f) + kEps);
    f32x4 ov = acc * rs;
    if constexpr (MODE == 1) {
#pragma unroll
      for (int jj = 0; jj < 4; ++jj) {
        const int n = 4 * quad + jj;
        const float xv = ov[jj] + p.b_f_bias[n & 7];
        ov[jj] = fminf(xv, 0.f) - log1pf(__expf(-fabsf(xv)));
      }
    }
    *(f32x4*)(out + (size_t)m * 16 + 4 * quad) = ov;
  }
}

DI void delta_prep(const Params& p, char* smem, int first, int nblk) {
  char* ws = p.ws;
  const u16* proj = (const u16*)(ws + OFF_PROJ);
  const float* braw = (const float*)(ws + OFF_BRAW);
  u16* qd_g = (u16*)(ws + OFF_R);
  u16* kT_g = (u16*)(ws + OFF_R + 32 * MiB);
  u16* at_g = (u16*)(ws + OFF_R + 64 * MiB);
  u16* uT_g = (u16*)p.out;
  u16* w_g = (u16*)((char*)p.out + 32 * MiB);
  float* gend_g = (float*)(ws + OFF_GEND);
  char* qL = smem;
  char* kL = smem + 16384;
  char* vL = smem + 32768;
  float* As = (float*)(smem + 49152);
  float* sc = (float*)(smem + 66560);
  float* g_s = sc;
  float* beta_s = sc + 64;
  float* rq_s = sc + 128;
  float* rk_s = sc + 192;
  float* ssq_s = sc + 256;
  float* fu_s = sc + 384;
  float* fw_s = sc + 448;
  const int tid_ = tidx();

  unsigned* flags = (unsigned*)(ws + OFF_FLAGS);
  const __amdgpu_buffer_rsrc_t r_qd = __builtin_amdgcn_make_buffer_rsrc(qd_g, 0, 32 << 20, 0x00020000);
  const __amdgpu_buffer_rsrc_t r_kT = __builtin_amdgcn_make_buffer_rsrc(kT_g, 0, 32 << 20, 0x00020000);
  const __amdgpu_buffer_rsrc_t r_at = __builtin_amdgcn_make_buffer_rsrc(at_g, 0, 16 << 20, 0x00020000);
  const __amdgpu_buffer_rsrc_t r_uT = __builtin_amdgcn_make_buffer_rsrc(uT_g, 0, 32 << 20, 0x00020000);
  const __amdgpu_buffer_rsrc_t r_w = __builtin_amdgcn_make_buffer_rsrc(w_g, 0, 32 << 20, 0x00020000);
  if (nblk >= 256 && ((int)blockIdx.x - first) >= (nblk >> 1)) {
    for (int i = 0; i < 7; ++i) __builtin_amdgcn_s_sleep(127);
  }
  for (int j = (int)blockIdx.x - first; j < 2048; j += nblk) {
    const int c = j >> 4, b = (j >> 3) & 1, h = j & 7;
    const int item = (b * 128 + c) * 8 + h;
    const int tok0 = b * 8192 + c * 64;
    const int tid = relaunder(tid_), lane = tid & 63, wave = tid >> 6, l15 = lane & 15, quad = lane >> 4;
    if (wave == 3) {
      const int row = tok0 + lane;
      const float br = braw[(size_t)row * 16 + h];
      const float ar = braw[(size_t)row * 16 + 8 + h] + p.a_dt_bias[h];
      const float beta = 1.f / (1.f + __expf(-br));
      const float sp = fmaxf(ar, 0.f) + log1pf(__expf(-fabsf(ar)));
      float g = -__expf(p.a_A_log[h]) * sp;
#pragma unroll
      for (int o = 1; o < 64; o <<= 1) { float t = __shfl_up(g, o); if (lane >= o) g += t; }
      g_s[lane] = g;
      beta_s[lane] = beta;
    } else {
      const int sec = wave, cgi = l15, rr = quad;
      const int col = sec * 1024 + h * 128 + cgi * 8;
      float w0[8], w1[8], w2[8], w3[8];
#pragma unroll
      for (int e = 0; e < 8; ++e) {
        w0[e] = p.a_conv_w[0 * 3072 + col + e]; w1[e] = p.a_conv_w[1 * 3072 + col + e];
        w2[e] = p.a_conv_w[2 * 3072 + col + e]; w3[e] = p.a_conv_w[3 * 3072 + col + e];
      }
      const u16* src = proj + (size_t)(tok0 + rr * 16) * 4096 + col;
      float x0[8], x1[8], x2[8], x3[8];
      if (c == 0 && rr == 0) {
#pragma unroll
        for (int e = 0; e < 8; ++e) { x0[e] = 0.f; x1[e] = 0.f; x2[e] = 0.f; }
      } else {
        unpack8(*(const u32x4*)(src - 3 * 4096), x0);
        unpack8(*(const u32x4*)(src - 2 * 4096), x1);
        unpack8(*(const u32x4*)(src - 1 * 4096), x2);
      }
      char* dstL = smem + sec * 16384;
#pragma unroll 4
      for (int r = 0; r < 16; ++r) {
        unpack8(*(const u32x4*)(src + (size_t)r * 4096), x3);
        float y[8];
        float ssq = 0.f;
#pragma unroll
        for (int e = 0; e < 8; ++e) {
          float v = w0[e] * x0[e] + w1[e] * x1[e] + w2[e] * x2[e] + w3[e] * x3[e];
          v = silu(v);
          y[e] = v;
          ssq += v * v;
          x0[e] = x1[e]; x1[e] = x2[e]; x2[e] = x3[e];
        }
        ssq += __shfl_xor(ssq, 1); ssq += __shfl_xor(ssq, 2); ssq += __shfl_xor(ssq, 4); ssq += __shfl_xor(ssq, 8);
        const int row = rr * 16 + r;
        if (sec < 2 && cgi == 0) ssq_s[sec * 64 + row] = ssq;
        *(u32x4*)(dstL + row * 256 + ((cgi ^ (row & 15)) << 4)) = packf8(y);
      }
    }
    __syncthreads();
    if (tid < 64) {
      const float rq = rsqrtf(ssq_s[tid] + kEps), rk = rsqrtf(ssq_s[64 + tid] + kEps);
      const float gi = g_s[tid], g63 = g_s[63];
      const float eg = __expf(gi);
      rq_s[tid] = rq; rk_s[tid] = rk;
      const float be = beta_s[tid];
      fu_s[tid] = be;
      fw_s[tid] = be * rk * eg;
      ssq_s[tid] = rq * kScale * eg;
      ssq_s[64 + tid] = rk * __expf(g63 - gi);
      if (tid == 0) __hip_atomic_store(gend_g + item, __expf(g63), __ATOMIC_RELAXED, __HIP_MEMORY_SCOPE_AGENT);
    }
    __syncthreads();
    {
      const int tid = relaunder(tid_), lane = tid & 63, wave = tid >> 6, l15 = lane & 15, quad = lane >> 4;
      bf16x8 bk[4], bq[4];
      const int rowI = 16 * wave + l15;
#pragma unroll
      for (int ks = 0; ks < 4; ++ks) {
        const int off = rowI * 256 + (((ks * 4 + quad) ^ (rowI & 15)) << 4);
        bk[ks] = *(const bf16x8*)(kL + off);
        bq[ks] = *(const bf16x8*)(qL + off);
      }
      const int i = rowI;
      const float gi = g_s[i], bi = beta_s[i] * rk_s[i], qi = kScale * rq_s[i];
      u32x2 keep = {0u, 0u};
#pragma unroll
      for (int J = 0; J < 4; ++J) {
        f32x4 skk = {0.f, 0.f, 0.f, 0.f}, sqk = {0.f, 0.f, 0.f, 0.f};
        const int rowJ = 16 * J + l15;
#pragma unroll
        for (int ks = 0; ks < 4; ++ks) {
          const bf16x8 ak = *(const bf16x8*)(kL + rowJ * 256 + (((ks * 4 + quad) ^ (rowJ & 15)) << 4));
          skk = mfma16(ak, bk[ks], skk);
          sqk = mfma16(ak, bq[ks], sqk);
        }
        const f32x4 gj4 = *(const f32x4*)(g_s + 16 * J + 4 * quad);
        const f32x4 rk4 = *(const f32x4*)(rk_s + 16 * J + 4 * quad);
        f32x4 a4, t4;
#pragma unroll
        for (int jj = 0; jj < 4; ++jj) {
          const int j = 16 * J + 4 * quad + jj;
          const float dec = (i >= j) ? __expf(gi - gj4[jj]) : 0.f;
          a4[jj] = (i > j) ? bi * rk4[jj] * skk[jj] * dec : 0.f;
          t4[jj] = qi * rk4[jj] * sqk[jj] * dec;
        }
        *(f32x4*)(As + i * 68 + 16 * J + 4 * quad) = a4;
        const u32x2 half = {pack2(t4[0], t4[1]), pack2(t4[2], t4[3])};
        if ((J & 1) == 0) keep = half;
        else {
          const u32x4 fr = {keep.x, keep.y, half.x, half.y};
          __builtin_amdgcn_raw_buffer_store_b128(fr, r_at, item * 8192 + ((wave * 2 + (J >> 1)) * 64 + lane) * 16, 0, 16);
        }
      }
    }
    {
      const int tid = relaunder(tid_);
#pragma unroll
      for (int it = 0; it < 4; ++it) {
        const int idx = tid + 256 * it;
        const int f = idx >> 6, ln = idx & 63, fl = ln & 15, fq = ln >> 4;
        {
          const int mt = f >> 2, ks = f & 3, i = 16 * mt + fl;
          const int c0 = 4 * ks + (fq >> 1), o8 = (fq & 1) * 8;
          const u32x2 lo = *(const u32x2*)(qL + i * 256 + ((c0 ^ (i & 15)) << 4) + o8);
          const u32x2 hi = *(const u32x2*)(qL + i * 256 + (((c0 + 2) ^ (i & 15)) << 4) + o8);
          const float s = ssq_s[i];
          const u32x4 o = {pack2(bflo(lo.x) * s, bfhi(lo.x) * s), pack2(bflo(lo.y) * s, bfhi(lo.y) * s),
                           pack2(bflo(hi.x) * s, bfhi(hi.x) * s), pack2(bflo(hi.y) * s, bfhi(hi.y) * s)};
          __builtin_amdgcn_raw_buffer_store_b128(o, r_qd, item * 16384 + idx * 16, 0, 16);
        }
        {
          const int mt = f >> 1, ks = f & 1, dk = 16 * mt + fl;
          float v[8];
#pragma unroll
          for (int e = 0; e < 8; ++e) {
            const int i = 32 * ks + ((e < 4) ? (4 * fq + e) : (16 + 4 * fq + e - 4));
            const u16 raw = *(const u16*)(kL + i * 256 + (((dk >> 3) ^ (i & 15)) << 4) + (dk & 7) * 2);
            v[e] = __uint_as_float(((unsigned)raw) << 16) * ssq_s[64 + i];
          }
          __builtin_amdgcn_raw_buffer_store_b128(packf8(v), r_kT, item * 16384 + idx * 16, 0, 16);
        }
      }
    }
    __syncthreads();
    {
      float U[64];
      const int tid = relaunder(tid_), wave = tid >> 6;
      const int cc = tid & 127, ch = cc >> 3, e2 = (cc & 7) * 2;
      const char* srcL = (wave < 2) ? vL : kL;
      const float* fr = (wave < 2) ? fu_s : fw_s;
#pragma unroll
      for (int i = 0; i < 64; ++i) {
        int ii = i;
        asm volatile("" : "+v"(ii));
        const u16 raw = *(const u16*)(srcL + ii * 256 + ((ch ^ (ii & 15)) << 4) + e2);
        float acc = __uint_as_float(((unsigned)raw) << 16) * fr[ii];
#pragma unroll
        for (int j = 0; j < i; ++j) acc -= As[i * 68 + j] * U[j];
        U[i] = acc;
      }
      if (wave < 2) {
        const int dofs = item * 16384 + (((cc >> 4) * 4) * 256 + (cc & 15) * 4) * 2;
#pragma unroll
        for (int mi = 0; mi < 4; ++mi)
#pragma unroll
          for (int q4 = 0; q4 < 4; ++q4) {
            const u32x2 o = {pack2(U[16 * mi + 4 * q4], U[16 * mi + 4 * q4 + 1]), pack2(U[16 * mi + 4 * q4 + 2], U[16 * mi + 4 * q4 + 3])};
            __builtin_amdgcn_raw_buffer_store_b64(o, r_uT, dofs + (mi * 256 + q4 * 64) * 2, 0, 16);
          }
      } else {
#pragma unroll
        for (int i = 0; i < 64; ++i) {
          int ii = i;
          asm volatile("" : "+v"(ii));
          *(u16*)(qL + ii * 256 + ((ch ^ (ii & 15)) << 4) + e2) = (u16)f2bf(U[i]);
        }
      }
    }
    __syncthreads();
    {
      const int tid = relaunder(tid_);
#pragma unroll
      for (int it = 0; it < 4; ++it) {
        const int idx = tid + 256 * it;
        const int f = idx >> 6, ln = idx & 63, fl = ln & 15, fq = ln >> 4;
        const int mt = f >> 2, ks = f & 3, i = 16 * mt + fl;
        const int c0 = 4 * ks + (fq >> 1), o8 = (fq & 1) * 8;
        const u32x2 lo = *(const u32x2*)(qL + i * 256 + ((c0 ^ (i & 15)) << 4) + o8);
        const u32x2 hi = *(const u32x2*)(qL + i * 256 + (((c0 + 2) ^ (i & 15)) << 4) + o8);
        const u32x4 o = {lo.x, lo.y, hi.x, hi.y};
        __builtin_amdgcn_raw_buffer_store_b128(o, r_w, item * 16384 + idx * 16, 0, 16);
      }
    }
    asm volatile("s_waitcnt vmcnt(0)" ::: "memory");
    __syncthreads();
    if (relaunder(tid_) == 0) __hip_atomic_store(flags + item, 1u, __ATOMIC_RELAXED, __HIP_MEMORY_SCOPE_AGENT);
  }
}

#define RAW_BARRIER() do { asm volatile("s_waitcnt lgkmcnt(0)" ::: "memory"); __builtin_amdgcn_s_barrier(); asm volatile("" ::: "memory"); } while (0)
#define GAS __attribute__((address_space(1)))
#define SCAN_LOAD(item_)                                                                                          \
  do {                                                                                                            \
    const GAS char* wb_ = (const GAS char*)((const char*)w_g + (size_t)(item_) * 16384);                          \
    const GAS char* qb_ = (const GAS char*)((const char*)qd_g + (size_t)(item_) * 16384);                         \
    const GAS char* kb_ = (const GAS char*)((const char*)kT_g + (size_t)(item_) * 16384);                         \
    const GAS char* ab_ = (const GAS char*)((const char*)at_g + (size_t)(item_) * 8192);                          \
    const GAS char* ub_ = (const GAS char*)((const char*)uT_g + (size_t)(item_) * 16384);                         \
    asm volatile("" : "+s"(wb_), "+s"(qb_), "+s"(kb_), "+s"(ab_), "+s"(ub_));                                     \
    _Pragma("unroll") for (int j = 0; j < 4; ++j) {                                                               \
      R[j] = *(const GAS u32x4*)(wb_ + (toff + 4096u * j));                                                       \
      R[4 + j] = *(const GAS u32x4*)(qb_ + (toff + 4096u * j));                                                   \
      R[8 + j] = *(const GAS u32x4*)(kb_ + (toff + 4096u * j));                                                   \
    }                                                                                                             \
    _Pragma("unroll") for (int j = 0; j < 2; ++j) R[12 + j] = *(const GAS u32x4*)(ab_ + (toff + 4096u * j));     \
    _Pragma("unroll") for (int mi = 0; mi < 4; ++mi) un[mi] = *(const GAS u32x2*)(ub_ + (uoff + 512u * mi));     \
    gn = gend_g[item_];                                                                                           \
  } while (0)
DI void delta_scan(const Params& p, char* smem) {
  char* ws = p.ws;
  const u16* qd_g = (const u16*)(ws + OFF_R);
  const u16* kT_g = (const u16*)(ws + OFF_R + 32 * MiB);
  const u16* at_g = (const u16*)(ws + OFF_R + 64 * MiB);
  const u16* uT_g = (const u16*)p.out;
  const u16* w_g = (const u16*)((const char*)p.out + 32 * MiB);
  const float* gend_g = (const float*)(ws + OFF_GEND);
  u16* o_g = (u16*)(ws + OFF_PROJ);
  unsigned* flags = (unsigned*)(ws + OFF_FLAGS);
  const int tid = tidx(), lane = tid & 63, wave = tid >> 6, l15 = lane & 15, quad = lane >> 4;
  char* Lw = smem;
  char* Lq = smem + 16384;
  char* Lk = smem + 32768;
  char* La = smem + 49152;
  char* Lo = smem + 57344;
  for (int unit = blockIdx.x; unit < 32; unit += gridDim.x) {
    const int bh = unit & 15, half = unit >> 4, b = bh >> 3, h = bh & 7;
    const int slice = half * 4 + wave;
    f32x4 S[8];
#pragma unroll
    for (int i = 0; i < 8; ++i) S[i] = (f32x4){0.f, 0.f, 0.f, 0.f};
    const unsigned toff = (unsigned)tid * 16u, uoff = (unsigned)(slice * 256 + lane) * 8u;
    u32x4 R[14];
    u32x2 un[4];
    float gn;
#define SCAN_WAIT(flv_, item_)                                                                                         \
  do {                                                                                                                 \
    unsigned f_ = (flv_), sp_ = 0u;                                                                                    \
    while (f_ == 0u && sp_ < (1u << 24)) { __builtin_amdgcn_s_sleep(2); f_ = __hip_atomic_load(flags + (item_), __ATOMIC_RELAXED, __HIP_MEMORY_SCOPE_AGENT); ++sp_; } \
    __builtin_amdgcn_fence(__ATOMIC_ACQUIRE, "workgroup");           \
  } while (0)
    unsigned fl;
    {
      const int item = (b * 128) * 8 + h;
      SCAN_WAIT(0u, item);
      SCAN_LOAD(item);
      fl = __hip_atomic_load(flags + ((b * 128 + 1) * 8 + h), __ATOMIC_RELAXED, __HIP_MEMORY_SCOPE_AGENT);
    }
    for (int c = 0; c < 128; ++c) {
#pragma unroll
      for (int j = 0; j < 4; ++j) {
        *(u32x4*)(Lw + (tid + 256 * j) * 16) = R[j];
        *(u32x4*)(Lq + (tid + 256 * j) * 16) = R[4 + j];
        *(u32x4*)(Lk + (tid + 256 * j) * 16) = R[8 + j];
      }
#pragma unroll
      for (int j = 0; j < 2; ++j) *(u32x4*)(La + (tid + 256 * j) * 16) = R[12 + j];
      u32x2 uc[4];
#pragma unroll
      for (int mi = 0; mi < 4; ++mi) uc[mi] = un[mi];
      const float gend = gn;
      RAW_BARRIER();
      if (c + 1 < 128) SCAN_WAIT(fl, (b * 128 + c + 1) * 8 + h);
      if (c > 0) {
        const int tokp = b * 8192 + (c - 1) * 64;
#pragma unroll
        for (int k2 = 0; k2 < 2; ++k2) {
          const int idx = tid + 256 * k2, row = idx >> 3, part = idx & 7;
          *(u32x4*)(o_g + (size_t)(tokp + row) * 4096 + h * 128 + half * 64 + part * 8) = *(const u32x4*)(Lo + idx * 16);
        }
      }
      if (c + 1 < 128) {
        const int item = (b * 128 + c + 1) * 8 + h;
        SCAN_LOAD(item);
        fl = (c + 2 < 128) ? __hip_atomic_load(flags + (item + 8), __ATOMIC_RELAXED, __HIP_MEMORY_SCOPE_AGENT) : 1u;
      }
      __builtin_amdgcn_sched_barrier(0);
      bf16x8 bS[4];
#pragma unroll
      for (int ks = 0; ks < 4; ++ks) bS[ks] = pack8(S[2 * ks], S[2 * ks + 1]);
      bf16x8 fr[16];
#pragma unroll
      for (int i = 0; i < 16; ++i) fr[i] = *(const bf16x8*)(Lw + (i * 64 + lane) * 16);
      __builtin_amdgcn_sched_barrier(0);
      f32x4 vn[4];
#pragma unroll
      for (int mi = 0; mi < 4; ++mi) vn[mi] = (f32x4){0.f, 0.f, 0.f, 0.f};
#pragma unroll
      for (int ks = 0; ks < 4; ++ks)
#pragma unroll
        for (int mi = 0; mi < 4; ++mi) vn[mi] = mfma16(fr[mi * 4 + ks], bS[ks], vn[mi]);
      __builtin_amdgcn_sched_barrier(0);
#pragma unroll
      for (int i = 0; i < 16; ++i) fr[i] = *(const bf16x8*)(Lk + (i * 64 + lane) * 16);
#pragma unroll
      for (int mi = 0; mi < 4; ++mi) {
        vn[mi][0] = bflo(uc[mi].x) - vn[mi][0]; vn[mi][1] = bfhi(uc[mi].x) - vn[mi][1];
        vn[mi][2] = bflo(uc[mi].y) - vn[mi][2]; vn[mi][3] = bfhi(uc[mi].y) - vn[mi][3];
      }
      bf16x8 bV[2];
      bV[0] = pack8(vn[0], vn[1]);
      bV[1] = pack8(vn[2], vn[3]);
#pragma unroll
      for (int mt = 0; mt < 8; ++mt) S[mt] = S[mt] * gend;
      __builtin_amdgcn_sched_barrier(0);
#pragma unroll
      for (int ks = 0; ks < 2; ++ks)
#pragma unroll
        for (int mt = 0; mt < 8; ++mt) S[mt] = mfma16(fr[mt * 2 + ks], bV[ks], S[mt]);
      __builtin_amdgcn_sched_barrier(0);
#pragma unroll
      for (int i = 0; i < 16; ++i) fr[i] = *(const bf16x8*)(Lq + (i * 64 + lane) * 16);
      __builtin_amdgcn_sched_barrier(0);
      f32x4 oacc[4];
#pragma unroll
      for (int mi = 0; mi < 4; ++mi) oacc[mi] = (f32x4){0.f, 0.f, 0.f, 0.f};
#pragma unroll
      for (int ks = 0; ks < 4; ++ks)
#pragma unroll
        for (int mi = 0; mi < 4; ++mi) oacc[mi] = mfma16(fr[mi * 4 + ks], bS[ks], oacc[mi]);
      __builtin_amdgcn_sched_barrier(0);
#pragma unroll
      for (int i = 0; i < 8; ++i) fr[i] = *(const bf16x8*)(La + (i * 64 + lane) * 16);
      __builtin_amdgcn_sched_barrier(0);
#pragma unroll
      for (int ks = 0; ks < 2; ++ks)
#pragma unroll
        for (int mi = 0; mi < 4; ++mi) oacc[mi] = mfma16(fr[mi * 2 + ks], bV[ks], oacc[mi]);
      __builtin_amdgcn_sched_barrier(0);
#pragma unroll
      for (int mi = 0; mi < 4; ++mi)
#pragma unroll
        for (int jj = 0; jj < 4; ++jj)
          *(u16*)(Lo + (16 * mi + 4 * quad + jj) * 128 + (wave * 16 + l15) * 2) = (u16)f2bf(oacc[mi][jj]);
      RAW_BARRIER();
    }
    {
      const int tokp = b * 8192 + 127 * 64;
#pragma unroll
      for (int k2 = 0; k2 < 2; ++k2) {
        const int idx = tid + 256 * k2, row = idx >> 3, part = idx & 7;
        *(u32x4*)(o_g + (size_t)(tokp + row) * 4096 + h * 128 + half * 64 + part * 8) = *(const u32x4*)(Lo + idx * 16);
      }
      RAW_BARRIER();
    }
  }
}

#undef SCAN_LOAD
#undef SCAN_WAIT

DI void gate_phase(const Params& p) {
  char* ws = p.ws;
  const u16* proj = (const u16*)(ws + OFF_PROJ);
  u16* y0 = (u16*)(ws + OFF_R + 32 * MiB);
  const int tidg = tidx();
  const int lane = tidg & 63, l15 = lane & 15, quad = lane >> 4;
  const int gw = blockIdx.x * 4 + (tidg >> 6), nw = gridDim.x * 4;
  float wn[8];
#pragma unroll
  for (int e = 0; e < 8; ++e) wn[e] = p.a_o_norm_w[l15 * 8 + e];
  for (int r4 = gw; r4 < 32768; r4 += nw) {
    const int rh = r4 * 4 + quad, tok = rh >> 3, h = rh & 7;
    float o[8], z[8];
    unpack8(*(const u32x4*)(proj + (size_t)tok * 4096 + h * 128 + l15 * 8), o);
    unpack8(*(const u32x4*)(proj + (size_t)tok * 4096 + 3072 + h * 128 + l15 * 8), z);
    float ssq = 0.f;
#pragma unroll
    for (int e = 0; e < 8; ++e) ssq += o[e] * o[e];
    ssq += __shfl_xor(ssq, 1); ssq += __shfl_xor(ssq, 2); ssq += __shfl_xor(ssq, 4); ssq += __shfl_xor(ssq, 8);
    const float rs = rsqrtf(ssq * (1.f / 128.f) + kEps);
#pragma unroll
    for (int e = 0; e < 8; ++e) o[e] = o[e] * rs * wn[e] * silu(z[e]);
    *(u32x4*)(y0 + (size_t)tok * 1024 + h * 128 + l15 * 8) = packf8(o);
  }
}

DI void qknorm_cumsum(const Params& p, char* smem) {
  char* ws = p.ws;
  u16* proj = (u16*)(ws + OFF_PROJ);
  const int tid = tidx(), lane = tid & 63, l15 = lane & 15, quad = lane >> 4;
  const int gw = blockIdx.x * 4 + (tid >> 6), nw = gridDim.x * 4;
  for (int idx = gw; idx < 65536; idx += nw) {
    const int which = idx >> 15, r4 = idx & 32767;
    const int rh = r4 * 4 + quad, tok = rh >> 3, h = rh & 7;
    const float* wv = which ? p.b_k_norm_w : p.b_q_norm_w;
    u16* ptr = proj + (size_t)tok * 4096 + which * 1024 + h * 128 + l15 * 8;
    float v[8];
    unpack8(*(const u32x4*)ptr, v);
    float ssq = 0.f;
#pragma unroll
    for (int e = 0; e < 8; ++e) ssq += v[e] * v[e];
    ssq += __shfl_xor(ssq, 1); ssq += __shfl_xor(ssq, 2); ssq += __shfl_xor(ssq, 4); ssq += __shfl_xor(ssq, 8);
    const float rs = rsqrtf(ssq * (1.f / 128.f) + kEps) * (which ? 1.f : kScale);
#pragma unroll
    for (int e = 0; e < 8; ++e) v[e] = v[e] * rs * wv[l15 * 8 + e];
    *(u32x4*)ptr = packf8(v);
  }
}

DI void attn_phase(const Params& p, char* smem) {
  char* ws = p.ws;
  const u16* proj = (const u16*)(ws + OFF_PROJ);
  const u16* vT = (const u16*)(ws + OFF_R + 32 * MiB);
  const float* fraw = (const float*)(ws + OFF_FRAW);
  u16* y1 = (u16*)(ws + OFF_R + 64 * MiB);
  float* bias_s = (float*)(smem + 65536);
  float* ca_s = bias_s + 128;
  const int tid_ = tidx();
  float mq = 0.f, mk = 0.f;
  for (int i = 0; i < 128; ++i) { mq = fmaxf(mq, fabsf(p.b_q_norm_w[i])); mk = fmaxf(mk, fabsf(p.b_k_norm_w[i])); }
  const float QKB = 128.f * kScale * mq * mk;
  float* mmin_s = (float*)(smem + 66320);

  unsigned* qctr = (unsigned*)(ws + OFF_BAR) + XCD_BAR_WORDS;
  int* qslot = (int*)(smem + 66304);
  int qx = blockIdx.x & 7, qtries = 0;
  while (true) {
    const int tid = relaunder(tid_), lane = tid & 63, wave = tid >> 6, l15 = lane & 15, quad = lane >> 4;
    if (tid == 0) *qslot = (int)atomicAdd(qctr + qx * 16, 1u);
    __syncthreads();
    const int it = *qslot;
    __syncthreads();
    if (it >= 128) { if (++qtries >= 8) break; qx = (qx + 1) & 7; continue; }
    const int qb = 63 - (it & 63);
    const int b = it >> 6, h = b ? ((qx + 4) & 7) : qx, bh = b * 8 + h, i0 = qb * 128;
    const int qrow0 = i0 + 32 * wave;
    const float fb = p.b_f_bias[h];
    bf16x8 bq[2][4];
#pragma unroll
    for (int nq = 0; nq < 2; ++nq)
#pragma unroll
      for (int ks = 0; ks < 4; ++ks)
        bq[nq][ks] = *(const bf16x8*)(proj + (size_t)(b * 8192 + qrow0 + 16 * nq + l15) * 4096 + h * 128 + 32 * ks + 8 * quad);
    f32x4 O[8][2];
#pragma unroll
    for (int dt = 0; dt < 8; ++dt) { O[dt][0] = (f32x4){0.f, 0.f, 0.f, 0.f}; O[dt][1] = (f32x4){0.f, 0.f, 0.f, 0.f}; }
    float mrun[2] = {-1e30f, -1e30f}, lrun[2] = {0.f, 0.f};

    const int kkey = wave * 4 + (lane >> 4);
    const int kch = (lane & 15) ^ (kkey & 15);
    const u16* Kg = proj + (size_t)(b * 8192 + kkey) * 4096 + 1024 + h * 128 + kch * 8;
    const int vd = wave * 8 + (lane >> 3);
    const int vch = (lane & 7) ^ ((((wave & 1) << 2) + (lane >> 4)) & 7);
    const u16* Vg = vT + (size_t)(bh * 128 + vd) * 8192 + vch * 8;
#define ATT_STAGE(buf, j0_)                                                                                                   \
  do {                                                                                                                        \
    _Pragma("unroll") for (int i = 0; i < 4; ++i) {                                                                           \
      __builtin_amdgcn_global_load_lds((const unsigned*)(Kg + (size_t)((j0_) + 16 * i) * 4096),                               \
                                       (unsigned*)(smem + (buf) * 32768 + (i * 4 + wave) * 1024), 16, 0, 0);                  \
      __builtin_amdgcn_global_load_lds((const unsigned*)(Vg + (size_t)(32 * i) * 8192 + (j0_)),                               \
                                       (unsigned*)(smem + (buf) * 32768 + 16384 + (i * 4 + wave) * 1024), 16, 0, 0);          \
    }                                                                                                                         \
  } while (0)
    int j0 = i0 + 64;
    ATT_STAGE(0, j0);
    float carry = 0.f, biasA = 0.f, frn = 0.f;
    if (wave == 0) {
      const float lfA = fraw[(size_t)(b * 8192 + i0 + lane) * 16 + h];
      const float lfB = fraw[(size_t)(b * 8192 + i0 + 64 + lane) * 16 + h];
      float pa = lfA, pb = lfB;
#pragma unroll
      for (int o = 1; o < 64; o <<= 1) {
        const float ta = __shfl_up(pa, o), tb = __shfl_up(pb, o);
        if (lane >= o) { pa += ta; pb += tb; }
      }
      const float lf0 = __shfl(lfA, 0), totA = __shfl(pa, 63);
      biasA = -(pa - lf0) * kLog2e;
      bias_s[lane] = -(totA - lf0 + pb) * kLog2e;
      carry = lf0;
    }
    if (lane == 0) { mmin_s[wave] = -1e30f; mmin_s[4 + wave] = -1e30f; }
    asm volatile("s_waitcnt vmcnt(0)" ::: "memory");
    __syncthreads();
    auto att_tile = [&](const int cur, const bool diag) __attribute__((always_inline)) -> bool {
      const int nj = j0 - 64;
      bool more = nj >= 0;
      if (more && j0 <= i0) {
        const float* mm = mmin_s + cur * 4;
        const float mmin = fminf(fminf(mm[0], mm[1]), fminf(mm[2], mm[3]));
        more = !((QKB + ca_s[cur]) * kLog2e < mmin - 30.f * kLog2e);
      }
      if (more) {
        ATT_STAGE(cur ^ 1, nj);
        if (wave == 0 && nj < i0) frn = fraw[(size_t)(b * 8192 + nj + lane) * 16 + h];
      }
      if (j0 <= qrow0 + 31) {
        const char* Ks = smem + cur * 32768;
        const char* Vs = Ks + 16384;
        const float* cs = bias_s + cur * 64;
        f32x4 s[4][2];
#pragma unroll
        for (int kt = 0; kt < 4; ++kt) { s[kt][0] = (f32x4){0.f, 0.f, 0.f, 0.f}; s[kt][1] = (f32x4){0.f, 0.f, 0.f, 0.f}; }
#pragma unroll
        for (int ks = 0; ks < 4; ++ks)
#pragma unroll
          for (int kt = 0; kt < 4; ++kt) {
            const int kl = 16 * kt + l15;
            const bf16x8 ak = *(const bf16x8*)(Ks + kl * 256 + (((ks * 4 + quad) ^ (kl & 15)) << 4));
            s[kt][0] = mfma16(ak, bq[0][ks], s[kt][0]);
            s[kt][1] = mfma16(ak, bq[1][ks], s[kt][1]);
          }
#pragma unroll
        for (int kt = 0; kt < 4; ++kt) {
          const f32x4 bias = *(const f32x4*)(cs + 16 * kt + 4 * quad);
#pragma unroll
          for (int nq = 0; nq < 2; ++nq)
#pragma unroll
            for (int jj = 0; jj < 4; ++jj) {
              float v = s[kt][nq][jj] + bias[jj];
              if (diag) { if (j0 + 16 * kt + 4 * quad + jj > qrow0 + 16 * nq + l15) v = -1e30f; }
              s[kt][nq][jj] = v;
            }
        }
        bf16x8 bP[2][2];
#pragma unroll
        for (int nq = 0; nq < 2; ++nq) {
          float tmax = -1e30f;
#pragma unroll
          for (int kt = 0; kt < 4; ++kt)
#pragma unroll
            for (int jj = 0; jj < 4; ++jj) tmax = fmaxf(tmax, s[kt][nq][jj]);
          tmax = fmaxf(tmax, __shfl_xor(tmax, 16));
          tmax = fmaxf(tmax, __shfl_xor(tmax, 32));
          const float mnew = fmaxf(mrun[nq], tmax);
          const float alpha = __builtin_amdgcn_exp2f(mrun[nq] - mnew);
          const bool grew = mnew > mrun[nq];
          mrun[nq] = mnew;
          float psum = 0.f;
#pragma unroll
          for (int kt = 0; kt < 4; ++kt)
#pragma unroll
            for (int jj = 0; jj < 4; ++jj) { const float pv = __builtin_amdgcn_exp2f(s[kt][nq][jj] - mnew); s[kt][nq][jj] = pv; psum += pv; }
          lrun[nq] = lrun[nq] * alpha + psum;
          if (__builtin_amdgcn_ballot_w64(grew) != 0ull) {
#pragma unroll
            for (int dt = 0; dt < 8; ++dt) O[dt][nq] = O[dt][nq] * alpha;
          }
          bP[0][nq] = pack8(s[0][nq], s[1][nq]);
          bP[1][nq] = pack8(s[2][nq], s[3][nq]);
        }
#pragma unroll
        for (int ks = 0; ks < 2; ++ks)
#pragma unroll
          for (int dt = 0; dt < 8; ++dt) {
            const int d = 16 * dt + l15, sw = (d >> 1) & 7, c0 = 4 * ks + (quad >> 1);
            const u32x2 lo = *(const u32x2*)(Vs + d * 128 + ((c0 ^ sw) << 4) + (quad & 1) * 8);
            const u32x2 hi = *(const u32x2*)(Vs + d * 128 + (((c0 + 2) ^ sw) << 4) + (quad & 1) * 8);
            const bf16x8 av = mk8(lo, hi);
            O[dt][0] = mfma16(av, bP[ks][0], O[dt][0]);
            O[dt][1] = mfma16(av, bP[ks][1], O[dt][1]);
          }
        float wm = fminf(mrun[0], mrun[1]);
#pragma unroll
        for (int o = 1; o < 64; o <<= 1) wm = fminf(wm, __shfl_xor(wm, o));
        if (lane == 0) mmin_s[(cur ^ 1) * 4 + wave] = wm;
      }
      if (more && wave == 0) {
        const int nb = cur ^ 1;
        if (nj == i0) {
          bias_s[nb * 64 + lane] = biasA;
          if (lane == 0) ca_s[nb] = carry;
        } else {
          const float lf = frn;
          float sf = lf;
#pragma unroll
          for (int o = 1; o < 64; o <<= 1) { const float t = __shfl_down(sf, o); if (lane + o < 64) sf += t; }
          bias_s[nb * 64 + lane] = (sf - lf + carry) * kLog2e;
          carry += __shfl(sf, 0);
          if (lane == 0) ca_s[nb] = carry;
        }
      }
      asm volatile("s_waitcnt vmcnt(0)" ::: "memory");
      __syncthreads();
      if (!more) return false;
      j0 = nj;
      return true;
    };
    if (att_tile(0, true) && att_tile(1, true)) {
      while (true) {
        if (!att_tile(0, false)) break;
        if (!att_tile(1, false)) break;
      }
    }
#undef ATT_STAGE
#pragma unroll
    for (int nq = 0; nq < 2; ++nq) {
      float l = lrun[nq];
      l += __shfl_xor(l, 16);
      l += __shfl_xor(l, 32);
      const float inv = 1.f / l;
      const size_t tok = (size_t)(b * 8192 + qrow0 + 16 * nq + l15);
#pragma unroll
      for (int dt = 0; dt < 8; ++dt) {
        const int d = 16 * dt + 4 * quad;
        const u32x2 z2 = *(const u32x2*)(proj + tok * 4096 + 3072 + h * 128 + d);
        const f32x4 o = O[dt][nq] * inv;
        u32x2 r = {pack2(o[0] * silu(bflo(z2.x)), o[1] * silu(bfhi(z2.x))), pack2(o[2] * silu(bflo(z2.y)), o[3] * silu(bfhi(z2.y)))};
        *(u32x2*)(y1 + tok * 1024 + h * 128 + d) = r;
      }
    }
  }
}

DI void final_norm(const Params& p) {
  const float* ss2 = (const float*)(p.ws + OFF_SS2);
  const int tidf = tidx();
  const int lane = tidf & 63;
  const int gw = blockIdx.x * 4 + (tidf >> 6), nw = gridDim.x * 4;
  const f32x4* w = (const f32x4*)p.final_norm_w;
  f32x4 wv[4];
#pragma unroll
  for (int i = 0; i < 4; ++i) wv[i] = w[lane + 64 * i];
  for (int row = gw; row < 16384; row += 4 * nw) {
    u32x2 r[4][4];
    float rs[4];
#pragma unroll
    for (int k = 0; k < 4; ++k) {
      const int rr = row + k * nw;
      const bool okr = rr < 16384;
      const int rc = okr ? rr : row;
      rs[k] = rsqrtf(ss2[rc] * (1.f / 1024.f) + kEps);
      const u32x2* hsrc = (const u32x2*)((const u16*)(p.ws + OFF_R) + (size_t)rc * 1024);
#pragma unroll
      for (int i = 0; i < 4; ++i) r[k][i] = hsrc[lane + 64 * i];
    }
#pragma unroll
    for (int k = 0; k < 4; ++k) {
      const int rr = row + k * nw;
      if (rr < 16384) {
        f32x4* o = (f32x4*)(p.out + (size_t)rr * 1024);
#pragma unroll
        for (int i = 0; i < 4; ++i) {
          f32x4 v = {bflo(r[k][i].x), bfhi(r[k][i].x), bflo(r[k][i].y), bfhi(r[k][i].y)};
          __builtin_nontemporal_store(v * rs[k] * wv[i], o + lane + 64 * i);
        }
      }
    }
  }
}

__global__ void __launch_bounds__(kThreads, 2) fwd_megakernel(Params p) {
  extern __shared__ __attribute__((aligned(16))) char smem[];
  cg::grid_group grid = cg::this_grid();
  char* ws = p.ws;
  __shared__ uint4 xb_words;
  if (threadIdx.x == 0) xb_words = make_uint4(0u, 0u, 0u, 0u);
  __syncthreads();
  if (p.ws == nullptr) grid.sync();
  XcdBarrier xb = xcd_barrier_post((unsigned*)(ws + OFF_BAR), (volatile LAS unsigned*)&xb_words);
  phase0(p, smem);
  xcd_barrier(xb);
  gemm_phase<1>(p, (const u16*)(ws + OFF_R), (const u16*)(ws + OFF_WTA_IN), 32, smem);
  skinny_gemm<0>(p, (const u16*)(ws + OFF_R), (const u16*)(ws + OFF_WTA_IN) + (size_t)4096 * 1024, (float*)(ws + OFF_BRAW));
  xcd_barrier(xb);
  {
    const bool overlap = gridDim.x >= 128;
    const int G = (int)gridDim.x, hG = G >> 1, bi = (int)blockIdx.x;
    const bool is_scan = overlap && bi < 32, is_idle = overlap && bi >= hG && bi < hG + 32;
    const int pfirst = overlap ? (bi < hG ? 32 : 64) : 0, pn = overlap ? G - 64 : G;
    if (!is_scan && !is_idle) delta_prep(p, smem, pfirst, pn);
    if (!is_scan && !is_idle) phase0b(p, smem, pfirst, pn);
    if (!overlap) xcd_barrier(xb);
    if (!overlap || blockIdx.x < 32) delta_scan(p, smem);
    xcd_barrier(xb);
  }
  gate_phase(p);
  xcd_barrier(xb);
  gemm_phase<2>(p, (const u16*)(ws + OFF_R + 32 * MiB), (const u16*)(ws + OFF_WTA_OUT), 8, smem);
  xcd_barrier(xb);
  gemm_phase<3>(p, (const u16*)(ws + OFF_R), (const u16*)(ws + OFF_WTB_IN), 32, smem);
  skinny_gemm<1>(p, (const u16*)(ws + OFF_R), (const u16*)(ws + OFF_WTB_IN) + (size_t)4096 * 1024, (float*)(ws + OFF_FRAW));
  xcd_barrier(xb);
  attn_phase(p, smem);
  xcd_barrier(xb);
  gemm_phase<4>(p, (const u16*)(ws + OFF_R + 64 * MiB), (const u16*)(ws + OFF_WTB_OUT), 8, smem);
  xcd_barrier(xb);
  final_norm(p);
}

extern "C" void kernel_launch(void* const* d_in, const int* in_sizes, int n_in, void* d_out, int out_size, void* d_ws, size_t ws_size,
                              hipStream_t stream) {
  static int grid_blocks = 0;
  if (!grid_blocks) {
    int dev = 0, cus = 0, per_cu = 0;
    hipGetDevice(&dev);
    hipDeviceGetAttribute(&cus, hipDeviceAttributeMultiprocessorCount, dev);
    hipFuncSetAttribute((const void*)fwd_megakernel, hipFuncAttributeMaxDynamicSharedMemorySize, kLds);
    hipOccupancyMaxActiveBlocksPerMultiprocessor(&per_cu, (const void*)fwd_megakernel, kThreads, kLds);
    if (per_cu < 1) per_cu = 1;
    if (per_cu > 2) per_cu = 2;
    grid_blocks = cus * per_cu;
  }
  Params p{};
  p.x = (const float*)d_in[0]; p.a_norm_w = (const float*)d_in[1]; p.a_w_in = (const float*)d_in[2]; p.a_conv_w = (const float*)d_in[3];
  p.a_A_log = (const float*)d_in[4]; p.a_dt_bias = (const float*)d_in[5]; p.a_o_norm_w = (const float*)d_in[6]; p.a_w_out = (const float*)d_in[7];
  p.b_norm_w = (const float*)d_in[8]; p.b_w_in = (const float*)d_in[9]; p.b_f_bias = (const float*)d_in[10]; p.b_q_norm_w = (const float*)d_in[11];
  p.b_k_norm_w = (const float*)d_in[12]; p.b_w_out = (const float*)d_in[13]; p.final_norm_w = (const float*)d_in[14];
  p.out = (float*)d_out;
  p.ws = (char*)d_ws;
  hipMemsetAsync((char*)d_ws + OFF_BAR, 0, CTL_BYTES, stream);
  void* args[] = {&p};
  hipError_t e = hipLaunchCooperativeKernel((const void*)fwd_megakernel, dim3(grid_blocks), dim3(kThreads), args, kLds, stream);
  if (e != hipSuccess) fprintf(stderr, "cooperative launch failed: %s (grid %d)\n", hipGetErrorString(e), grid_blocks);
}
```

```cpp
#include <hip/hip_runtime.h>
#include <hip/hip_cooperative_groups.h>
#include <cstdio>
namespace cg = cooperative_groups;

typedef unsigned short u16;
typedef __attribute__((ext_vector_type(8))) short bf16x8;
typedef __attribute__((ext_vector_type(4))) float f32x4;
typedef __attribute__((ext_vector_type(4))) unsigned u32x4;
typedef __attribute__((ext_vector_type(2))) unsigned u32x2;
#define DI __device__ __forceinline__

constexpr int kThreads = 256;
constexpr int kLds = 69632;
constexpr float kEps = 1e-6f;
constexpr float kScale = 0.08838834764831845f;
constexpr float kLog2e = 1.4426950408889634f;

constexpr size_t MiB = 1048576;
constexpr size_t OFF_WTA_IN = 0;
constexpr size_t OFF_WTA_OUT = 8650752;
constexpr size_t OFF_WTB_IN = 10747904;
constexpr size_t OFF_WTB_OUT = 19398656;
constexpr size_t OFF_SMALL = 21495808;
constexpr size_t OFF_RS0 = OFF_SMALL;
constexpr size_t OFF_SS1 = OFF_RS0 + 65536;
constexpr size_t OFF_SS2 = OFF_SS1 + 65536;
constexpr size_t OFF_BRAW = OFF_SS2 + 65536;
constexpr size_t OFF_FRAW = OFF_BRAW + 1048576;
constexpr size_t OFF_CCUM = OFF_FRAW + 1048576;
constexpr size_t OFF_GEND = OFF_CCUM + 524288;
constexpr size_t OFF_BAR = OFF_GEND + 8192;
constexpr size_t OFF_FLAGS = OFF_BAR + 13824 + 512;
constexpr size_t CTL_BYTES = 13824 + 512 + 8192;
constexpr size_t OFF_PROJ = OFF_SMALL + 3 * MiB;
constexpr size_t OFF_R = OFF_PROJ + 128 * MiB;

struct Params {
  const float *x, *a_norm_w, *a_w_in, *a_conv_w, *a_A_log, *a_dt_bias, *a_o_norm_w, *a_w_out;
  const float *b_norm_w, *b_w_in, *b_f_bias, *b_q_norm_w, *b_k_norm_w, *b_w_out, *final_norm_w;
  float* out;
  char* ws;
};

typedef __attribute__((ext_vector_type(2))) float f32x2;
typedef __attribute__((ext_vector_type(2))) __bf16 bf16x2_t;
DI unsigned pack2(float a, float b) { f32x2 v = {a, b}; return __builtin_bit_cast(unsigned, __builtin_convertvector(v, bf16x2_t)); }
DI unsigned f2bf(float x) { return pack2(x, 0.f) & 0xffffu; }
DI float bflo(unsigned u) { return __uint_as_float(u << 16); }
DI float bfhi(unsigned u) { return __uint_as_float(u & 0xffff0000u); }
DI f32x4 mfma16(bf16x8 a, bf16x8 b, f32x4 c) { return __builtin_amdgcn_mfma_f32_16x16x32_bf16(a, b, c, 0, 0, 0); }
DI bf16x8 mk8(u32x2 lo, u32x2 hi) { u32x4 v = {lo.x, lo.y, hi.x, hi.y}; return __builtin_bit_cast(bf16x8, v); }
DI bf16x8 pack8(f32x4 a, f32x4 b) { u32x4 v = {pack2(a[0], a[1]), pack2(a[2], a[3]), pack2(b[0], b[1]), pack2(b[2], b[3])}; return __builtin_bit_cast(bf16x8, v); }
DI bf16x8 ld2(const u16* p) { return mk8(*(const u32x2*)p, *(const u32x2*)(p + 16)); }
DI int relaunder(int t) { asm volatile("" : "+v"(t)); return t; }
DI int tidx() { int t = threadIdx.x; asm volatile("" : "+v"(t)); return t; }
template <int CTRL> DI float dpp_f(float x) { return __int_as_float(__builtin_amdgcn_update_dpp(0, __float_as_int(x), CTRL, 0xF, 0xF, true)); }
DI float readlane_f(float x, const int l) { return __int_as_float(__builtin_amdgcn_readlane(__float_as_int(x), l)); }
DI float silu(float x) { return x / (1.f + __expf(-x)); }
DI void unpack8(u32x4 v, float* f) {
  f[0] = bflo(v.x); f[1] = bfhi(v.x); f[2] = bflo(v.y); f[3] = bfhi(v.y);
  f[4] = bflo(v.z); f[5] = bfhi(v.z); f[6] = bflo(v.w); f[7] = bfhi(v.w);
}
DI u32x4 packf8(const float* f) { u32x4 v = {pack2(f[0], f[1]), pack2(f[2], f[3]), pack2(f[4], f[5]), pack2(f[6], f[7])}; return v; }


#define XB_TMO      128
#define XB_XCNT(j)  (256  + 64 * (j))
#define XB_XSUB(j)  (1280 + 64 * (j))
#define XB_XGEN(j)  (2304 + 64 * (j))
#define XB_TOP      3328
#define XB_TOPGEN   3392
#define XCD_BAR_WORDS 3456
#define XB_SPIN_CAP (1u << 23)
#define LAS __attribute__((address_space(3)))
DI unsigned xb_ld(unsigned* p) { return __hip_atomic_load(p, __ATOMIC_RELAXED, __HIP_MEMORY_SCOPE_AGENT); }
DI unsigned xb_add(unsigned* p, unsigned v) { return __hip_atomic_fetch_add(p, v, __ATOMIC_RELAXED, __HIP_MEMORY_SCOPE_AGENT); }
DI unsigned xb_xcc_id() { return (unsigned)__builtin_amdgcn_s_getreg((3 << 11) | 20) & 0xFu; }
#define XB_SPIN(cond, bar) do { unsigned _sp = 0; while (cond) { __builtin_amdgcn_s_sleep(1); \
    if ((++_sp & 255u) == 0u) { if (xb_ld(&(bar)[XB_TMO])) break; if (_sp > XB_SPIN_CAP) { atomicAdd(&(bar)[XB_TMO], 1u); break; } } } } while (0)
struct XcdBarrier { unsigned* bar; unsigned x; volatile LAS unsigned* st; };
DI XcdBarrier xcd_barrier_post(unsigned* bar, volatile LAS unsigned* st) {
  XcdBarrier b; b.bar = bar; b.x = xb_xcc_id(); b.st = st;
  if (threadIdx.x == 0) (void)xb_add(&bar[XB_XCNT(b.x)], 1u);
  return b;
}
DI void xcd_barrier_complete(unsigned* bar, unsigned x, unsigned& nloc, unsigned& nx) {
  const unsigned G = gridDim.x * gridDim.y * gridDim.z;
  unsigned sum, cnt, mine, sp = 0u;
  for (;;) {
    sum = 0u; cnt = 0u; mine = 0u;
#pragma unroll
    for (unsigned j = 0; j < 16; ++j) { const unsigned c = xb_ld(&bar[XB_XCNT(j)]); sum += c; cnt += (c > 0u) ? 1u : 0u; mine = (j == x) ? c : mine; }
    if (sum == G) break;
    __builtin_amdgcn_s_sleep(1);
    if ((++sp & 255u) == 0u) { if (xb_ld(&bar[XB_TMO])) break; if (sp > XB_SPIN_CAP) { atomicAdd(&bar[XB_TMO], 1u); break; } }
  }
  nloc = mine > 0u ? mine : 1u; nx = cnt > 0u ? cnt : 1u;
}
DI void xcd_barrier(const XcdBarrier& b) {
  asm volatile("s_waitcnt vmcnt(0)" ::: "memory");
  __syncthreads();
  if (threadIdx.x == 0) {
    unsigned* bar = b.bar;
    __builtin_amdgcn_s_waitcnt(0);
    unsigned nloc = b.st[0], nx = b.st[1];
    if (nloc == 0u) { xcd_barrier_complete(bar, b.x, nloc, nx); b.st[0] = nloc; b.st[1] = nx; }
    const unsigned old = xb_add(&bar[XB_XSUB(b.x)], 1u);
    const unsigned gen = old / nloc;
    if (old + 1u == (gen + 1u) * nloc) {
      __builtin_amdgcn_fence(__ATOMIC_RELEASE, "agent");
      asm volatile("s_waitcnt vmcnt(0)" ::: "memory");
      const unsigned og = xb_add(&bar[XB_TOP], 1u);
      const unsigned tg = og / nx;
      if (og + 1u == (tg + 1u) * nx) xb_add(&bar[XB_TOPGEN], 1u);
      else XB_SPIN(xb_ld(&bar[XB_TOPGEN]) == tg, bar);
      __builtin_amdgcn_fence(__ATOMIC_ACQUIRE, "agent");
      xb_add(&bar[XB_XGEN(b.x)], 1u);
      asm volatile("s_waitcnt vmcnt(0)" ::: "memory");
    } else {
      XB_SPIN(xb_ld(&bar[XB_XGEN(b.x)]) == gen, bar);
      __builtin_amdgcn_fence(__ATOMIC_ACQUIRE, "agent");
      asm volatile("s_waitcnt vmcnt(0)" ::: "memory");
    }
  }
  __syncthreads();
}

DI void transpose_tile(const float* __restrict__ W, int N, int Npad, const float* __restrict__ kscale, u16* __restrict__ WT, int tile, char* smem) {
  float(*t)[65] = (float(*)[65])smem;
  const int nt = Npad / 64;
  const int k0 = (tile / nt) * 64, n0 = (tile % nt) * 64;
  const int tid = tidx();
  {
    const int tx = tid & 63, ty = tid >> 6;
#pragma unroll 4
    for (int i = 0; i < 16; ++i) {
      const int k = k0 + ty + 4 * i, n = n0 + tx;
      float v = 0.f;
      if (n < N) { v = W[(size_t)k * N + n]; if (kscale) v *= kscale[k]; }
      t[ty + 4 * i][tx] = v;
    }
  }
  __syncthreads();
  {
    const int kx2 = (tid & 31) * 2, ny0 = tid >> 5;
#pragma unroll 4
    for (int i = 0; i < 8; ++i) {
      const int ny = ny0 + 8 * i;
      *(unsigned*)(WT + (size_t)(n0 + ny) * 1024 + k0 + kx2) = pack2(t[kx2][ny], t[kx2 + 1][ny]);
    }
  }
  __syncthreads();
}

DI void phase0(const Params& p, char* smem) {
  char* ws = p.ws;
  {
    float* ss = (float*)(ws + OFF_SS1);
    for (int i = blockIdx.x * kThreads + tidx(); i < 32768; i += gridDim.x * kThreads) ss[i] = 0.f;
  }
  for (int t = blockIdx.x; t < 1312; t += gridDim.x) {
    if (t < 1056) transpose_tile(p.a_w_in, 4112, 4224, p.a_norm_w, (u16*)(ws + OFF_WTA_IN), t, smem);
    else transpose_tile(p.a_w_out, 1024, 1024, nullptr, (u16*)(ws + OFF_WTA_OUT), t - 1056, smem);
  }
  const int tid0 = tidx();
  const int lane = tid0 & 63;
  const int gw = blockIdx.x * 4 + (tid0 >> 6), nw = gridDim.x * 4;
  u16* xb = (u16*)(ws + OFF_R);
  float* rs0 = (float*)(ws + OFF_RS0);
  for (int row = gw; row < 16384; row += 4 * nw) {
    f32x4 v[4][4];
#pragma unroll
    for (int k = 0; k < 4; ++k) {
      const int rr = row + k * nw;
      const f32x4* xr = (const f32x4*)(p.x + (size_t)(rr < 16384 ? rr : row) * 1024);
#pragma unroll
      for (int i = 0; i < 4; ++i) v[k][i] = __builtin_nontemporal_load(xr + lane + 64 * i);
    }
#pragma unroll
    for (int k = 0; k < 4; ++k) {
      const int rr = row + k * nw;
      float ss = 0.f;
#pragma unroll
      for (int i = 0; i < 4; ++i) ss += v[k][i][0] * v[k][i][0] + v[k][i][1] * v[k][i][1] + v[k][i][2] * v[k][i][2] + v[k][i][3] * v[k][i][3];
#pragma unroll
      for (int o = 32; o >= 1; o >>= 1) ss += __shfl_xor(ss, o);
      if (rr < 16384) {
        u32x2* xo = (u32x2*)(xb + (size_t)rr * 1024);
#pragma unroll
        for (int i = 0; i < 4; ++i) { u32x2 o = {pack2(v[k][i][0], v[k][i][1]), pack2(v[k][i][2], v[k][i][3])}; xo[lane + 64 * i] = o; }
        if (lane == 0) rs0[rr] = rsqrtf(ss * (1.f / 1024.f) + kEps);
      }
    }
  }
}

DI void phase0b(const Params& p, char* smem, int first, int nblk) {
  char* ws = p.ws;
  for (int t = (int)blockIdx.x - first; t < 1312; t += nblk) {
    if (t < 1056) transpose_tile(p.b_w_in, 4104, 4224, p.b_norm_w, (u16*)(ws + OFF_WTB_IN), t, smem);
    else transpose_tile(p.b_w_out, 1024, 1024, nullptr, (u16*)(ws + OFF_WTB_OUT), t - 1056, smem);
  }
}

template <int EPI>
DI void gemm_phase(const Params& p, const u16* __restrict__ A, const u16* __restrict__ Bt, int nTn, char* smem) {
  const int tid = tidx(), lane = tid & 63, wave = tid >> 6;
  const int wr = wave >> 1, wc = wave & 1;
  const int l15 = lane & 15, quad = lane >> 4;
  char* ws = p.ws;
  const int NX = ((gridDim.x & 7) == 0) ? 8 : 1;
  const int xg = blockIdx.x % NX, lb = blockIdx.x / NX, Lb = gridDim.x / NX;
  const int nTnG = nTn >> 3, nSuper = 16 * nTnG;
  const int srow = wave * 8 + (lane >> 3);
  const int sch = (lane & 7) ^ ((((wave & 1) << 2) + (lane >> 4)) & 7);
#define GEMM_TILE(seq_, tm_, tn_, ok_)                                                            \
  do {                                                                                            \
    const int sidx_ = xg + NX * ((seq_) >> 6);                                                    \
    ok_ = sidx_ < nSuper;                                                                         \
    const int tl_ = (seq_) & 63;                                                                  \
    tm_ = (sidx_ / nTnG) * 8 + (tl_ & 7);                                                         \
    tn_ = (sidx_ % nTnG) * 8 + (tl_ >> 3);                                                        \
  } while (0)
#define GEMM_STAGE(buf, kt)                                                                                                   \
  do {                                                                                                                        \
    _Pragma("unroll") for (int i = 0; i < 4; ++i) {                                                                           \
      __builtin_amdgcn_global_load_lds((const unsigned*)(Ag + (size_t)i * 32 * 1024 + (kt) * 64),                             \
                                       (unsigned*)(smem + (buf) * 32768 + (i * 4 + wave) * 1024), 16, 0, 0);                  \
      __builtin_amdgcn_global_load_lds((const unsigned*)(Bg + (size_t)i * 32 * 1024 + (kt) * 64),                             \
                                       (unsigned*)(smem + (buf) * 32768 + 16384 + (i * 4 + wave) * 1024), 16, 0, 0);          \
    }                                                                                                                         \
  } while (0)
  int seq = lb, tm, tn;
  bool ok;
  GEMM_TILE(seq, tm, tn, ok);
  const u16* Ag = A + (size_t)(tm * 128 + srow) * 1024 + sch * 8;
  const u16* Bg = Bt + (size_t)(tn * 128 + srow) * 1024 + sch * 8;
  if (ok) GEMM_STAGE(0, 0);
  while (ok) {
    int tm2, tn2;
    bool ok2;
    GEMM_TILE(seq + Lb, tm2, tn2, ok2);
    f32x4 acc[4][4];
#pragma unroll
    for (int a = 0; a < 4; ++a)
#pragma unroll
      for (int b = 0; b < 4; ++b) acc[a][b] = (f32x4){0.f, 0.f, 0.f, 0.f};
    asm volatile("s_waitcnt vmcnt(0)" ::: "memory");
    __syncthreads();
#pragma unroll 2
    for (int kt = 0; kt < 16; ++kt) {
      const int cur = kt & 1;
      if (kt + 1 < 16) GEMM_STAGE(cur ^ 1, kt + 1);
      else if (ok2) {
        Ag = A + (size_t)(tm2 * 128 + srow) * 1024 + sch * 8;
        Bg = Bt + (size_t)(tn2 * 128 + srow) * 1024 + sch * 8;
        GEMM_STAGE(0, 0);
      }
      const char* sa = smem + cur * 32768;
      const char* sb = sa + 16384;
#pragma unroll
      for (int ks = 0; ks < 2; ++ks) {
        bf16x8 fa[4], fb[4];
        const int ch = ks * 4 + quad;
#pragma unroll
        for (int mi = 0; mi < 4; ++mi) {
          const int row = wr * 64 + mi * 16 + l15;
          fa[mi] = *(const bf16x8*)(sa + row * 128 + ((ch ^ ((row >> 1) & 7)) << 4));
        }
#pragma unroll
        for (int ni = 0; ni < 4; ++ni) {
          const int row = wc * 64 + ni * 16 + l15;
          fb[ni] = *(const bf16x8*)(sb + row * 128 + ((ch ^ ((row >> 1) & 7)) << 4));
        }
#pragma unroll
        for (int ni = 0; ni < 4; ++ni)
#pragma unroll
          for (int mi = 0; mi < 4; ++mi) acc[ni][mi] = mfma16(fb[ni], fa[mi], acc[ni][mi]);
      }
      if (kt < 15) {
        asm volatile("s_waitcnt vmcnt(0)" ::: "memory");
        __syncthreads();
      }
    }
    float hnorm[4] = {1.f, 1.f, 1.f, 1.f};
    if constexpr (EPI == 3) {
      if (tn < 16) {
        float* part = (float*)(smem + 65536);
        float ssq[4];
#pragma unroll
        for (int mi = 0; mi < 4; ++mi) {
          const float rs = rsqrtf(((const float*)(ws + OFF_SS1))[tm * 128 + wr * 64 + mi * 16 + l15] * (1.f / 1024.f) + kEps);
          float s = 0.f;
#pragma unroll
          for (int ni = 0; ni < 4; ++ni) { const f32x4 v = acc[ni][mi] * rs; s += v[0] * v[0] + v[1] * v[1] + v[2] * v[2] + v[3] * v[3]; }
          s += __shfl_xor(s, 16);
          s += __shfl_xor(s, 32);
          ssq[mi] = s;
          if (quad == 0) part[(wr * 2 + wc) * 64 + mi * 16 + l15] = s;
        }
        __syncthreads();
#pragma unroll
        for (int mi = 0; mi < 4; ++mi) {
          const float tot = ssq[mi] + part[(wr * 2 + (wc ^ 1)) * 64 + mi * 16 + l15];
          hnorm[mi] = rsqrtf(tot * (1.f / 128.f) + kEps) * (tn < 8 ? kScale * kLog2e : 1.f);
        }
      }
    }
#pragma unroll
    for (int mi = 0; mi < 4; ++mi) {
      const int m = tm * 128 + wr * 64 + mi * 16 + l15;
      if constexpr (EPI == 1) {
        const float rs = ((const float*)(ws + OFF_RS0))[m];
        u16* proj = (u16*)(ws + OFF_PROJ);
        float* braw = (float*)(ws + OFF_BRAW);
#pragma unroll
        for (int ni = 0; ni < 4; ++ni) {
          const int nb = tn * 128 + wc * 64 + ni * 16 + quad * 4;
          f32x4 v = acc[ni][mi] * rs;
          if (nb < 4096) { u32x2 o = {pack2(v[0], v[1]), pack2(v[2], v[3])}; __builtin_nontemporal_store(o, (u32x2*)(proj + (size_t)m * 4096 + nb)); }
          else if (nb < 4112) { *(f32x4*)(braw + (size_t)m * 16 + (nb - 4096)) = v; }
        }
      } else if constexpr (EPI == 2 || EPI == 4) {
        float* ssp = (float*)(ws + (EPI == 2 ? OFF_SS1 : OFF_SS2));
        u16* hb = (u16*)(ws + OFF_R);
        float ssq = 0.f;
#pragma unroll
        for (int ni = 0; ni < 4; ++ni) {
          const int nb = tn * 128 + wc * 64 + ni * 16 + quad * 4;
          f32x4 v;
          if constexpr (EPI == 2) {
            v = acc[ni][mi] + __builtin_nontemporal_load((const f32x4*)(p.x + (size_t)m * 1024 + nb));
            u32x2 o = {pack2(v[0], v[1]), pack2(v[2], v[3])};
            *(u32x2*)(hb + (size_t)m * 1024 + nb) = o;
            v[0] = bflo(o.x); v[1] = bfhi(o.x); v[2] = bflo(o.y); v[3] = bfhi(o.y);
          } else {
            const u32x2 r = *(const u32x2*)(hb + (size_t)m * 1024 + nb);
            v = acc[ni][mi];
            v[0] += bflo(r.x); v[1] += bfhi(r.x); v[2] += bflo(r.y); v[3] += bfhi(r.y);
            const u32x2 o = {pack2(v[0], v[1]), pack2(v[2], v[3])};
            *(u32x2*)(hb + (size_t)m * 1024 + nb) = o;
            v[0] = bflo(o.x); v[1] = bfhi(o.x); v[2] = bflo(o.y); v[3] = bfhi(o.y);
          }
          ssq += v[0] * v[0] + v[1] * v[1] + v[2] * v[2] + v[3] * v[3];
        }
        ssq += __shfl_xor(ssq, 16);
        ssq += __shfl_xor(ssq, 32);
        if (quad == 0) atomicAdd(ssp + m, ssq);
      } else if constexpr (EPI == 3) {
        const float rs = rsqrtf(((const float*)(ws + OFF_SS1))[m] * (1.f / 1024.f) + kEps);
        u16* proj = (u16*)(ws + OFF_PROJ);
        u16* vT = (u16*)(ws + OFF_R + 32 * MiB);
        float* fraw = (float*)(ws + OFF_FRAW);
        float hs = 1.f;
        if (tn < 16) hs = hnorm[mi];
#pragma unroll
        for (int ni = 0; ni < 4; ++ni) {
          const int nb = tn * 128 + wc * 64 + ni * 16 + quad * 4;
          f32x4 v = acc[ni][mi] * rs;
          if (tn < 16) {
            const f32x4 wv = *(const f32x4*)((tn < 8 ? p.b_q_norm_w : p.b_k_norm_w) + (nb & 127));
            v = v * hs * wv;
          }
          if (nb < 4096) {
            if ((nb >> 10) != 2) { u32x2 o = {pack2(v[0], v[1]), pack2(v[2], v[3])}; __builtin_nontemporal_store(o, (u32x2*)(proj + (size_t)m * 4096 + nb)); }
            else {
              const int hd = nb - 2048;
              const int b = m >> 13, t = m & 8191;
              u16* dst = vT + ((size_t)(b * 1024 + hd)) * 8192 + t;
#pragma unroll
              for (int jj = 0; jj < 4; ++jj) dst[(size_t)jj * 8192] = (u16)f2bf(v[jj]);
            }
          } else if (nb < 4104) { *(f32x4*)(fraw + (size_t)m * 16 + (nb - 4096)) = v; }
        }
      }
    }
    seq += Lb; tm = tm2; tn = tn2; ok = ok2;
  }
#undef GEMM_STAGE
#undef GEMM_TILE
}


template <int MODE>
DI void skinny_gemm(const Params& p, const u16* __restrict__ A, const u16* __restrict__ Wt16, float* __restrict__ out) {
  const int tid = tidx(), lane = tid & 63, l15 = lane & 15, quad = lane >> 4;
  const int gw = blockIdx.x * 4 + (tid >> 6), nw = gridDim.x * 4;
  for (int mt = gw; mt < 1024; mt += nw) {
    const int m = mt * 16 + l15;
    const u16* ap = A + (size_t)m * 1024 + quad * 8;
    const u16* bp = Wt16 + (size_t)l15 * 1024 + quad * 8;
    f32x4 acc = {0.f, 0.f, 0.f, 0.f};
#pragma unroll 8
    for (int ks = 0; ks < 32; ++ks) acc = mfma16(*(const bf16x8*)(bp + ks * 32), *(const bf16x8*)(ap + ks * 32), acc);
    float rs;
    if constexpr (MODE == 0) rs = ((const float*)(p.ws + OFF_RS0))[m];
    else rs = rsqrtf(((const float*)(p.ws + OFF_SS1))[m] * (1.f / 1024.f) + kEps);
    f32x4 ov = acc * rs;
    if constexpr (MODE == 1) {
#pragma unroll
      for (int jj = 0; jj < 4; ++jj) {
        const int n = 4 * quad + jj;
        const float xv = ov[jj] + p.b_f_bias[n & 7];
        ov[jj] = fminf(xv, 0.f) - log1pf(__expf(-fabsf(xv)));
      }
    }
    *(f32x4*)(out + (size_t)m * 16 + 4 * quad) = ov;
  }
}

DI void delta_prep(const Params& p, char* smem, int first, int nblk) {
  char* ws = p.ws;
  const u16* proj = (const u16*)(ws + OFF_PROJ);
  const float* braw = (const float*)(ws + OFF_BRAW);
  u16* qd_g = (u16*)(ws + OFF_R);
  u16* kT_g = (u16*)(ws + OFF_R + 32 * MiB);
  u16* at_g = (u16*)(ws + OFF_R + 64 * MiB);
  u16* uT_g = (u16*)p.out;
  u16* w_g = (u16*)((char*)p.out + 32 * MiB);
  float* gend_g = (float*)(ws + OFF_GEND);
  char* qL = smem;
  char* kL = smem + 16384;
  char* vL = smem + 32768;
  float* As = (float*)(smem + 49152);
  float* sc = (float*)(smem + 66560);
  float* g_s = sc;
  float* beta_s = sc + 64;
  float* rq_s = sc + 128;
  float* rk_s = sc + 192;
  float* ssq_s = sc + 256;
  float* fu_s = sc + 384;
  float* fw_s = sc + 448;
  const int tid_ = tidx();

  unsigned* flags = (unsigned*)(ws + OFF_FLAGS);
  const __amdgpu_buffer_rsrc_t r_qd = __builtin_amdgcn_make_buffer_rsrc(qd_g, 0, 32 << 20, 0x00020000);
  const __amdgpu_buffer_rsrc_t r_kT = __builtin_amdgcn_make_buffer_rsrc(kT_g, 0, 32 << 20, 0x00020000);
  const __amdgpu_buffer_rsrc_t r_at = __builtin_amdgcn_make_buffer_rsrc(at_g, 0, 16 << 20, 0x00020000);
  const __amdgpu_buffer_rsrc_t r_uT = __builtin_amdgcn_make_buffer_rsrc(uT_g, 0, 32 << 20, 0x00020000);
  const __amdgpu_buffer_rsrc_t r_w = __builtin_amdgcn_make_buffer_rsrc(w_g, 0, 32 << 20, 0x00020000);
  if (nblk >= 256 && ((int)blockIdx.x - first) >= (nblk >> 1)) {
    for (int i = 0; i < 7; ++i) __builtin_amdgcn_s_sleep(127);
  }
  for (int j = (int)blockIdx.x - first; j < 2048; j += nblk) {
    const int c = j >> 4, b = (j >> 3) & 1, h = j & 7;
    const int item = (b * 128 + c) * 8 + h;
    const int tok0 = b * 8192 + c * 64;
    const int tid = relaunder(tid_), lane = tid & 63, wave = tid >> 6, l15 = lane & 15, quad = lane >> 4;
    if (wave == 3) {
      const int row = tok0 + lane;
      const float br = braw[(size_t)row * 16 + h];
      const float ar = braw[(size_t)row * 16 + 8 + h] + p.a_dt_bias[h];
      const float beta = 1.f / (1.f + __expf(-br));
      const float sp = fmaxf(ar, 0.f) + log1pf(__expf(-fabsf(ar)));
      float g = -__expf(p.a_A_log[h]) * sp;
#pragma unroll
      for (int o = 1; o < 64; o <<= 1) { float t = __shfl_up(g, o); if (lane >= o) g += t; }
      g_s[lane] = g;
      beta_s[lane] = beta;
    } else {
      const int sec = wave, cgi = l15, rr = quad;
      const int col = sec * 1024 + h * 128 + cgi * 8;
      float w0[8], w1[8], w2[8], w3[8];
#pragma unroll
      for (int e = 0; e < 8; ++e) {
        w0[e] = p.a_conv_w[0 * 3072 + col + e]; w1[e] = p.a_conv_w[1 * 3072 + col + e];
        w2[e] = p.a_conv_w[2 * 3072 + col + e]; w3[e] = p.a_conv_w[3 * 3072 + col + e];
      }
      const u16* src = proj + (size_t)(tok0 + rr * 16) * 4096 + col;
      float x0[8], x1[8], x2[8], x3[8];
      if (c == 0 && rr == 0) {
#pragma unroll
        for (int e = 0; e < 8; ++e) { x0[e] = 0.f; x1[e] = 0.f; x2[e] = 0.f; }
      } else {
        unpack8(*(const u32x4*)(src - 3 * 4096), x0);
        unpack8(*(const u32x4*)(src - 2 * 4096), x1);
        unpack8(*(const u32x4*)(src - 1 * 4096), x2);
      }
      char* dstL = smem + sec * 16384;
#pragma unroll 4
      for (int r = 0; r < 16; ++r) {
        unpack8(*(const u32x4*)(src + (size_t)r * 4096), x3);
        float y[8];
        float ssq = 0.f;
#pragma unroll
        for (int e = 0; e < 8; ++e) {
          float v = w0[e] * x0[e] + w1[e] * x1[e] + w2[e] * x2[e] + w3[e] * x3[e];
          v = silu(v);
          y[e] = v;
          ssq += v * v;
          x0[e] = x1[e]; x1[e] = x2[e]; x2[e] = x3[e];
        }
        ssq += __shfl_xor(ssq, 1); ssq += __shfl_xor(ssq, 2); ssq += __shfl_xor(ssq, 4); ssq += __shfl_xor(ssq, 8);
        const int row = rr * 16 + r;
        if (sec < 2 && cgi == 0) ssq_s[sec * 64 + row] = ssq;
        *(u32x4*)(dstL + row * 256 + ((cgi ^ (row & 15)) << 4)) = packf8(y);
      }
    }
    __syncthreads();
    if (tid < 64) {
      const float rq = rsqrtf(ssq_s[tid] + kEps), rk = rsqrtf(ssq_s[64 + tid] + kEps);
      const float gi = g_s[tid], g63 = g_s[63];
      const float eg = __expf(gi);
      rq_s[tid] = rq; rk_s[tid] = rk;
      const float be = beta_s[tid];
      fu_s[tid] = be;
      fw_s[tid] = be * rk * eg;
      ssq_s[tid] = rq * kScale * eg;
      ssq_s[64 + tid] = rk * __expf(g63 - gi);
      if (tid == 0) __hip_atomic_store(gend_g + item, __expf(g63), __ATOMIC_RELAXED, __HIP_MEMORY_SCOPE_AGENT);
    }
    __syncthreads();
    {
      const int tid = relaunder(tid_), lane = tid & 63, wave = tid >> 6, l15 = lane & 15, quad = lane >> 4;
      bf16x8 bk[4], bq[4];
      const int rowI = 16 * wave + l15;
#pragma unroll
      for (int ks = 0; ks < 4; ++ks) {
        const int off = rowI * 256 + (((ks * 4 + quad) ^ (rowI & 15)) << 4);
        bk[ks] = *(const bf16x8*)(kL + off);
        bq[ks] = *(const bf16x8*)(qL + off);
      }
      const int i = rowI;
      const float gi = g_s[i], bi = beta_s[i] * rk_s[i], qi = kScale * rq_s[i];
      u32x2 keep = {0u, 0u};
#pragma unroll
      for (int J = 0; J < 4; ++J) {
        f32x4 skk = {0.f, 0.f, 0.f, 0.f}, sqk = {0.f, 0.f, 0.f, 0.f};
        const int rowJ = 16 * J + l15;
#pragma unroll
        for (int ks = 0; ks < 4; ++ks) {
          const bf16x8 ak = *(const bf16x8*)(kL + rowJ * 256 + (((ks * 4 + quad) ^ (rowJ & 15)) << 4));
          skk = mfma16(ak, bk[ks], skk);
          sqk = mfma16(ak, bq[ks], sqk);
        }
        const f32x4 gj4 = *(const f32x4*)(g_s + 16 * J + 4 * quad);
        const f32x4 rk4 = *(const f32x4*)(rk_s + 16 * J + 4 * quad);
        f32x4 a4, t4;
#pragma unroll
        for (int jj = 0; jj < 4; ++jj) {
          const int j = 16 * J + 4 * quad + jj;
          const float dec = (i >= j) ? __expf(gi - gj4[jj]) : 0.f;
          a4[jj] = (i > j) ? bi * rk4[jj] * skk[jj] * dec : 0.f;
          t4[jj] = qi * rk4[jj] * sqk[jj] * dec;
        }
        *(f32x4*)(As + i * 68 + 16 * J + 4 * quad) = a4;
        const u32x2 half = {pack2(t4[0], t4[1]), pack2(t4[2], t4[3])};
        if ((J & 1) == 0) keep = half;
        else {
          const u32x4 fr = {keep.x, keep.y, half.x, half.y};
          __builtin_amdgcn_raw_buffer_store_b128(fr, r_at, item * 8192 + ((wave * 2 + (J >> 1)) * 64 + lane) * 16, 0, 16);
        }
      }
    }
    {
      const int tid = relaunder(tid_);
#pragma unroll
      for (int it = 0; it < 4; ++it) {
        const int idx = tid + 256 * it;
        const int f = idx >> 6, ln = idx & 63, fl = ln & 15, fq = ln >> 4;
        {
          const int mt = f >> 2, ks = f & 3, i = 16 * mt + fl;
          const int c0 = 4 * ks + (fq >> 1), o8 = (fq & 1) * 8;
          const u32x2 lo = *(const u32x2*)(qL + i * 256 + ((c0 ^ (i & 15)) << 4) + o8);
          const u32x2 hi = *(const u32x2*)(qL + i * 256 + (((c0 + 2) ^ (i & 15)) << 4) + o8);
          const float s = ssq_s[i];
          const u32x4 o = {pack2(bflo(lo.x) * s, bfhi(lo.x) * s), pack2(bflo(lo.y) * s, bfhi(lo.y) * s),
                           pack2(bflo(hi.x) * s, bfhi(hi.x) * s), pack2(bflo(hi.y) * s, bfhi(hi.y) * s)};
          __builtin_amdgcn_raw_buffer_store_b128(o, r_qd, item * 16384 + idx * 16, 0, 16);
        }
        {
          const int mt = f >> 1, ks = f & 1, dk = 16 * mt + fl;
          float v[8];
#pragma unroll
          for (int e = 0; e < 8; ++e) {
            const int i = 32 * ks + ((e < 4) ? (4 * fq + e) : (16 + 4 * fq + e - 4));
            const u16 raw = *(const u16*)(kL + i * 256 + (((dk >> 3) ^ (i & 15)) << 4) + (dk & 7) * 2);
            v[e] = __uint_as_float(((unsigned)raw) << 16) * ssq_s[64 + i];
          }
          __builtin_amdgcn_raw_buffer_store_b128(packf8(v), r_kT, item * 16384 + idx * 16, 0, 16);
        }
      }
    }
    __syncthreads();
    {
      float U[64];
      const int tid = relaunder(tid_), wave = tid >> 6;
      const int cc = tid & 127, ch = cc >> 3, e2 = (cc & 7) * 2;
      const char* srcL = (wave < 2) ? vL : kL;
      const float* fr = (wave < 2) ? fu_s : fw_s;
#pragma unroll
      for (int i = 0; i < 64; ++i) {
        int ii = i;
        asm volatile("" : "+v"(ii));
        const u16 raw = *(const u16*)(srcL + ii * 256 + ((ch ^ (ii & 15)) << 4) + e2);
        float acc = __uint_as_float(((unsigned)raw) << 16) * fr[ii];
#pragma unroll
        for (int j = 0; j < i; ++j) acc -= As[i * 68 + j] * U[j];
        U[i] = acc;
      }
      if (wave < 2) {
        const int dofs = item * 16384 + (((cc >> 4) * 4) * 256 + (cc & 15) * 4) * 2;
#pragma unroll
        for (int mi = 0; mi < 4; ++mi)
#pragma unroll
          for (int q4 = 0; q4 < 4; ++q4) {
            const u32x2 o = {pack2(U[16 * mi + 4 * q4], U[16 * mi + 4 * q4 + 1]), pack2(U[16 * mi + 4 * q4 + 2], U[16 * mi + 4 * q4 + 3])};
            __builtin_amdgcn_raw_buffer_store_b64(o, r_uT, dofs + (mi * 256 + q4 * 64) * 2, 0, 16);
          }
      } else {
#pragma unroll
        for (int i = 0; i < 64; ++i) {
          int ii = i;
          asm volatile("" : "+v"(ii));
          *(u16*)(qL + ii * 256 + ((ch ^ (ii & 15)) << 4) + e2) = (u16)f2bf(U[i]);
        }
      }
    }
    __syncthreads();
    {
      const int tid = relaunder(tid_);
#pragma unroll
      for (int it = 0; it < 4; ++it) {
        const int idx = tid + 256 * it;
        const int f = idx >> 6, ln = idx & 63, fl = ln & 15, fq = ln >> 4;
        const int mt = f >> 2, ks = f & 3, i = 16 * mt + fl;
        const int c0 = 4 * ks + (fq >> 1), o8 = (fq & 1) * 8;
        const u32x2 lo = *(const u32x2*)(qL + i * 256 + ((c0 ^ (i & 15)) << 4) + o8);
        const u32x2 hi = *(const u32x2*)(qL + i * 256 + (((c0 + 2) ^ (i & 15)) << 4) + o8);
        const u32x4 o = {lo.x, lo.y, hi.x, hi.y};
        __builtin_amdgcn_raw_buffer_store_b128(o, r_w, item * 16384 + idx * 16, 0, 16);
      }
    }
    asm volatile("s_waitcnt vmcnt(0)" ::: "memory");
    __syncthreads();
    if (relaunder(tid_) == 0) __hip_atomic_store(flags + item, 1u, __ATOMIC_RELAXED, __HIP_MEMORY_SCOPE_AGENT);
  }
}

#define RAW_BARRIER() do { asm volatile("s_waitcnt lgkmcnt(0)" ::: "memory"); __builtin_amdgcn_s_barrier(); asm volatile("" ::: "memory"); } while (0)
#define GAS __attribute__((address_space(1)))
#define SCAN_LOAD(item_)                                                                                          \
  do {                                                                                                            \
    const GAS char* wb_ = (const GAS char*)((const char*)w_g + (size_t)(item_) * 16384);                          \
    const GAS char* qb_ = (const GAS char*)((const char*)qd_g + (size_t)(item_) * 16384);                         \
    const GAS char* kb_ = (const GAS char*)((const char*)kT_g + (size_t)(item_) * 16384);                         \
    const GAS char* ab_ = (const GAS char*)((const char*)at_g + (size_t)(item_) * 8192);                          \
    const GAS char* ub_ = (const GAS char*)((const char*)uT_g + (size_t)(item_) * 16384);                         \
    asm volatile("" : "+s"(wb_), "+s"(qb_), "+s"(kb_), "+s"(ab_), "+s"(ub_));                                     \
    _Pragma("unroll") for (int j = 0; j < 4; ++j) {                                                               \
      R[j] = *(const GAS u32x4*)(wb_ + (toff + 4096u * j));                                                       \
      R[4 + j] = *(const GAS u32x4*)(qb_ + (toff + 4096u * j));                                                   \
      R[8 + j] = *(const GAS u32x4*)(kb_ + (toff + 4096u * j));                                                   \
    }                                                                                                             \
    _Pragma("unroll") for (int j = 0; j < 2; ++j) R[12 + j] = *(const GAS u32x4*)(ab_ + (toff + 4096u * j));     \
    _Pragma("unroll") for (int mi = 0; mi < 4; ++mi) un[mi] = *(const GAS u32x2*)(ub_ + (uoff + 512u * mi));     \
    gn = gend_g[item_];                                                                                           \
  } while (0)
DI void delta_scan(const Params& p, char* smem) {
  char* ws = p.ws;
  const u16* qd_g = (const u16*)(ws + OFF_R);
  const u16* kT_g = (const u16*)(ws + OFF_R + 32 * MiB);
  const u16* at_g = (const u16*)(ws + OFF_R + 64 * MiB);
  const u16* uT_g = (const u16*)p.out;
  const u16* w_g = (const u16*)((const char*)p.out + 32 * MiB);
  const float* gend_g = (const float*)(ws + OFF_GEND);
  u16* o_g = (u16*)(ws + OFF_PROJ);
  unsigned* flags = (unsigned*)(ws + OFF_FLAGS);
  const int tid = tidx(), lane = tid & 63, wave = tid >> 6, l15 = lane & 15, quad = lane >> 4;
  char* Lw = smem;
  char* Lq = smem + 16384;
  char* Lk = smem + 32768;
  char* La = smem + 49152;
  char* Lo = smem + 57344;
  for (int unit = blockIdx.x; unit < 32; unit += gridDim.x) {
    const int bh = unit & 15, half = unit >> 4, b = bh >> 3, h = bh & 7;
    const int slice = half * 4 + wave;
    f32x4 S[8];
#pragma unroll
    for (int i = 0; i < 8; ++i) S[i] = (f32x4){0.f, 0.f, 0.f, 0.f};
    const unsigned toff = (unsigned)tid * 16u, uoff = (unsigned)(slice * 256 + lane) * 8u;
    u32x4 R[14];
    u32x2 un[4];
    float gn;
#define SCAN_WAIT(flv_, item_)                                                                                         \
  do {                                                                                                                 \
    unsigned f_ = (flv_), sp_ = 0u;                                                                                    \
    while (f_ == 0u && sp_ < (1u << 24)) { __builtin_amdgcn_s_sleep(2); f_ = __hip_atomic_load(flags + (item_), __ATOMIC_RELAXED, __HIP_MEMORY_SCOPE_AGENT); ++sp_; } \
    __builtin_amdgcn_fence(__ATOMIC_ACQUIRE, "workgroup");           \
  } while (0)
    unsigned fl;
    {
      const int item = (b * 128) * 8 + h;
      SCAN_WAIT(0u, item);
      SCAN_LOAD(item);
      fl = __hip_atomic_load(flags + ((b * 128 + 1) * 8 + h), __ATOMIC_RELAXED, __HIP_MEMORY_SCOPE_AGENT);
    }
    for (int c = 0; c < 128; ++c) {
#pragma unroll
      for (int j = 0; j < 4; ++j) {
        *(u32x4*)(Lw + (tid + 256 * j) * 16) = R[j];
        *(u32x4*)(Lq + (tid + 256 * j) * 16) = R[4 + j];
        *(u32x4*)(Lk + (tid + 256 * j) * 16) = R[8 + j];
      }
#pragma unroll
      for (int j = 0; j < 2; ++j) *(u32x4*)(La + (tid + 256 * j) * 16) = R[12 + j];
      u32x2 uc[4];
#pragma unroll
      for (int mi = 0; mi < 4; ++mi) uc[mi] = un[mi];
      const float gend = gn;
      RAW_BARRIER();
      if (c + 1 < 128) SCAN_WAIT(fl, (b * 128 + c + 1) * 8 + h);
      if (c > 0) {
        const int tokp = b * 8192 + (c - 1) * 64;
#pragma unroll
        for (int k2 = 0; k2 < 2; ++k2) {
          const int idx = tid + 256 * k2, row = idx >> 3, part = idx & 7;
          *(u32x4*)(o_g + (size_t)(tokp + row) * 4096 + h * 128 + half * 64 + part * 8) = *(const u32x4*)(Lo + idx * 16);
        }
      }
      if (c + 1 < 128) {
        const int item = (b * 128 + c + 1) * 8 + h;
        SCAN_LOAD(item);
        fl = (c + 2 < 128) ? __hip_atomic_load(flags + (item + 8), __ATOMIC_RELAXED, __HIP_MEMORY_SCOPE_AGENT) : 1u;
      }
      __builtin_amdgcn_sched_barrier(0);
      bf16x8 bS[4];
#pragma unroll
      for (int ks = 0; ks < 4; ++ks) bS[ks] = pack8(S[2 * ks], S[2 * ks + 1]);
      bf16x8 fr[16];
#pragma unroll
      for (int i = 0; i < 16; ++i) fr[i] = *(const bf16x8*)(Lw + (i * 64 + lane) * 16);
      __builtin_amdgcn_sched_barrier(0);
      f32x4 vn[4];
#pragma unroll
      for (int mi = 0; mi < 4; ++mi) vn[mi] = (f32x4){0.f, 0.f, 0.f, 0.f};
#pragma unroll
      for (int ks = 0; ks < 4; ++ks)
#pragma unroll
        for (int mi = 0; mi < 4; ++mi) vn[mi] = mfma16(fr[mi * 4 + ks], bS[ks], vn[mi]);
      __builtin_amdgcn_sched_barrier(0);
#pragma unroll
      for (int i = 0; i < 16; ++i) fr[i] = *(const bf16x8*)(Lk + (i * 64 + lane) * 16);
#pragma unroll
      for (int mi = 0; mi < 4; ++mi) {
        vn[mi][0] = bflo(uc[mi].x) - vn[mi][0]; vn[mi][1] = bfhi(uc[mi].x) - vn[mi][1];
        vn[mi][2] = bflo(uc[mi].y) - vn[mi][2]; vn[mi][3] = bfhi(uc[mi].y) - vn[mi][3];
      }
      bf16x8 bV[2];
      bV[0] = pack8(vn[0], vn[1]);
      bV[1] = pack8(vn[2], vn[3]);
#pragma unroll
      for (int mt = 0; mt < 8; ++mt) S[mt] = S[mt] * gend;
      __builtin_amdgcn_sched_barrier(0);
#pragma unroll
      for (int ks = 0; ks < 2; ++ks)
#pragma unroll
        for (int mt = 0; mt < 8; ++mt) S[mt] = mfma16(fr[mt * 2 + ks], bV[ks], S[mt]);
      __builtin_amdgcn_sched_barrier(0);
#pragma unroll
      for (int i = 0; i < 16; ++i) fr[i] = *(const bf16x8*)(Lq + (i * 64 + lane) * 16);
      __builtin_amdgcn_sched_barrier(0);
      f32x4 oacc[4];
#pragma unroll
      for (int mi = 0; mi < 4; ++mi) oacc[mi] = (f32x4){0.f, 0.f, 0.f, 0.f};
#pragma unroll
      for (int ks = 0; ks < 4; ++ks)
#pragma unroll
        for (int mi = 0; mi < 4; ++mi) oacc[mi] = mfma16(fr[mi * 4 + ks], bS[ks], oacc[mi]);
      __builtin_amdgcn_sched_barrier(0);
#pragma unroll
      for (int i = 0; i < 8; ++i) fr[i] = *(const bf16x8*)(La + (i * 64 + lane) * 16);
      __builtin_amdgcn_sched_barrier(0);
#pragma unroll
      for (int ks = 0; ks < 2; ++ks)
#pragma unroll
        for (int mi = 0; mi < 4; ++mi) oacc[mi] = mfma16(fr[mi * 2 + ks], bV[ks], oacc[mi]);
      __builtin_amdgcn_sched_barrier(0);
#pragma unroll
      for (int mi = 0; mi < 4; ++mi)
#pragma unroll
        for (int jj = 0; jj < 4; ++jj)
          *(u16*)(Lo + (16 * mi + 4 * quad + jj) * 128 + (wave * 16 + l15) * 2) = (u16)f2bf(oacc[mi][jj]);
      RAW_BARRIER();
    }
    {
      const int tokp = b * 8192 + 127 * 64;
#pragma unroll
      for (int k2 = 0; k2 < 2; ++k2) {
        const int idx = tid + 256 * k2, row = idx >> 3, part = idx & 7;
        *(u32x4*)(o_g + (size_t)(tokp + row) * 4096 + h * 128 + half * 64 + part * 8) = *(const u32x4*)(Lo + idx * 16);
      }
      RAW_BARRIER();
    }
  }
}

#undef SCAN_LOAD
#undef SCAN_WAIT

DI void gate_phase(const Params& p) {
  char* ws = p.ws;
  const u16* proj = (const u16*)(ws + OFF_PROJ);
  u16* y0 = (u16*)(ws + OFF_R + 32 * MiB);
  const int tidg = tidx();
  const int lane = tidg & 63, l15 = lane & 15, quad = lane >> 4;
  const int gw = blockIdx.x * 4 + (tidg >> 6), nw = gridDim.x * 4;
  float wn[8];
#pragma unroll
  for (int e = 0; e < 8; ++e) wn[e] = p.a_o_norm_w[l15 * 8 + e];
  for (int r4 = gw; r4 < 32768; r4 += nw) {
    const int rh = r4 * 4 + quad, tok = rh >> 3, h = rh & 7;
    float o[8], z[8];
    unpack8(*(const u32x4*)(proj + (size_t)tok * 4096 + h * 128 + l15 * 8), o);
    unpack8(*(const u32x4*)(proj + (size_t)tok * 4096 + 3072 + h * 128 + l15 * 8), z);
    float ssq = 0.f;
#pragma unroll
    for (int e = 0; e < 8; ++e) ssq += o[e] * o[e];
    ssq += __shfl_xor(ssq, 1); ssq += __shfl_xor(ssq, 2); ssq += __shfl_xor(ssq, 4); ssq += __shfl_xor(ssq, 8);
    const float rs = rsqrtf(ssq * (1.f / 128.f) + kEps);
#pragma unroll
    for (int e = 0; e < 8; ++e) o[e] = o[e] * rs * wn[e] * silu(z[e]);
    *(u32x4*)(y0 + (size_t)tok * 1024 + h * 128 + l15 * 8) = packf8(o);
  }
}

DI void qknorm_cumsum(const Params& p, char* smem) {
  char* ws = p.ws;
  u16* proj = (u16*)(ws + OFF_PROJ);
  const int tid = tidx(), lane = tid & 63, l15 = lane & 15, quad = lane >> 4;
  const int gw = blockIdx.x * 4 + (tid >> 6), nw = gridDim.x * 4;
  for (int idx = gw; idx < 65536; idx += nw) {
    const int which = idx >> 15, r4 = idx & 32767;
    const int rh = r4 * 4 + quad, tok = rh >> 3, h = rh & 7;
    const float* wv = which ? p.b_k_norm_w : p.b_q_norm_w;
    u16* ptr = proj + (size_t)tok * 4096 + which * 1024 + h * 128 + l15 * 8;
    float v[8];
    unpack8(*(const u32x4*)ptr, v);
    float ssq = 0.f;
#pragma unroll
    for (int e = 0; e < 8; ++e) ssq += v[e] * v[e];
    ssq += __shfl_xor(ssq, 1); ssq += __shfl_xor(ssq, 2); ssq += __shfl_xor(ssq, 4); ssq += __shfl_xor(ssq, 8);
    const float rs = rsqrtf(ssq * (1.f / 128.f) + kEps) * (which ? 1.f : kScale);
#pragma unroll
    for (int e = 0; e < 8; ++e) v[e] = v[e] * rs * wv[l15 * 8 + e];
    *(u32x4*)ptr = packf8(v);
  }
}

DI void attn_phase(const Params& p, char* smem) {
  char* ws = p.ws;
  const u16* proj = (const u16*)(ws + OFF_PROJ);
  const u16* vT = (const u16*)(ws + OFF_R + 32 * MiB);
  const float* fraw = (const float*)(ws + OFF_FRAW);
  u16* y1 = (u16*)(ws + OFF_R + 64 * MiB);
  float* bias_s = (float*)(smem + 65536);
  float* ca_s = bias_s + 128;
  const int tid_ = tidx();
  float mq = 0.f, mk = 0.f;
  for (int i = 0; i < 128; ++i) { mq = fmaxf(mq, fabsf(p.b_q_norm_w[i])); mk = fmaxf(mk, fabsf(p.b_k_norm_w[i])); }
  const float QKB = 128.f * kScale * mq * mk;
  float* mmin_s = (float*)(smem + 66320);

  unsigned* qctr = (unsigned*)(ws + OFF_BAR) + XCD_BAR_WORDS;
  int* qslot = (int*)(smem + 66304);
  int qx = blockIdx.x & 7, qtries = 0;
  while (true) {
    const int tid = relaunder(tid_), lane = tid & 63, wave = tid >> 6, l15 = lane & 15, quad = lane >> 4;
    if (tid == 0) *qslot = (int)atomicAdd(qctr + qx * 16, 1u);
    __syncthreads();
    const int it = *qslot;
    __syncthreads();
    if (it >= 128) { if (++qtries >= 8) break; qx = (qx + 1) & 7; continue; }
    const int qb = 63 - (it & 63);
    const int b = it >> 6, h = b ? ((qx + 4) & 7) : qx, bh = b * 8 + h, i0 = qb * 128;
    const int qrow0 = i0 + 32 * wave;
    const float fb = p.b_f_bias[h];
    bf16x8 bq[2][4];
#pragma unroll
    for (int nq = 0; nq < 2; ++nq)
#pragma unroll
      for (int ks = 0; ks < 4; ++ks)
        bq[nq][ks] = *(const bf16x8*)(proj + (size_t)(b * 8192 + qrow0 + 16 * nq + l15) * 4096 + h * 128 + 32 * ks + 8 * quad);
    f32x4 O[8][2];
#pragma unroll
    for (int dt = 0; dt < 8; ++dt) { O[dt][0] = (f32x4){0.f, 0.f, 0.f, 0.f}; O[dt][1] = (f32x4){0.f, 0.f, 0.f, 0.f}; }
    float mrun[2] = {-1e30f, -1e30f}, lrun[2] = {0.f, 0.f};

    const int kkey = wave * 4 + (lane >> 4);
    const int kch = (lane & 15) ^ (kkey & 15);
    const u16* Kg = proj + (size_t)(b * 8192 + kkey) * 4096 + 1024 + h * 128 + kch * 8;
    const int vd = wave * 8 + (lane >> 3);
    const int vch = (lane & 7) ^ ((((wave & 1) << 2) + (lane >> 4)) & 7);
    const u16* Vg = vT + (size_t)(bh * 128 + vd) * 8192 + vch * 8;
#define ATT_STAGE(buf, j0_)                                                                                                   \
  do {                                                                                                                        \
    _Pragma("unroll") for (int i = 0; i < 4; ++i) {                                                                           \
      __builtin_amdgcn_global_load_lds((const unsigned*)(Kg + (size_t)((j0_) + 16 * i) * 4096),                               \
                                       (unsigned*)(smem + (buf) * 32768 + (i * 4 + wave) * 1024), 16, 0, 0);                  \
      __builtin_amdgcn_global_load_lds((const unsigned*)(Vg + (size_t)(32 * i) * 8192 + (j0_)),                               \
                                       (unsigned*)(smem + (buf) * 32768 + 16384 + (i * 4 + wave) * 1024), 16, 0, 0);          \
    }                                                                                                                         \
  } while (0)
    int j0 = i0 + 64;
    ATT_STAGE(0, j0);
    float carry = 0.f, biasA = 0.f, frn = 0.f;
    if (wave == 0) {
      const float lfA = fraw[(size_t)(b * 8192 + i0 + lane) * 16 + h];
      const float lfB = fraw[(size_t)(b * 8192 + i0 + 64 + lane) * 16 + h];
      float pa = lfA, pb = lfB;
#pragma unroll
      for (int o = 1; o < 64; o <<= 1) {
        const float ta = __shfl_up(pa, o), tb = __shfl_up(pb, o);
        if (lane >= o) { pa += ta; pb += tb; }
      }
      const float lf0 = __shfl(lfA, 0), totA = __shfl(pa, 63);
      biasA = -(pa - lf0) * kLog2e;
      bias_s[lane] = -(totA - lf0 + pb) * kLog2e;
      carry = lf0;
    }
    if (lane == 0) { mmin_s[wave] = -1e30f; mmin_s[4 + wave] = -1e30f; }
    asm volatile("s_waitcnt vmcnt(0)" ::: "memory");
    __syncthreads();
    auto att_tile = [&](const int cur, const bool diag) __attribute__((always_inline)) -> bool {
      const int nj = j0 - 64;
      bool more = nj >= 0;
      if (more && j0 <= i0) {
        const float* mm = mmin_s + cur * 4;
        const float mmin = fminf(fminf(mm[0], mm[1]), fminf(mm[2], mm[3]));
        more = !((QKB + ca_s[cur]) * kLog2e < mmin - 30.f * kLog2e);
      }
      if (more) {
        ATT_STAGE(cur ^ 1, nj);
        if (wave == 0 && nj < i0) frn = fraw[(size_t)(b * 8192 + nj + lane) * 16 + h];
      }
      if (j0 <= qrow0 + 31) {
        const char* Ks = smem + cur * 32768;
        const char* Vs = Ks + 16384;
        const float* cs = bias_s + cur * 64;
        f32x4 s[4][2];
#pragma unroll
        for (int kt = 0; kt < 4; ++kt) { s[kt][0] = (f32x4){0.f, 0.f, 0.f, 0.f}; s[kt][1] = (f32x4){0.f, 0.f, 0.f, 0.f}; }
#pragma unroll
        for (int ks = 0; ks < 4; ++ks)
#pragma unroll
          for (int kt = 0; kt < 4; ++kt) {
            const int kl = 16 * kt + l15;
            const bf16x8 ak = *(const bf16x8*)(Ks + kl * 256 + (((ks * 4 + quad) ^ (kl & 15)) << 4));
            s[kt][0] = mfma16(ak, bq[0][ks], s[kt][0]);
            s[kt][1] = mfma16(ak, bq[1][ks], s[kt][1]);
          }
#pragma unroll
        for (int kt = 0; kt < 4; ++kt) {
          const f32x4 bias = *(const f32x4*)(cs + 16 * kt + 4 * quad);
#pragma unroll
          for (int nq = 0; nq < 2; ++nq)
#pragma unroll
            for (int jj = 0; jj < 4; ++jj) {
              float v = s[kt][nq][jj] + bias[jj];
              if (diag) { if (j0 + 16 * kt + 4 * quad + jj > qrow0 + 16 * nq + l15) v = -1e30f; }
              s[kt][nq][jj] = v;
            }
        }
        bf16x8 bP[2][2];
#pragma unroll
        for (int nq = 0; nq < 2; ++nq) {
          float tmax = -1e30f;
#pragma unroll
          for (int kt = 0; kt < 4; ++kt)
#pragma unroll
            for (int jj = 0; jj < 4; ++jj) tmax = fmaxf(tmax, s[kt][nq][jj]);
          tmax = fmaxf(tmax, __shfl_xor(tmax, 16));
          tmax = fmaxf(tmax, __shfl_xor(tmax, 32));
          const float mnew = fmaxf(mrun[nq], tmax);
          const float alpha = __builtin_amdgcn_exp2f(mrun[nq] - mnew);
          const bool grew = mnew > mrun[nq];
          mrun[nq] = mnew;
          float psum = 0.f;
#pragma unroll
          for (int kt = 0; kt < 4; ++kt)
#pragma unroll
            for (int jj = 0; jj < 4; ++jj) { const float pv = __builtin_amdgcn_exp2f(s[kt][nq][jj] - mnew); s[kt][nq][jj] = pv; psum += pv; }
          lrun[nq] = lrun[nq] * alpha + psum;
          if (__builtin_amdgcn_ballot_w64(grew) != 0ull) {
#pragma unroll
            for (int dt = 0; dt < 8; ++dt) O[dt][nq] = O[dt][nq] * alpha;
          }
          bP[0][nq] = pack8(s[0][nq], s[1][nq]);
          bP[1][nq] = pack8(s[2][nq], s[3][nq]);
        }
#pragma unroll
        for (int ks = 0; ks < 2; ++ks)
#pragma unroll
          for (int dt = 0; dt < 8; ++dt) {
            const int d = 16 * dt + l15, sw = (d >> 1) & 7, c0 = 4 * ks + (quad >> 1);
            const u32x2 lo = *(const u32x2*)(Vs + d * 128 + ((c0 ^ sw) << 4) + (quad & 1) * 8);
            const u32x2 hi = *(const u32x2*)(Vs + d * 128 + (((c0 + 2) ^ sw) << 4) + (quad & 1) * 8);
            const bf16x8 av = mk8(lo, hi);
            O[dt][0] = mfma16(av, bP[ks][0], O[dt][0]);
            O[dt][1] = mfma16(av, bP[ks][1], O[dt][1]);
          }
        float wm = fminf(mrun[0], mrun[1]);
#pragma unroll
        for (int o = 1; o < 64; o <<= 1) wm = fminf(wm, __shfl_xor(wm, o));
        if (lane == 0) mmin_s[(cur ^ 1) * 4 + wave] = wm;
      }
      if (more && wave == 0) {
        const int nb = cur ^ 1;
        if (nj == i0) {
          bias_s[nb * 64 + lane] = biasA;
          if (lane == 0) ca_s[nb] = carry;
        } else {
          const float lf = frn;
          float x = lf;
          x += dpp_f<0x101>(x); x += dpp_f<0x102>(x); x += dpp_f<0x104>(x); x += dpp_f<0x108>(x);
          const float t0 = readlane_f(x, 0), t1 = readlane_f(x, 16), t2 = readlane_f(x, 32), t3 = readlane_f(x, 48);
          const int rowi = lane >> 4;
          const float radd = (rowi == 0) ? (t1 + t2 + t3) : (rowi == 1) ? (t2 + t3) : (rowi == 2) ? t3 : 0.f;
          const float sf = x + radd;
          bias_s[nb * 64 + lane] = (sf - lf + carry) * kLog2e;
          carry += (t0 + t1) + (t2 + t3);
          if (lane == 0) ca_s[nb] = carry;
        }
      }
      asm volatile("s_waitcnt vmcnt(0)" ::: "memory");
      __syncthreads();
      if (!more) return false;
      j0 = nj;
      return true;
    };
    if (att_tile(0, true) && att_tile(1, true)) {
      while (true) {
        if (!att_tile(0, false)) break;
        if (!att_tile(1, false)) break;
      }
    }
#undef ATT_STAGE
#pragma unroll
    for (int nq = 0; nq < 2; ++nq) {
      float l = lrun[nq];
      l += __shfl_xor(l, 16);
      l += __shfl_xor(l, 32);
      const float inv = 1.f / l;
      const size_t tok = (size_t)(b * 8192 + qrow0 + 16 * nq + l15);
#pragma unroll
      for (int dt = 0; dt < 8; ++dt) {
        const int d = 16 * dt + 4 * quad;
        const u32x2 z2 = *(const u32x2*)(proj + tok * 4096 + 3072 + h * 128 + d);
        const f32x4 o = O[dt][nq] * inv;
        u32x2 r = {pack2(o[0] * silu(bflo(z2.x)), o[1] * silu(bfhi(z2.x))), pack2(o[2] * silu(bflo(z2.y)), o[3] * silu(bfhi(z2.y)))};
        *(u32x2*)(y1 + tok * 1024 + h * 128 + d) = r;
      }
    }
  }
}

DI void final_norm(const Params& p) {
  const float* ss2 = (const float*)(p.ws + OFF_SS2);
  const int tidf = tidx();
  const int lane = tidf & 63;
  const int gw = blockIdx.x * 4 + (tidf >> 6), nw = gridDim.x * 4;
  const f32x4* w = (const f32x4*)p.final_norm_w;
  f32x4 wv[4];
#pragma unroll
  for (int i = 0; i < 4; ++i) wv[i] = w[lane + 64 * i];
  for (int row = gw; row < 16384; row += 4 * nw) {
    u32x2 r[4][4];
    float rs[4];
#pragma unroll
    for (int k = 0; k < 4; ++k) {
      const int rr = row + k * nw;
      const bool okr = rr < 16384;
      const int rc = okr ? rr : row;
      rs[k] = rsqrtf(ss2[rc] * (1.f / 1024.f) + kEps);
      const u32x2* hsrc = (const u32x2*)((const u16*)(p.ws + OFF_R) + (size_t)rc * 1024);
#pragma unroll
      for (int i = 0; i < 4; ++i) r[k][i] = hsrc[lane + 64 * i];
    }
#pragma unroll
    for (int k = 0; k < 4; ++k) {
      const int rr = row + k * nw;
      if (rr < 16384) {
        f32x4* o = (f32x4*)(p.out + (size_t)rr * 1024);
#pragma unroll
        for (int i = 0; i < 4; ++i) {
          f32x4 v = {bflo(r[k][i].x), bfhi(r[k][i].x), bflo(r[k][i].y), bfhi(r[k][i].y)};
          __builtin_nontemporal_store(v * rs[k] * wv[i], o + lane + 64 * i);
        }
      }
    }
  }
}

__global__ void __launch_bounds__(kThreads, 2) fwd_megakernel(Params p) {
  extern __shared__ __attribute__((aligned(16))) char smem[];
  cg::grid_group grid = cg::this_grid();
  char* ws = p.ws;
  __shared__ uint4 xb_words;
  if (threadIdx.x == 0) xb_words = make_uint4(0u, 0u, 0u, 0u);
  __syncthreads();
  if (p.ws == nullptr) grid.sync();
  XcdBarrier xb = xcd_barrier_post((unsigned*)(ws + OFF_BAR), (volatile LAS unsigned*)&xb_words);
  phase0(p, smem);
  xcd_barrier(xb);
  gemm_phase<1>(p, (const u16*)(ws + OFF_R), (const u16*)(ws + OFF_WTA_IN), 32, smem);
  skinny_gemm<0>(p, (const u16*)(ws + OFF_R), (const u16*)(ws + OFF_WTA_IN) + (size_t)4096 * 1024, (float*)(ws + OFF_BRAW));
  xcd_barrier(xb);
  {
    const bool overlap = gridDim.x >= 128;
    const int G = (int)gridDim.x, hG = G >> 1, bi = (int)blockIdx.x;
    const bool is_scan = overlap && bi < 32, is_idle = overlap && bi >= hG && bi < hG + 32;
    const int pfirst = overlap ? (bi < hG ? 32 : 64) : 0, pn = overlap ? G - 64 : G;
    if (!is_scan && !is_idle) delta_prep(p, smem, pfirst, pn);
    if (!is_scan && !is_idle) phase0b(p, smem, pfirst, pn);
    if (!overlap) xcd_barrier(xb);
    if (!overlap || blockIdx.x < 32) delta_scan(p, smem);
    xcd_barrier(xb);
  }
  gate_phase(p);
  xcd_barrier(xb);
  gemm_phase<2>(p, (const u16*)(ws + OFF_R + 32 * MiB), (const u16*)(ws + OFF_WTA_OUT), 8, smem);
  xcd_barrier(xb);
  gemm_phase<3>(p, (const u16*)(ws + OFF_R), (const u16*)(ws + OFF_WTB_IN), 32, smem);
  skinny_gemm<1>(p, (const u16*)(ws + OFF_R), (const u16*)(ws + OFF_WTB_IN) + (size_t)4096 * 1024, (float*)(ws + OFF_FRAW));
  xcd_barrier(xb);
  attn_phase(p, smem);
  xcd_barrier(xb);
  gemm_phase<4>(p, (const u16*)(ws + OFF_R + 64 * MiB), (const u16*)(ws + OFF_WTB_OUT), 8, smem);
  xcd_barrier(xb);
  final_norm(p);
}

extern "C" void kernel_launch(void* const* d_in, const int* in_sizes, int n_in, void* d_out, int out_size, void* d_ws, size_t ws_size,
                              hipStream_t stream) {
  static int grid_blocks = 0;
  if (!grid_blocks) {
    int dev = 0, cus = 0, per_cu = 0;
    hipGetDevice(&dev);
    hipDeviceGetAttribute(&cus, hipDeviceAttributeMultiprocessorCount, dev);
    hipFuncSetAttribute((const void*)fwd_megakernel, hipFuncAttributeMaxDynamicSharedMemorySize, kLds);
    hipOccupancyMaxActiveBlocksPerMultiprocessor(&per_cu, (const void*)fwd_megakernel, kThreads, kLds);
    if (per_cu < 1) per_cu = 1;
    if (per_cu > 2) per_cu = 2;
    grid_blocks = cus * per_cu;
  }
  Params p{};
  p.x = (const float*)d_in[0]; p.a_norm_w = (const float*)d_in[1]; p.a_w_in = (const float*)d_in[2]; p.a_conv_w = (const float*)d_in[3];
  p.a_A_log = (const float*)d_in[4]; p.a_dt_bias = (const float*)d_in[5]; p.a_o_norm_w = (const float*)d_in[6]; p.a_w_out = (const float*)d_in[7];
  p.b_norm_w = (const float*)d_in[8]; p.b_w_in = (const float*)d_in[9]; p.b_f_bias = (const float*)d_in[10]; p.b_q_norm_w = (const float*)d_in[11];
  p.b_k_norm_w = (const float*)d_in[12]; p.b_w_out = (const float*)d_in[13]; p.final_norm_w = (const float*)d_in[14];
  p.out = (float*)d_out;
  p.ws = (char*)d_ws;
  hipMemsetAsync((char*)d_ws + OFF_BAR, 0, CTL_BYTES, stream);
  void* args[] = {&p};
  hipError_t e = hipLaunchCooperativeKernel((const void*)fwd_megakernel, dim3(grid_blocks), dim3(kThreads), args, kLds, stream);
  if (e != hipSuccess) fprintf(stderr, "cooperative launch failed: %s (grid %d)\n", hipGetErrorString(e), grid_blocks);
}
```

```cpp
#include <hip/hip_runtime.h>
#include <hip/hip_cooperative_groups.h>
#include <cstdio>
namespace cg = cooperative_groups;

typedef unsigned short u16;
typedef __attribute__((ext_vector_type(8))) short bf16x8;
typedef __attribute__((ext_vector_type(4))) float f32x4;
typedef __attribute__((ext_vector_type(4))) unsigned u32x4;
typedef __attribute__((ext_vector_type(2))) unsigned u32x2;
#define DI __device__ __forceinline__

constexpr int kThreads = 256;
constexpr int kLds = 69632;
constexpr float kEps = 1e-6f;
constexpr float kScale = 0.08838834764831845f;
constexpr float kLog2e = 1.4426950408889634f;

constexpr size_t MiB = 1048576;
constexpr size_t OFF_WTA_IN = 0;
constexpr size_t OFF_WTA_OUT = 8650752;
constexpr size_t OFF_WTB_IN = 10747904;
constexpr size_t OFF_WTB_OUT = 19398656;
constexpr size_t OFF_SMALL = 21495808;
constexpr size_t OFF_RS0 = OFF_SMALL;
constexpr size_t OFF_SS1 = OFF_RS0 + 65536;
constexpr size_t OFF_SS2 = OFF_SS1 + 65536;
constexpr size_t OFF_BRAW = OFF_SS2 + 65536;
constexpr size_t OFF_FRAW = OFF_BRAW + 1048576;
constexpr size_t OFF_CCUM = OFF_FRAW + 1048576;
constexpr size_t OFF_GEND = OFF_CCUM + 524288;
constexpr size_t OFF_BAR = OFF_GEND + 8192;
constexpr size_t OFF_FLAGS = OFF_BAR + 13824 + 512;
constexpr size_t CTL_BYTES = 13824 + 512 + 8192;
constexpr size_t OFF_PROJ = OFF_SMALL + 3 * MiB;
constexpr size_t OFF_R = OFF_PROJ + 128 * MiB;

struct Params {
  const float *x, *a_norm_w, *a_w_in, *a_conv_w, *a_A_log, *a_dt_bias, *a_o_norm_w, *a_w_out;
  const float *b_norm_w, *b_w_in, *b_f_bias, *b_q_norm_w, *b_k_norm_w, *b_w_out, *final_norm_w;
  float* out;
  char* ws;
};

typedef __attribute__((ext_vector_type(2))) float f32x2;
typedef __attribute__((ext_vector_type(2))) __bf16 bf16x2_t;
DI unsigned pack2(float a, float b) { f32x2 v = {a, b}; return __builtin_bit_cast(unsigned, __builtin_convertvector(v, bf16x2_t)); }
DI unsigned f2bf(float x) { return pack2(x, 0.f) & 0xffffu; }
DI float bflo(unsigned u) { return __uint_as_float(u << 16); }
DI float bfhi(unsigned u) { return __uint_as_float(u & 0xffff0000u); }
DI f32x4 mfma16(bf16x8 a, bf16x8 b, f32x4 c) { return __builtin_amdgcn_mfma_f32_16x16x32_bf16(a, b, c, 0, 0, 0); }
DI bf16x8 mk8(u32x2 lo, u32x2 hi) { u32x4 v = {lo.x, lo.y, hi.x, hi.y}; return __builtin_bit_cast(bf16x8, v); }
DI bf16x8 pack8(f32x4 a, f32x4 b) { u32x4 v = {pack2(a[0], a[1]), pack2(a[2], a[3]), pack2(b[0], b[1]), pack2(b[2], b[3])}; return __builtin_bit_cast(bf16x8, v); }
DI bf16x8 ld2(const u16* p) { return mk8(*(const u32x2*)p, *(const u32x2*)(p + 16)); }
DI int relaunder(int t) { asm volatile("" : "+v"(t)); return t; }
DI int tidx() { int t = threadIdx.x; asm volatile("" : "+v"(t)); return t; }
template <int CTRL> DI float dpp_f(float x) { return __int_as_float(__builtin_amdgcn_update_dpp(0, __float_as_int(x), CTRL, 0xF, 0xF, true)); }
DI float readlane_f(float x, const int l) { return __int_as_float(__builtin_amdgcn_readlane(__float_as_int(x), l)); }
DI float silu(float x) { return x / (1.f + __expf(-x)); }
DI void unpack8(u32x4 v, float* f) {
  f[0] = bflo(v.x); f[1] = bfhi(v.x); f[2] = bflo(v.y); f[3] = bfhi(v.y);
  f[4] = bflo(v.z); f[5] = bfhi(v.z); f[6] = bflo(v.w); f[7] = bfhi(v.w);
}
DI u32x4 packf8(const float* f) { u32x4 v = {pack2(f[0], f[1]), pack2(f[2], f[3]), pack2(f[4], f[5]), pack2(f[6], f[7])}; return v; }


#define XB_TMO      128
#define XB_XCNT(j)  (256  + 64 * (j))
#define XB_XSUB(j)  (1280 + 64 * (j))
#define XB_XGEN(j)  (2304 + 64 * (j))
#define XB_TOP      3328
#define XB_TOPGEN   3392
#define XCD_BAR_WORDS 3456
#define XB_SPIN_CAP (1u << 23)
#define LAS __attribute__((address_space(3)))
DI unsigned xb_ld(unsigned* p) { return __hip_atomic_load(p, __ATOMIC_RELAXED, __HIP_MEMORY_SCOPE_AGENT); }
DI unsigned xb_add(unsigned* p, unsigned v) { return __hip_atomic_fetch_add(p, v, __ATOMIC_RELAXED, __HIP_MEMORY_SCOPE_AGENT); }
DI unsigned xb_xcc_id() { return (unsigned)__builtin_amdgcn_s_getreg((3 << 11) | 20) & 0xFu; }
#define XB_SPIN(cond, bar) do { unsigned _sp = 0; while (cond) { __builtin_amdgcn_s_sleep(1); \
    if ((++_sp & 255u) == 0u) { if (xb_ld(&(bar)[XB_TMO])) break; if (_sp > XB_SPIN_CAP) { atomicAdd(&(bar)[XB_TMO], 1u); break; } } } } while (0)
struct XcdBarrier { unsigned* bar; unsigned x; volatile LAS unsigned* st; };
DI XcdBarrier xcd_barrier_post(unsigned* bar, volatile LAS unsigned* st) {
  XcdBarrier b; b.bar = bar; b.x = xb_xcc_id(); b.st = st;
  if (threadIdx.x == 0) (void)xb_add(&bar[XB_XCNT(b.x)], 1u);
  return b;
}
DI void xcd_barrier_complete(unsigned* bar, unsigned x, unsigned& nloc, unsigned& nx) {
  const unsigned G = gridDim.x * gridDim.y * gridDim.z;
  unsigned sum, cnt, mine, sp = 0u;
  for (;;) {
    sum = 0u; cnt = 0u; mine = 0u;
#pragma unroll
    for (unsigned j = 0; j < 16; ++j) { const unsigned c = xb_ld(&bar[XB_XCNT(j)]); sum += c; cnt += (c > 0u) ? 1u : 0u; mine = (j == x) ? c : mine; }
    if (sum == G) break;
    __builtin_amdgcn_s_sleep(1);
    if ((++sp & 255u) == 0u) { if (xb_ld(&bar[XB_TMO])) break; if (sp > XB_SPIN_CAP) { atomicAdd(&bar[XB_TMO], 1u); break; } }
  }
  nloc = mine > 0u ? mine : 1u; nx = cnt > 0u ? cnt : 1u;
}
DI void xcd_barrier(const XcdBarrier& b) {
  asm volatile("s_waitcnt vmcnt(0)" ::: "memory");
  __syncthreads();
  if (threadIdx.x == 0) {
    unsigned* bar = b.bar;
    __builtin_amdgcn_s_waitcnt(0);
    unsigned nloc = b.st[0], nx = b.st[1];
    if (nloc == 0u) { xcd_barrier_complete(bar, b.x, nloc, nx); b.st[0] = nloc; b.st[1] = nx; }
    const unsigned old = xb_add(&bar[XB_XSUB(b.x)], 1u);
    const unsigned gen = old / nloc;
    if (old + 1u == (gen + 1u) * nloc) {
      __builtin_amdgcn_fence(__ATOMIC_RELEASE, "agent");
      asm volatile("s_waitcnt vmcnt(0)" ::: "memory");
      const unsigned og = xb_add(&bar[XB_TOP], 1u);
      const unsigned tg = og / nx;
      if (og + 1u == (tg + 1u) * nx) xb_add(&bar[XB_TOPGEN], 1u);
      else XB_SPIN(xb_ld(&bar[XB_TOPGEN]) == tg, bar);
      __builtin_amdgcn_fence(__ATOMIC_ACQUIRE, "agent");
      xb_add(&bar[XB_XGEN(b.x)], 1u);
      asm volatile("s_waitcnt vmcnt(0)" ::: "memory");
    } else {
      XB_SPIN(xb_ld(&bar[XB_XGEN(b.x)]) == gen, bar);
      __builtin_amdgcn_fence(__ATOMIC_ACQUIRE, "agent");
      asm volatile("s_waitcnt vmcnt(0)" ::: "memory");
    }
  }
  __syncthreads();
}

DI void transpose_tile(const float* __restrict__ W, int N, int Npad, const float* __restrict__ kscale, u16* __restrict__ WT, int tile, char* smem) {
  float(*t)[65] = (float(*)[65])smem;
  const int nt = Npad / 64;
  const int k0 = (tile / nt) * 64, n0 = (tile % nt) * 64;
  const int tid = tidx();
  {
    const int tx = tid & 63, ty = tid >> 6;
#pragma unroll 4
    for (int i = 0; i < 16; ++i) {
      const int k = k0 + ty + 4 * i, n = n0 + tx;
      float v = 0.f;
      if (n < N) { v = W[(size_t)k * N + n]; if (kscale) v *= kscale[k]; }
      t[ty + 4 * i][tx] = v;
    }
  }
  __syncthreads();
  {
    const int kx2 = (tid & 31) * 2, ny0 = tid >> 5;
#pragma unroll 4
    for (int i = 0; i < 8; ++i) {
      const int ny = ny0 + 8 * i;
      *(unsigned*)(WT + (size_t)(n0 + ny) * 1024 + k0 + kx2) = pack2(t[kx2][ny], t[kx2 + 1][ny]);
    }
  }
  __syncthreads();
}

DI void phase0(const Params& p, char* smem) {
  char* ws = p.ws;
  {
    float* ss = (float*)(ws + OFF_SS1);
    for (int i = blockIdx.x * kThreads + tidx(); i < 32768; i += gridDim.x * kThreads) ss[i] = 0.f;
  }
  for (int t = blockIdx.x; t < 1312; t += gridDim.x) {
    if (t < 1056) transpose_tile(p.a_w_in, 4112, 4224, p.a_norm_w, (u16*)(ws + OFF_WTA_IN), t, smem);
    else transpose_tile(p.a_w_out, 1024, 1024, nullptr, (u16*)(ws + OFF_WTA_OUT), t - 1056, smem);
  }
  const int tid0 = tidx();
  const int lane = tid0 & 63;
  const int gw = blockIdx.x * 4 + (tid0 >> 6), nw = gridDim.x * 4;
  u16* xb = (u16*)(ws + OFF_R);
  float* rs0 = (float*)(ws + OFF_RS0);
  for (int row = gw; row < 16384; row += 4 * nw) {
    f32x4 v[4][4];
#pragma unroll
    for (int k = 0; k < 4; ++k) {
      const int rr = row + k * nw;
      const f32x4* xr = (const f32x4*)(p.x + (size_t)(rr < 16384 ? rr : row) * 1024);
#pragma unroll
      for (int i = 0; i < 4; ++i) v[k][i] = __builtin_nontemporal_load(xr + lane + 64 * i);
    }
#pragma unroll
    for (int k = 0; k < 4; ++k) {
      const int rr = row + k * nw;
      float ss = 0.f;
#pragma unroll
      for (int i = 0; i < 4; ++i) ss += v[k][i][0] * v[k][i][0] + v[k][i][1] * v[k][i][1] + v[k][i][2] * v[k][i][2] + v[k][i][3] * v[k][i][3];
#pragma unroll
      for (int o = 32; o >= 1; o >>= 1) ss += __shfl_xor(ss, o);
      if (rr < 16384) {
        u32x2* xo = (u32x2*)(xb + (size_t)rr * 1024);
#pragma unroll
        for (int i = 0; i < 4; ++i) { u32x2 o = {pack2(v[k][i][0], v[k][i][1]), pack2(v[k][i][2], v[k][i][3])}; xo[lane + 64 * i] = o; }
        if (lane == 0) rs0[rr] = rsqrtf(ss * (1.f / 1024.f) + kEps);
      }
    }
  }
}

DI void phase0b(const Params& p, char* smem, int first, int nblk) {
  char* ws = p.ws;
  for (int t = (int)blockIdx.x - first; t < 1312; t += nblk) {
    if (t < 1056) transpose_tile(p.b_w_in, 4104, 4224, p.b_norm_w, (u16*)(ws + OFF_WTB_IN), t, smem);
    else transpose_tile(p.b_w_out, 1024, 1024, nullptr, (u16*)(ws + OFF_WTB_OUT), t - 1056, smem);
  }
}

template <int EPI>
DI void gemm_phase(const Params& p, const u16* __restrict__ A, const u16* __restrict__ Bt, int nTn, char* smem) {
  const int tid = tidx(), lane = tid & 63, wave = tid >> 6;
  const int wr = wave >> 1, wc = wave & 1;
  const int l15 = lane & 15, quad = lane >> 4;
  char* ws = p.ws;
  const int NX = ((gridDim.x & 7) == 0) ? 8 : 1;
  const int xg = blockIdx.x % NX, lb = blockIdx.x / NX, Lb = gridDim.x / NX;
  const int nTnG = nTn >> 3, nSuper = 16 * nTnG;
  const int srow = wave * 8 + (lane >> 3);
  const int sch = (lane & 7) ^ ((((wave & 1) << 2) + (lane >> 4)) & 7);
#define GEMM_TILE(seq_, tm_, tn_, ok_)                                                            \
  do {                                                                                            \
    const int sidx_ = xg + NX * ((seq_) >> 6);                                                    \
    ok_ = sidx_ < nSuper;                                                                         \
    const int tl_ = (seq_) & 63;                                                                  \
    tm_ = (sidx_ / nTnG) * 8 + (tl_ & 7);                                                         \
    tn_ = (sidx_ % nTnG) * 8 + (tl_ >> 3);                                                        \
  } while (0)
#define GEMM_STAGE(buf, kt)                                                                                                   \
  do {                                                                                                                        \
    _Pragma("unroll") for (int i = 0; i < 4; ++i) {                                                                           \
      __builtin_amdgcn_global_load_lds((const unsigned*)(Ag + (size_t)i * 32 * 1024 + (kt) * 64),                             \
                                       (unsigned*)(smem + (buf) * 32768 + (i * 4 + wave) * 1024), 16, 0, 0);                  \
      __builtin_amdgcn_global_load_lds((const unsigned*)(Bg + (size_t)i * 32 * 1024 + (kt) * 64),                             \
                                       (unsigned*)(smem + (buf) * 32768 + 16384 + (i * 4 + wave) * 1024), 16, 0, 0);          \
    }                                                                                                                         \
  } while (0)
  int seq = lb, tm, tn;
  bool ok;
  GEMM_TILE(seq, tm, tn, ok);
  const u16* Ag = A + (size_t)(tm * 128 + srow) * 1024 + sch * 8;
  const u16* Bg = Bt + (size_t)(tn * 128 + srow) * 1024 + sch * 8;
  if (ok) GEMM_STAGE(0, 0);
  while (ok) {
    int tm2, tn2;
    bool ok2;
    GEMM_TILE(seq + Lb, tm2, tn2, ok2);
    f32x4 acc[4][4];
#pragma unroll
    for (int a = 0; a < 4; ++a)
#pragma unroll
      for (int b = 0; b < 4; ++b) acc[a][b] = (f32x4){0.f, 0.f, 0.f, 0.f};
    asm volatile("s_waitcnt vmcnt(0)" ::: "memory");
    __syncthreads();
#pragma unroll 2
    for (int kt = 0; kt < 16; ++kt) {
      const int cur = kt & 1;
      if (kt + 1 < 16) GEMM_STAGE(cur ^ 1, kt + 1);
      else if (ok2) {
        Ag = A + (size_t)(tm2 * 128 + srow) * 1024 + sch * 8;
        Bg = Bt + (size_t)(tn2 * 128 + srow) * 1024 + sch * 8;
        GEMM_STAGE(0, 0);
      }
      const char* sa = smem + cur * 32768;
      const char* sb = sa + 16384;
#pragma unroll
      for (int ks = 0; ks < 2; ++ks) {
        bf16x8 fa[4], fb[4];
        const int ch = ks * 4 + quad;
#pragma unroll
        for (int mi = 0; mi < 4; ++mi) {
          const int row = wr * 64 + mi * 16 + l15;
          fa[mi] = *(const bf16x8*)(sa + row * 128 + ((ch ^ ((row >> 1) & 7)) << 4));
        }
#pragma unroll
        for (int ni = 0; ni < 4; ++ni) {
          const int row = wc * 64 + ni * 16 + l15;
          fb[ni] = *(const bf16x8*)(sb + row * 128 + ((ch ^ ((row >> 1) & 7)) << 4));
        }
#pragma unroll
        for (int ni = 0; ni < 4; ++ni)
#pragma unroll
          for (int mi = 0; mi < 4; ++mi) acc[ni][mi] = mfma16(fb[ni], fa[mi], acc[ni][mi]);
      }
      if (kt < 15) {
        asm volatile("s_waitcnt vmcnt(0)" ::: "memory");
        __syncthreads();
      }
    }
    float hnorm[4] = {1.f, 1.f, 1.f, 1.f};
    if constexpr (EPI == 3) {
      if (tn < 16) {
        float* part = (float*)(smem + 65536);
        float ssq[4];
#pragma unroll
        for (int mi = 0; mi < 4; ++mi) {
          const float rs = rsqrtf(((const float*)(ws + OFF_SS1))[tm * 128 + wr * 64 + mi * 16 + l15] * (1.f / 1024.f) + kEps);
          float s = 0.f;
#pragma unroll
          for (int ni = 0; ni < 4; ++ni) { const f32x4 v = acc[ni][mi] * rs; s += v[0] * v[0] + v[1] * v[1] + v[2] * v[2] + v[3] * v[3]; }
          s += __shfl_xor(s, 16);
          s += __shfl_xor(s, 32);
          ssq[mi] = s;
          if (quad == 0) part[(wr * 2 + wc) * 64 + mi * 16 + l15] = s;
        }
        __syncthreads();
#pragma unroll
        for (int mi = 0; mi < 4; ++mi) {
          const float tot = ssq[mi] + part[(wr * 2 + (wc ^ 1)) * 64 + mi * 16 + l15];
          hnorm[mi] = rsqrtf(tot * (1.f / 128.f) + kEps) * (tn < 8 ? kScale * kLog2e : 1.f);
        }
      }
    }
#pragma unroll
    for (int mi = 0; mi < 4; ++mi) {
      const int m = tm * 128 + wr * 64 + mi * 16 + l15;
      if constexpr (EPI == 1) {
        const float rs = ((const float*)(ws + OFF_RS0))[m];
        u16* proj = (u16*)(ws + OFF_PROJ);
        float* braw = (float*)(ws + OFF_BRAW);
#pragma unroll
        for (int ni = 0; ni < 4; ++ni) {
          const int nb = tn * 128 + wc * 64 + ni * 16 + quad * 4;
          f32x4 v = acc[ni][mi] * rs;
          if (nb < 4096) { u32x2 o = {pack2(v[0], v[1]), pack2(v[2], v[3])}; __builtin_nontemporal_store(o, (u32x2*)(proj + (size_t)m * 4096 + nb)); }
          else if (nb < 4112) { *(f32x4*)(braw + (size_t)m * 16 + (nb - 4096)) = v; }
        }
      } else if constexpr (EPI == 2 || EPI == 4) {
        float* ssp = (float*)(ws + (EPI == 2 ? OFF_SS1 : OFF_SS2));
        u16* hb = (u16*)(ws + OFF_R);
        float ssq = 0.f;
#pragma unroll
        for (int ni = 0; ni < 4; ++ni) {
          const int nb = tn * 128 + wc * 64 + ni * 16 + quad * 4;
          f32x4 v;
          if constexpr (EPI == 2) {
            v = acc[ni][mi] + __builtin_nontemporal_load((const f32x4*)(p.x + (size_t)m * 1024 + nb));
            u32x2 o = {pack2(v[0], v[1]), pack2(v[2], v[3])};
            *(u32x2*)(hb + (size_t)m * 1024 + nb) = o;
            v[0] = bflo(o.x); v[1] = bfhi(o.x); v[2] = bflo(o.y); v[3] = bfhi(o.y);
          } else {
            const u32x2 r = *(const u32x2*)(hb + (size_t)m * 1024 + nb);
            v = acc[ni][mi];
            v[0] += bflo(r.x); v[1] += bfhi(r.x); v[2] += bflo(r.y); v[3] += bfhi(r.y);
            const u32x2 o = {pack2(v[0], v[1]), pack2(v[2], v[3])};
            *(u32x2*)(hb + (size_t)m * 1024 + nb) = o;
            v[0] = bflo(o.x); v[1] = bfhi(o.x); v[2] = bflo(o.y); v[3] = bfhi(o.y);
          }
          ssq += v[0] * v[0] + v[1] * v[1] + v[2] * v[2] + v[3] * v[3];
        }
        ssq += __shfl_xor(ssq, 16);
        ssq += __shfl_xor(ssq, 32);
        if (quad == 0) atomicAdd(ssp + m, ssq);
      } else if constexpr (EPI == 3) {
        const float rs = rsqrtf(((const float*)(ws + OFF_SS1))[m] * (1.f / 1024.f) + kEps);
        u16* proj = (u16*)(ws + OFF_PROJ);
        u16* vT = (u16*)(ws + OFF_R + 32 * MiB);
        float* fraw = (float*)(ws + OFF_FRAW);
        float hs = 1.f;
        if (tn < 16) hs = hnorm[mi];
#pragma unroll
        for (int ni = 0; ni < 4; ++ni) {
          const int nb = tn * 128 + wc * 64 + ni * 16 + quad * 4;
          f32x4 v = acc[ni][mi] * rs;
          if (tn < 16) {
            const f32x4 wv = *(const f32x4*)((tn < 8 ? p.b_q_norm_w : p.b_k_norm_w) + (nb & 127));
            v = v * hs * wv;
          }
          if (nb < 4096) {
            if ((nb >> 10) != 2) { u32x2 o = {pack2(v[0], v[1]), pack2(v[2], v[3])}; __builtin_nontemporal_store(o, (u32x2*)(proj + (size_t)m * 4096 + nb)); }
            else {
              const int hd = nb - 2048;
              const int b = m >> 13, t = m & 8191;
              u16* dst = vT + ((size_t)(b * 1024 + hd)) * 8192 + t;
#pragma unroll
              for (int jj = 0; jj < 4; ++jj) dst[(size_t)jj * 8192] = (u16)f2bf(v[jj]);
            }
          } else if (nb < 4104) { *(f32x4*)(fraw + (size_t)m * 16 + (nb - 4096)) = v; }
        }
      }
    }
    seq += Lb; tm = tm2; tn = tn2; ok = ok2;
  }
#undef GEMM_STAGE
#undef GEMM_TILE
}


template <int MODE>
DI void skinny_gemm(const Params& p, const u16* __restrict__ A, const u16* __restrict__ Wt16, float* __restrict__ out) {
  const int tid = tidx(), lane = tid & 63, l15 = lane & 15, quad = lane >> 4;
  const int gw = blockIdx.x * 4 + (tid >> 6), nw = gridDim.x * 4;
  for (int mt = gw; mt < 1024; mt += nw) {
    const int m = mt * 16 + l15;
    const u16* ap = A + (size_t)m * 1024 + quad * 8;
    const u16* bp = Wt16 + (size_t)l15 * 1024 + quad * 8;
    f32x4 acc = {0.f, 0.f, 0.f, 0.f};
#pragma unroll 8
    for (int ks = 0; ks < 32; ++ks) acc = mfma16(*(const bf16x8*)(bp + ks * 32), *(const bf16x8*)(ap + ks * 32), acc);
    float rs;
    if constexpr (MODE == 0) rs = ((const float*)(p.ws + OFF_RS0))[m];
    else rs = rsqrtf(((const float*)(p.ws + OFF_SS1))[m] * (1.f / 1024.f) + kEps);
    f32x4 ov = acc * rs;
    if constexpr (MODE == 1) {
#pragma unroll
      for (int jj = 0; jj < 4; ++jj) {
        const int n = 4 * quad + jj;
        const float xv = ov[jj] + p.b_f_bias[n & 7];
        ov[jj] = fminf(xv, 0.f) - log1pf(__expf(-fabsf(xv)));
      }
    }
    *(f32x4*)(out + (size_t)m * 16 + 4 * quad) = ov;
  }
}

DI void delta_prep(const Params& p, char* smem, int first, int nblk) {
  char* ws = p.ws;
  const u16* proj = (const u16*)(ws + OFF_PROJ);
  const float* braw = (const float*)(ws + OFF_BRAW);
  u16* qd_g = (u16*)(ws + OFF_R);
  u16* kT_g = (u16*)(ws + OFF_R + 32 * MiB);
  u16* at_g = (u16*)(ws + OFF_R + 64 * MiB);
  u16* uT_g = (u16*)p.out;
  u16* w_g = (u16*)((char*)p.out + 32 * MiB);
  float* gend_g = (float*)(ws + OFF_GEND);
  char* qL = smem;
  char* kL = smem + 16384;
  char* vL = smem + 32768;
  float* As = (float*)(smem + 49152);
  float* sc = (float*)(smem + 66560);
  float* g_s = sc;
  float* beta_s = sc + 64;
  float* rq_s = sc + 128;
  float* rk_s = sc + 192;
  float* ssq_s = sc + 256;
  float* fu_s = sc + 384;
  float* fw_s = sc + 448;
  const int tid_ = tidx();

  unsigned* flags = (unsigned*)(ws + OFF_FLAGS);
  const __amdgpu_buffer_rsrc_t r_qd = __builtin_amdgcn_make_buffer_rsrc(qd_g, 0, 32 << 20, 0x00020000);
  const __amdgpu_buffer_rsrc_t r_kT = __builtin_amdgcn_make_buffer_rsrc(kT_g, 0, 32 << 20, 0x00020000);
  const __amdgpu_buffer_rsrc_t r_at = __builtin_amdgcn_make_buffer_rsrc(at_g, 0, 16 << 20, 0x00020000);
  const __amdgpu_buffer_rsrc_t r_uT = __builtin_amdgcn_make_buffer_rsrc(uT_g, 0, 32 << 20, 0x00020000);
  const __amdgpu_buffer_rsrc_t r_w = __builtin_amdgcn_make_buffer_rsrc(w_g, 0, 32 << 20, 0x00020000);
  if (nblk >= 256 && ((int)blockIdx.x - first) >= (nblk >> 1)) {
    for (int i = 0; i < 7; ++i) __builtin_amdgcn_s_sleep(127);
  }
  for (int j = (int)blockIdx.x - first; j < 2048; j += nblk) {
    const int c = j >> 4, b = (j >> 3) & 1, h = j & 7;
    const int item = (b * 128 + c) * 8 + h;
    const int tok0 = b * 8192 + c * 64;
    const int tid = relaunder(tid_), lane = tid & 63, wave = tid >> 6, l15 = lane & 15, quad = lane >> 4;
    if (wave == 3) {
      const int row = tok0 + lane;
      const float br = braw[(size_t)row * 16 + h];
      const float ar = braw[(size_t)row * 16 + 8 + h] + p.a_dt_bias[h];
      const float beta = 1.f / (1.f + __expf(-br));
      const float sp = fmaxf(ar, 0.f) + log1pf(__expf(-fabsf(ar)));
      float g = -__expf(p.a_A_log[h]) * sp;
#pragma unroll
      for (int o = 1; o < 64; o <<= 1) { float t = __shfl_up(g, o); if (lane >= o) g += t; }
      g_s[lane] = g;
      beta_s[lane] = beta;
    } else {
      const int sec = wave, cgi = l15, rr = quad;
      const int col = sec * 1024 + h * 128 + cgi * 8;
      float w0[8], w1[8], w2[8], w3[8];
#pragma unroll
      for (int e = 0; e < 8; ++e) {
        w0[e] = p.a_conv_w[0 * 3072 + col + e]; w1[e] = p.a_conv_w[1 * 3072 + col + e];
        w2[e] = p.a_conv_w[2 * 3072 + col + e]; w3[e] = p.a_conv_w[3 * 3072 + col + e];
      }
      const u16* src = proj + (size_t)(tok0 + rr * 16) * 4096 + col;
      float x0[8], x1[8], x2[8], x3[8];
      if (c == 0 && rr == 0) {
#pragma unroll
        for (int e = 0; e < 8; ++e) { x0[e] = 0.f; x1[e] = 0.f; x2[e] = 0.f; }
      } else {
        unpack8(*(const u32x4*)(src - 3 * 4096), x0);
        unpack8(*(const u32x4*)(src - 2 * 4096), x1);
        unpack8(*(const u32x4*)(src - 1 * 4096), x2);
      }
      char* dstL = smem + sec * 16384;
#pragma unroll 4
      for (int r = 0; r < 16; ++r) {
        unpack8(*(const u32x4*)(src + (size_t)r * 4096), x3);
        float y[8];
        float ssq = 0.f;
#pragma unroll
        for (int e = 0; e < 8; ++e) {
          float v = w0[e] * x0[e] + w1[e] * x1[e] + w2[e] * x2[e] + w3[e] * x3[e];
          v = silu(v);
          y[e] = v;
          ssq += v * v;
          x0[e] = x1[e]; x1[e] = x2[e]; x2[e] = x3[e];
        }
        ssq += __shfl_xor(ssq, 1); ssq += __shfl_xor(ssq, 2); ssq += __shfl_xor(ssq, 4); ssq += __shfl_xor(ssq, 8);
        const int row = rr * 16 + r;
        if (sec < 2 && cgi == 0) ssq_s[sec * 64 + row] = ssq;
        *(u32x4*)(dstL + row * 256 + ((cgi ^ (row & 15)) << 4)) = packf8(y);
      }
    }
    __syncthreads();
    if (tid < 64) {
      const float rq = rsqrtf(ssq_s[tid] + kEps), rk = rsqrtf(ssq_s[64 + tid] + kEps);
      const float gi = g_s[tid], g63 = g_s[63];
      const float eg = __expf(gi);
      rq_s[tid] = rq; rk_s[tid] = rk;
      const float be = beta_s[tid];
      fu_s[tid] = be;
      fw_s[tid] = be * rk * eg;
      ssq_s[tid] = rq * kScale * eg;
      ssq_s[64 + tid] = rk * __expf(g63 - gi);
      if (tid == 0) __hip_atomic_store(gend_g + item, __expf(g63), __ATOMIC_RELAXED, __HIP_MEMORY_SCOPE_AGENT);
    }
    __syncthreads();
    {
      const int tid = relaunder(tid_), lane = tid & 63, wave = tid >> 6, l15 = lane & 15, quad = lane >> 4;
      bf16x8 bk[4], bq[4];
      const int rowI = 16 * wave + l15;
#pragma unroll
      for (int ks = 0; ks < 4; ++ks) {
        const int off = rowI * 256 + (((ks * 4 + quad) ^ (rowI & 15)) << 4);
        bk[ks] = *(const bf16x8*)(kL + off);
        bq[ks] = *(const bf16x8*)(qL + off);
      }
      const int i = rowI;
      const float gi = g_s[i], bi = beta_s[i] * rk_s[i], qi = kScale * rq_s[i];
      u32x2 keep = {0u, 0u};
#pragma unroll
      for (int J = 0; J < 4; ++J) {
        f32x4 skk = {0.f, 0.f, 0.f, 0.f}, sqk = {0.f, 0.f, 0.f, 0.f};
        const int rowJ = 16 * J + l15;
#pragma unroll
        for (int ks = 0; ks < 4; ++ks) {
          const bf16x8 ak = *(const bf16x8*)(kL + rowJ * 256 + (((ks * 4 + quad) ^ (rowJ & 15)) << 4));
          skk = mfma16(ak, bk[ks], skk);
          sqk = mfma16(ak, bq[ks], sqk);
        }
        const f32x4 gj4 = *(const f32x4*)(g_s + 16 * J + 4 * quad);
        const f32x4 rk4 = *(const f32x4*)(rk_s + 16 * J + 4 * quad);
        f32x4 a4, t4;
#pragma unroll
        for (int jj = 0; jj < 4; ++jj) {
          const int j = 16 * J + 4 * quad + jj;
          const float dec = (i >= j) ? __expf(gi - gj4[jj]) : 0.f;
          a4[jj] = (i > j) ? bi * rk4[jj] * skk[jj] * dec : 0.f;
          t4[jj] = qi * rk4[jj] * sqk[jj] * dec;
        }
        *(f32x4*)(As + i * 68 + 16 * J + 4 * quad) = a4;
        const u32x2 half = {pack2(t4[0], t4[1]), pack2(t4[2], t4[3])};
        if ((J & 1) == 0) keep = half;
        else {
          const u32x4 fr = {keep.x, keep.y, half.x, half.y};
          __builtin_amdgcn_raw_buffer_store_b128(fr, r_at, item * 8192 + ((wave * 2 + (J >> 1)) * 64 + lane) * 16, 0, 16);
        }
      }
    }
    {
      const int tid = relaunder(tid_);
#pragma unroll
      for (int it = 0; it < 4; ++it) {
        const int idx = tid + 256 * it;
        const int f = idx >> 6, ln = idx & 63, fl = ln & 15, fq = ln >> 4;
        {
          const int mt = f >> 2, ks = f & 3, i = 16 * mt + fl;
          const int c0 = 4 * ks + (fq >> 1), o8 = (fq & 1) * 8;
          const u32x2 lo = *(const u32x2*)(qL + i * 256 + ((c0 ^ (i & 15)) << 4) + o8);
          const u32x2 hi = *(const u32x2*)(qL + i * 256 + (((c0 + 2) ^ (i & 15)) << 4) + o8);
          const float s = ssq_s[i];
          const u32x4 o = {pack2(bflo(lo.x) * s, bfhi(lo.x) * s), pack2(bflo(lo.y) * s, bfhi(lo.y) * s),
                           pack2(bflo(hi.x) * s, bfhi(hi.x) * s), pack2(bflo(hi.y) * s, bfhi(hi.y) * s)};
          __builtin_amdgcn_raw_buffer_store_b128(o, r_qd, item * 16384 + idx * 16, 0, 16);
        }
        {
          const int mt = f >> 1, ks = f & 1, dk = 16 * mt + fl;
          float v[8];
#pragma unroll
          for (int e = 0; e < 8; ++e) {
            const int i = 32 * ks + ((e < 4) ? (4 * fq + e) : (16 + 4 * fq + e - 4));
            const u16 raw = *(const u16*)(kL + i * 256 + (((dk >> 3) ^ (i & 15)) << 4) + (dk & 7) * 2);
            v[e] = __uint_as_float(((unsigned)raw) << 16) * ssq_s[64 + i];
          }
          __builtin_amdgcn_raw_buffer_store_b128(packf8(v), r_kT, item * 16384 + idx * 16, 0, 16);
        }
      }
    }
    __syncthreads();
    {
      float U[64];
      const int tid = relaunder(tid_), wave = tid >> 6;
      const int cc = tid & 127, ch = cc >> 3, e2 = (cc & 7) * 2;
      const char* srcL = (wave < 2) ? vL : kL;
      const float* fr = (wave < 2) ? fu_s : fw_s;
#pragma unroll
      for (int i = 0; i < 64; ++i) {
        int ii = i;
        asm volatile("" : "+v"(ii));
        const u16 raw = *(const u16*)(srcL + ii * 256 + ((ch ^ (ii & 15)) << 4) + e2);
        float acc = __uint_as_float(((unsigned)raw) << 16) * fr[ii];
#pragma unroll
        for (int j = 0; j < i; ++j) acc -= As[i * 68 + j] * U[j];
        U[i] = acc;
      }
      if (wave < 2) {
        const int dofs = item * 16384 + (((cc >> 4) * 4) * 256 + (cc & 15) * 4) * 2;
#pragma unroll
        for (int mi = 0; mi < 4; ++mi)
#pragma unroll
          for (int q4 = 0; q4 < 4; ++q4) {
            const u32x2 o = {pack2(U[16 * mi + 4 * q4], U[16 * mi + 4 * q4 + 1]), pack2(U[16 * mi + 4 * q4 + 2], U[16 * mi + 4 * q4 + 3])};
            __builtin_amdgcn_raw_buffer_store_b64(o, r_uT, dofs + (mi * 256 + q4 * 64) * 2, 0, 16);
          }
      } else {
#pragma unroll
        for (int i = 0; i < 64; ++i) {
          int ii = i;
          asm volatile("" : "+v"(ii));
          *(u16*)(qL + ii * 256 + ((ch ^ (ii & 15)) << 4) + e2) = (u16)f2bf(U[i]);
        }
      }
    }
    __syncthreads();
    {
      const int tid = relaunder(tid_);
#pragma unroll
      for (int it = 0; it < 4; ++it) {
        const int idx = tid + 256 * it;
        const int f = idx >> 6, ln = idx & 63, fl = ln & 15, fq = ln >> 4;
        const int mt = f >> 2, ks = f & 3, i = 16 * mt + fl;
        const int c0 = 4 * ks + (fq >> 1), o8 = (fq & 1) * 8;
        const u32x2 lo = *(const u32x2*)(qL + i * 256 + ((c0 ^ (i & 15)) << 4) + o8);
        const u32x2 hi = *(const u32x2*)(qL + i * 256 + (((c0 + 2) ^ (i & 15)) << 4) + o8);
        const u32x4 o = {lo.x, lo.y, hi.x, hi.y};
        __builtin_amdgcn_raw_buffer_store_b128(o, r_w, item * 16384 + idx * 16, 0, 16);
      }
    }
    asm volatile("s_waitcnt vmcnt(0)" ::: "memory");
    __syncthreads();
    if (relaunder(tid_) == 0) __hip_atomic_store(flags + item, 1u, __ATOMIC_RELAXED, __HIP_MEMORY_SCOPE_AGENT);
  }
}

#define RAW_BARRIER() do { asm volatile("s_waitcnt lgkmcnt(0)" ::: "memory"); __builtin_amdgcn_s_barrier(); asm volatile("" ::: "memory"); } while (0)
#define GAS __attribute__((address_space(1)))
#define SCAN_LOAD(item_)                                                                                          \
  do {                                                                                                            \
    const GAS char* wb_ = (const GAS char*)((const char*)w_g + (size_t)(item_) * 16384);                          \
    const GAS char* qb_ = (const GAS char*)((const char*)qd_g + (size_t)(item_) * 16384);                         \
    const GAS char* kb_ = (const GAS char*)((const char*)kT_g + (size_t)(item_) * 16384);                         \
    const GAS char* ab_ = (const GAS char*)((const char*)at_g + (size_t)(item_) * 8192);                          \
    const GAS char* ub_ = (const GAS char*)((const char*)uT_g + (size_t)(item_) * 16384);                         \
    asm volatile("" : "+s"(wb_), "+s"(qb_), "+s"(kb_), "+s"(ab_), "+s"(ub_));                                     \
    _Pragma("unroll") for (int j = 0; j < 4; ++j) {                                                               \
      R[j] = *(const GAS u32x4*)(wb_ + (toff + 4096u * j));                                                       \
      R[4 + j] = *(const GAS u32x4*)(qb_ + (toff + 4096u * j));                                                   \
      R[8 + j] = *(const GAS u32x4*)(kb_ + (toff + 4096u * j));                                                   \
    }                                                                                                             \
    _Pragma("unroll") for (int j = 0; j < 2; ++j) R[12 + j] = *(const GAS u32x4*)(ab_ + (toff + 4096u * j));     \
    _Pragma("unroll") for (int mi = 0; mi < 4; ++mi) un[mi] = *(const GAS u32x2*)(ub_ + (uoff + 512u * mi));     \
    gn = gend_g[item_];                                                                                           \
  } while (0)
DI void delta_scan(const Params& p, char* smem) {
  char* ws = p.ws;
  const u16* qd_g = (const u16*)(ws + OFF_R);
  const u16* kT_g = (const u16*)(ws + OFF_R + 32 * MiB);
  const u16* at_g = (const u16*)(ws + OFF_R + 64 * MiB);
  const u16* uT_g = (const u16*)p.out;
  const u16* w_g = (const u16*)((const char*)p.out + 32 * MiB);
  const float* gend_g = (const float*)(ws + OFF_GEND);
  u16* o_g = (u16*)(ws + OFF_PROJ);
  unsigned* flags = (unsigned*)(ws + OFF_FLAGS);
  const int tid = tidx(), lane = tid & 63, wave = tid >> 6, l15 = lane & 15, quad = lane >> 4;
  char* Lw = smem;
  char* Lq = smem + 16384;
  char* Lk = smem + 32768;
  char* La = smem + 49152;
  char* Lo = smem + 57344;
  for (int unit = blockIdx.x; unit < 32; unit += gridDim.x) {
    const int bh = unit & 15, half = unit >> 4, b = bh >> 3, h = bh & 7;
    const int slice = half * 4 + wave;
    f32x4 S[8];
#pragma unroll
    for (int i = 0; i < 8; ++i) S[i] = (f32x4){0.f, 0.f, 0.f, 0.f};
    const unsigned toff = (unsigned)tid * 16u, uoff = (unsigned)(slice * 256 + lane) * 8u;
    u32x4 R[14];
    u32x2 un[4];
    float gn;
#define SCAN_WAIT(flv_, item_)                                                                                         \
  do {                                                                                                                 \
    unsigned f_ = (flv_), sp_ = 0u;                                                                                    \
    while (f_ == 0u && sp_ < (1u << 24)) { __builtin_amdgcn_s_sleep(2); f_ = __hip_atomic_load(flags + (item_), __ATOMIC_RELAXED, __HIP_MEMORY_SCOPE_AGENT); ++sp_; } \
    __builtin_amdgcn_fence(__ATOMIC_ACQUIRE, "workgroup");           \
  } while (0)
    unsigned fl;
    {
      const int item = (b * 128) * 8 + h;
      SCAN_WAIT(0u, item);
      SCAN_LOAD(item);
      fl = __hip_atomic_load(flags + ((b * 128 + 1) * 8 + h), __ATOMIC_RELAXED, __HIP_MEMORY_SCOPE_AGENT);
    }
    for (int c = 0; c < 128; ++c) {
#pragma unroll
      for (int j = 0; j < 4; ++j) {
        *(u32x4*)(Lw + (tid + 256 * j) * 16) = R[j];
        *(u32x4*)(Lq + (tid + 256 * j) * 16) = R[4 + j];
        *(u32x4*)(Lk + (tid + 256 * j) * 16) = R[8 + j];
      }
#pragma unroll
      for (int j = 0; j < 2; ++j) *(u32x4*)(La + (tid + 256 * j) * 16) = R[12 + j];
      u32x2 uc[4];
#pragma unroll
      for (int mi = 0; mi < 4; ++mi) uc[mi] = un[mi];
      const float gend = gn;
      RAW_BARRIER();
      if (c + 1 < 128) SCAN_WAIT(fl, (b * 128 + c + 1) * 8 + h);
      if (c > 0) {
        const int tokp = b * 8192 + (c - 1) * 64;
#pragma unroll
        for (int k2 = 0; k2 < 2; ++k2) {
          const int idx = tid + 256 * k2, row = idx >> 3, part = idx & 7;
          *(u32x4*)(o_g + (size_t)(tokp + row) * 4096 + h * 128 + half * 64 + part * 8) = *(const u32x4*)(Lo + idx * 16);
        }
      }
      if (c + 1 < 128) {
        const int item = (b * 128 + c + 1) * 8 + h;
        SCAN_LOAD(item);
        fl = (c + 2 < 128) ? __hip_atomic_load(flags + (item + 8), __ATOMIC_RELAXED, __HIP_MEMORY_SCOPE_AGENT) : 1u;
      }
      __builtin_amdgcn_sched_barrier(0);
      bf16x8 bS[4];
#pragma unroll
      for (int ks = 0; ks < 4; ++ks) bS[ks] = pack8(S[2 * ks], S[2 * ks + 1]);
      bf16x8 fr[16];
#pragma unroll
      for (int i = 0; i < 16; ++i) fr[i] = *(const bf16x8*)(Lw + (i * 64 + lane) * 16);
      __builtin_amdgcn_sched_barrier(0);
      f32x4 vn[4];
#pragma unroll
      for (int mi = 0; mi < 4; ++mi) vn[mi] = (f32x4){0.f, 0.f, 0.f, 0.f};
#pragma unroll
      for (int ks = 0; ks < 4; ++ks)
#pragma unroll
        for (int mi = 0; mi < 4; ++mi) vn[mi] = mfma16(fr[mi * 4 + ks], bS[ks], vn[mi]);
      __builtin_amdgcn_sched_barrier(0);
#pragma unroll
      for (int i = 0; i < 16; ++i) fr[i] = *(const bf16x8*)(Lk + (i * 64 + lane) * 16);
#pragma unroll
      for (int mi = 0; mi < 4; ++mi) {
        vn[mi][0] = bflo(uc[mi].x) - vn[mi][0]; vn[mi][1] = bfhi(uc[mi].x) - vn[mi][1];
        vn[mi][2] = bflo(uc[mi].y) - vn[mi][2]; vn[mi][3] = bfhi(uc[mi].y) - vn[mi][3];
      }
      bf16x8 bV[2];
      bV[0] = pack8(vn[0], vn[1]);
      bV[1] = pack8(vn[2], vn[3]);
#pragma unroll
      for (int mt = 0; mt < 8; ++mt) S[mt] = S[mt] * gend;
      __builtin_amdgcn_sched_barrier(0);
#pragma unroll
      for (int ks = 0; ks < 2; ++ks)
#pragma unroll
        for (int mt = 0; mt < 8; ++mt) S[mt] = mfma16(fr[mt * 2 + ks], bV[ks], S[mt]);
      __builtin_amdgcn_sched_barrier(0);
#pragma unroll
      for (int i = 0; i < 16; ++i) fr[i] = *(const bf16x8*)(Lq + (i * 64 + lane) * 16);
      __builtin_amdgcn_sched_barrier(0);
      f32x4 oacc[4];
#pragma unroll
      for (int mi = 0; mi < 4; ++mi) oacc[mi] = (f32x4){0.f, 0.f, 0.f, 0.f};
#pragma unroll
      for (int ks = 0; ks < 4; ++ks)
#pragma unroll
        for (int mi = 0; mi < 4; ++mi) oacc[mi] = mfma16(fr[mi * 4 + ks], bS[ks], oacc[mi]);
      __builtin_amdgcn_sched_barrier(0);
#pragma unroll
      for (int i = 0; i < 8; ++i) fr[i] = *(const bf16x8*)(La + (i * 64 + lane) * 16);
      __builtin_amdgcn_sched_barrier(0);
#pragma unroll
      for (int ks = 0; ks < 2; ++ks)
#pragma unroll
        for (int mi = 0; mi < 4; ++mi) oacc[mi] = mfma16(fr[mi * 2 + ks], bV[ks], oacc[mi]);
      __builtin_amdgcn_sched_barrier(0);
#pragma unroll
      for (int mi = 0; mi < 4; ++mi)
#pragma unroll
        for (int jj = 0; jj < 4; ++jj)
          *(u16*)(Lo + (16 * mi + 4 * quad + jj) * 128 + (wave * 16 + l15) * 2) = (u16)f2bf(oacc[mi][jj]);
      RAW_BARRIER();
    }
    {
      const int tokp = b * 8192 + 127 * 64;
#pragma unroll
      for (int k2 = 0; k2 < 2; ++k2) {
        const int idx = tid + 256 * k2, row = idx >> 3, part = idx & 7;
        *(u32x4*)(o_g + (size_t)(tokp + row) * 4096 + h * 128 + half * 64 + part * 8) = *(const u32x4*)(Lo + idx * 16);
      }
      RAW_BARRIER();
    }
  }
}

#undef SCAN_LOAD
#undef SCAN_WAIT

DI void gate_phase(const Params& p) {
  char* ws = p.ws;
  const u16* proj = (const u16*)(ws + OFF_PROJ);
  u16* y0 = (u16*)(ws + OFF_R + 32 * MiB);
  const int tidg = tidx();
  const int lane = tidg & 63, l15 = lane & 15, quad = lane >> 4;
  const int gw = blockIdx.x * 4 + (tidg >> 6), nw = gridDim.x * 4;
  float wn[8];
#pragma unroll
  for (int e = 0; e < 8; ++e) wn[e] = p.a_o_norm_w[l15 * 8 + e];
  for (int r4 = gw; r4 < 32768; r4 += nw) {
    const int rh = r4 * 4 + quad, tok = rh >> 3, h = rh & 7;
    float o[8], z[8];
    unpack8(*(const u32x4*)(proj + (size_t)tok * 4096 + h * 128 + l15 * 8), o);
    unpack8(*(const u32x4*)(proj + (size_t)tok * 4096 + 3072 + h * 128 + l15 * 8), z);
    float ssq = 0.f;
#pragma unroll
    for (int e = 0; e < 8; ++e) ssq += o[e] * o[e];
    ssq += __shfl_xor(ssq, 1); ssq += __shfl_xor(ssq, 2); ssq += __shfl_xor(ssq, 4); ssq += __shfl_xor(ssq, 8);
    const float rs = rsqrtf(ssq * (1.f / 128.f) + kEps);
#pragma unroll
    for (int e = 0; e < 8; ++e) o[e] = o[e] * rs * wn[e] * silu(z[e]);
    *(u32x4*)(y0 + (size_t)tok * 1024 + h * 128 + l15 * 8) = packf8(o);
  }
}

DI void qknorm_cumsum(const Params& p, char* smem) {
  char* ws = p.ws;
  u16* proj = (u16*)(ws + OFF_PROJ);
  const int tid = tidx(), lane = tid & 63, l15 = lane & 15, quad = lane >> 4;
  const int gw = blockIdx.x * 4 + (tid >> 6), nw = gridDim.x * 4;
  for (int idx = gw; idx < 65536; idx += nw) {
    const int which = idx >> 15, r4 = idx & 32767;
    const int rh = r4 * 4 + quad, tok = rh >> 3, h = rh & 7;
    const float* wv = which ? p.b_k_norm_w : p.b_q_norm_w;
    u16* ptr = proj + (size_t)tok * 4096 + which * 1024 + h * 128 + l15 * 8;
    float v[8];
    unpack8(*(const u32x4*)ptr, v);
    float ssq = 0.f;
#pragma unroll
    for (int e = 0; e < 8; ++e) ssq += v[e] * v[e];
    ssq += __shfl_xor(ssq, 1); ssq += __shfl_xor(ssq, 2); ssq += __shfl_xor(ssq, 4); ssq += __shfl_xor(ssq, 8);
    const float rs = rsqrtf(ssq * (1.f / 128.f) + kEps) * (which ? 1.f : kScale);
#pragma unroll
    for (int e = 0; e < 8; ++e) v[e] = v[e] * rs * wv[l15 * 8 + e];
    *(u32x4*)ptr = packf8(v);
  }
}

DI void attn_phase(const Params& p, char* smem) {
  char* ws = p.ws;
  const u16* proj = (const u16*)(ws + OFF_PROJ);
  const u16* vT = (const u16*)(ws + OFF_R + 32 * MiB);
  const float* fraw = (const float*)(ws + OFF_FRAW);
  u16* y1 = (u16*)(ws + OFF_R + 64 * MiB);
  float* bias_s = (float*)(smem + 65536);
  float* ca_s = bias_s + 128;
  const int tid_ = tidx();
  float mq = 0.f, mk = 0.f;
  for (int i = 0; i < 128; ++i) { mq = fmaxf(mq, fabsf(p.b_q_norm_w[i])); mk = fmaxf(mk, fabsf(p.b_k_norm_w[i])); }
  const float QKB = 128.f * kScale * mq * mk;
  float* mmin_s = (float*)(smem + 66320);

  unsigned* qctr = (unsigned*)(ws + OFF_BAR) + XCD_BAR_WORDS;
  int* qslot = (int*)(smem + 66304);
  int qx = blockIdx.x & 7, qtries = 0;
  while (true) {
    const int tid = relaunder(tid_), lane = tid & 63, wave = tid >> 6, l15 = lane & 15, quad = lane >> 4;
    if (tid == 0) *qslot = (int)atomicAdd(qctr + qx * 16, 1u);
    __syncthreads();
    const int it = *qslot;
    __syncthreads();
    if (it >= 128) { if (++qtries >= 8) break; qx = (qx + 1) & 7; continue; }
    const int qb = 63 - (it & 63);
    const int b = it >> 6, h = b ? ((qx + 4) & 7) : qx, bh = b * 8 + h, i0 = qb * 128;
    const int qrow0 = i0 + 32 * wave;
    const float fb = p.b_f_bias[h];
    bf16x8 bq[2][4];
#pragma unroll
    for (int nq = 0; nq < 2; ++nq)
#pragma unroll
      for (int ks = 0; ks < 4; ++ks)
        bq[nq][ks] = *(const bf16x8*)(proj + (size_t)(b * 8192 + qrow0 + 16 * nq + l15) * 4096 + h * 128 + 32 * ks + 8 * quad);
    f32x4 O[8][2];
#pragma unroll
    for (int dt = 0; dt < 8; ++dt) { O[dt][0] = (f32x4){0.f, 0.f, 0.f, 0.f}; O[dt][1] = (f32x4){0.f, 0.f, 0.f, 0.f}; }
    float mrun[2] = {-1e30f, -1e30f}, lrun[2] = {0.f, 0.f};

    const int kkey = wave * 4 + (lane >> 4);
    const int kch = (lane & 15) ^ (kkey & 15);
    const u16* Kg = proj + (size_t)(b * 8192 + kkey) * 4096 + 1024 + h * 128 + kch * 8;
    const int vd = wave * 8 + (lane >> 3);
    const int vch = (lane & 7) ^ ((((wave & 1) << 2) + (lane >> 4)) & 7);
    const u16* Vg = vT + (size_t)(bh * 128 + vd) * 8192 + vch * 8;
#define ATT_STAGE(buf, j0_)                                                                                                   \
  do {                                                                                                                        \
    _Pragma("unroll") for (int i = 0; i < 4; ++i) {                                                                           \
      __builtin_amdgcn_global_load_lds((const unsigned*)(Kg + (size_t)((j0_) + 16 * i) * 4096),                               \
                                       (unsigned*)(smem + (buf) * 32768 + (i * 4 + wave) * 1024), 16, 0, 0);                  \
      __builtin_amdgcn_global_load_lds((const unsigned*)(Vg + (size_t)(32 * i) * 8192 + (j0_)),                               \
                                       (unsigned*)(smem + (buf) * 32768 + 16384 + (i * 4 + wave) * 1024), 16, 0, 0);          \
    }                                                                                                                         \
  } while (0)
    int j0 = i0 + 64;
    ATT_STAGE(0, j0);
    float carry = 0.f, biasA = 0.f, frn = 0.f;
    if (wave == 0) {
      const float lfA = fraw[(size_t)(b * 8192 + i0 + lane) * 16 + h];
      const float lfB = fraw[(size_t)(b * 8192 + i0 + 64 + lane) * 16 + h];
      float pa = lfA, pb = lfB;
#pragma unroll
      for (int o = 1; o < 64; o <<= 1) {
        const float ta = __shfl_up(pa, o), tb = __shfl_up(pb, o);
        if (lane >= o) { pa += ta; pb += tb; }
      }
      const float lf0 = __shfl(lfA, 0), totA = __shfl(pa, 63);
      biasA = -(pa - lf0) * kLog2e;
      bias_s[lane] = -(totA - lf0 + pb) * kLog2e;
      carry = lf0;
    }
    if (lane == 0) { mmin_s[wave] = -1e30f; mmin_s[4 + wave] = -1e30f; }
    asm volatile("s_waitcnt vmcnt(0)" ::: "memory");
    __syncthreads();
    auto att_tile = [&](const int cur, const bool diag) __attribute__((always_inline)) -> bool {
      const int nj = j0 - 64;
      bool more = nj >= 0;
      if (more && j0 <= i0) {
        const float* mm = mmin_s + cur * 4;
        const float mmin = fminf(fminf(mm[0], mm[1]), fminf(mm[2], mm[3]));
        more = !((QKB + ca_s[cur]) * kLog2e < mmin - 30.f * kLog2e);
      }
      if (more) {
        ATT_STAGE(cur ^ 1, nj);
        if (wave == 0 && nj < i0) frn = fraw[(size_t)(b * 8192 + nj + lane) * 16 + h];
      }
      if (j0 <= qrow0 + 31) {
        const char* Ks = smem + cur * 32768;
        const char* Vs = Ks + 16384;
        const float* cs = bias_s + cur * 64;
        f32x4 s[4][2];
#pragma unroll
        for (int kt = 0; kt < 4; ++kt) { s[kt][0] = (f32x4){0.f, 0.f, 0.f, 0.f}; s[kt][1] = (f32x4){0.f, 0.f, 0.f, 0.f}; }
#pragma unroll
        for (int ks = 0; ks < 4; ++ks)
#pragma unroll
          for (int kt = 0; kt < 4; ++kt) {
            const int kl = 16 * kt + l15;
            const bf16x8 ak = *(const bf16x8*)(Ks + kl * 256 + (((ks * 4 + quad) ^ (kl & 15)) << 4));
            s[kt][0] = mfma16(ak, bq[0][ks], s[kt][0]);
            s[kt][1] = mfma16(ak, bq[1][ks], s[kt][1]);
          }
#pragma unroll
        for (int kt = 0; kt < 4; ++kt) {
          const f32x4 bias = *(const f32x4*)(cs + 16 * kt + 4 * quad);
#pragma unroll
          for (int nq = 0; nq < 2; ++nq)
#pragma unroll
            for (int jj = 0; jj < 4; ++jj) {
              float v = s[kt][nq][jj] + bias[jj];
              if (diag) { if (j0 + 16 * kt + 4 * quad + jj > qrow0 + 16 * nq + l15) v = -1e30f; }
              s[kt][nq][jj] = v;
            }
        }
        bf16x8 bP[2][2];
#pragma unroll
        for (int nq = 0; nq < 2; ++nq) {
          float tmax = -1e30f;
#pragma unroll
          for (int kt = 0; kt < 4; ++kt)
#pragma unroll
            for (int jj = 0; jj < 4; ++jj) tmax = fmaxf(tmax, s[kt][nq][jj]);
          tmax = fmaxf(tmax, __shfl_xor(tmax, 16));
          tmax = fmaxf(tmax, __shfl_xor(tmax, 32));
          const float mnew = fmaxf(mrun[nq], tmax);
          const float alpha = __builtin_amdgcn_exp2f(mrun[nq] - mnew);
          const bool grew = mnew > mrun[nq];
          mrun[nq] = mnew;
          float psum = 0.f;
#pragma unroll
          for (int kt = 0; kt < 4; ++kt)
#pragma unroll
            for (int jj = 0; jj < 4; ++jj) { const float pv = __builtin_amdgcn_exp2f(s[kt][nq][jj] - mnew); s[kt][nq][jj] = pv; psum += pv; }
          lrun[nq] = lrun[nq] * alpha + psum;
          if (__builtin_amdgcn_ballot_w64(grew) != 0ull) {
#pragma unroll
            for (int dt = 0; dt < 8; ++dt) O[dt][nq] = O[dt][nq] * alpha;
          }
          bP[0][nq] = pack8(s[0][nq], s[1][nq]);
          bP[1][nq] = pack8(s[2][nq], s[3][nq]);
        }
#pragma unroll
        for (int ks = 0; ks < 2; ++ks)
#pragma unroll
          for (int dt = 0; dt < 8; ++dt) {
            const int d = 16 * dt + l15, sw = (d >> 1) & 7, c0 = 4 * ks + (quad >> 1);
            const u32x2 lo = *(const u32x2*)(Vs + d * 128 + ((c0 ^ sw) << 4) + (quad & 1) * 8);
            const u32x2 hi = *(const u32x2*)(Vs + d * 128 + (((c0 + 2) ^ sw) << 4) + (quad & 1) * 8);
            const bf16x8 av = mk8(lo, hi);
            O[dt][0] = mfma16(av, bP[ks][0], O[dt][0]);
            O[dt][1] = mfma16(av, bP[ks][1], O[dt][1]);
          }
        float wm = fminf(mrun[0], mrun[1]);
        wm = fminf(wm, dpp_f<0x121>(wm)); wm = fminf(wm, dpp_f<0x122>(wm)); wm = fminf(wm, dpp_f<0x124>(wm)); wm = fminf(wm, dpp_f<0x128>(wm));
        wm = fminf(fminf(readlane_f(wm, 0), readlane_f(wm, 16)), fminf(readlane_f(wm, 32), readlane_f(wm, 48)));
        if (lane == 0) mmin_s[(cur ^ 1) * 4 + wave] = wm;
      }
      if (more && wave == 0) {
        const int nb = cur ^ 1;
        if (nj == i0) {
          bias_s[nb * 64 + lane] = biasA;
          if (lane == 0) ca_s[nb] = carry;
        } else {
          const float lf = frn;
          float x = lf;
          x += dpp_f<0x101>(x); x += dpp_f<0x102>(x); x += dpp_f<0x104>(x); x += dpp_f<0x108>(x);
          const float t0 = readlane_f(x, 0), t1 = readlane_f(x, 16), t2 = readlane_f(x, 32), t3 = readlane_f(x, 48);
          const int rowi = lane >> 4;
          const float radd = (rowi == 0) ? (t1 + t2 + t3) : (rowi == 1) ? (t2 + t3) : (rowi == 2) ? t3 : 0.f;
          const float sf = x + radd;
          bias_s[nb * 64 + lane] = (sf - lf + carry) * kLog2e;
          carry += (t0 + t1) + (t2 + t3);
          if (lane == 0) ca_s[nb] = carry;
        }
      }
      asm volatile("s_waitcnt vmcnt(0)" ::: "memory");
      __syncthreads();
      if (!more) return false;
      j0 = nj;
      return true;
    };
    if (att_tile(0, true) && att_tile(1, true)) {
      while (true) {
        if (!att_tile(0, false)) break;
        if (!att_tile(1, false)) break;
      }
    }
#undef ATT_STAGE
#pragma unroll
    for (int nq = 0; nq < 2; ++nq) {
      float l = lrun[nq];
      l += __shfl_xor(l, 16);
      l += __shfl_xor(l, 32);
      const float inv = 1.f / l;
      const size_t tok = (size_t)(b * 8192 + qrow0 + 16 * nq + l15);
#pragma unroll
      for (int dt = 0; dt < 8; ++dt) {
        const int d = 16 * dt + 4 * quad;
        const u32x2 z2 = *(const u32x2*)(proj + tok * 4096 + 3072 + h * 128 + d);
        const f32x4 o = O[dt][nq] * inv;
        u32x2 r = {pack2(o[0] * silu(bflo(z2.x)), o[1] * silu(bfhi(z2.x))), pack2(o[2] * silu(bflo(z2.y)), o[3] * silu(bfhi(z2.y)))};
        *(u32x2*)(y1 + tok * 1024 + h * 128 + d) = r;
      }
    }
  }
}

DI void final_norm(const Params& p) {
  const float* ss2 = (const float*)(p.ws + OFF_SS2);
  const int tidf = tidx();
  const int lane = tidf & 63;
  const int gw = blockIdx.x * 4 + (tidf >> 6), nw = gridDim.x * 4;
  const f32x4* w = (const f32x4*)p.final_norm_w;
  f32x4 wv[4];
#pragma unroll
  for (int i = 0; i < 4; ++i) wv[i] = w[lane + 64 * i];
  for (int row = gw; row < 16384; row += 4 * nw) {
    u32x2 r[4][4];
    float rs[4];
#pragma unroll
    for (int k = 0; k < 4; ++k) {
      const int rr = row + k * nw;
      const bool okr = rr < 16384;
      const int rc = okr ? rr : row;
      rs[k] = rsqrtf(ss2[rc] * (1.f / 1024.f) + kEps);
      const u32x2* hsrc = (const u32x2*)((const u16*)(p.ws + OFF_R) + (size_t)rc * 1024);
#pragma unroll
      for (int i = 0; i < 4; ++i) r[k][i] = hsrc[lane + 64 * i];
    }
#pragma unroll
    for (int k = 0; k < 4; ++k) {
      const int rr = row + k * nw;
      if (rr < 16384) {
        f32x4* o = (f32x4*)(p.out + (size_t)rr * 1024);
#pragma unroll
        for (int i = 0; i < 4; ++i) {
          f32x4 v = {bflo(r[k][i].x), bfhi(r[k][i].x), bflo(r[k][i].y), bfhi(r[k][i].y)};
          __builtin_nontemporal_store(v * rs[k] * wv[i], o + lane + 64 * i);
        }
      }
    }
  }
}

__global__ void __launch_bounds__(kThreads, 2) fwd_megakernel(Params p) {
  extern __shared__ __attribute__((aligned(16))) char smem[];
  cg::grid_group grid = cg::this_grid();
  char* ws = p.ws;
  __shared__ uint4 xb_words;
  if (threadIdx.x == 0) xb_words = make_uint4(0u, 0u, 0u, 0u);
  __syncthreads();
  if (p.ws == nullptr) grid.sync();
  XcdBarrier xb = xcd_barrier_post((unsigned*)(ws + OFF_BAR), (volatile LAS unsigned*)&xb_words);
  phase0(p, smem);
  xcd_barrier(xb);
  gemm_phase<1>(p, (const u16*)(ws + OFF_R), (const u16*)(ws + OFF_WTA_IN), 32, smem);
  skinny_gemm<0>(p, (const u16*)(ws + OFF_R), (const u16*)(ws + OFF_WTA_IN) + (size_t)4096 * 1024, (float*)(ws + OFF_BRAW));
  xcd_barrier(xb);
  {
    const bool overlap = gridDim.x >= 128;
    const int G = (int)gridDim.x, hG = G >> 1, bi = (int)blockIdx.x;
    const bool is_scan = overlap && bi < 32, is_idle = overlap && bi >= hG && bi < hG + 32;
    const int pfirst = overlap ? (bi < hG ? 32 : 64) : 0, pn = overlap ? G - 64 : G;
    if (!is_scan && !is_idle) delta_prep(p, smem, pfirst, pn);
    if (!is_scan && !is_idle) phase0b(p, smem, pfirst, pn);
    if (!overlap) xcd_barrier(xb);
    if (!overlap || blockIdx.x < 32) delta_scan(p, smem);
    xcd_barrier(xb);
  }
  gate_phase(p);
  xcd_barrier(xb);
  gemm_phase<2>(p, (const u16*)(ws + OFF_R + 32 * MiB), (const u16*)(ws + OFF_WTA_OUT), 8, smem);
  xcd_barrier(xb);
  gemm_phase<3>(p, (const u16*)(ws + OFF_R), (const u16*)(ws + OFF_WTB_IN), 32, smem);
  skinny_gemm<1>(p, (const u16*)(ws + OFF_R), (const u16*)(ws + OFF_WTB_IN) + (size_t)4096 * 1024, (float*)(ws + OFF_FRAW));
  xcd_barrier(xb);
  attn_phase(p, smem);
  xcd_barrier(xb);
  gemm_phase<4>(p, (const u16*)(ws + OFF_R + 64 * MiB), (const u16*)(ws + OFF_WTB_OUT), 8, smem);
  xcd_barrier(xb);
  final_norm(p);
}

extern "C" void kernel_launch(void* const* d_in, const int* in_sizes, int n_in, void* d_out, int out_size, void* d_ws, size_t ws_size,
                              hipStream_t stream) {
  static int grid_blocks = 0;
  if (!grid_blocks) {
    int dev = 0, cus = 0, per_cu = 0;
    hipGetDevice(&dev);
    hipDeviceGetAttribute(&cus, hipDeviceAttributeMultiprocessorCount, dev);
    hipFuncSetAttribute((const void*)fwd_megakernel, hipFuncAttributeMaxDynamicSharedMemorySize, kLds);
    hipOccupancyMaxActiveBlocksPerMultiprocessor(&per_cu, (const void*)fwd_megakernel, kThreads, kLds);
    if (per_cu < 1) per_cu = 1;
    if (per_cu > 2) per_cu = 2;
    grid_blocks = cus * per_cu;
  }
  Params p{};
  p.x = (const float*)d_in[0]; p.a_norm_w = (const float*)d_in[1]; p.a_w_in = (const float*)d_in[2]; p.a_conv_w = (const float*)d_in[3];
  p.a_A_log = (const float*)d_in[4]; p.a_dt_bias = (const float*)d_in[5]; p.a_o_norm_w = (const float*)d_in[6]; p.a_w_out = (const float*)d_in[7];
  p.b_norm_w = (const float*)d_in[8]; p.b_w_in = (const float*)d_in[9]; p.b_f_bias = (const float*)d_in[10]; p.b_q_norm_w = (const float*)d_in[11];
  p.b_k_norm_w = (const float*)d_in[12]; p.b_w_out = (const float*)d_in[13]; p.final_norm_w = (const float*)d_in[14];
  p.out = (float*)d_out;
  p.ws = (char*)d_ws;
  hipMemsetAsync((char*)d_ws + OFF_BAR, 0, CTL_BYTES, stream);
  void* args[] = {&p};
  hipError_t e = hipLaunchCooperativeKernel((const void*)fwd_megakernel, dim3(grid_blocks), dim3(kThreads), args, kLds, stream);
  if (e != hipSuccess) fprintf(stderr, "cooperative launch failed: %s (grid %d)\n", hipGetErrorString(e), grid_blocks);
}
```

```cpp
#include <hip/hip_runtime.h>
#include <hip/hip_cooperative_groups.h>
#include <cstdio>
namespace cg = cooperative_groups;

typedef unsigned short u16;
typedef __attribute__((ext_vector_type(8))) short bf16x8;
typedef __attribute__((ext_vector_type(4))) float f32x4;
typedef __attribute__((ext_vector_type(4))) unsigned u32x4;
typedef __attribute__((ext_vector_type(2))) unsigned u32x2;
#define DI __device__ __forceinline__

constexpr int kThreads = 256;
constexpr int kLds = 69632;
constexpr float kEps = 1e-6f;
constexpr float kScale = 0.08838834764831845f;
constexpr float kLog2e = 1.4426950408889634f;

constexpr size_t MiB = 1048576;
constexpr size_t OFF_WTA_IN = 0;
constexpr size_t OFF_WTA_OUT = 8650752;
constexpr size_t OFF_WTB_IN = 10747904;
constexpr size_t OFF_WTB_OUT = 19398656;
constexpr size_t OFF_SMALL = 21495808;
constexpr size_t OFF_RS0 = OFF_SMALL;
constexpr size_t OFF_SS1 = OFF_RS0 + 65536;
constexpr size_t OFF_SS2 = OFF_SS1 + 65536;
constexpr size_t OFF_BRAW = OFF_SS2 + 65536;
constexpr size_t OFF_FRAW = OFF_BRAW + 1048576;
constexpr size_t OFF_CCUM = OFF_FRAW + 1048576;
constexpr size_t OFF_GEND = OFF_CCUM + 524288;
constexpr size_t OFF_BAR = OFF_GEND + 8192;
constexpr size_t OFF_FLAGS = OFF_BAR + 13824 + 512;
constexpr size_t CTL_BYTES = 13824 + 512 + 8192;
constexpr size_t OFF_PROJ = OFF_SMALL + 3 * MiB;
constexpr size_t OFF_R = OFF_PROJ + 128 * MiB;

struct Params {
  const float *x, *a_norm_w, *a_w_in, *a_conv_w, *a_A_log, *a_dt_bias, *a_o_norm_w, *a_w_out;
  const float *b_norm_w, *b_w_in, *b_f_bias, *b_q_norm_w, *b_k_norm_w, *b_w_out, *final_norm_w;
  float* out;
  char* ws;
};

typedef __attribute__((ext_vector_type(2))) float f32x2;
typedef __attribute__((ext_vector_type(2))) __bf16 bf16x2_t;
DI unsigned pack2(float a, float b) { f32x2 v = {a, b}; return __builtin_bit_cast(unsigned, __builtin_convertvector(v, bf16x2_t)); }
DI unsigned f2bf(float x) { return pack2(x, 0.f) & 0xffffu; }
DI float bflo(unsigned u) { return __uint_as_float(u << 16); }
DI float bfhi(unsigned u) { return __uint_as_float(u & 0xffff0000u); }
DI f32x4 mfma16(bf16x8 a, bf16x8 b, f32x4 c) { return __builtin_amdgcn_mfma_f32_16x16x32_bf16(a, b, c, 0, 0, 0); }
DI bf16x8 mk8(u32x2 lo, u32x2 hi) { u32x4 v = {lo.x, lo.y, hi.x, hi.y}; return __builtin_bit_cast(bf16x8, v); }
DI bf16x8 pack8(f32x4 a, f32x4 b) { u32x4 v = {pack2(a[0], a[1]), pack2(a[2], a[3]), pack2(b[0], b[1]), pack2(b[2], b[3])}; return __builtin_bit_cast(bf16x8, v); }
DI bf16x8 ld2(const u16* p) { return mk8(*(const u32x2*)p, *(const u32x2*)(p + 16)); }
DI int relaunder(int t) { asm volatile("" : "+v"(t)); return t; }
DI int tidx() { int t = threadIdx.x; asm volatile("" : "+v"(t)); return t; }
template <int CTRL> DI float dpp_f(float x) { return __int_as_float(__builtin_amdgcn_update_dpp(0, __float_as_int(x), CTRL, 0xF, 0xF, true)); }
DI float readlane_f(float x, const int l) { return __int_as_float(__builtin_amdgcn_readlane(__float_as_int(x), l)); }
DI float silu(float x) { return x / (1.f + __expf(-x)); }
DI void unpack8(u32x4 v, float* f) {
  f[0] = bflo(v.x); f[1] = bfhi(v.x); f[2] = bflo(v.y); f[3] = bfhi(v.y);
  f[4] = bflo(v.z); f[5] = bfhi(v.z); f[6] = bflo(v.w); f[7] = bfhi(v.w);
}
DI u32x4 packf8(const float* f) { u32x4 v = {pack2(f[0], f[1]), pack2(f[2], f[3]), pack2(f[4], f[5]), pack2(f[6], f[7])}; return v; }


#define XB_TMO      128
#define XB_XCNT(j)  (256  + 64 * (j))
#define XB_XSUB(j)  (1280 + 64 * (j))
#define XB_XGEN(j)  (2304 + 64 * (j))
#define XB_TOP      3328
#define XB_TOPGEN   3392
#define XCD_BAR_WORDS 3456
#define XB_SPIN_CAP (1u << 23)
#define LAS __attribute__((address_space(3)))
DI unsigned xb_ld(unsigned* p) { return __hip_atomic_load(p, __ATOMIC_RELAXED, __HIP_MEMORY_SCOPE_AGENT); }
DI unsigned xb_add(unsigned* p, unsigned v) { return __hip_atomic_fetch_add(p, v, __ATOMIC_RELAXED, __HIP_MEMORY_SCOPE_AGENT); }
DI unsigned xb_xcc_id() { return (unsigned)__builtin_amdgcn_s_getreg((3 << 11) | 20) & 0xFu; }
#define XB_SPIN(cond, bar) do { unsigned _sp = 0; while (cond) { __builtin_amdgcn_s_sleep(1); \
    if ((++_sp & 255u) == 0u) { if (xb_ld(&(bar)[XB_TMO])) break; if (_sp > XB_SPIN_CAP) { atomicAdd(&(bar)[XB_TMO], 1u); break; } } } } while (0)
struct XcdBarrier { unsigned* bar; unsigned x; volatile LAS unsigned* st; };
DI XcdBarrier xcd_barrier_post(unsigned* bar, volatile LAS unsigned* st) {
  XcdBarrier b; b.bar = bar; b.x = xb_xcc_id(); b.st = st;
  if (threadIdx.x == 0) (void)xb_add(&bar[XB_XCNT(b.x)], 1u);
  return b;
}
DI void xcd_barrier_complete(unsigned* bar, unsigned x, unsigned& nloc, unsigned& nx) {
  const unsigned G = gridDim.x * gridDim.y * gridDim.z;
  unsigned sum, cnt, mine, sp = 0u;
  for (;;) {
    sum = 0u; cnt = 0u; mine = 0u;
#pragma unroll
    for (unsigned j = 0; j < 16; ++j) { const unsigned c = xb_ld(&bar[XB_XCNT(j)]); sum += c; cnt += (c > 0u) ? 1u : 0u; mine = (j == x) ? c : mine; }
    if (sum == G) break;
    __builtin_amdgcn_s_sleep(1);
    if ((++sp & 255u) == 0u) { if (xb_ld(&bar[XB_TMO])) break; if (sp > XB_SPIN_CAP) { atomicAdd(&bar[XB_TMO], 1u); break; } }
  }
  nloc = mine > 0u ? mine : 1u; nx = cnt > 0u ? cnt : 1u;
}
DI void xcd_barrier(const XcdBarrier& b) {
  asm volatile("s_waitcnt vmcnt(0)" ::: "memory");
  __syncthreads();
  if (threadIdx.x == 0) {
    unsigned* bar = b.bar;
    __builtin_amdgcn_s_waitcnt(0);
    unsigned nloc = b.st[0], nx = b.st[1];
    if (nloc == 0u) { xcd_barrier_complete(bar, b.x, nloc, nx); b.st[0] = nloc; b.st[1] = nx; }
    const unsigned old = xb_add(&bar[XB_XSUB(b.x)], 1u);
    const unsigned gen = old / nloc;
    if (old + 1u == (gen + 1u) * nloc) {
      __builtin_amdgcn_fence(__ATOMIC_RELEASE, "agent");
      asm volatile("s_waitcnt vmcnt(0)" ::: "memory");
      const unsigned og = xb_add(&bar[XB_TOP], 1u);
      const unsigned tg = og / nx;
      if (og + 1u == (tg + 1u) * nx) xb_add(&bar[XB_TOPGEN], 1u);
      else XB_SPIN(xb_ld(&bar[XB_TOPGEN]) == tg, bar);
      __builtin_amdgcn_fence(__ATOMIC_ACQUIRE, "agent");
      xb_add(&bar[XB_XGEN(b.x)], 1u);
      asm volatile("s_waitcnt vmcnt(0)" ::: "memory");
    } else {
      XB_SPIN(xb_ld(&bar[XB_XGEN(b.x)]) == gen, bar);
      __builtin_amdgcn_fence(__ATOMIC_ACQUIRE, "agent");
      asm volatile("s_waitcnt vmcnt(0)" ::: "memory");
    }
  }
  __syncthreads();
}

DI void transpose_tile(const float* __restrict__ W, int N, int Npad, const float* __restrict__ kscale, u16* __restrict__ WT, int tile, char* smem) {
  float(*t)[65] = (float(*)[65])smem;
  const int nt = Npad / 64;
  const int k0 = (tile / nt) * 64, n0 = (tile % nt) * 64;
  const int tid = tidx();
  {
    const int tx = tid & 63, ty = tid >> 6;
#pragma unroll 4
    for (int i = 0; i < 16; ++i) {
      const int k = k0 + ty + 4 * i, n = n0 + tx;
      float v = 0.f;
      if (n < N) { v = W[(size_t)k * N + n]; if (kscale) v *= kscale[k]; }
      t[ty + 4 * i][tx] = v;
    }
  }
  __syncthreads();
  {
    const int kx2 = (tid & 31) * 2, ny0 = tid >> 5;
#pragma unroll 4
    for (int i = 0; i < 8; ++i) {
      const int ny = ny0 + 8 * i;
      *(unsigned*)(WT + (size_t)(n0 + ny) * 1024 + k0 + kx2) = pack2(t[kx2][ny], t[kx2 + 1][ny]);
    }
  }
  __syncthreads();
}

DI void phase0(const Params& p, char* smem) {
  char* ws = p.ws;
  {
    float* ss = (float*)(ws + OFF_SS1);
    for (int i = blockIdx.x * kThreads + tidx(); i < 32768; i += gridDim.x * kThreads) ss[i] = 0.f;
  }
  for (int t = blockIdx.x; t < 1312; t += gridDim.x) {
    if (t < 1056) transpose_tile(p.a_w_in, 4112, 4224, p.a_norm_w, (u16*)(ws + OFF_WTA_IN), t, smem);
    else transpose_tile(p.a_w_out, 1024, 1024, nullptr, (u16*)(ws + OFF_WTA_OUT), t - 1056, smem);
  }
  const int tid0 = tidx();
  const int lane = tid0 & 63;
  const int gw = blockIdx.x * 4 + (tid0 >> 6), nw = gridDim.x * 4;
  u16* xb = (u16*)(ws + OFF_R);
  float* rs0 = (float*)(ws + OFF_RS0);
  for (int row = gw; row < 16384; row += 4 * nw) {
    f32x4 v[4][4];
#pragma unroll
    for (int k = 0; k < 4; ++k) {
      const int rr = row + k * nw;
      const f32x4* xr = (const f32x4*)(p.x + (size_t)(rr < 16384 ? rr : row) * 1024);
#pragma unroll
      for (int i = 0; i < 4; ++i) v[k][i] = __builtin_nontemporal_load(xr + lane + 64 * i);
    }
#pragma unroll
    for (int k = 0; k < 4; ++k) {
      const int rr = row + k * nw;
      float ss = 0.f;
#pragma unroll
      for (int i = 0; i < 4; ++i) ss += v[k][i][0] * v[k][i][0] + v[k][i][1] * v[k][i][1] + v[k][i][2] * v[k][i][2] + v[k][i][3] * v[k][i][3];
      ss += dpp_f<0x121>(ss); ss += dpp_f<0x122>(ss); ss += dpp_f<0x124>(ss); ss += dpp_f<0x128>(ss);
      ss = (readlane_f(ss, 0) + readlane_f(ss, 16)) + (readlane_f(ss, 32) + readlane_f(ss, 48));
      if (rr < 16384) {
        u32x2* xo = (u32x2*)(xb + (size_t)rr * 1024);
#pragma unroll
        for (int i = 0; i < 4; ++i) { u32x2 o = {pack2(v[k][i][0], v[k][i][1]), pack2(v[k][i][2], v[k][i][3])}; xo[lane + 64 * i] = o; }
        if (lane == 0) rs0[rr] = rsqrtf(ss * (1.f / 1024.f) + kEps);
      }
    }
  }
}

DI void phase0b(const Params& p, char* smem, int first, int nblk) {
  char* ws = p.ws;
  for (int t = (int)blockIdx.x - first; t < 1312; t += nblk) {
    if (t < 1056) transpose_tile(p.b_w_in, 4104, 4224, p.b_norm_w, (u16*)(ws + OFF_WTB_IN), t, smem);
    else transpose_tile(p.b_w_out, 1024, 1024, nullptr, (u16*)(ws + OFF_WTB_OUT), t - 1056, smem);
  }
}

template <int EPI>
DI void gemm_phase(const Params& p, const u16* __restrict__ A, const u16* __restrict__ Bt, int nTn, char* smem) {
  const int tid = tidx(), lane = tid & 63, wave = tid >> 6;
  const int wr = wave >> 1, wc = wave & 1;
  const int l15 = lane & 15, quad = lane >> 4;
  char* ws = p.ws;
  const int NX = ((gridDim.x & 7) == 0) ? 8 : 1;
  const int xg = blockIdx.x % NX, lb = blockIdx.x / NX, Lb = gridDim.x / NX;
  const int nTnG = nTn >> 3, nSuper = 16 * nTnG;
  const int srow = wave * 8 + (lane >> 3);
  const int sch = (lane & 7) ^ ((((wave & 1) << 2) + (lane >> 4)) & 7);
#define GEMM_TILE(seq_, tm_, tn_, ok_)                                                            \
  do {                                                                                            \
    const int sidx_ = xg + NX * ((seq_) >> 6);                                                    \
    ok_ = sidx_ < nSuper;                                                                         \
    const int tl_ = (seq_) & 63;                                                                  \
    tm_ = (sidx_ / nTnG) * 8 + (tl_ & 7);                                                         \
    tn_ = (sidx_ % nTnG) * 8 + (tl_ >> 3);                                                        \
  } while (0)
#define GEMM_STAGE(buf, kt)                                                                                                   \
  do {                                                                                                                        \
    _Pragma("unroll") for (int i = 0; i < 4; ++i) {                                                                           \
      __builtin_amdgcn_global_load_lds((const unsigned*)(Ag + (size_t)i * 32 * 1024 + (kt) * 64),                             \
                                       (unsigned*)(smem + (buf) * 32768 + (i * 4 + wave) * 1024), 16, 0, 0);                  \
      __builtin_amdgcn_global_load_lds((const unsigned*)(Bg + (size_t)i * 32 * 1024 + (kt) * 64),                             \
                                       (unsigned*)(smem + (buf) * 32768 + 16384 + (i * 4 + wave) * 1024), 16, 0, 0);          \
    }                                                                                                                         \
  } while (0)
  int seq = lb, tm, tn;
  bool ok;
  GEMM_TILE(seq, tm, tn, ok);
  const u16* Ag = A + (size_t)(tm * 128 + srow) * 1024 + sch * 8;
  const u16* Bg = Bt + (size_t)(tn * 128 + srow) * 1024 + sch * 8;
  if (ok) GEMM_STAGE(0, 0);
  while (ok) {
    int tm2, tn2;
    bool ok2;
    GEMM_TILE(seq + Lb, tm2, tn2, ok2);
    f32x4 acc[4][4];
#pragma unroll
    for (int a = 0; a < 4; ++a)
#pragma unroll
      for (int b = 0; b < 4; ++b) acc[a][b] = (f32x4){0.f, 0.f, 0.f, 0.f};
    asm volatile("s_waitcnt vmcnt(0)" ::: "memory");
    __syncthreads();
#pragma unroll 2
    for (int kt = 0; kt < 16; ++kt) {
      const int cur = kt & 1;
      if (kt + 1 < 16) GEMM_STAGE(cur ^ 1, kt + 1);
      else if (ok2) {
        Ag = A + (size_t)(tm2 * 128 + srow) * 1024 + sch * 8;
        Bg = Bt + (size_t)(tn2 * 128 + srow) * 1024 + sch * 8;
        GEMM_STAGE(0, 0);
      }
      const char* sa = smem + cur * 32768;
      const char* sb = sa + 16384;
#pragma unroll
      for (int ks = 0; ks < 2; ++ks) {
        bf16x8 fa[4], fb[4];
        const int ch = ks * 4 + quad;
#pragma unroll
        for (int mi = 0; mi < 4; ++mi) {
          const int row = wr * 64 + mi * 16 + l15;
          fa[mi] = *(const bf16x8*)(sa + row * 128 + ((ch ^ ((row >> 1) & 7)) << 4));
        }
#pragma unroll
        for (int ni = 0; ni < 4; ++ni) {
          const int row = wc * 64 + ni * 16 + l15;
          fb[ni] = *(const bf16x8*)(sb + row * 128 + ((ch ^ ((row >> 1) & 7)) << 4));
        }
#pragma unroll
        for (int ni = 0; ni < 4; ++ni)
#pragma unroll
          for (int mi = 0; mi < 4; ++mi) acc[ni][mi] = mfma16(fb[ni], fa[mi], acc[ni][mi]);
      }
      if (kt < 15) {
        asm volatile("s_waitcnt vmcnt(0)" ::: "memory");
        __syncthreads();
      }
    }
    float hnorm[4] = {1.f, 1.f, 1.f, 1.f};
    if constexpr (EPI == 3) {
      if (tn < 16) {
        float* part = (float*)(smem + 65536);
        float ssq[4];
#pragma unroll
        for (int mi = 0; mi < 4; ++mi) {
          const float rs = rsqrtf(((const float*)(ws + OFF_SS1))[tm * 128 + wr * 64 + mi * 16 + l15] * (1.f / 1024.f) + kEps);
          float s = 0.f;
#pragma unroll
          for (int ni = 0; ni < 4; ++ni) { const f32x4 v = acc[ni][mi] * rs; s += v[0] * v[0] + v[1] * v[1] + v[2] * v[2] + v[3] * v[3]; }
          s += __shfl_xor(s, 16);
          s += __shfl_xor(s, 32);
          ssq[mi] = s;
          if (quad == 0) part[(wr * 2 + wc) * 64 + mi * 16 + l15] = s;
        }
        __syncthreads();
#pragma unroll
        for (int mi = 0; mi < 4; ++mi) {
          const float tot = ssq[mi] + part[(wr * 2 + (wc ^ 1)) * 64 + mi * 16 + l15];
          hnorm[mi] = rsqrtf(tot * (1.f / 128.f) + kEps) * (tn < 8 ? kScale * kLog2e : 1.f);
        }
      }
    }
#pragma unroll
    for (int mi = 0; mi < 4; ++mi) {
      const int m = tm * 128 + wr * 64 + mi * 16 + l15;
      if constexpr (EPI == 1) {
        const float rs = ((const float*)(ws + OFF_RS0))[m];
        u16* proj = (u16*)(ws + OFF_PROJ);
        float* braw = (float*)(ws + OFF_BRAW);
#pragma unroll
        for (int ni = 0; ni < 4; ++ni) {
          const int nb = tn * 128 + wc * 64 + ni * 16 + quad * 4;
          f32x4 v = acc[ni][mi] * rs;
          if (nb < 4096) { u32x2 o = {pack2(v[0], v[1]), pack2(v[2], v[3])}; __builtin_nontemporal_store(o, (u32x2*)(proj + (size_t)m * 4096 + nb)); }
          else if (nb < 4112) { *(f32x4*)(braw + (size_t)m * 16 + (nb - 4096)) = v; }
        }
      } else if constexpr (EPI == 2 || EPI == 4) {
        float* ssp = (float*)(ws + (EPI == 2 ? OFF_SS1 : OFF_SS2));
        u16* hb = (u16*)(ws + OFF_R);
        float ssq = 0.f;
#pragma unroll
        for (int ni = 0; ni < 4; ++ni) {
          const int nb = tn * 128 + wc * 64 + ni * 16 + quad * 4;
          f32x4 v;
          if constexpr (EPI == 2) {
            v = acc[ni][mi] + __builtin_nontemporal_load((const f32x4*)(p.x + (size_t)m * 1024 + nb));
            u32x2 o = {pack2(v[0], v[1]), pack2(v[2], v[3])};
            *(u32x2*)(hb + (size_t)m * 1024 + nb) = o;
            v[0] = bflo(o.x); v[1] = bfhi(o.x); v[2] = bflo(o.y); v[3] = bfhi(o.y);
          } else {
            const u32x2 r = *(const u32x2*)(hb + (size_t)m * 1024 + nb);
            v = acc[ni][mi];
            v[0] += bflo(r.x); v[1] += bfhi(r.x); v[2] += bflo(r.y); v[3] += bfhi(r.y);
            const u32x2 o = {pack2(v[0], v[1]), pack2(v[2], v[3])};
            *(u32x2*)(hb + (size_t)m * 1024 + nb) = o;
            v[0] = bflo(o.x); v[1] = bfhi(o.x); v[2] = bflo(o.y); v[3] = bfhi(o.y);
          }
          ssq += v[0] * v[0] + v[1] * v[1] + v[2] * v[2] + v[3] * v[3];
        }
        ssq += __shfl_xor(ssq, 16);
        ssq += __shfl_xor(ssq, 32);
        if (quad == 0) atomicAdd(ssp + m, ssq);
      } else if constexpr (EPI == 3) {
        const float rs = rsqrtf(((const float*)(ws + OFF_SS1))[m] * (1.f / 1024.f) + kEps);
        u16* proj = (u16*)(ws + OFF_PROJ);
        u16* vT = (u16*)(ws + OFF_R + 32 * MiB);
        float* fraw = (float*)(ws + OFF_FRAW);
        float hs = 1.f;
        if (tn < 16) hs = hnorm[mi];
#pragma unroll
        for (int ni = 0; ni < 4; ++ni) {
          const int nb = tn * 128 + wc * 64 + ni * 16 + quad * 4;
          f32x4 v = acc[ni][mi] * rs;
          if (tn < 16) {
            const f32x4 wv = *(const f32x4*)((tn < 8 ? p.b_q_norm_w : p.b_k_norm_w) + (nb & 127));
            v = v * hs * wv;
          }
          if (nb < 4096) {
            if ((nb >> 10) != 2) { u32x2 o = {pack2(v[0], v[1]), pack2(v[2], v[3])}; __builtin_nontemporal_store(o, (u32x2*)(proj + (size_t)m * 4096 + nb)); }
            else {
              const int hd = nb - 2048;
              const int b = m >> 13, t = m & 8191;
              u16* dst = vT + ((size_t)(b * 1024 + hd)) * 8192 + t;
#pragma unroll
              for (int jj = 0; jj < 4; ++jj) dst[(size_t)jj * 8192] = (u16)f2bf(v[jj]);
            }
          } else if (nb < 4104) { *(f32x4*)(fraw + (size_t)m * 16 + (nb - 4096)) = v; }
        }
      }
    }
    seq += Lb; tm = tm2; tn = tn2; ok = ok2;
  }
#undef GEMM_STAGE
#undef GEMM_TILE
}


template <int MODE>
DI void skinny_gemm(const Params& p, const u16* __restrict__ A, const u16* __restrict__ Wt16, float* __restrict__ out) {
  const int tid = tidx(), lane = tid & 63, l15 = lane & 15, quad = lane >> 4;
  const int gw = blockIdx.x * 4 + (tid >> 6), nw = gridDim.x * 4;
  for (int mt = gw; mt < 1024; mt += nw) {
    const int m = mt * 16 + l15;
    const u16* ap = A + (size_t)m * 1024 + quad * 8;
    const u16* bp = Wt16 + (size_t)l15 * 1024 + quad * 8;
    f32x4 acc = {0.f, 0.f, 0.f, 0.f};
#pragma unroll 8
    for (int ks = 0; ks < 32; ++ks) acc = mfma16(*(const bf16x8*)(bp + ks * 32), *(const bf16x8*)(ap + ks * 32), acc);
    float rs;
    if constexpr (MODE == 0) rs = ((const float*)(p.ws + OFF_RS0))[m];
    else rs = rsqrtf(((const float*)(p.ws + OFF_SS1))[m] * (1.f / 1024.f) + kEps);
    f32x4 ov = acc * rs;
    if constexpr (MODE == 1) {
#pragma unroll
      for (int jj = 0; jj < 4; ++jj) {
        const int n = 4 * quad + jj;
        const float xv = ov[jj] + p.b_f_bias[n & 7];
        ov[jj] = fminf(xv, 0.f) - log1pf(__expf(-fabsf(xv)));
      }
    }
    *(f32x4*)(out + (size_t)m * 16 + 4 * quad) = ov;
  }
}

DI void delta_prep(const Params& p, char* smem, int first, int nblk) {
  char* ws = p.ws;
  const u16* proj = (const u16*)(ws + OFF_PROJ);
  const float* braw = (const float*)(ws + OFF_BRAW);
  u16* qd_g = (u16*)(ws + OFF_R);
  u16* kT_g = (u16*)(ws + OFF_R + 32 * MiB);
  u16* at_g = (u16*)(ws + OFF_R + 64 * MiB);
  u16* uT_g = (u16*)p.out;
  u16* w_g = (u16*)((char*)p.out + 32 * MiB);
  float* gend_g = (float*)(ws + OFF_GEND);
  char* qL = smem;
  char* kL = smem + 16384;
  char* vL = smem + 32768;
  float* As = (float*)(smem + 49152);
  float* sc = (float*)(smem + 66560);
  float* g_s = sc;
  float* beta_s = sc + 64;
  float* rq_s = sc + 128;
  float* rk_s = sc + 192;
  float* ssq_s = sc + 256;
  float* fu_s = sc + 384;
  float* fw_s = sc + 448;
  const int tid_ = tidx();

  unsigned* flags = (unsigned*)(ws + OFF_FLAGS);
  const __amdgpu_buffer_rsrc_t r_qd = __builtin_amdgcn_make_buffer_rsrc(qd_g, 0, 32 << 20, 0x00020000);
  const __amdgpu_buffer_rsrc_t r_kT = __builtin_amdgcn_make_buffer_rsrc(kT_g, 0, 32 << 20, 0x00020000);
  const __amdgpu_buffer_rsrc_t r_at = __builtin_amdgcn_make_buffer_rsrc(at_g, 0, 16 << 20, 0x00020000);
  const __amdgpu_buffer_rsrc_t r_uT = __builtin_amdgcn_make_buffer_rsrc(uT_g, 0, 32 << 20, 0x00020000);
  const __amdgpu_buffer_rsrc_t r_w = __builtin_amdgcn_make_buffer_rsrc(w_g, 0, 32 << 20, 0x00020000);
  if (nblk >= 256 && ((int)blockIdx.x - first) >= (nblk >> 1)) {
    for (int i = 0; i < 7; ++i) __builtin_amdgcn_s_sleep(127);
  }
  for (int j = (int)blockIdx.x - first; j < 2048; j += nblk) {
    const int c = j >> 4, b = (j >> 3) & 1, h = j & 7;
    const int item = (b * 128 + c) * 8 + h;
    const int tok0 = b * 8192 + c * 64;
    const int tid = relaunder(tid_), lane = tid & 63, wave = tid >> 6, l15 = lane & 15, quad = lane >> 4;
    if (wave == 3) {
      const int row = tok0 + lane;
      const float br = braw[(size_t)row * 16 + h];
      const float ar = braw[(size_t)row * 16 + 8 + h] + p.a_dt_bias[h];
      const float beta = 1.f / (1.f + __expf(-br));
      const float sp = fmaxf(ar, 0.f) + log1pf(__expf(-fabsf(ar)));
      float g = -__expf(p.a_A_log[h]) * sp;
#pragma unroll
      for (int o = 1; o < 64; o <<= 1) { float t = __shfl_up(g, o); if (lane >= o) g += t; }
      g_s[lane] = g;
      beta_s[lane] = beta;
    } else {
      const int sec = wave, cgi = l15, rr = quad;
      const int col = sec * 1024 + h * 128 + cgi * 8;
      float w0[8], w1[8], w2[8], w3[8];
#pragma unroll
      for (int e = 0; e < 8; ++e) {
        w0[e] = p.a_conv_w[0 * 3072 + col + e]; w1[e] = p.a_conv_w[1 * 3072 + col + e];
        w2[e] = p.a_conv_w[2 * 3072 + col + e]; w3[e] = p.a_conv_w[3 * 3072 + col + e];
      }
      const u16* src = proj + (size_t)(tok0 + rr * 16) * 4096 + col;
      float x0[8], x1[8], x2[8], x3[8];
      if (c == 0 && rr == 0) {
#pragma unroll
        for (int e = 0; e < 8; ++e) { x0[e] = 0.f; x1[e] = 0.f; x2[e] = 0.f; }
      } else {
        unpack8(*(const u32x4*)(src - 3 * 4096), x0);
        unpack8(*(const u32x4*)(src - 2 * 4096), x1);
        unpack8(*(const u32x4*)(src - 1 * 4096), x2);
      }
      char* dstL = smem + sec * 16384;
#pragma unroll 4
      for (int r = 0; r < 16; ++r) {
        unpack8(*(const u32x4*)(src + (size_t)r * 4096), x3);
        float y[8];
        float ssq = 0.f;
#pragma unroll
        for (int e = 0; e < 8; ++e) {
          float v = w0[e] * x0[e] + w1[e] * x1[e] + w2[e] * x2[e] + w3[e] * x3[e];
          v = silu(v);
          y[e] = v;
          ssq += v * v;
          x0[e] = x1[e]; x1[e] = x2[e]; x2[e] = x3[e];
        }
        ssq += dpp_f<0x121>(ssq); ssq += dpp_f<0x122>(ssq); ssq += dpp_f<0x124>(ssq); ssq += dpp_f<0x128>(ssq);
        const int row = rr * 16 + r;
        if (sec < 2 && cgi == 0) ssq_s[sec * 64 + row] = ssq;
        *(u32x4*)(dstL + row * 256 + ((cgi ^ (row & 15)) << 4)) = packf8(y);
      }
    }
    __syncthreads();
    if (tid < 64) {
      const float rq = rsqrtf(ssq_s[tid] + kEps), rk = rsqrtf(ssq_s[64 + tid] + kEps);
      const float gi = g_s[tid], g63 = g_s[63];
      const float eg = __expf(gi);
      rq_s[tid] = rq; rk_s[tid] = rk;
      const float be = beta_s[tid];
      fu_s[tid] = be;
      fw_s[tid] = be * rk * eg;
      ssq_s[tid] = rq * kScale * eg;
      ssq_s[64 + tid] = rk * __expf(g63 - gi);
      if (tid == 0) __hip_atomic_store(gend_g + item, __expf(g63), __ATOMIC_RELAXED, __HIP_MEMORY_SCOPE_AGENT);
    }
    __syncthreads();
    {
      const int tid = relaunder(tid_), lane = tid & 63, wave = tid >> 6, l15 = lane & 15, quad = lane >> 4;
      bf16x8 bk[4], bq[4];
      const int rowI = 16 * wave + l15;
#pragma unroll
      for (int ks = 0; ks < 4; ++ks) {
        const int off = rowI * 256 + (((ks * 4 + quad) ^ (rowI & 15)) << 4);
        bk[ks] = *(const bf16x8*)(kL + off);
        bq[ks] = *(const bf16x8*)(qL + off);
      }
      const int i = rowI;
      const float gi = g_s[i], bi = beta_s[i] * rk_s[i], qi = kScale * rq_s[i];
      u32x2 keep = {0u, 0u};
#pragma unroll
      for (int J = 0; J < 4; ++J) {
        f32x4 skk = {0.f, 0.f, 0.f, 0.f}, sqk = {0.f, 0.f, 0.f, 0.f};
        const int rowJ = 16 * J + l15;
#pragma unroll
        for (int ks = 0; ks < 4; ++ks) {
          const bf16x8 ak = *(const bf16x8*)(kL + rowJ * 256 + (((ks * 4 + quad) ^ (rowJ & 15)) << 4));
          skk = mfma16(ak, bk[ks], skk);
          sqk = mfma16(ak, bq[ks], sqk);
        }
        const f32x4 gj4 = *(const f32x4*)(g_s + 16 * J + 4 * quad);
        const f32x4 rk4 = *(const f32x4*)(rk_s + 16 * J + 4 * quad);
        f32x4 a4, t4;
#pragma unroll
        for (int jj = 0; jj < 4; ++jj) {
          const int j = 16 * J + 4 * quad + jj;
          const float dec = (i >= j) ? __expf(gi - gj4[jj]) : 0.f;
          a4[jj] = (i > j) ? bi * rk4[jj] * skk[jj] * dec : 0.f;
          t4[jj] = qi * rk4[jj] * sqk[jj] * dec;
        }
        *(f32x4*)(As + i * 68 + 16 * J + 4 * quad) = a4;
        const u32x2 half = {pack2(t4[0], t4[1]), pack2(t4[2], t4[3])};
        if ((J & 1) == 0) keep = half;
        else {
          const u32x4 fr = {keep.x, keep.y, half.x, half.y};
          __builtin_amdgcn_raw_buffer_store_b128(fr, r_at, item * 8192 + ((wave * 2 + (J >> 1)) * 64 + lane) * 16, 0, 16);
        }
      }
    }
    {
      const int tid = relaunder(tid_);
#pragma unroll
      for (int it = 0; it < 4; ++it) {
        const int idx = tid + 256 * it;
        const int f = idx >> 6, ln = idx & 63, fl = ln & 15, fq = ln >> 4;
        {
          const int mt = f >> 2, ks = f & 3, i = 16 * mt + fl;
          const int c0 = 4 * ks + (fq >> 1), o8 = (fq & 1) * 8;
          const u32x2 lo = *(const u32x2*)(qL + i * 256 + ((c0 ^ (i & 15)) << 4) + o8);
          const u32x2 hi = *(const u32x2*)(qL + i * 256 + (((c0 + 2) ^ (i & 15)) << 4) + o8);
          const float s = ssq_s[i];
          const u32x4 o = {pack2(bflo(lo.x) * s, bfhi(lo.x) * s), pack2(bflo(lo.y) * s, bfhi(lo.y) * s),
                           pack2(bflo(hi.x) * s, bfhi(hi.x) * s), pack2(bflo(hi.y) * s, bfhi(hi.y) * s)};
          __builtin_amdgcn_raw_buffer_store_b128(o, r_qd, item * 16384 + idx * 16, 0, 16);
        }
        {
          const int mt = f >> 1, ks = f & 1, dk = 16 * mt + fl;
          float v[8];
#pragma unroll
          for (int e = 0; e < 8; ++e) {
            const int i = 32 * ks + ((e < 4) ? (4 * fq + e) : (16 + 4 * fq + e - 4));
            const u16 raw = *(const u16*)(kL + i * 256 + (((dk >> 3) ^ (i & 15)) << 4) + (dk & 7) * 2);
            v[e] = __uint_as_float(((unsigned)raw) << 16) * ssq_s[64 + i];
          }
          __builtin_amdgcn_raw_buffer_store_b128(packf8(v), r_kT, item * 16384 + idx * 16, 0, 16);
        }
      }
    }
    __syncthreads();
    {
      float U[64];
      const int tid = relaunder(tid_), wave = tid >> 6;
      const int cc = tid & 127, ch = cc >> 3, e2 = (cc & 7) * 2;
      const char* srcL = (wave < 2) ? vL : kL;
      const float* fr = (wave < 2) ? fu_s : fw_s;
#pragma unroll
      for (int i = 0; i < 64; ++i) {
        int ii = i;
        asm volatile("" : "+v"(ii));
        const u16 raw = *(const u16*)(srcL + ii * 256 + ((ch ^ (ii & 15)) << 4) + e2);
        float acc = __uint_as_float(((unsigned)raw) << 16) * fr[ii];
#pragma unroll
        for (int j = 0; j < i; ++j) acc -= As[i * 68 + j] * U[j];
        U[i] = acc;
      }
      if (wave < 2) {
        const int dofs = item * 16384 + (((cc >> 4) * 4) * 256 + (cc & 15) * 4) * 2;
#pragma unroll
        for (int mi = 0; mi < 4; ++mi)
#pragma unroll
          for (int q4 = 0; q4 < 4; ++q4) {
            const u32x2 o = {pack2(U[16 * mi + 4 * q4], U[16 * mi + 4 * q4 + 1]), pack2(U[16 * mi + 4 * q4 + 2], U[16 * mi + 4 * q4 + 3])};
            __builtin_amdgcn_raw_buffer_store_b64(o, r_uT, dofs + (mi * 256 + q4 * 64) * 2, 0, 16);
          }
      } else {
#pragma unroll
        for (int i = 0; i < 64; ++i) {
          int ii = i;
          asm volatile("" : "+v"(ii));
          *(u16*)(qL + ii * 256 + ((ch ^ (ii & 15)) << 4) + e2) = (u16)f2bf(U[i]);
        }
      }
    }
    __syncthreads();
    {
      const int tid = relaunder(tid_);
#pragma unroll
      for (int it = 0; it < 4; ++it) {
        const int idx = tid + 256 * it;
        const int f = idx >> 6, ln = idx & 63, fl = ln & 15, fq = ln >> 4;
        const int mt = f >> 2, ks = f & 3, i = 16 * mt + fl;
        const int c0 = 4 * ks + (fq >> 1), o8 = (fq & 1) * 8;
        const u32x2 lo = *(const u32x2*)(qL + i * 256 + ((c0 ^ (i & 15)) << 4) + o8);
        const u32x2 hi = *(const u32x2*)(qL + i * 256 + (((c0 + 2) ^ (i & 15)) << 4) + o8);
        const u32x4 o = {lo.x, lo.y, hi.x, hi.y};
        __builtin_amdgcn_raw_buffer_store_b128(o, r_w, item * 16384 + idx * 16, 0, 16);
      }
    }
    asm volatile("s_waitcnt vmcnt(0)" ::: "memory");
    __syncthreads();
    if (relaunder(tid_) == 0) __hip_atomic_store(flags + item, 1u, __ATOMIC_RELAXED, __HIP_MEMORY_SCOPE_AGENT);
  }
}

#define RAW_BARRIER() do { asm volatile("s_waitcnt lgkmcnt(0)" ::: "memory"); __builtin_amdgcn_s_barrier(); asm volatile("" ::: "memory"); } while (0)
#define GAS __attribute__((address_space(1)))
#define SCAN_LOAD(item_)                                                                                          \
  do {                                                                                                            \
    const GAS char* wb_ = (const GAS char*)((const char*)w_g + (size_t)(item_) * 16384);                          \
    const GAS char* qb_ = (const GAS char*)((const char*)qd_g + (size_t)(item_) * 16384);                         \
    const GAS char* kb_ = (const GAS char*)((const char*)kT_g + (size_t)(item_) * 16384);                         \
    const GAS char* ab_ = (const GAS char*)((const char*)at_g + (size_t)(item_) * 8192);                          \
    const GAS char* ub_ = (const GAS char*)((const char*)uT_g + (size_t)(item_) * 16384);                         \
    asm volatile("" : "+s"(wb_), "+s"(qb_), "+s"(kb_), "+s"(ab_), "+s"(ub_));                                     \
    _Pragma("unroll") for (int j = 0; j < 4; ++j) {                                                               \
      R[j] = *(const GAS u32x4*)(wb_ + (toff + 4096u * j));                                                       \
      R[4 + j] = *(const GAS u32x4*)(qb_ + (toff + 4096u * j));                                                   \
      R[8 + j] = *(const GAS u32x4*)(kb_ + (toff + 4096u * j));                                                   \
    }                                                                                                             \
    _Pragma("unroll") for (int j = 0; j < 2; ++j) R[12 + j] = *(const GAS u32x4*)(ab_ + (toff + 4096u * j));     \
    _Pragma("unroll") for (int mi = 0; mi < 4; ++mi) un[mi] = *(const GAS u32x2*)(ub_ + (uoff + 512u * mi));     \
    gn = gend_g[item_];                                                                                           \
  } while (0)
DI void delta_scan(const Params& p, char* smem) {
  char* ws = p.ws;
  const u16* qd_g = (const u16*)(ws + OFF_R);
  const u16* kT_g = (const u16*)(ws + OFF_R + 32 * MiB);
  const u16* at_g = (const u16*)(ws + OFF_R + 64 * MiB);
  const u16* uT_g = (const u16*)p.out;
  const u16* w_g = (const u16*)((const char*)p.out + 32 * MiB);
  const float* gend_g = (const float*)(ws + OFF_GEND);
  u16* o_g = (u16*)(ws + OFF_PROJ);
  unsigned* flags = (unsigned*)(ws + OFF_FLAGS);
  const int tid = tidx(), lane = tid & 63, wave = tid >> 6, l15 = lane & 15, quad = lane >> 4;
  char* Lw = smem;
  char* Lq = smem + 16384;
  char* Lk = smem + 32768;
  char* La = smem + 49152;
  char* Lo = smem + 57344;
  for (int unit = blockIdx.x; unit < 32; unit += gridDim.x) {
    const int bh = unit & 15, half = unit >> 4, b = bh >> 3, h = bh & 7;
    const int slice = half * 4 + wave;
    f32x4 S[8];
#pragma unroll
    for (int i = 0; i < 8; ++i) S[i] = (f32x4){0.f, 0.f, 0.f, 0.f};
    const unsigned toff = (unsigned)tid * 16u, uoff = (unsigned)(slice * 256 + lane) * 8u;
    u32x4 R[14];
    u32x2 un[4];
    float gn;
#define SCAN_WAIT(flv_, item_)                                                                                         \
  do {                                                                                                                 \
    unsigned f_ = (flv_), sp_ = 0u;                                                                                    \
    while (f_ == 0u && sp_ < (1u << 24)) { __builtin_amdgcn_s_sleep(2); f_ = __hip_atomic_load(flags + (item_), __ATOMIC_RELAXED, __HIP_MEMORY_SCOPE_AGENT); ++sp_; } \
    __builtin_amdgcn_fence(__ATOMIC_ACQUIRE, "workgroup");           \
  } while (0)
    unsigned fl;
    {
      const int item = (b * 128) * 8 + h;
      SCAN_WAIT(0u, item);
      SCAN_LOAD(item);
      fl = __hip_atomic_load(flags + ((b * 128 + 1) * 8 + h), __ATOMIC_RELAXED, __HIP_MEMORY_SCOPE_AGENT);
    }
    for (int c = 0; c < 128; ++c) {
#pragma unroll
      for (int j = 0; j < 4; ++j) {
        *(u32x4*)(Lw + (tid + 256 * j) * 16) = R[j];
        *(u32x4*)(Lq + (tid + 256 * j) * 16) = R[4 + j];
        *(u32x4*)(Lk + (tid + 256 * j) * 16) = R[8 + j];
      }
#pragma unroll
      for (int j = 0; j < 2; ++j) *(u32x4*)(La + (tid + 256 * j) * 16) = R[12 + j];
      u32x2 uc[4];
#pragma unroll
      for (int mi = 0; mi < 4; ++mi) uc[mi] = un[mi];
      const float gend = gn;
      RAW_BARRIER();
      if (c + 1 < 128) SCAN_WAIT(fl, (b * 128 + c + 1) * 8 + h);
      if (c > 0) {
        const int tokp = b * 8192 + (c - 1) * 64;
#pragma unroll
        for (int k2 = 0; k2 < 2; ++k2) {
          const int idx = tid + 256 * k2, row = idx >> 3, part = idx & 7;
          *(u32x4*)(o_g + (size_t)(tokp + row) * 4096 + h * 128 + half * 64 + part * 8) = *(const u32x4*)(Lo + idx * 16);
        }
      }
      if (c + 1 < 128) {
        const int item = (b * 128 + c + 1) * 8 + h;
        SCAN_LOAD(item);
        fl = (c + 2 < 128) ? __hip_atomic_load(flags + (item + 8), __ATOMIC_RELAXED, __HIP_MEMORY_SCOPE_AGENT) : 1u;
      }
      __builtin_amdgcn_sched_barrier(0);
      bf16x8 bS[4];
#pragma unroll
      for (int ks = 0; ks < 4; ++ks) bS[ks] = pack8(S[2 * ks], S[2 * ks + 1]);
      bf16x8 fr[16];
#pragma unroll
      for (int i = 0; i < 16; ++i) fr[i] = *(const bf16x8*)(Lw + (i * 64 + lane) * 16);
      __builtin_amdgcn_sched_barrier(0);
      f32x4 vn[4];
#pragma unroll
      for (int mi = 0; mi < 4; ++mi) vn[mi] = (f32x4){0.f, 0.f, 0.f, 0.f};
#pragma unroll
      for (int ks = 0; ks < 4; ++ks)
#pragma unroll
        for (int mi = 0; mi < 4; ++mi) vn[mi] = mfma16(fr[mi * 4 + ks], bS[ks], vn[mi]);
      __builtin_amdgcn_sched_barrier(0);
#pragma unroll
      for (int i = 0; i < 16; ++i) fr[i] = *(const bf16x8*)(Lk + (i * 64 + lane) * 16);
#pragma unroll
      for (int mi = 0; mi < 4; ++mi) {
        vn[mi][0] = bflo(uc[mi].x) - vn[mi][0]; vn[mi][1] = bfhi(uc[mi].x) - vn[mi][1];
        vn[mi][2] = bflo(uc[mi].y) - vn[mi][2]; vn[mi][3] = bfhi(uc[mi].y) - vn[mi][3];
      }
      bf16x8 bV[2];
      bV[0] = pack8(vn[0], vn[1]);
      bV[1] = pack8(vn[2], vn[3]);
#pragma unroll
      for (int mt = 0; mt < 8; ++mt) S[mt] = S[mt] * gend;
      __builtin_amdgcn_sched_barrier(0);
#pragma unroll
      for (int ks = 0; ks < 2; ++ks)
#pragma unroll
        for (int mt = 0; mt < 8; ++mt) S[mt] = mfma16(fr[mt * 2 + ks], bV[ks], S[mt]);
      __builtin_amdgcn_sched_barrier(0);
#pragma unroll
      for (int i = 0; i < 16; ++i) fr[i] = *(const bf16x8*)(Lq + (i * 64 + lane) * 16);
      __builtin_amdgcn_sched_barrier(0);
      f32x4 oacc[4];
#pragma unroll
      for (int mi = 0; mi < 4; ++mi) oacc[mi] = (f32x4){0.f, 0.f, 0.f, 0.f};
#pragma unroll
      for (int ks = 0; ks < 4; ++ks)
#pragma unroll
        for (int mi = 0; mi < 4; ++mi) oacc[mi] = mfma16(fr[mi * 4 + ks], bS[ks], oacc[mi]);
      __builtin_amdgcn_sched_barrier(0);
#pragma unroll
      for (int i = 0; i < 8; ++i) fr[i] = *(const bf16x8*)(La + (i * 64 + lane) * 16);
      __builtin_amdgcn_sched_barrier(0);
#pragma unroll
      for (int ks = 0; ks < 2; ++ks)
#pragma unroll
        for (int mi = 0; mi < 4; ++mi) oacc[mi] = mfma16(fr[mi * 2 + ks], bV[ks], oacc[mi]);
      __builtin_amdgcn_sched_barrier(0);
#pragma unroll
      for (int mi = 0; mi < 4; ++mi)
#pragma unroll
        for (int jj = 0; jj < 4; ++jj)
          *(u16*)(Lo + (16 * mi + 4 * quad + jj) * 128 + (wave * 16 + l15) * 2) = (u16)f2bf(oacc[mi][jj]);
      RAW_BARRIER();
    }
    {
      const int tokp = b * 8192 + 127 * 64;
#pragma unroll
      for (int k2 = 0; k2 < 2; ++k2) {
        const int idx = tid + 256 * k2, row = idx >> 3, part = idx & 7;
        *(u32x4*)(o_g + (size_t)(tokp + row) * 4096 + h * 128 + half * 64 + part * 8) = *(const u32x4*)(Lo + idx * 16);
      }
      RAW_BARRIER();
    }
  }
}

#undef SCAN_LOAD
#undef SCAN_WAIT

DI void gate_phase(const Params& p) {
  char* ws = p.ws;
  const u16* proj = (const u16*)(ws + OFF_PROJ);
  u16* y0 = (u16*)(ws + OFF_R + 32 * MiB);
  const int tidg = tidx();
  const int lane = tidg & 63, l15 = lane & 15, quad = lane >> 4;
  const int gw = blockIdx.x * 4 + (tidg >> 6), nw = gridDim.x * 4;
  float wn[8];
#pragma unroll
  for (int e = 0; e < 8; ++e) wn[e] = p.a_o_norm_w[l15 * 8 + e];
  for (int r4 = gw; r4 < 32768; r4 += nw) {
    const int rh = r4 * 4 + quad, tok = rh >> 3, h = rh & 7;
    float o[8], z[8];
    unpack8(*(const u32x4*)(proj + (size_t)tok * 4096 + h * 128 + l15 * 8), o);
    unpack8(*(const u32x4*)(proj + (size_t)tok * 4096 + 3072 + h * 128 + l15 * 8), z);
    float ssq = 0.f;
#pragma unroll
    for (int e = 0; e < 8; ++e) ssq += o[e] * o[e];
    ssq += dpp_f<0x121>(ssq); ssq += dpp_f<0x122>(ssq); ssq += dpp_f<0x124>(ssq); ssq += dpp_f<0x128>(ssq);
    const float rs = rsqrtf(ssq * (1.f / 128.f) + kEps);
#pragma unroll
    for (int e = 0; e < 8; ++e) o[e] = o[e] * rs * wn[e] * silu(z[e]);
    *(u32x4*)(y0 + (size_t)tok * 1024 + h * 128 + l15 * 8) = packf8(o);
  }
}

DI void qknorm_cumsum(const Params& p, char* smem) {
  char* ws = p.ws;
  u16* proj = (u16*)(ws + OFF_PROJ);
  const int tid = tidx(), lane = tid & 63, l15 = lane & 15, quad = lane >> 4;
  const int gw = blockIdx.x * 4 + (tid >> 6), nw = gridDim.x * 4;
  for (int idx = gw; idx < 65536; idx += nw) {
    const int which = idx >> 15, r4 = idx & 32767;
    const int rh = r4 * 4 + quad, tok = rh >> 3, h = rh & 7;
    const float* wv = which ? p.b_k_norm_w : p.b_q_norm_w;
    u16* ptr = proj + (size_t)tok * 4096 + which * 1024 + h * 128 + l15 * 8;
    float v[8];
    unpack8(*(const u32x4*)ptr, v);
    float ssq = 0.f;
#pragma unroll
    for (int e = 0; e < 8; ++e) ssq += v[e] * v[e];
    ssq += __shfl_xor(ssq, 1); ssq += __shfl_xor(ssq, 2); ssq += __shfl_xor(ssq, 4); ssq += __shfl_xor(ssq, 8);
    const float rs = rsqrtf(ssq * (1.f / 128.f) + kEps) * (which ? 1.f : kScale);
#pragma unroll
    for (int e = 0; e < 8; ++e) v[e] = v[e] * rs * wv[l15 * 8 + e];
    *(u32x4*)ptr = packf8(v);
  }
}

DI void attn_phase(const Params& p, char* smem) {
  char* ws = p.ws;
  const u16* proj = (const u16*)(ws + OFF_PROJ);
  const u16* vT = (const u16*)(ws + OFF_R + 32 * MiB);
  const float* fraw = (const float*)(ws + OFF_FRAW);
  u16* y1 = (u16*)(ws + OFF_R + 64 * MiB);
  float* bias_s = (float*)(smem + 65536);
  float* ca_s = bias_s + 128;
  const int tid_ = tidx();
  float mq = 0.f, mk = 0.f;
  for (int i = 0; i < 128; ++i) { mq = fmaxf(mq, fabsf(p.b_q_norm_w[i])); mk = fmaxf(mk, fabsf(p.b_k_norm_w[i])); }
  const float QKB = 128.f * kScale * mq * mk;
  float* mmin_s = (float*)(smem + 66320);

  unsigned* qctr = (unsigned*)(ws + OFF_BAR) + XCD_BAR_WORDS;
  int* qslot = (int*)(smem + 66304);
  int qx = blockIdx.x & 7, qtries = 0;
  while (true) {
    const int tid = relaunder(tid_), lane = tid & 63, wave = tid >> 6, l15 = lane & 15, quad = lane >> 4;
    if (tid == 0) *qslot = (int)atomicAdd(qctr + qx * 16, 1u);
    __syncthreads();
    const int it = *qslot;
    __syncthreads();
    if (it >= 128) { if (++qtries >= 8) break; qx = (qx + 1) & 7; continue; }
    const int qb = 63 - (it & 63);
    const int b = it >> 6, h = b ? ((qx + 4) & 7) : qx, bh = b * 8 + h, i0 = qb * 128;
    const int qrow0 = i0 + 32 * wave;
    const float fb = p.b_f_bias[h];
    bf16x8 bq[2][4];
#pragma unroll
    for (int nq = 0; nq < 2; ++nq)
#pragma unroll
      for (int ks = 0; ks < 4; ++ks)
        bq[nq][ks] = *(const bf16x8*)(proj + (size_t)(b * 8192 + qrow0 + 16 * nq + l15) * 4096 + h * 128 + 32 * ks + 8 * quad);
    f32x4 O[8][2];
#pragma unroll
    for (int dt = 0; dt < 8; ++dt) { O[dt][0] = (f32x4){0.f, 0.f, 0.f, 0.f}; O[dt][1] = (f32x4){0.f, 0.f, 0.f, 0.f}; }
    float mrun[2] = {-1e30f, -1e30f}, lrun[2] = {0.f, 0.f};

    const int kkey = wave * 4 + (lane >> 4);
    const int kch = (lane & 15) ^ (kkey & 15);
    const u16* Kg = proj + (size_t)(b * 8192 + kkey) * 4096 + 1024 + h * 128 + kch * 8;
    const int vd = wave * 8 + (lane >> 3);
    const int vch = (lane & 7) ^ ((((wave & 1) << 2) + (lane >> 4)) & 7);
    const u16* Vg = vT + (size_t)(bh * 128 + vd) * 8192 + vch * 8;
#define ATT_STAGE(buf, j0_)                                                                                                   \
  do {                                                                                                                        \
    _Pragma("unroll") for (int i = 0; i < 4; ++i) {                                                                           \
      __builtin_amdgcn_global_load_lds((const unsigned*)(Kg + (size_t)((j0_) + 16 * i) * 4096),                               \
                                       (unsigned*)(smem + (buf) * 32768 + (i * 4 + wave) * 1024), 16, 0, 0);                  \
      __builtin_amdgcn_global_load_lds((const unsigned*)(Vg + (size_t)(32 * i) * 8192 + (j0_)),                               \
                                       (unsigned*)(smem + (buf) * 32768 + 16384 + (i * 4 + wave) * 1024), 16, 0, 0);          \
    }                                                                                                                         \
  } while (0)
    int j0 = i0 + 64;
    ATT_STAGE(0, j0);
    float carry = 0.f, biasA = 0.f, frn = 0.f;
    if (wave == 0) {
      const float lfA = fraw[(size_t)(b * 8192 + i0 + lane) * 16 + h];
      const float lfB = fraw[(size_t)(b * 8192 + i0 + 64 + lane) * 16 + h];
      float pa = lfA, pb = lfB;
#pragma unroll
      for (int o = 1; o < 64; o <<= 1) {
        const float ta = __shfl_up(pa, o), tb = __shfl_up(pb, o);
        if (lane >= o) { pa += ta; pb += tb; }
      }
      const float lf0 = __shfl(lfA, 0), totA = __shfl(pa, 63);
      biasA = -(pa - lf0) * kLog2e;
      bias_s[lane] = -(totA - lf0 + pb) * kLog2e;
      carry = lf0;
    }
    if (lane == 0) { mmin_s[wave] = -1e30f; mmin_s[4 + wave] = -1e30f; }
    asm volatile("s_waitcnt vmcnt(0)" ::: "memory");
    __syncthreads();
    auto att_tile = [&](const int cur, const bool diag) __attribute__((always_inline)) -> bool {
      const int nj = j0 - 64;
      bool more = nj >= 0;
      if (more && j0 <= i0) {
        const float* mm = mmin_s + cur * 4;
        const float mmin = fminf(fminf(mm[0], mm[1]), fminf(mm[2], mm[3]));
        more = !((QKB + ca_s[cur]) * kLog2e < mmin - 30.f * kLog2e);
      }
      if (more) {
        ATT_STAGE(cur ^ 1, nj);
        if (wave == 0 && nj < i0) frn = fraw[(size_t)(b * 8192 + nj + lane) * 16 + h];
      }
      if (j0 <= qrow0 + 31) {
        const char* Ks = smem + cur * 32768;
        const char* Vs = Ks + 16384;
        const float* cs = bias_s + cur * 64;
        f32x4 s[4][2];
#pragma unroll
        for (int kt = 0; kt < 4; ++kt) { s[kt][0] = (f32x4){0.f, 0.f, 0.f, 0.f}; s[kt][1] = (f32x4){0.f, 0.f, 0.f, 0.f}; }
#pragma unroll
        for (int ks = 0; ks < 4; ++ks)
#pragma unroll
          for (int kt = 0; kt < 4; ++kt) {
            const int kl = 16 * kt + l15;
            const bf16x8 ak = *(const bf16x8*)(Ks + kl * 256 + (((ks * 4 + quad) ^ (kl & 15)) << 4));
            s[kt][0] = mfma16(ak, bq[0][ks], s[kt][0]);
            s[kt][1] = mfma16(ak, bq[1][ks], s[kt][1]);
          }
#pragma unroll
        for (int kt = 0; kt < 4; ++kt) {
          const f32x4 bias = *(const f32x4*)(cs + 16 * kt + 4 * quad);
#pragma unroll
          for (int nq = 0; nq < 2; ++nq)
#pragma unroll
            for (int jj = 0; jj < 4; ++jj) {
              float v = s[kt][nq][jj] + bias[jj];
              if (diag) { if (j0 + 16 * kt + 4 * quad + jj > qrow0 + 16 * nq + l15) v = -1e30f; }
              s[kt][nq][jj] = v;
            }
        }
        bf16x8 bP[2][2];
#pragma unroll
        for (int nq = 0; nq < 2; ++nq) {
          float tmax = -1e30f;
#pragma unroll
          for (int kt = 0; kt < 4; ++kt)
#pragma unroll
            for (int jj = 0; jj < 4; ++jj) tmax = fmaxf(tmax, s[kt][nq][jj]);
          tmax = fmaxf(tmax, __shfl_xor(tmax, 16));
          tmax = fmaxf(tmax, __shfl_xor(tmax, 32));
          const float mnew = fmaxf(mrun[nq], tmax);
          const float alpha = __builtin_amdgcn_exp2f(mrun[nq] - mnew);
          const bool grew = mnew > mrun[nq];
          mrun[nq] = mnew;
          float psum = 0.f;
#pragma unroll
          for (int kt = 0; kt < 4; ++kt)
#pragma unroll
            for (int jj = 0; jj < 4; ++jj) { const float pv = __builtin_amdgcn_exp2f(s[kt][nq][jj] - mnew); s[kt][nq][jj] = pv; psum += pv; }
          lrun[nq] = lrun[nq] * alpha + psum;
          if (__builtin_amdgcn_ballot_w64(grew) != 0ull) {
#pragma unroll
            for (int dt = 0; dt < 8; ++dt) O[dt][nq] = O[dt][nq] * alpha;
          }
          bP[0][nq] = pack8(s[0][nq], s[1][nq]);
          bP[1][nq] = pack8(s[2][nq], s[3][nq]);
        }
#pragma unroll
        for (int ks = 0; ks < 2; ++ks)
#pragma unroll
          for (int dt = 0; dt < 8; ++dt) {
            const int d = 16 * dt + l15, sw = (d >> 1) & 7, c0 = 4 * ks + (quad >> 1);
            const u32x2 lo = *(const u32x2*)(Vs + d * 128 + ((c0 ^ sw) << 4) + (quad & 1) * 8);
            const u32x2 hi = *(const u32x2*)(Vs + d * 128 + (((c0 + 2) ^ sw) << 4) + (quad & 1) * 8);
            const bf16x8 av = mk8(lo, hi);
            O[dt][0] = mfma16(av, bP[ks][0], O[dt][0]);
            O[dt][1] = mfma16(av, bP[ks][1], O[dt][1]);
          }
        float wm = fminf(mrun[0], mrun[1]);
        wm = fminf(wm, dpp_f<0x121>(wm)); wm = fminf(wm, dpp_f<0x122>(wm)); wm = fminf(wm, dpp_f<0x124>(wm)); wm = fminf(wm, dpp_f<0x128>(wm));
        wm = fminf(fminf(readlane_f(wm, 0), readlane_f(wm, 16)), fminf(readlane_f(wm, 32), readlane_f(wm, 48)));
        if (lane == 0) mmin_s[(cur ^ 1) * 4 + wave] = wm;
      }
      if (more && wave == 0) {
        const int nb = cur ^ 1;
        if (nj == i0) {
          bias_s[nb * 64 + lane] = biasA;
          if (lane == 0) ca_s[nb] = carry;
        } else {
          const float lf = frn;
          float x = lf;
          x += dpp_f<0x101>(x); x += dpp_f<0x102>(x); x += dpp_f<0x104>(x); x += dpp_f<0x108>(x);
          const float t0 = readlane_f(x, 0), t1 = readlane_f(x, 16), t2 = readlane_f(x, 32), t3 = readlane_f(x, 48);
          const int rowi = lane >> 4;
          const float radd = (rowi == 0) ? (t1 + t2 + t3) : (rowi == 1) ? (t2 + t3) : (rowi == 2) ? t3 : 0.f;
          const float sf = x + radd;
          bias_s[nb * 64 + lane] = (sf - lf + carry) * kLog2e;
          carry += (t0 + t1) + (t2 + t3);
          if (lane == 0) ca_s[nb] = carry;
        }
      }
      asm volatile("s_waitcnt vmcnt(0)" ::: "memory");
      __syncthreads();
      if (!more) return false;
      j0 = nj;
      return true;
    };
    if (att_tile(0, true) && att_tile(1, true)) {
      while (true) {
        if (!att_tile(0, false)) break;
        if (!att_tile(1, false)) break;
      }
    }
#undef ATT_STAGE
#pragma unroll
    for (int nq = 0; nq < 2; ++nq) {
      float l = lrun[nq];
      l += __shfl_xor(l, 16);
      l += __shfl_xor(l, 32);
      const float inv = 1.f / l;
      const size_t tok = (size_t)(b * 8192 + qrow0 + 16 * nq + l15);
#pragma unroll
      for (int dt = 0; dt < 8; ++dt) {
        const int d = 16 * dt + 4 * quad;
        const u32x2 z2 = *(const u32x2*)(proj + tok * 4096 + 3072 + h * 128 + d);
        const f32x4 o = O[dt][nq] * inv;
        u32x2 r = {pack2(o[0] * silu(bflo(z2.x)), o[1] * silu(bfhi(z2.x))), pack2(o[2] * silu(bflo(z2.y)), o[3] * silu(bfhi(z2.y)))};
        *(u32x2*)(y1 + tok * 1024 + h * 128 + d) = r;
      }
    }
  }
}

DI void final_norm(const Params& p) {
  const float* ss2 = (const float*)(p.ws + OFF_SS2);
  const int tidf = tidx();
  const int lane = tidf & 63;
  const int gw = blockIdx.x * 4 + (tidf >> 6), nw = gridDim.x * 4;
  const f32x4* w = (const f32x4*)p.final_norm_w;
  f32x4 wv[4];
#pragma unroll
  for (int i = 0; i < 4; ++i) wv[i] = w[lane + 64 * i];
  for (int row = gw; row < 16384; row += 4 * nw) {
    u32x2 r[4][4];
    float rs[4];
#pragma unroll
    for (int k = 0; k < 4; ++k) {
      const int rr = row + k * nw;
      const bool okr = rr < 16384;
      const int rc = okr ? rr : row;
      rs[k] = rsqrtf(ss2[rc] * (1.f / 1024.f) + kEps);
      const u32x2* hsrc = (const u32x2*)((const u16*)(p.ws + OFF_R) + (size_t)rc * 1024);
#pragma unroll
      for (int i = 0; i < 4; ++i) r[k][i] = hsrc[lane + 64 * i];
    }
#pragma unroll
    for (int k = 0; k < 4; ++k) {
      const int rr = row + k * nw;
      if (rr < 16384) {
        f32x4* o = (f32x4*)(p.out + (size_t)rr * 1024);
#pragma unroll
        for (int i = 0; i < 4; ++i) {
          f32x4 v = {bflo(r[k][i].x), bfhi(r[k][i].x), bflo(r[k][i].y), bfhi(r[k][i].y)};
          __builtin_nontemporal_store(v * rs[k] * wv[i], o + lane + 64 * i);
        }
      }
    }
  }
}

__global__ void __launch_bounds__(kThreads, 2) fwd_megakernel(Params p) {
  extern __shared__ __attribute__((aligned(16))) char smem[];
  cg::grid_group grid = cg::this_grid();
  char* ws = p.ws;
  __shared__ uint4 xb_words;
  if (threadIdx.x == 0) xb_words = make_uint4(0u, 0u, 0u, 0u);
  __syncthreads();
  if (p.ws == nullptr) grid.sync();
  XcdBarrier xb = xcd_barrier_post((unsigned*)(ws + OFF_BAR), (volatile LAS unsigned*)&xb_words);
  phase0(p, smem);
  xcd_barrier(xb);
  gemm_phase<1>(p, (const u16*)(ws + OFF_R), (const u16*)(ws + OFF_WTA_IN), 32, smem);
  skinny_gemm<0>(p, (const u16*)(ws + OFF_R), (const u16*)(ws + OFF_WTA_IN) + (size_t)4096 * 1024, (float*)(ws + OFF_BRAW));
  xcd_barrier(xb);
  {
    const bool overlap = gridDim.x >= 128;
    const int G = (int)gridDim.x, hG = G >> 1, bi = (int)blockIdx.x;
    const bool is_scan = overlap && bi < 32, is_idle = overlap && bi >= hG && bi < hG + 32;
    const int pfirst = overlap ? (bi < hG ? 32 : 64) : 0, pn = overlap ? G - 64 : G;
    if (!is_scan && !is_idle) delta_prep(p, smem, pfirst, pn);
    if (!is_scan && !is_idle) phase0b(p, smem, pfirst, pn);
    if (!overlap) xcd_barrier(xb);
    if (!overlap || blockIdx.x < 32) delta_scan(p, smem);
    xcd_barrier(xb);
  }
  gate_phase(p);
  xcd_barrier(xb);
  gemm_phase<2>(p, (const u16*)(ws + OFF_R + 32 * MiB), (const u16*)(ws + OFF_WTA_OUT), 8, smem);
  xcd_barrier(xb);
  gemm_phase<3>(p, (const u16*)(ws + OFF_R), (const u16*)(ws + OFF_WTB_IN), 32, smem);
  skinny_gemm<1>(p, (const u16*)(ws + OFF_R), (const u16*)(ws + OFF_WTB_IN) + (size_t)4096 * 1024, (float*)(ws + OFF_FRAW));
  xcd_barrier(xb);
  attn_phase(p, smem);
  xcd_barrier(xb);
  gemm_phase<4>(p, (const u16*)(ws + OFF_R + 64 * MiB), (const u16*)(ws + OFF_WTB_OUT), 8, smem);
  xcd_barrier(xb);
  final_norm(p);
}

extern "C" void kernel_launch(void* const* d_in, const int* in_sizes, int n_in, void* d_out, int out_size, void* d_ws, size_t ws_size,
                              hipStream_t stream) {
  static int grid_blocks = 0;
  if (!grid_blocks) {
    int dev = 0, cus = 0, per_cu = 0;
    hipGetDevice(&dev);
    hipDeviceGetAttribute(&cus, hipDeviceAttributeMultiprocessorCount, dev);
    hipFuncSetAttribute((const void*)fwd_megakernel, hipFuncAttributeMaxDynamicSharedMemorySize, kLds);
    hipOccupancyMaxActiveBlocksPerMultiprocessor(&per_cu, (const void*)fwd_megakernel, kThreads, kLds);
    if (per_cu < 1) per_cu = 1;
    if (per_cu > 2) per_cu = 2;
    grid_blocks = cus * per_cu;
  }
  Params p{};
  p.x = (const float*)d_in[0]; p.a_norm_w = (const float*)d_in[1]; p.a_w_in = (const float*)d_in[2]; p.a_conv_w = (const float*)d_in[3];
  p.a_A_log = (const float*)d_in[4]; p.a_dt_bias = (const float*)d_in[5]; p.a_o_norm_w = (const float*)d_in[6]; p.a_w_out = (const float*)d_in[7];
  p.b_norm_w = (const float*)d_in[8]; p.b_w_in = (const float*)d_in[9]; p.b_f_bias = (const float*)d_in[10]; p.b_q_norm_w = (const float*)d_in[11];
  p.b_k_norm_w = (const float*)d_in[12]; p.b_w_out = (const float*)d_in[13]; p.final_norm_w = (const float*)d_in[14];
  p.out = (float*)d_out;
  p.ws = (char*)d_ws;
  hipMemsetAsync((char*)d_ws + OFF_BAR, 0, CTL_BYTES, stream);
  void* args[] = {&p};
  hipError_t e = hipLaunchCooperativeKernel((const void*)fwd_megakernel, dim3(grid_blocks), dim3(kThreads), args, kLds, stream);
  if (e != hipSuccess) fprintf(stderr, "cooperative launch failed: %s (grid %d)\n", hipGetErrorString(e), grid_blocks);
}
```

```cpp
#include <hip/hip_runtime.h>
#include <hip/hip_cooperative_groups.h>
#include <cstdio>
namespace cg = cooperative_groups;

typedef unsigned short u16;
typedef __attribute__((ext_vector_type(8))) short bf16x8;
typedef __attribute__((ext_vector_type(4))) float f32x4;
typedef __attribute__((ext_vector_type(4))) unsigned u32x4;
typedef __attribute__((ext_vector_type(2))) unsigned u32x2;
#define DI __device__ __forceinline__

constexpr int kThreads = 256;
constexpr int kLds = 69632;
constexpr float kEps = 1e-6f;
constexpr float kScale = 0.08838834764831845f;
constexpr float kLog2e = 1.4426950408889634f;

constexpr size_t MiB = 1048576;
constexpr size_t OFF_WTA_IN = 0;
constexpr size_t OFF_WTA_OUT = 8650752;
constexpr size_t OFF_WTB_IN = 10747904;
constexpr size_t OFF_WTB_OUT = 19398656;
constexpr size_t OFF_SMALL = 21495808;
constexpr size_t OFF_RS0 = OFF_SMALL;
constexpr size_t OFF_SS1 = OFF_RS0 + 65536;
constexpr size_t OFF_SS2 = OFF_SS1 + 65536;
constexpr size_t OFF_BRAW = OFF_SS2 + 65536;
constexpr size_t OFF_FRAW = OFF_BRAW + 1048576;
constexpr size_t OFF_CCUM = OFF_FRAW + 1048576;
constexpr size_t OFF_GEND = OFF_CCUM + 524288;
constexpr size_t OFF_BAR = OFF_GEND + 8192;
constexpr size_t OFF_FLAGS = OFF_BAR + 13824 + 512;
constexpr size_t CTL_BYTES = 13824 + 512 + 8192;
constexpr size_t OFF_PROJ = OFF_SMALL + 3 * MiB;
constexpr size_t OFF_R = OFF_PROJ + 128 * MiB;

struct Params {
  const float *x, *a_norm_w, *a_w_in, *a_conv_w, *a_A_log, *a_dt_bias, *a_o_norm_w, *a_w_out;
  const float *b_norm_w, *b_w_in, *b_f_bias, *b_q_norm_w, *b_k_norm_w, *b_w_out, *final_norm_w;
  float* out;
  char* ws;
};

typedef __attribute__((ext_vector_type(2))) float f32x2;
typedef __attribute__((ext_vector_type(2))) __bf16 bf16x2_t;
DI unsigned pack2(float a, float b) { f32x2 v = {a, b}; return __builtin_bit_cast(unsigned, __builtin_convertvector(v, bf16x2_t)); }
DI unsigned f2bf(float x) { return pack2(x, 0.f) & 0xffffu; }
DI float bflo(unsigned u) { return __uint_as_float(u << 16); }
DI float bfhi(unsigned u) { return __uint_as_float(u & 0xffff0000u); }
DI f32x4 mfma16(bf16x8 a, bf16x8 b, f32x4 c) { return __builtin_amdgcn_mfma_f32_16x16x32_bf16(a, b, c, 0, 0, 0); }
DI bf16x8 mk8(u32x2 lo, u32x2 hi) { u32x4 v = {lo.x, lo.y, hi.x, hi.y}; return __builtin_bit_cast(bf16x8, v); }
DI bf16x8 pack8(f32x4 a, f32x4 b) { u32x4 v = {pack2(a[0], a[1]), pack2(a[2], a[3]), pack2(b[0], b[1]), pack2(b[2], b[3])}; return __builtin_bit_cast(bf16x8, v); }
DI bf16x8 ld2(const u16* p) { return mk8(*(const u32x2*)p, *(const u32x2*)(p + 16)); }
DI int relaunder(int t) { asm volatile("" : "+v"(t)); return t; }
DI int tidx() { int t = threadIdx.x; asm volatile("" : "+v"(t)); return t; }
template <int CTRL> DI float dpp_f(float x) { return __int_as_float(__builtin_amdgcn_update_dpp(0, __float_as_int(x), CTRL, 0xF, 0xF, true)); }
DI float readlane_f(float x, const int l) { return __int_as_float(__builtin_amdgcn_readlane(__float_as_int(x), l)); }
DI float silu(float x) { return x / (1.f + __expf(-x)); }
DI void unpack8(u32x4 v, float* f) {
  f[0] = bflo(v.x); f[1] = bfhi(v.x); f[2] = bflo(v.y); f[3] = bfhi(v.y);
  f[4] = bflo(v.z); f[5] = bfhi(v.z); f[6] = bflo(v.w); f[7] = bfhi(v.w);
}
DI u32x4 packf8(const float* f) { u32x4 v = {pack2(f[0], f[1]), pack2(f[2], f[3]), pack2(f[4], f[5]), pack2(f[6], f[7])}; return v; }


#define XB_TMO      128
#define XB_XCNT(j)  (256  + 64 * (j))
#define XB_XSUB(j)  (1280 + 64 * (j))
#define XB_XGEN(j)  (2304 + 64 * (j))
#define XB_TOP      3328
#define XB_TOPGEN   3392
#define XCD_BAR_WORDS 3456
#define XB_SPIN_CAP (1u << 23)
#define LAS __attribute__((address_space(3)))
DI unsigned xb_ld(unsigned* p) { return __hip_atomic_load(p, __ATOMIC_RELAXED, __HIP_MEMORY_SCOPE_AGENT); }
DI unsigned xb_add(unsigned* p, unsigned v) { return __hip_atomic_fetch_add(p, v, __ATOMIC_RELAXED, __HIP_MEMORY_SCOPE_AGENT); }
DI unsigned xb_xcc_id() { return (unsigned)__builtin_amdgcn_s_getreg((3 << 11) | 20) & 0xFu; }
#define XB_SPIN(cond, bar) do { unsigned _sp = 0; while (cond) { __builtin_amdgcn_s_sleep(1); \
    if ((++_sp & 255u) == 0u) { if (xb_ld(&(bar)[XB_TMO])) break; if (_sp > XB_SPIN_CAP) { atomicAdd(&(bar)[XB_TMO], 1u); break; } } } } while (0)
struct XcdBarrier { unsigned* bar; unsigned x; volatile LAS unsigned* st; };
DI XcdBarrier xcd_barrier_post(unsigned* bar, volatile LAS unsigned* st) {
  XcdBarrier b; b.bar = bar; b.x = xb_xcc_id(); b.st = st;
  if (threadIdx.x == 0) (void)xb_add(&bar[XB_XCNT(b.x)], 1u);
  return b;
}
DI void xcd_barrier_complete(unsigned* bar, unsigned x, unsigned& nloc, unsigned& nx) {
  const unsigned G = gridDim.x * gridDim.y * gridDim.z;
  unsigned sum, cnt, mine, sp = 0u;
  for (;;) {
    sum = 0u; cnt = 0u; mine = 0u;
#pragma unroll
    for (unsigned j = 0; j < 16; ++j) { const unsigned c = xb_ld(&bar[XB_XCNT(j)]); sum += c; cnt += (c > 0u) ? 1u : 0u; mine = (j == x) ? c : mine; }
    if (sum == G) break;
    __builtin_amdgcn_s_sleep(1);
    if ((++sp & 255u) == 0u) { if (xb_ld(&bar[XB_TMO])) break; if (sp > XB_SPIN_CAP) { atomicAdd(&bar[XB_TMO], 1u); break; } }
  }
  nloc = mine > 0u ? mine : 1u; nx = cnt > 0u ? cnt : 1u;
}
DI void xcd_barrier(const XcdBarrier& b) {
  asm volatile("s_waitcnt vmcnt(0)" ::: "memory");
  __syncthreads();
  if (threadIdx.x == 0) {
    unsigned* bar = b.bar;
    __builtin_amdgcn_s_waitcnt(0);
    unsigned nloc = b.st[0], nx = b.st[1];
    if (nloc == 0u) { xcd_barrier_complete(bar, b.x, nloc, nx); b.st[0] = nloc; b.st[1] = nx; }
    const unsigned old = xb_add(&bar[XB_XSUB(b.x)], 1u);
    const unsigned gen = old / nloc;
    if (old + 1u == (gen + 1u) * nloc) {
      __builtin_amdgcn_fence(__ATOMIC_RELEASE, "agent");
      asm volatile("s_waitcnt vmcnt(0)" ::: "memory");
      const unsigned og = xb_add(&bar[XB_TOP], 1u);
      const unsigned tg = og / nx;
      if (og + 1u == (tg + 1u) * nx) xb_add(&bar[XB_TOPGEN], 1u);
      else XB_SPIN(xb_ld(&bar[XB_TOPGEN]) == tg, bar);
      __builtin_amdgcn_fence(__ATOMIC_ACQUIRE, "agent");
      xb_add(&bar[XB_XGEN(b.x)], 1u);
      asm volatile("s_waitcnt vmcnt(0)" ::: "memory");
    } else {
      XB_SPIN(xb_ld(&bar[XB_XGEN(b.x)]) == gen, bar);
      __builtin_amdgcn_fence(__ATOMIC_ACQUIRE, "agent");
      asm volatile("s_waitcnt vmcnt(0)" ::: "memory");
    }
  }
  __syncthreads();
}

DI void transpose_tile(const float* __restrict__ W, int N, int Npad, const float* __restrict__ kscale, u16* __restrict__ WT, int tile, char* smem) {
  float(*t)[65] = (float(*)[65])smem;
  const int nt = Npad / 64;
  const int k0 = (tile / nt) * 64, n0 = (tile % nt) * 64;
  const int tid = tidx();
  {
    const int tx = tid & 63, ty = tid >> 6;
#pragma unroll 4
    for (int i = 0; i < 16; ++i) {
      const int k = k0 + ty + 4 * i, n = n0 + tx;
      float v = 0.f;
      if (n < N) { v = W[(size_t)k * N + n]; if (kscale) v *= kscale[k]; }
      t[ty + 4 * i][tx] = v;
    }
  }
  __syncthreads();
  {
    const int kx2 = (tid & 31) * 2, ny0 = tid >> 5;
#pragma unroll 4
    for (int i = 0; i < 8; ++i) {
      const int ny = ny0 + 8 * i;
      *(unsigned*)(WT + (size_t)(n0 + ny) * 1024 + k0 + kx2) = pack2(t[kx2][ny], t[kx2 + 1][ny]);
    }
  }
  __syncthreads();
}

DI void phase0(const Params& p, char* smem) {
  char* ws = p.ws;
  {
    float* ss = (float*)(ws + OFF_SS1);
    for (int i = blockIdx.x * kThreads + tidx(); i < 32768; i += gridDim.x * kThreads) ss[i] = 0.f;
  }
  for (int t = blockIdx.x; t < 1312; t += gridDim.x) {
    if (t < 1056) transpose_tile(p.a_w_in, 4112, 4224, p.a_norm_w, (u16*)(ws + OFF_WTA_IN), t, smem);
    else transpose_tile(p.a_w_out, 1024, 1024, nullptr, (u16*)(ws + OFF_WTA_OUT), t - 1056, smem);
  }
  const int tid0 = tidx();
  const int lane = tid0 & 63;
  const int gw = blockIdx.x * 4 + (tid0 >> 6), nw = gridDim.x * 4;
  u16* xb = (u16*)(ws + OFF_R);
  float* rs0 = (float*)(ws + OFF_RS0);
  for (int row = gw; row < 16384; row += 4 * nw) {
    f32x4 v[4][4];
#pragma unroll
    for (int k = 0; k < 4; ++k) {
      const int rr = row + k * nw;
      const f32x4* xr = (const f32x4*)(p.x + (size_t)(rr < 16384 ? rr : row) * 1024);
#pragma unroll
      for (int i = 0; i < 4; ++i) v[k][i] = __builtin_nontemporal_load(xr + lane + 64 * i);
    }
#pragma unroll
    for (int k = 0; k < 4; ++k) {
      const int rr = row + k * nw;
      float ss = 0.f;
#pragma unroll
      for (int i = 0; i < 4; ++i) ss += v[k][i][0] * v[k][i][0] + v[k][i][1] * v[k][i][1] + v[k][i][2] * v[k][i][2] + v[k][i][3] * v[k][i][3];
      ss += dpp_f<0x121>(ss); ss += dpp_f<0x122>(ss); ss += dpp_f<0x124>(ss); ss += dpp_f<0x128>(ss);
      ss = (readlane_f(ss, 0) + readlane_f(ss, 16)) + (readlane_f(ss, 32) + readlane_f(ss, 48));
      if (rr < 16384) {
        u32x2* xo = (u32x2*)(xb + (size_t)rr * 1024);
#pragma unroll
        for (int i = 0; i < 4; ++i) { u32x2 o = {pack2(v[k][i][0], v[k][i][1]), pack2(v[k][i][2], v[k][i][3])}; xo[lane + 64 * i] = o; }
        if (lane == 0) rs0[rr] = rsqrtf(ss * (1.f / 1024.f) + kEps);
      }
    }
  }
}

DI void phase0b(const Params& p, char* smem, int first, int nblk) {
  char* ws = p.ws;
  for (int t = (int)blockIdx.x - first; t < 1312; t += nblk) {
    if (t < 1056) transpose_tile(p.b_w_in, 4104, 4224, p.b_norm_w, (u16*)(ws + OFF_WTB_IN), t, smem);
    else transpose_tile(p.b_w_out, 1024, 1024, nullptr, (u16*)(ws + OFF_WTB_OUT), t - 1056, smem);
  }
}

template <int EPI>
DI void gemm_phase(const Params& p, const u16* __restrict__ A, const u16* __restrict__ Bt, int nTn, char* smem) {
  const int tid = tidx(), lane = tid & 63, wave = tid >> 6;
  const int wr = wave >> 1, wc = wave & 1;
  const int l15 = lane & 15, quad = lane >> 4;
  char* ws = p.ws;
  const int NX = ((gridDim.x & 7) == 0) ? 8 : 1;
  const int xg = blockIdx.x % NX, lb = blockIdx.x / NX, Lb = gridDim.x / NX;
  const int nTnG = nTn >> 3, nSuper = 16 * nTnG;
  const int srow = wave * 8 + (lane >> 3);
  const int sch = (lane & 7) ^ ((((wave & 1) << 2) + (lane >> 4)) & 7);
#define GEMM_TILE(seq_, tm_, tn_, ok_)                                                            \
  do {                                                                                            \
    const int sidx_ = xg + NX * ((seq_) >> 6);                                                    \
    ok_ = sidx_ < nSuper;                                                                         \
    const int tl_ = (seq_) & 63;                                                                  \
    tm_ = (sidx_ / nTnG) * 8 + (tl_ & 7);                                                         \
    tn_ = (sidx_ % nTnG) * 8 + (tl_ >> 3);                                                        \
  } while (0)
#define GEMM_STAGE(buf, kt)                                                                                                   \
  do {                                                                                                                        \
    _Pragma("unroll") for (int i = 0; i < 4; ++i) {                                                                           \
      __builtin_amdgcn_global_load_lds((const unsigned*)(Ag + (size_t)i * 32 * 1024 + (kt) * 64),                             \
                                       (unsigned*)(smem + (buf) * 32768 + (i * 4 + wave) * 1024), 16, 0, 0);                  \
      __builtin_amdgcn_global_load_lds((const unsigned*)(Bg + (size_t)i * 32 * 1024 + (kt) * 64),                             \
                                       (unsigned*)(smem + (buf) * 32768 + 16384 + (i * 4 + wave) * 1024), 16, 0, 0);          \
    }                                                                                                                         \
  } while (0)
  int seq = lb, tm, tn;
  bool ok;
  GEMM_TILE(seq, tm, tn, ok);
  const u16* Ag = A + (size_t)(tm * 128 + srow) * 1024 + sch * 8;
  const u16* Bg = Bt + (size_t)(tn * 128 + srow) * 1024 + sch * 8;
  if (ok) GEMM_STAGE(0, 0);
  while (ok) {
    int tm2, tn2;
    bool ok2;
    GEMM_TILE(seq + Lb, tm2, tn2, ok2);
    f32x4 acc[4][4];
#pragma unroll
    for (int a = 0; a < 4; ++a)
#pragma unroll
      for (int b = 0; b < 4; ++b) acc[a][b] = (f32x4){0.f, 0.f, 0.f, 0.f};
    asm volatile("s_waitcnt vmcnt(0)" ::: "memory");
    __syncthreads();
#pragma unroll 2
    for (int kt = 0; kt < 16; ++kt) {
      const int cur = kt & 1;
      if (kt + 1 < 16) GEMM_STAGE(cur ^ 1, kt + 1);
      else if (ok2) {
        Ag = A + (size_t)(tm2 * 128 + srow) * 1024 + sch * 8;
        Bg = Bt + (size_t)(tn2 * 128 + srow) * 1024 + sch * 8;
        GEMM_STAGE(0, 0);
      }
      const char* sa = smem + cur * 32768;
      const char* sb = sa + 16384;
#pragma unroll
      for (int ks = 0; ks < 2; ++ks) {
        bf16x8 fa[4], fb[4];
        const int ch = ks * 4 + quad;
#pragma unroll
        for (int mi = 0; mi < 4; ++mi) {
          const int row = wr * 64 + mi * 16 + l15;
          fa[mi] = *(const bf16x8*)(sa + row * 128 + ((ch ^ ((row >> 1) & 7)) << 4));
        }
#pragma unroll
        for (int ni = 0; ni < 4; ++ni) {
          const int row = wc * 64 + ni * 16 + l15;
          fb[ni] = *(const bf16x8*)(sb + row * 128 + ((ch ^ ((row >> 1) & 7)) << 4));
        }
#pragma unroll
        for (int ni = 0; ni < 4; ++ni)
#pragma unroll
          for (int mi = 0; mi < 4; ++mi) acc[ni][mi] = mfma16(fb[ni], fa[mi], acc[ni][mi]);
      }
      if (kt < 15) {
        asm volatile("s_waitcnt vmcnt(0)" ::: "memory");
        __syncthreads();
      }
    }
    float hnorm[4] = {1.f, 1.f, 1.f, 1.f};
    if constexpr (EPI == 3) {
      if (tn < 16) {
        float* part = (float*)(smem + 65536);
        float ssq[4];
#pragma unroll
        for (int mi = 0; mi < 4; ++mi) {
          const float rs = rsqrtf(((const float*)(ws + OFF_SS1))[tm * 128 + wr * 64 + mi * 16 + l15] * (1.f / 1024.f) + kEps);
          float s = 0.f;
#pragma unroll
          for (int ni = 0; ni < 4; ++ni) { const f32x4 v = acc[ni][mi] * rs; s += v[0] * v[0] + v[1] * v[1] + v[2] * v[2] + v[3] * v[3]; }
          s += __shfl_xor(s, 16);
          s += __shfl_xor(s, 32);
          ssq[mi] = s;
          if (quad == 0) part[(wr * 2 + wc) * 64 + mi * 16 + l15] = s;
        }
        __syncthreads();
#pragma unroll
        for (int mi = 0; mi < 4; ++mi) {
          const float tot = ssq[mi] + part[(wr * 2 + (wc ^ 1)) * 64 + mi * 16 + l15];
          hnorm[mi] = rsqrtf(tot * (1.f / 128.f) + kEps) * (tn < 8 ? kScale * kLog2e : 1.f);
        }
      }
    }
#pragma unroll
    for (int mi = 0; mi < 4; ++mi) {
      const int m = tm * 128 + wr * 64 + mi * 16 + l15;
      if constexpr (EPI == 1) {
        const float rs = ((const float*)(ws + OFF_RS0))[m];
        u16* proj = (u16*)(ws + OFF_PROJ);
        float* braw = (float*)(ws + OFF_BRAW);
#pragma unroll
        for (int ni = 0; ni < 4; ++ni) {
          const int nb = tn * 128 + wc * 64 + ni * 16 + quad * 4;
          f32x4 v = acc[ni][mi] * rs;
          if (nb < 4096) { u32x2 o = {pack2(v[0], v[1]), pack2(v[2], v[3])}; __builtin_nontemporal_store(o, (u32x2*)(proj + (size_t)m * 4096 + nb)); }
          else if (nb < 4112) { *(f32x4*)(braw + (size_t)m * 16 + (nb - 4096)) = v; }
        }
      } else if constexpr (EPI == 2 || EPI == 4) {
        float* ssp = (float*)(ws + (EPI == 2 ? OFF_SS1 : OFF_SS2));
        u16* hb = (u16*)(ws + OFF_R);
        float ssq = 0.f;
#pragma unroll
        for (int ni = 0; ni < 4; ++ni) {
          const int nb = tn * 128 + wc * 64 + ni * 16 + quad * 4;
          f32x4 v;
          if constexpr (EPI == 2) {
            v = acc[ni][mi] + __builtin_nontemporal_load((const f32x4*)(p.x + (size_t)m * 1024 + nb));
            u32x2 o = {pack2(v[0], v[1]), pack2(v[2], v[3])};
            *(u32x2*)(hb + (size_t)m * 1024 + nb) = o;
            v[0] = bflo(o.x); v[1] = bfhi(o.x); v[2] = bflo(o.y); v[3] = bfhi(o.y);
          } else {
            const u32x2 r = *(const u32x2*)(hb + (size_t)m * 1024 + nb);
            v = acc[ni][mi];
            v[0] += bflo(r.x); v[1] += bfhi(r.x); v[2] += bflo(r.y); v[3] += bfhi(r.y);
            const u32x2 o = {pack2(v[0], v[1]), pack2(v[2], v[3])};
            *(u32x2*)(hb + (size_t)m * 1024 + nb) = o;
            v[0] = bflo(o.x); v[1] = bfhi(o.x); v[2] = bflo(o.y); v[3] = bfhi(o.y);
          }
          ssq += v[0] * v[0] + v[1] * v[1] + v[2] * v[2] + v[3] * v[3];
        }
        ssq += __shfl_xor(ssq, 16);
        ssq += __shfl_xor(ssq, 32);
        if (quad == 0) atomicAdd(ssp + m, ssq);
      } else if constexpr (EPI == 3) {
        const float rs = rsqrtf(((const float*)(ws + OFF_SS1))[m] * (1.f / 1024.f) + kEps);
        u16* proj = (u16*)(ws + OFF_PROJ);
        u16* vT = (u16*)(ws + OFF_R + 32 * MiB);
        float* fraw = (float*)(ws + OFF_FRAW);
        float hs = 1.f;
        if (tn < 16) hs = hnorm[mi];
#pragma unroll
        for (int ni = 0; ni < 4; ++ni) {
          const int nb = tn * 128 + wc * 64 + ni * 16 + quad * 4;
          f32x4 v = acc[ni][mi] * rs;
          if (tn < 16) {
            const f32x4 wv = *(const f32x4*)((tn < 8 ? p.b_q_norm_w : p.b_k_norm_w) + (nb & 127));
            v = v * hs * wv;
          }
          if (nb < 4096) {
            if ((nb >> 10) != 2) { u32x2 o = {pack2(v[0], v[1]), pack2(v[2], v[3])}; __builtin_nontemporal_store(o, (u32x2*)(proj + (size_t)m * 4096 + nb)); }
            else {
              const int hd = nb - 2048;
              const int b = m >> 13, t = m & 8191;
              u16* dst = vT + ((size_t)(b * 1024 + hd)) * 8192 + t;
#pragma unroll
              for (int jj = 0; jj < 4; ++jj) dst[(size_t)jj * 8192] = (u16)f2bf(v[jj]);
            }
          } else if (nb < 4104) { *(f32x4*)(fraw + (size_t)m * 16 + (nb - 4096)) = v; }
        }
      }
    }
    seq += Lb; tm = tm2; tn = tn2; ok = ok2;
  }
#undef GEMM_STAGE
#undef GEMM_TILE
}


template <int MODE>
DI void skinny_gemm(const Params& p, const u16* __restrict__ A, const u16* __restrict__ Wt16, float* __restrict__ out) {
  const int tid = tidx(), lane = tid & 63, l15 = lane & 15, quad = lane >> 4;
  const int gw = blockIdx.x * 4 + (tid >> 6), nw = gridDim.x * 4;
  for (int mt = gw; mt < 1024; mt += nw) {
    const int m = mt * 16 + l15;
    const u16* ap = A + (size_t)m * 1024 + quad * 8;
    const u16* bp = Wt16 + (size_t)l15 * 1024 + quad * 8;
    f32x4 acc = {0.f, 0.f, 0.f, 0.f};
#pragma unroll 8
    for (int ks = 0; ks < 32; ++ks) acc = mfma16(*(const bf16x8*)(bp + ks * 32), *(const bf16x8*)(ap + ks * 32), acc);
    float rs;
    if constexpr (MODE == 0) rs = ((const float*)(p.ws + OFF_RS0))[m];
    else rs = rsqrtf(((const float*)(p.ws + OFF_SS1))[m] * (1.f / 1024.f) + kEps);
    f32x4 ov = acc * rs;
    if constexpr (MODE == 1) {
#pragma unroll
      for (int jj = 0; jj < 4; ++jj) {
        const int n = 4 * quad + jj;
        const float xv = ov[jj] + p.b_f_bias[n & 7];
        ov[jj] = fminf(xv, 0.f) - log1pf(__expf(-fabsf(xv)));
      }
    }
    *(f32x4*)(out + (size_t)m * 16 + 4 * quad) = ov;
  }
}

DI void delta_prep(const Params& p, char* smem, int first, int nblk) {
  char* ws = p.ws;
  const u16* proj = (const u16*)(ws + OFF_PROJ);
  const float* braw = (const float*)(ws + OFF_BRAW);
  u16* qd_g = (u16*)(ws + OFF_R);
  u16* kT_g = (u16*)(ws + OFF_R + 32 * MiB);
  u16* at_g = (u16*)(ws + OFF_R + 64 * MiB);
  u16* uT_g = (u16*)p.out;
  u16* w_g = (u16*)((char*)p.out + 32 * MiB);
  float* gend_g = (float*)(ws + OFF_GEND);
  char* qL = smem;
  char* kL = smem + 16384;
  char* vL = smem + 32768;
  float* As = (float*)(smem + 49152);
  float* sc = (float*)(smem + 66560);
  float* g_s = sc;
  float* beta_s = sc + 64;
  float* rq_s = sc + 128;
  float* rk_s = sc + 192;
  float* ssq_s = sc + 256;
  float* fu_s = sc + 384;
  float* fw_s = sc + 448;
  const int tid_ = tidx();

  unsigned* flags = (unsigned*)(ws + OFF_FLAGS);
  const __amdgpu_buffer_rsrc_t r_qd = __builtin_amdgcn_make_buffer_rsrc(qd_g, 0, 32 << 20, 0x00020000);
  const __amdgpu_buffer_rsrc_t r_kT = __builtin_amdgcn_make_buffer_rsrc(kT_g, 0, 32 << 20, 0x00020000);
  const __amdgpu_buffer_rsrc_t r_at = __builtin_amdgcn_make_buffer_rsrc(at_g, 0, 16 << 20, 0x00020000);
  const __amdgpu_buffer_rsrc_t r_uT = __builtin_amdgcn_make_buffer_rsrc(uT_g, 0, 32 << 20, 0x00020000);
  const __amdgpu_buffer_rsrc_t r_w = __builtin_amdgcn_make_buffer_rsrc(w_g, 0, 32 << 20, 0x00020000);
  if (nblk >= 256 && ((int)blockIdx.x - first) >= (nblk >> 1)) {
    for (int i = 0; i < 7; ++i) __builtin_amdgcn_s_sleep(127);
  }
  for (int j = (int)blockIdx.x - first; j < 2048; j += nblk) {
    const int c = j >> 4, b = (j >> 3) & 1, h = j & 7;
    const int item = (b * 128 + c) * 8 + h;
    const int tok0 = b * 8192 + c * 64;
    const int tid = relaunder(tid_), lane = tid & 63, wave = tid >> 6, l15 = lane & 15, quad = lane >> 4;
    if (wave == 3) {
      const int row = tok0 + lane;
      const float br = braw[(size_t)row * 16 + h];
      const float ar = braw[(size_t)row * 16 + 8 + h] + p.a_dt_bias[h];
      const float beta = 1.f / (1.f + __expf(-br));
      const float sp = fmaxf(ar, 0.f) + log1pf(__expf(-fabsf(ar)));
      float g = -__expf(p.a_A_log[h]) * sp;
#pragma unroll
      for (int o = 1; o < 64; o <<= 1) { float t = __shfl_up(g, o); if (lane >= o) g += t; }
      g_s[lane] = g;
      beta_s[lane] = beta;
    } else {
      const int sec = wave, cgi = l15, rr = quad;
      const int col = sec * 1024 + h * 128 + cgi * 8;
      float w0[8], w1[8], w2[8], w3[8];
#pragma unroll
      for (int e = 0; e < 8; ++e) {
        w0[e] = p.a_conv_w[0 * 3072 + col + e]; w1[e] = p.a_conv_w[1 * 3072 + col + e];
        w2[e] = p.a_conv_w[2 * 3072 + col + e]; w3[e] = p.a_conv_w[3 * 3072 + col + e];
      }
      const u16* src = proj + (size_t)(tok0 + rr * 16) * 4096 + col;
      float x0[8], x1[8], x2[8], x3[8];
      if (c == 0 && rr == 0) {
#pragma unroll
        for (int e = 0; e < 8; ++e) { x0[e] = 0.f; x1[e] = 0.f; x2[e] = 0.f; }
      } else {
        unpack8(*(const u32x4*)(src - 3 * 4096), x0);
        unpack8(*(const u32x4*)(src - 2 * 4096), x1);
        unpack8(*(const u32x4*)(src - 1 * 4096), x2);
      }
      char* dstL = smem + sec * 16384;
#pragma unroll 4
      for (int r = 0; r < 16; ++r) {
        unpack8(*(const u32x4*)(src + (size_t)r * 4096), x3);
        float y[8];
        float ssq = 0.f;
#pragma unroll
        for (int e = 0; e < 8; ++e) {
          float v = w0[e] * x0[e] + w1[e] * x1[e] + w2[e] * x2[e] + w3[e] * x3[e];
          v = silu(v);
          y[e] = v;
          ssq += v * v;
          x0[e] = x1[e]; x1[e] = x2[e]; x2[e] = x3[e];
        }
        ssq += dpp_f<0x121>(ssq); ssq += dpp_f<0x122>(ssq); ssq += dpp_f<0x124>(ssq); ssq += dpp_f<0x128>(ssq);
        const int row = rr * 16 + r;
        if (sec < 2 && cgi == 0) ssq_s[sec * 64 + row] = ssq;
        *(u32x4*)(dstL + row * 256 + ((cgi ^ (row & 15)) << 4)) = packf8(y);
      }
    }
    __syncthreads();
    if (tid < 64) {
      const float rq = rsqrtf(ssq_s[tid] + kEps), rk = rsqrtf(ssq_s[64 + tid] + kEps);
      const float gi = g_s[tid], g63 = g_s[63];
      const float eg = __expf(gi);
      rq_s[tid] = rq; rk_s[tid] = rk;
      const float be = beta_s[tid];
      fu_s[tid] = be;
      fw_s[tid] = be * rk * eg;
      ssq_s[tid] = rq * kScale * eg;
      ssq_s[64 + tid] = rk * __expf(g63 - gi);
      if (tid == 0) __hip_atomic_store(gend_g + item, __expf(g63), __ATOMIC_RELAXED, __HIP_MEMORY_SCOPE_AGENT);
    }
    __syncthreads();
    {
      const int tid = relaunder(tid_), lane = tid & 63, wave = tid >> 6, l15 = lane & 15, quad = lane >> 4;
      bf16x8 bk[4], bq[4];
      const int rowI = 16 * wave + l15;
#pragma unroll
      for (int ks = 0; ks < 4; ++ks) {
        const int off = rowI * 256 + (((ks * 4 + quad) ^ (rowI & 15)) << 4);
        bk[ks] = *(const bf16x8*)(kL + off);
        bq[ks] = *(const bf16x8*)(qL + off);
      }
      const int i = rowI;
      const float gi = g_s[i], bi = beta_s[i] * rk_s[i], qi = kScale * rq_s[i];
      u32x2 keep = {0u, 0u};
#pragma unroll
      for (int J = 0; J < 4; ++J) {
        f32x4 skk = {0.f, 0.f, 0.f, 0.f}, sqk = {0.f, 0.f, 0.f, 0.f};
        const int rowJ = 16 * J + l15;
#pragma unroll
        for (int ks = 0; ks < 4; ++ks) {
          const bf16x8 ak = *(const bf16x8*)(kL + rowJ * 256 + (((ks * 4 + quad) ^ (rowJ & 15)) << 4));
          skk = mfma16(ak, bk[ks], skk);
          sqk = mfma16(ak, bq[ks], sqk);
        }
        const f32x4 gj4 = *(const f32x4*)(g_s + 16 * J + 4 * quad);
        const f32x4 rk4 = *(const f32x4*)(rk_s + 16 * J + 4 * quad);
        f32x4 a4, t4;
#pragma unroll
        for (int jj = 0; jj < 4; ++jj) {
          const int j = 16 * J + 4 * quad + jj;
          const float dec = (i >= j) ? __expf(gi - gj4[jj]) : 0.f;
          a4[jj] = (i > j) ? bi * rk4[jj] * skk[jj] * dec : 0.f;
          t4[jj] = qi * rk4[jj] * sqk[jj] * dec;
        }
        *(f32x4*)(As + i * 68 + 16 * J + 4 * quad) = a4;
        const u32x2 half = {pack2(t4[0], t4[1]), pack2(t4[2], t4[3])};
        if ((J & 1) == 0) keep = half;
        else {
          const u32x4 fr = {keep.x, keep.y, half.x, half.y};
          __builtin_amdgcn_raw_buffer_store_b128(fr, r_at, item * 8192 + ((wave * 2 + (J >> 1)) * 64 + lane) * 16, 0, 16);
        }
      }
    }
    {
      const int tid = relaunder(tid_);
#pragma unroll
      for (int it = 0; it < 4; ++it) {
        const int idx = tid + 256 * it;
        const int f = idx >> 6, ln = idx & 63, fl = ln & 15, fq = ln >> 4;
        {
          const int mt = f >> 2, ks = f & 3, i = 16 * mt + fl;
          const int c0 = 4 * ks + (fq >> 1), o8 = (fq & 1) * 8;
          const u32x2 lo = *(const u32x2*)(qL + i * 256 + ((c0 ^ (i & 15)) << 4) + o8);
          const u32x2 hi = *(const u32x2*)(qL + i * 256 + (((c0 + 2) ^ (i & 15)) << 4) + o8);
          const float s = ssq_s[i];
          const u32x4 o = {pack2(bflo(lo.x) * s, bfhi(lo.x) * s), pack2(bflo(lo.y) * s, bfhi(lo.y) * s),
                           pack2(bflo(hi.x) * s, bfhi(hi.x) * s), pack2(bflo(hi.y) * s, bfhi(hi.y) * s)};
          __builtin_amdgcn_raw_buffer_store_b128(o, r_qd, item * 16384 + idx * 16, 0, 16);
        }
        {
          const int mt = f >> 1, ks = f & 1, dk = 16 * mt + fl;
          float v[8];
#pragma unroll
          for (int e = 0; e < 8; ++e) {
            const int i = 32 * ks + ((e < 4) ? (4 * fq + e) : (16 + 4 * fq + e - 4));
            const u16 raw = *(const u16*)(kL + i * 256 + (((dk >> 3) ^ (i & 15)) << 4) + (dk & 7) * 2);
            v[e] = __uint_as_float(((unsigned)raw) << 16) * ssq_s[64 + i];
          }
          __builtin_amdgcn_raw_buffer_store_b128(packf8(v), r_kT, item * 16384 + idx * 16, 0, 16);
        }
      }
    }
    __syncthreads();
    {
      float U[64];
      const int tid = relaunder(tid_), wave = tid >> 6;
      const int cc = tid & 127, ch = cc >> 3, e2 = (cc & 7) * 2;
      const char* srcL = (wave < 2) ? vL : kL;
      const float* fr = (wave < 2) ? fu_s : fw_s;
#pragma unroll
      for (int i = 0; i < 64; ++i) {
        int ii = i;
        asm volatile("" : "+v"(ii));
        const u16 raw = *(const u16*)(srcL + ii * 256 + ((ch ^ (ii & 15)) << 4) + e2);
        float acc = __uint_as_float(((unsigned)raw) << 16) * fr[ii];
#pragma unroll
        for (int j = 0; j < i; ++j) acc -= As[i * 68 + j] * U[j];
        U[i] = acc;
      }
      if (wave < 2) {
        const int dofs = item * 16384 + (((cc >> 4) * 4) * 256 + (cc & 15) * 4) * 2;
#pragma unroll
        for (int mi = 0; mi < 4; ++mi)
#pragma unroll
          for (int q4 = 0; q4 < 4; ++q4) {
            const u32x2 o = {pack2(U[16 * mi + 4 * q4], U[16 * mi + 4 * q4 + 1]), pack2(U[16 * mi + 4 * q4 + 2], U[16 * mi + 4 * q4 + 3])};
            __builtin_amdgcn_raw_buffer_store_b64(o, r_uT, dofs + (mi * 256 + q4 * 64) * 2, 0, 16);
          }
      } else {
#pragma unroll
        for (int i = 0; i < 64; ++i) {
          int ii = i;
          asm volatile("" : "+v"(ii));
          *(u16*)(qL + ii * 256 + ((ch ^ (ii & 15)) << 4) + e2) = (u16)f2bf(U[i]);
        }
      }
    }
    __syncthreads();
    {
      const int tid = relaunder(tid_);
#pragma unroll
      for (int it = 0; it < 4; ++it) {
        const int idx = tid + 256 * it;
        const int f = idx >> 6, ln = idx & 63, fl = ln & 15, fq = ln >> 4;
        const int mt = f >> 2, ks = f & 3, i = 16 * mt + fl;
        const int c0 = 4 * ks + (fq >> 1), o8 = (fq & 1) * 8;
        const u32x2 lo = *(const u32x2*)(qL + i * 256 + ((c0 ^ (i & 15)) << 4) + o8);
        const u32x2 hi = *(const u32x2*)(qL + i * 256 + (((c0 + 2) ^ (i & 15)) << 4) + o8);
        const u32x4 o = {lo.x, lo.y, hi.x, hi.y};
        __builtin_amdgcn_raw_buffer_store_b128(o, r_w, item * 16384 + idx * 16, 0, 16);
      }
    }
    asm volatile("s_waitcnt vmcnt(0)" ::: "memory");
    __syncthreads();
    if (relaunder(tid_) == 0) __hip_atomic_store(flags + item, 1u, __ATOMIC_RELAXED, __HIP_MEMORY_SCOPE_AGENT);
  }
}

#define RAW_BARRIER() do { asm volatile("s_waitcnt lgkmcnt(0)" ::: "memory"); __builtin_amdgcn_s_barrier(); asm volatile("" ::: "memory"); } while (0)
#define GAS __attribute__((address_space(1)))
#define SCAN_LOAD(item_)                                                                                          \
  do {                                                                                                            \
    const GAS char* wb_ = (const GAS char*)((const char*)w_g + (size_t)(item_) * 16384);                          \
    const GAS char* qb_ = (const GAS char*)((const char*)qd_g + (size_t)(item_) * 16384);                         \
    const GAS char* kb_ = (const GAS char*)((const char*)kT_g + (size_t)(item_) * 16384);                         \
    const GAS char* ab_ = (const GAS char*)((const char*)at_g + (size_t)(item_) * 8192);                          \
    const GAS char* ub_ = (const GAS char*)((const char*)uT_g + (size_t)(item_) * 16384);                         \
    asm volatile("" : "+s"(wb_), "+s"(qb_), "+s"(kb_), "+s"(ab_), "+s"(ub_));                                     \
    _Pragma("unroll") for (int j = 0; j < 4; ++j) {                                                               \
      R[j] = *(const GAS u32x4*)(wb_ + (toff + 4096u * j));                                                       \
      R[4 + j] = *(const GAS u32x4*)(qb_ + (toff + 4096u * j));                                                   \
      R[8 + j] = *(const GAS u32x4*)(kb_ + (toff + 4096u * j));                                                   \
    }                                                                                                             \
    _Pragma("unroll") for (int j = 0; j < 2; ++j) R[12 + j] = *(const GAS u32x4*)(ab_ + (toff + 4096u * j));     \
    _Pragma("unroll") for (int mi = 0; mi < 4; ++mi) un[mi] = *(const GAS u32x2*)(ub_ + (uoff + 512u * mi));     \
    gn = gend_g[item_];                                                                                           \
  } while (0)
DI void delta_scan(const Params& p, char* smem) {
  char* ws = p.ws;
  const u16* qd_g = (const u16*)(ws + OFF_R);
  const u16* kT_g = (const u16*)(ws + OFF_R + 32 * MiB);
  const u16* at_g = (const u16*)(ws + OFF_R + 64 * MiB);
  const u16* uT_g = (const u16*)p.out;
  const u16* w_g = (const u16*)((const char*)p.out + 32 * MiB);
  const float* gend_g = (const float*)(ws + OFF_GEND);
  u16* o_g = (u16*)(ws + OFF_PROJ);
  unsigned* flags = (unsigned*)(ws + OFF_FLAGS);
  const int tid = tidx(), lane = tid & 63, wave = tid >> 6, l15 = lane & 15, quad = lane >> 4;
  char* Lw = smem;
  char* Lq = smem + 16384;
  char* Lk = smem + 32768;
  char* La = smem + 49152;
  char* Lo = smem + 57344;
  for (int unit = blockIdx.x; unit < 32; unit += gridDim.x) {
    const int bh = unit & 15, half = unit >> 4, b = bh >> 3, h = bh & 7;
    const int slice = half * 4 + wave;
    f32x4 S[8];
#pragma unroll
    for (int i = 0; i < 8; ++i) S[i] = (f32x4){0.f, 0.f, 0.f, 0.f};
    const unsigned toff = (unsigned)tid * 16u, uoff = (unsigned)(slice * 256 + lane) * 8u;
    u32x4 R[14];
    u32x2 un[4];
    float gn;
#define SCAN_WAIT(flv_, item_)                                                                                         \
  do {                                                                                                                 \
    unsigned f_ = (flv_), sp_ = 0u;                                                                                    \
    while (f_ == 0u && sp_ < (1u << 24)) { __builtin_amdgcn_s_sleep(2); f_ = __hip_atomic_load(flags + (item_), __ATOMIC_RELAXED, __HIP_MEMORY_SCOPE_AGENT); ++sp_; } \
    __builtin_amdgcn_fence(__ATOMIC_ACQUIRE, "workgroup");           \
  } while (0)
    unsigned fl;
    {
      const int item = (b * 128) * 8 + h;
      SCAN_WAIT(0u, item);
      SCAN_LOAD(item);
      fl = __hip_atomic_load(flags + ((b * 128 + 1) * 8 + h), __ATOMIC_RELAXED, __HIP_MEMORY_SCOPE_AGENT);
    }
    for (int c = 0; c < 128; ++c) {
#pragma unroll
      for (int j = 0; j < 4; ++j) {
        *(u32x4*)(Lw + (tid + 256 * j) * 16) = R[j];
        *(u32x4*)(Lq + (tid + 256 * j) * 16) = R[4 + j];
        *(u32x4*)(Lk + (tid + 256 * j) * 16) = R[8 + j];
      }
#pragma unroll
      for (int j = 0; j < 2; ++j) *(u32x4*)(La + (tid + 256 * j) * 16) = R[12 + j];
      u32x2 uc[4];
#pragma unroll
      for (int mi = 0; mi < 4; ++mi) uc[mi] = un[mi];
      const float gend = gn;
      RAW_BARRIER();
      if (c + 1 < 128) SCAN_WAIT(fl, (b * 128 + c + 1) * 8 + h);
      if (c > 0) {
        const int tokp = b * 8192 + (c - 1) * 64;
#pragma unroll
        for (int k2 = 0; k2 < 2; ++k2) {
          const int idx = tid + 256 * k2, row = idx >> 3, part = idx & 7;
          *(u32x4*)(o_g + (size_t)(tokp + row) * 4096 + h * 128 + half * 64 + part * 8) = *(const u32x4*)(Lo + idx * 16);
        }
      }
      if (c + 1 < 128) {
        const int item = (b * 128 + c + 1) * 8 + h;
        SCAN_LOAD(item);
        fl = (c + 2 < 128) ? __hip_atomic_load(flags + (item + 8), __ATOMIC_RELAXED, __HIP_MEMORY_SCOPE_AGENT) : 1u;
      }
      __builtin_amdgcn_sched_barrier(0);
      bf16x8 bS[4];
#pragma unroll
      for (int ks = 0; ks < 4; ++ks) bS[ks] = pack8(S[2 * ks], S[2 * ks + 1]);
      bf16x8 fr[16];
#pragma unroll
      for (int i = 0; i < 16; ++i) fr[i] = *(const bf16x8*)(Lw + (i * 64 + lane) * 16);
      __builtin_amdgcn_sched_barrier(0);
      f32x4 vn[4];
#pragma unroll
      for (int mi = 0; mi < 4; ++mi) vn[mi] = (f32x4){0.f, 0.f, 0.f, 0.f};
#pragma unroll
      for (int ks = 0; ks < 4; ++ks)
#pragma unroll
        for (int mi = 0; mi < 4; ++mi) vn[mi] = mfma16(fr[mi * 4 + ks], bS[ks], vn[mi]);
      __builtin_amdgcn_sched_barrier(0);
#pragma unroll
      for (int i = 0; i < 16; ++i) fr[i] = *(const bf16x8*)(Lk + (i * 64 + lane) * 16);
#pragma unroll
      for (int mi = 0; mi < 4; ++mi) {
        vn[mi][0] = bflo(uc[mi].x) - vn[mi][0]; vn[mi][1] = bfhi(uc[mi].x) - vn[mi][1];
        vn[mi][2] = bflo(uc[mi].y) - vn[mi][2]; vn[mi][3] = bfhi(uc[mi].y) - vn[mi][3];
      }
      bf16x8 bV[2];
      bV[0] = pack8(vn[0], vn[1]);
      bV[1] = pack8(vn[2], vn[3]);
#pragma unroll
      for (int mt = 0; mt < 8; ++mt) S[mt] = S[mt] * gend;
      __builtin_amdgcn_sched_barrier(0);
#pragma unroll
      for (int ks = 0; ks < 2; ++ks)
#pragma unroll
        for (int mt = 0; mt < 8; ++mt) S[mt] = mfma16(fr[mt * 2 + ks], bV[ks], S[mt]);
      __builtin_amdgcn_sched_barrier(0);
#pragma unroll
      for (int i = 0; i < 16; ++i) fr[i] = *(const bf16x8*)(Lq + (i * 64 + lane) * 16);
      __builtin_amdgcn_sched_barrier(0);
      f32x4 oacc[4];
#pragma unroll
      for (int mi = 0; mi < 4; ++mi) oacc[mi] = (f32x4){0.f, 0.f, 0.f, 0.f};
#pragma unroll
      for (int ks = 0; ks < 4; ++ks)
#pragma unroll
        for (int mi = 0; mi < 4; ++mi) oacc[mi] = mfma16(fr[mi * 4 + ks], bS[ks], oacc[mi]);
      __builtin_amdgcn_sched_barrier(0);
#pragma unroll
      for (int i = 0; i < 8; ++i) fr[i] = *(const bf16x8*)(La + (i * 64 + lane) * 16);
      __builtin_amdgcn_sched_barrier(0);
#pragma unroll
      for (int ks = 0; ks < 2; ++ks)
#pragma unroll
        for (int mi = 0; mi < 4; ++mi) oacc[mi] = mfma16(fr[mi * 2 + ks], bV[ks], oacc[mi]);
      __builtin_amdgcn_sched_barrier(0);
#pragma unroll
      for (int mi = 0; mi < 4; ++mi)
#pragma unroll
        for (int jj = 0; jj < 4; ++jj)
          *(u16*)(Lo + (16 * mi + 4 * quad + jj) * 128 + (wave * 16 + l15) * 2) = (u16)f2bf(oacc[mi][jj]);
      RAW_BARRIER();
    }
    {
      const int tokp = b * 8192 + 127 * 64;
#pragma unroll
      for (int k2 = 0; k2 < 2; ++k2) {
        const int idx = tid + 256 * k2, row = idx >> 3, part = idx & 7;
        *(u32x4*)(o_g + (size_t)(tokp + row) * 4096 + h * 128 + half * 64 + part * 8) = *(const u32x4*)(Lo + idx * 16);
      }
      RAW_BARRIER();
    }
  }
}

#undef SCAN_LOAD
#undef SCAN_WAIT

DI void gate_phase(const Params& p) {
  char* ws = p.ws;
  const u16* proj = (const u16*)(ws + OFF_PROJ);
  u16* y0 = (u16*)(ws + OFF_R + 32 * MiB);
  const int tidg = tidx();
  const int lane = tidg & 63, l15 = lane & 15, quad = lane >> 4;
  const int gw = blockIdx.x * 4 + (tidg >> 6), nw = gridDim.x * 4;
  float wn[8];
#pragma unroll
  for (int e = 0; e < 8; ++e) wn[e] = p.a_o_norm_w[l15 * 8 + e];
  for (int r4 = gw; r4 < 32768; r4 += nw) {
    const int rh = r4 * 4 + quad, tok = rh >> 3, h = rh & 7;
    float o[8], z[8];
    unpack8(*(const u32x4*)(proj + (size_t)tok * 4096 + h * 128 + l15 * 8), o);
    unpack8(*(const u32x4*)(proj + (size_t)tok * 4096 + 3072 + h * 128 + l15 * 8), z);
    float ssq = 0.f;
#pragma unroll
    for (int e = 0; e < 8; ++e) ssq += o[e] * o[e];
    ssq += dpp_f<0x121>(ssq); ssq += dpp_f<0x122>(ssq); ssq += dpp_f<0x124>(ssq); ssq += dpp_f<0x128>(ssq);
    const float rs = rsqrtf(ssq * (1.f / 128.f) + kEps);
#pragma unroll
    for (int e = 0; e < 8; ++e) o[e] = o[e] * rs * wn[e] * silu(z[e]);
    *(u32x4*)(y0 + (size_t)tok * 1024 + h * 128 + l15 * 8) = packf8(o);
  }
}

DI void qknorm_cumsum(const Params& p, char* smem) {
  char* ws = p.ws;
  u16* proj = (u16*)(ws + OFF_PROJ);
  const int tid = tidx(), lane = tid & 63, l15 = lane & 15, quad = lane >> 4;
  const int gw = blockIdx.x * 4 + (tid >> 6), nw = gridDim.x * 4;
  for (int idx = gw; idx < 65536; idx += nw) {
    const int which = idx >> 15, r4 = idx & 32767;
    const int rh = r4 * 4 + quad, tok = rh >> 3, h = rh & 7;
    const float* wv = which ? p.b_k_norm_w : p.b_q_norm_w;
    u16* ptr = proj + (size_t)tok * 4096 + which * 1024 + h * 128 + l15 * 8;
    float v[8];
    unpack8(*(const u32x4*)ptr, v);
    float ssq = 0.f;
#pragma unroll
    for (int e = 0; e < 8; ++e) ssq += v[e] * v[e];
    ssq += __shfl_xor(ssq, 1); ssq += __shfl_xor(ssq, 2); ssq += __shfl_xor(ssq, 4); ssq += __shfl_xor(ssq, 8);
    const float rs = rsqrtf(ssq * (1.f / 128.f) + kEps) * (which ? 1.f : kScale);
#pragma unroll
    for (int e = 0; e < 8; ++e) v[e] = v[e] * rs * wv[l15 * 8 + e];
    *(u32x4*)ptr = packf8(v);
  }
}

DI void attn_phase(const Params& p, char* smem) {
  char* ws = p.ws;
  const u16* proj = (const u16*)(ws + OFF_PROJ);
  const u16* vT = (const u16*)(ws + OFF_R + 32 * MiB);
  const float* fraw = (const float*)(ws + OFF_FRAW);
  u16* y1 = (u16*)(ws + OFF_R + 64 * MiB);
  float* bias_s = (float*)(smem + 65536);
  float* ca_s = bias_s + 128;
  const int tid_ = tidx();
  float mq = 0.f, mk = 0.f;
  for (int i = 0; i < 128; ++i) { mq = fmaxf(mq, fabsf(p.b_q_norm_w[i])); mk = fmaxf(mk, fabsf(p.b_k_norm_w[i])); }
  const float QKB = 128.f * kScale * mq * mk;
  float* mmin_s = (float*)(smem + 66320);

  unsigned* qctr = (unsigned*)(ws + OFF_BAR) + XCD_BAR_WORDS;
  int* qslot = (int*)(smem + 66304);
  int qx = blockIdx.x & 7, qtries = 0;
  while (true) {
    const int tid = relaunder(tid_), lane = tid & 63, wave = tid >> 6, l15 = lane & 15, quad = lane >> 4;
    if (tid == 0) *qslot = (int)atomicAdd(qctr + qx * 16, 1u);
    __syncthreads();
    const int it = *qslot;
    __syncthreads();
    if (it >= 128) { if (++qtries >= 8) break; qx = (qx + 1) & 7; continue; }
    const int qb = 63 - (it & 63);
    const int b = it >> 6, h = b ? ((qx + 4) & 7) : qx, bh = b * 8 + h, i0 = qb * 128;
    const int qrow0 = i0 + 32 * wave;
    const float fb = p.b_f_bias[h];
    bf16x8 bq[2][4];
#pragma unroll
    for (int nq = 0; nq < 2; ++nq)
#pragma unroll
      for (int ks = 0; ks < 4; ++ks)
        bq[nq][ks] = *(const bf16x8*)(proj + (size_t)(b * 8192 + qrow0 + 16 * nq + l15) * 4096 + h * 128 + 32 * ks + 8 * quad);
    f32x4 O[8][2];
#pragma unroll
    for (int dt = 0; dt < 8; ++dt) { O[dt][0] = (f32x4){0.f, 0.f, 0.f, 0.f}; O[dt][1] = (f32x4){0.f, 0.f, 0.f, 0.f}; }
    float mrun[2] = {-1e30f, -1e30f}, lrun[2] = {0.f, 0.f};

    const int kkey = wave * 4 + (lane >> 4);
    const int kch = (lane & 15) ^ (kkey & 15);
    const u16* Kg = proj + (size_t)(b * 8192 + kkey) * 4096 + 1024 + h * 128 + kch * 8;
    const int vd = wave * 8 + (lane >> 3);
    const int vch = (lane & 7) ^ ((((wave & 1) << 2) + (lane >> 4)) & 7);
    const u16* Vg = vT + (size_t)(bh * 128 + vd) * 8192 + vch * 8;
#define ATT_STAGE(buf, j0_)                                                                                                   \
  do {                                                                                                                        \
    _Pragma("unroll") for (int i = 0; i < 4; ++i) {                                                                           \
      __builtin_amdgcn_global_load_lds((const unsigned*)(Kg + (size_t)((j0_) + 16 * i) * 4096),                               \
                                       (unsigned*)(smem + (buf) * 32768 + (i * 4 + wave) * 1024), 16, 0, 0);                  \
      __builtin_amdgcn_global_load_lds((const unsigned*)(Vg + (size_t)(32 * i) * 8192 + (j0_)),                               \
                                       (unsigned*)(smem + (buf) * 32768 + 16384 + (i * 4 + wave) * 1024), 16, 0, 0);          \
    }                                                                                                                         \
  } while (0)
    int j0 = i0 + 64;
    ATT_STAGE(0, j0);
    float carry = 0.f, biasA = 0.f, frn = 0.f;
    if (wave == 0) {
      const float lfA = fraw[(size_t)(b * 8192 + i0 + lane) * 16 + h];
      const float lfB = fraw[(size_t)(b * 8192 + i0 + 64 + lane) * 16 + h];
      float pa = lfA, pb = lfB;
#pragma unroll
      for (int o = 1; o < 64; o <<= 1) {
        const float ta = __shfl_up(pa, o), tb = __shfl_up(pb, o);
        if (lane >= o) { pa += ta; pb += tb; }
      }
      const float lf0 = __shfl(lfA, 0), totA = __shfl(pa, 63);
      biasA = -(pa - lf0) * kLog2e;
      bias_s[lane] = -(totA - lf0 + pb) * kLog2e;
      carry = lf0;
    }
    if (lane == 0) { mmin_s[wave] = -1e30f; mmin_s[4 + wave] = -1e30f; }
    asm volatile("s_waitcnt vmcnt(0)" ::: "memory");
    __syncthreads();
    auto att_tile = [&](const int cur, const bool diag) __attribute__((always_inline)) -> bool {
      const int nj = j0 - 64;
      bool more = nj >= 0;
      if (more && j0 <= i0) {
        const float* mm = mmin_s + cur * 4;
        const float mmin = fminf(fminf(mm[0], mm[1]), fminf(mm[2], mm[3]));
        more = !((QKB + ca_s[cur]) * kLog2e < mmin - 30.f * kLog2e);
      }
      if (more) {
        ATT_STAGE(cur ^ 1, nj);
        if (wave == 0 && nj < i0) frn = fraw[(size_t)(b * 8192 + nj + lane) * 16 + h];
      }
      if (j0 <= qrow0 + 31) {
        const char* Ks = smem + cur * 32768;
        const char* Vs = Ks + 16384;
        const float* cs = bias_s + cur * 64;
        f32x4 s[4][2];
#pragma unroll
        for (int kt = 0; kt < 4; ++kt) { s[kt][0] = (f32x4){0.f, 0.f, 0.f, 0.f}; s[kt][1] = (f32x4){0.f, 0.f, 0.f, 0.f}; }
#pragma unroll
        for (int ks = 0; ks < 4; ++ks)
#pragma unroll
          for (int kt = 0; kt < 4; ++kt) {
            const int kl = 16 * kt + l15;
            const bf16x8 ak = *(const bf16x8*)(Ks + kl * 256 + (((ks * 4 + quad) ^ (kl & 15)) << 4));
            s[kt][0] = mfma16(ak, bq[0][ks], s[kt][0]);
            s[kt][1] = mfma16(ak, bq[1][ks], s[kt][1]);
          }
#pragma unroll
        for (int kt = 0; kt < 4; ++kt) {
          const f32x4 bias = *(const f32x4*)(cs + 16 * kt + 4 * quad);
#pragma unroll
          for (int nq = 0; nq < 2; ++nq)
#pragma unroll
            for (int jj = 0; jj < 4; ++jj) {
              float v = s[kt][nq][jj] + bias[jj];
              if (diag) { if (j0 + 16 * kt + 4 * quad + jj > qrow0 + 16 * nq + l15) v = -1e30f; }
              s[kt][nq][jj] = v;
            }
        }
        bf16x8 bP[2][2];
#pragma unroll
        for (int nq = 0; nq < 2; ++nq) {
          float tmax = -1e30f;
#pragma unroll
          for (int kt = 0; kt < 4; ++kt)
#pragma unroll
            for (int jj = 0; jj < 4; ++jj) tmax = fmaxf(tmax, s[kt][nq][jj]);
          tmax = fmaxf(tmax, __shfl_xor(tmax, 16));
          {
            const unsigned tc = __float_as_uint(tmax);
            const auto r32 = __builtin_amdgcn_permlane32_swap(tc, tc, false, false);
            tmax = fmaxf(__uint_as_float(r32[0]), __uint_as_float(r32[1]));
          }
          const float mnew = fmaxf(mrun[nq], tmax);
          const float alpha = __builtin_amdgcn_exp2f(mrun[nq] - mnew);
          const bool grew = mnew > mrun[nq];
          mrun[nq] = mnew;
          float psum = 0.f;
#pragma unroll
          for (int kt = 0; kt < 4; ++kt)
#pragma unroll
            for (int jj = 0; jj < 4; ++jj) { const float pv = __builtin_amdgcn_exp2f(s[kt][nq][jj] - mnew); s[kt][nq][jj] = pv; psum += pv; }
          lrun[nq] = lrun[nq] * alpha + psum;
          if (__builtin_amdgcn_ballot_w64(grew) != 0ull) {
#pragma unroll
            for (int dt = 0; dt < 8; ++dt) O[dt][nq] = O[dt][nq] * alpha;
          }
          bP[0][nq] = pack8(s[0][nq], s[1][nq]);
          bP[1][nq] = pack8(s[2][nq], s[3][nq]);
        }
#pragma unroll
        for (int ks = 0; ks < 2; ++ks)
#pragma unroll
          for (int dt = 0; dt < 8; ++dt) {
            const int d = 16 * dt + l15, sw = (d >> 1) & 7, c0 = 4 * ks + (quad >> 1);
            const u32x2 lo = *(const u32x2*)(Vs + d * 128 + ((c0 ^ sw) << 4) + (quad & 1) * 8);
            const u32x2 hi = *(const u32x2*)(Vs + d * 128 + (((c0 + 2) ^ sw) << 4) + (quad & 1) * 8);
            const bf16x8 av = mk8(lo, hi);
            O[dt][0] = mfma16(av, bP[ks][0], O[dt][0]);
            O[dt][1] = mfma16(av, bP[ks][1], O[dt][1]);
          }
        float wm = fminf(mrun[0], mrun[1]);
        wm = fminf(wm, dpp_f<0x121>(wm)); wm = fminf(wm, dpp_f<0x122>(wm)); wm = fminf(wm, dpp_f<0x124>(wm)); wm = fminf(wm, dpp_f<0x128>(wm));
        wm = fminf(fminf(readlane_f(wm, 0), readlane_f(wm, 16)), fminf(readlane_f(wm, 32), readlane_f(wm, 48)));
        if (lane == 0) mmin_s[(cur ^ 1) * 4 + wave] = wm;
      }
      if (more && wave == 0) {
        const int nb = cur ^ 1;
        if (nj == i0) {
          bias_s[nb * 64 + lane] = biasA;
          if (lane == 0) ca_s[nb] = carry;
        } else {
          const float lf = frn;
          float x = lf;
          x += dpp_f<0x101>(x); x += dpp_f<0x102>(x); x += dpp_f<0x104>(x); x += dpp_f<0x108>(x);
          const float t0 = readlane_f(x, 0), t1 = readlane_f(x, 16), t2 = readlane_f(x, 32), t3 = readlane_f(x, 48);
          const int rowi = lane >> 4;
          const float radd = (rowi == 0) ? (t1 + t2 + t3) : (rowi == 1) ? (t2 + t3) : (rowi == 2) ? t3 : 0.f;
          const float sf = x + radd;
          bias_s[nb * 64 + lane] = (sf - lf + carry) * kLog2e;
          carry += (t0 + t1) + (t2 + t3);
          if (lane == 0) ca_s[nb] = carry;
        }
      }
      asm volatile("s_waitcnt vmcnt(0)" ::: "memory");
      __syncthreads();
      if (!more) return false;
      j0 = nj;
      return true;
    };
    if (att_tile(0, true) && att_tile(1, true)) {
      while (true) {
        if (!att_tile(0, false)) break;
        if (!att_tile(1, false)) break;
      }
    }
#undef ATT_STAGE
#pragma unroll
    for (int nq = 0; nq < 2; ++nq) {
      float l = lrun[nq];
      l += __shfl_xor(l, 16);
      l += __shfl_xor(l, 32);
      const float inv = 1.f / l;
      const size_t tok = (size_t)(b * 8192 + qrow0 + 16 * nq + l15);
#pragma unroll
      for (int dt = 0; dt < 8; ++dt) {
        const int d = 16 * dt + 4 * quad;
        const u32x2 z2 = *(const u32x2*)(proj + tok * 4096 + 3072 + h * 128 + d);
        const f32x4 o = O[dt][nq] * inv;
        u32x2 r = {pack2(o[0] * silu(bflo(z2.x)), o[1] * silu(bfhi(z2.x))), pack2(o[2] * silu(bflo(z2.y)), o[3] * silu(bfhi(z2.y)))};
        *(u32x2*)(y1 + tok * 1024 + h * 128 + d) = r;
      }
    }
  }
}

DI void final_norm(const Params& p) {
  const float* ss2 = (const float*)(p.ws + OFF_SS2);
  const int tidf = tidx();
  const int lane = tidf & 63;
  const int gw = blockIdx.x * 4 + (tidf >> 6), nw = gridDim.x * 4;
  const f32x4* w = (const f32x4*)p.final_norm_w;
  f32x4 wv[4];
#pragma unroll
  for (int i = 0; i < 4; ++i) wv[i] = w[lane + 64 * i];
  for (int row = gw; row < 16384; row += 4 * nw) {
    u32x2 r[4][4];
    float rs[4];
#pragma unroll
    for (int k = 0; k < 4; ++k) {
      const int rr = row + k * nw;
      const bool okr = rr < 16384;
      const int rc = okr ? rr : row;
      rs[k] = rsqrtf(ss2[rc] * (1.f / 1024.f) + kEps);
      const u32x2* hsrc = (const u32x2*)((const u16*)(p.ws + OFF_R) + (size_t)rc * 1024);
#pragma unroll
      for (int i = 0; i < 4; ++i) r[k][i] = hsrc[lane + 64 * i];
    }
#pragma unroll
    for (int k = 0; k < 4; ++k) {
      const int rr = row + k * nw;
      if (rr < 16384) {
        f32x4* o = (f32x4*)(p.out + (size_t)rr * 1024);
#pragma unroll
        for (int i = 0; i < 4; ++i) {
          f32x4 v = {bflo(r[k][i].x), bfhi(r[k][i].x), bflo(r[k][i].y), bfhi(r[k][i].y)};
          __builtin_nontemporal_store(v * rs[k] * wv[i], o + lane + 64 * i);
        }
      }
    }
  }
}

__global__ void __launch_bounds__(kThreads, 2) fwd_megakernel(Params p) {
  extern __shared__ __attribute__((aligned(16))) char smem[];
  cg::grid_group grid = cg::this_grid();
  char* ws = p.ws;
  __shared__ uint4 xb_words;
  if (threadIdx.x == 0) xb_words = make_uint4(0u, 0u, 0u, 0u);
  __syncthreads();
  if (p.ws == nullptr) grid.sync();
  XcdBarrier xb = xcd_barrier_post((unsigned*)(ws + OFF_BAR), (volatile LAS unsigned*)&xb_words);
  phase0(p, smem);
  xcd_barrier(xb);
  gemm_phase<1>(p, (const u16*)(ws + OFF_R), (const u16*)(ws + OFF_WTA_IN), 32, smem);
  skinny_gemm<0>(p, (const u16*)(ws + OFF_R), (const u16*)(ws + OFF_WTA_IN) + (size_t)4096 * 1024, (float*)(ws + OFF_BRAW));
  xcd_barrier(xb);
  {
    const bool overlap = gridDim.x >= 128;
    const int G = (int)gridDim.x, hG = G >> 1, bi = (int)blockIdx.x;
    const bool is_scan = overlap && bi < 32, is_idle = overlap && bi >= hG && bi < hG + 32;
    const int pfirst = overlap ? (bi < hG ? 32 : 64) : 0, pn = overlap ? G - 64 : G;
    if (!is_scan && !is_idle) delta_prep(p, smem, pfirst, pn);
    if (!is_scan && !is_idle) phase0b(p, smem, pfirst, pn);
    if (!overlap) xcd_barrier(xb);
    if (!overlap || blockIdx.x < 32) delta_scan(p, smem);
    xcd_barrier(xb);
  }
  gate_phase(p);
  xcd_barrier(xb);
  gemm_phase<2>(p, (const u16*)(ws + OFF_R + 32 * MiB), (const u16*)(ws + OFF_WTA_OUT), 8, smem);
  xcd_barrier(xb);
  gemm_phase<3>(p, (const u16*)(ws + OFF_R), (const u16*)(ws + OFF_WTB_IN), 32, smem);
  skinny_gemm<1>(p, (const u16*)(ws + OFF_R), (const u16*)(ws + OFF_WTB_IN) + (size_t)4096 * 1024, (float*)(ws + OFF_FRAW));
  xcd_barrier(xb);
  attn_phase(p, smem);
  xcd_barrier(xb);
  gemm_phase<4>(p, (const u16*)(ws + OFF_R + 64 * MiB), (const u16*)(ws + OFF_WTB_OUT), 8, smem);
  xcd_barrier(xb);
  final_norm(p);
}

extern "C" void kernel_launch(void* const* d_in, const int* in_sizes, int n_in, void* d_out, int out_size, void* d_ws, size_t ws_size,
                              hipStream_t stream) {
  static int grid_blocks = 0;
  if (!grid_blocks) {
    int dev = 0, cus = 0, per_cu = 0;
    hipGetDevice(&dev);
    hipDeviceGetAttribute(&cus, hipDeviceAttributeMultiprocessorCount, dev);
    hipFuncSetAttribute((const void*)fwd_megakernel, hipFuncAttributeMaxDynamicSharedMemorySize, kLds);
    hipOccupancyMaxActiveBlocksPerMultiprocessor(&per_cu, (const void*)fwd_megakernel, kThreads, kLds);
    if (per_cu < 1) per_cu = 1;
    if (per_cu > 2) per_cu = 2;
    grid_blocks = cus * per_cu;
  }
  Params p{};
  p.x = (const float*)d_in[0]; p.a_norm_w = (const float*)d_in[1]; p.a_w_in = (const float*)d_in[2]; p.a_conv_w = (const float*)d_in[3];
  p.a_A_log = (const float*)d_in[4]; p.a_dt_bias = (const float*)d_in[5]; p.a_o_norm_w = (const float*)d_in[6]; p.a_w_out = (const float*)d_in[7];
  p.b_norm_w = (const float*)d_in[8]; p.b_w_in = (const float*)d_in[9]; p.b_f_bias = (const float*)d_in[10]; p.b_q_norm_w = (const float*)d_in[11];
  p.b_k_norm_w = (const float*)d_in[12]; p.b_w_out = (const float*)d_in[13]; p.final_norm_w = (const float*)d_in[14];
  p.out = (float*)d_out;
  p.ws = (char*)d_ws;
  hipMemsetAsync((char*)d_ws + OFF_BAR, 0, CTL_BYTES, stream);
  void* args[] = {&p};
  hipError_t e = hipLaunchCooperativeKernel((const void*)fwd_megakernel, dim3(grid_blocks), dim3(kThreads), args, kLds, stream);
  if (e != hipSuccess) fprintf(stderr, "cooperative launch failed: %s (grid %d)\n", hipGetErrorString(e), grid_blocks);
}
```

```cpp
#include <hip/hip_runtime.h>
#include <hip/hip_cooperative_groups.h>
#include <cstdio>
namespace cg = cooperative_groups;

typedef unsigned short u16;
typedef __attribute__((ext_vector_type(8))) short bf16x8;
typedef __attribute__((ext_vector_type(4))) float f32x4;
typedef __attribute__((ext_vector_type(4))) unsigned u32x4;
typedef __attribute__((ext_vector_type(2))) unsigned u32x2;
#define DI __device__ __forceinline__

constexpr int kThreads = 256;
constexpr int kLds = 69632;
constexpr float kEps = 1e-6f;
constexpr float kScale = 0.08838834764831845f;
constexpr float kLog2e = 1.4426950408889634f;

constexpr size_t MiB = 1048576;
constexpr size_t OFF_WTA_IN = 0;
constexpr size_t OFF_WTA_OUT = 8650752;
constexpr size_t OFF_WTB_IN = 10747904;
constexpr size_t OFF_WTB_OUT = 19398656;
constexpr size_t OFF_SMALL = 21495808;
constexpr size_t OFF_RS0 = OFF_SMALL;
constexpr size_t OFF_SS1 = OFF_RS0 + 65536;
constexpr size_t OFF_SS2 = OFF_SS1 + 65536;
constexpr size_t OFF_BRAW = OFF_SS2 + 65536;
constexpr size_t OFF_FRAW = OFF_BRAW + 1048576;
constexpr size_t OFF_CCUM = OFF_FRAW + 1048576;
constexpr size_t OFF_GEND = OFF_CCUM + 524288;
constexpr size_t OFF_BAR = OFF_GEND + 8192;
constexpr size_t OFF_FLAGS = OFF_BAR + 13824 + 512;
constexpr size_t CTL_BYTES = 13824 + 512 + 8192;
constexpr size_t OFF_PROJ = OFF_SMALL + 3 * MiB;
constexpr size_t OFF_R = OFF_PROJ + 128 * MiB;

struct Params {
  const float *x, *a_norm_w, *a_w_in, *a_conv_w, *a_A_log, *a_dt_bias, *a_o_norm_w, *a_w_out;
  const float *b_norm_w, *b_w_in, *b_f_bias, *b_q_norm_w, *b_k_norm_w, *b_w_out, *final_norm_w;
  float* out;
  char* ws;
};

typedef __attribute__((ext_vector_type(2))) float f32x2;
typedef __attribute__((ext_vector_type(2))) __bf16 bf16x2_t;
DI unsigned pack2(float a, float b) { f32x2 v = {a, b}; return __builtin_bit_cast(unsigned, __builtin_convertvector(v, bf16x2_t)); }
DI unsigned f2bf(float x) { return pack2(x, 0.f) & 0xffffu; }
DI float bflo(unsigned u) { return __uint_as_float(u << 16); }
DI float bfhi(unsigned u) { return __uint_as_float(u & 0xffff0000u); }
DI f32x4 mfma16(bf16x8 a, bf16x8 b, f32x4 c) { return __builtin_amdgcn_mfma_f32_16x16x32_bf16(a, b, c, 0, 0, 0); }
DI bf16x8 mk8(u32x2 lo, u32x2 hi) { u32x4 v = {lo.x, lo.y, hi.x, hi.y}; return __builtin_bit_cast(bf16x8, v); }
DI bf16x8 pack8(f32x4 a, f32x4 b) { u32x4 v = {pack2(a[0], a[1]), pack2(a[2], a[3]), pack2(b[0], b[1]), pack2(b[2], b[3])}; return __builtin_bit_cast(bf16x8, v); }
DI bf16x8 ld2(const u16* p) { return mk8(*(const u32x2*)p, *(const u32x2*)(p + 16)); }
DI int relaunder(int t) { asm volatile("" : "+v"(t)); return t; }
DI int tidx() { int t = threadIdx.x; asm volatile("" : "+v"(t)); return t; }
template <int CTRL> DI float dpp_f(float x) { return __int_as_float(__builtin_amdgcn_update_dpp(0, __float_as_int(x), CTRL, 0xF, 0xF, true)); }
DI float readlane_f(float x, const int l) { return __int_as_float(__builtin_amdgcn_readlane(__float_as_int(x), l)); }
DI float silu(float x) { return x / (1.f + __expf(-x)); }
DI void unpack8(u32x4 v, float* f) {
  f[0] = bflo(v.x); f[1] = bfhi(v.x); f[2] = bflo(v.y); f[3] = bfhi(v.y);
  f[4] = bflo(v.z); f[5] = bfhi(v.z); f[6] = bflo(v.w); f[7] = bfhi(v.w);
}
DI u32x4 packf8(const float* f) { u32x4 v = {pack2(f[0], f[1]), pack2(f[2], f[3]), pack2(f[4], f[5]), pack2(f[6], f[7])}; return v; }


#define XB_TMO      128
#define XB_XCNT(j)  (256  + 64 * (j))
#define XB_XSUB(j)  (1280 + 64 * (j))
#define XB_XGEN(j)  (2304 + 64 * (j))
#define XB_TOP      3328
#define XB_TOPGEN   3392
#define XCD_BAR_WORDS 3456
#define XB_SPIN_CAP (1u << 23)
#define LAS __attribute__((address_space(3)))
DI unsigned xb_ld(unsigned* p) { return __hip_atomic_load(p, __ATOMIC_RELAXED, __HIP_MEMORY_SCOPE_AGENT); }
DI unsigned xb_add(unsigned* p, unsigned v) { return __hip_atomic_fetch_add(p, v, __ATOMIC_RELAXED, __HIP_MEMORY_SCOPE_AGENT); }
DI unsigned xb_xcc_id() { return (unsigned)__builtin_amdgcn_s_getreg((3 << 11) | 20) & 0xFu; }
#define XB_SPIN(cond, bar) do { unsigned _sp = 0; while (cond) { __builtin_amdgcn_s_sleep(1); \
    if ((++_sp & 255u) == 0u) { if (xb_ld(&(bar)[XB_TMO])) break; if (_sp > XB_SPIN_CAP) { atomicAdd(&(bar)[XB_TMO], 1u); break; } } } } while (0)
struct XcdBarrier { unsigned* bar; unsigned x; volatile LAS unsigned* st; };
DI XcdBarrier xcd_barrier_post(unsigned* bar, volatile LAS unsigned* st) {
  XcdBarrier b; b.bar = bar; b.x = xb_xcc_id(); b.st = st;
  if (threadIdx.x == 0) (void)xb_add(&bar[XB_XCNT(b.x)], 1u);
  return b;
}
DI void xcd_barrier_complete(unsigned* bar, unsigned x, unsigned& nloc, unsigned& nx) {
  const unsigned G = gridDim.x * gridDim.y * gridDim.z;
  unsigned sum, cnt, mine, sp = 0u;
  for (;;) {
    sum = 0u; cnt = 0u; mine = 0u;
#pragma unroll
    for (unsigned j = 0; j < 16; ++j) { const unsigned c = xb_ld(&bar[XB_XCNT(j)]); sum += c; cnt += (c > 0u) ? 1u : 0u; mine = (j == x) ? c : mine; }
    if (sum == G) break;
    __builtin_amdgcn_s_sleep(1);
    if ((++sp & 255u) == 0u) { if (xb_ld(&bar[XB_TMO])) break; if (sp > XB_SPIN_CAP) { atomicAdd(&bar[XB_TMO], 1u); break; } }
  }
  nloc = mine > 0u ? mine : 1u; nx = cnt > 0u ? cnt : 1u;
}
DI void xcd_barrier(const XcdBarrier& b) {
  asm volatile("s_waitcnt vmcnt(0)" ::: "memory");
  __syncthreads();
  if (threadIdx.x == 0) {
    unsigned* bar = b.bar;
    __builtin_amdgcn_s_waitcnt(0);
    unsigned nloc = b.st[0], nx = b.st[1];
    if (nloc == 0u) { xcd_barrier_complete(bar, b.x, nloc, nx); b.st[0] = nloc; b.st[1] = nx; }
    const unsigned old = xb_add(&bar[XB_XSUB(b.x)], 1u);
    const unsigned gen = old / nloc;
    if (old + 1u == (gen + 1u) * nloc) {
      __builtin_amdgcn_fence(__ATOMIC_RELEASE, "agent");
      asm volatile("s_waitcnt vmcnt(0)" ::: "memory");
      const unsigned og = xb_add(&bar[XB_TOP], 1u);
      const unsigned tg = og / nx;
      if (og + 1u == (tg + 1u) * nx) xb_add(&bar[XB_TOPGEN], 1u);
      else XB_SPIN(xb_ld(&bar[XB_TOPGEN]) == tg, bar);
      __builtin_amdgcn_fence(__ATOMIC_ACQUIRE, "agent");
      xb_add(&bar[XB_XGEN(b.x)], 1u);
      asm volatile("s_waitcnt vmcnt(0)" ::: "memory");
    } else {
      XB_SPIN(xb_ld(&bar[XB_XGEN(b.x)]) == gen, bar);
      __builtin_amdgcn_fence(__ATOMIC_ACQUIRE, "agent");
      asm volatile("s_waitcnt vmcnt(0)" ::: "memory");
    }
  }
  __syncthreads();
}

DI void transpose_tile(const float* __restrict__ W, int N, int Npad, const float* __restrict__ kscale, u16* __restrict__ WT, int tile, char* smem) {
  float(*t)[65] = (float(*)[65])smem;
  const int nt = Npad / 64;
  const int k0 = (tile / nt) * 64, n0 = (tile % nt) * 64;
  const int tid = tidx();
  {
    const int tx = tid & 63, ty = tid >> 6;
#pragma unroll 4
    for (int i = 0; i < 16; ++i) {
      const int k = k0 + ty + 4 * i, n = n0 + tx;
      float v = 0.f;
      if (n < N) { v = W[(size_t)k * N + n]; if (kscale) v *= kscale[k]; }
      t[ty + 4 * i][tx] = v;
    }
  }
  __syncthreads();
  {
    const int kx2 = (tid & 31) * 2, ny0 = tid >> 5;
#pragma unroll 4
    for (int i = 0; i < 8; ++i) {
      const int ny = ny0 + 8 * i;
      *(unsigned*)(WT + (size_t)(n0 + ny) * 1024 + k0 + kx2) = pack2(t[kx2][ny], t[kx2 + 1][ny]);
    }
  }
  __syncthreads();
}

DI void phase0(const Params& p, char* smem) {
  char* ws = p.ws;
  {
    float* ss = (float*)(ws + OFF_SS1);
    for (int i = blockIdx.x * kThreads + tidx(); i < 32768; i += gridDim.x * kThreads) ss[i] = 0.f;
  }
  for (int t = blockIdx.x; t < 1312; t += gridDim.x) {
    if (t < 1056) transpose_tile(p.a_w_in, 4112, 4224, p.a_norm_w, (u16*)(ws + OFF_WTA_IN), t, smem);
    else transpose_tile(p.a_w_out, 1024, 1024, nullptr, (u16*)(ws + OFF_WTA_OUT), t - 1056, smem);
  }
  const int tid0 = tidx();
  const int lane = tid0 & 63;
  const int gw = blockIdx.x * 4 + (tid0 >> 6), nw = gridDim.x * 4;
  u16* xb = (u16*)(ws + OFF_R);
  float* rs0 = (float*)(ws + OFF_RS0);
  for (int row = gw; row < 16384; row += 4 * nw) {
    f32x4 v[4][4];
#pragma unroll
    for (int k = 0; k < 4; ++k) {
      const int rr = row + k * nw;
      const f32x4* xr = (const f32x4*)(p.x + (size_t)(rr < 16384 ? rr : row) * 1024);
#pragma unroll
      for (int i = 0; i < 4; ++i) v[k][i] = __builtin_nontemporal_load(xr + lane + 64 * i);
    }
#pragma unroll
    for (int k = 0; k < 4; ++k) {
      const int rr = row + k * nw;
      float ss = 0.f;
#pragma unroll
      for (int i = 0; i < 4; ++i) ss += v[k][i][0] * v[k][i][0] + v[k][i][1] * v[k][i][1] + v[k][i][2] * v[k][i][2] + v[k][i][3] * v[k][i][3];
      ss += dpp_f<0x121>(ss); ss += dpp_f<0x122>(ss); ss += dpp_f<0x124>(ss); ss += dpp_f<0x128>(ss);
      ss = (readlane_f(ss, 0) + readlane_f(ss, 16)) + (readlane_f(ss, 32) + readlane_f(ss, 48));
      if (rr < 16384) {
        u32x2* xo = (u32x2*)(xb + (size_t)rr * 1024);
#pragma unroll
        for (int i = 0; i < 4; ++i) { u32x2 o = {pack2(v[k][i][0], v[k][i][1]), pack2(v[k][i][2], v[k][i][3])}; xo[lane + 64 * i] = o; }
        if (lane == 0) rs0[rr] = rsqrtf(ss * (1.f / 1024.f) + kEps);
      }
    }
  }
}

DI void phase0b(const Params& p, char* smem, int first, int nblk) {
  char* ws = p.ws;
  for (int t = (int)blockIdx.x - first; t < 1312; t += nblk) {
    if (t < 1056) transpose_tile(p.b_w_in, 4104, 4224, p.b_norm_w, (u16*)(ws + OFF_WTB_IN), t, smem);
    else transpose_tile(p.b_w_out, 1024, 1024, nullptr, (u16*)(ws + OFF_WTB_OUT), t - 1056, smem);
  }
}

template <int EPI>
DI void gemm_phase(const Params& p, const u16* __restrict__ A, const u16* __restrict__ Bt, int nTn, char* smem) {
  const int tid = tidx(), lane = tid & 63, wave = tid >> 6;
  const int wr = wave >> 1, wc = wave & 1;
  const int l15 = lane & 15, quad = lane >> 4;
  char* ws = p.ws;
  const int NX = ((gridDim.x & 7) == 0) ? 8 : 1;
  const int xg = blockIdx.x % NX, lb = blockIdx.x / NX, Lb = gridDim.x / NX;
  const int nTnG = nTn >> 3, nSuper = 16 * nTnG;
  const int srow = wave * 8 + (lane >> 3);
  const int sch = (lane & 7) ^ ((((wave & 1) << 2) + (lane >> 4)) & 7);
#define GEMM_TILE(seq_, tm_, tn_, ok_)                                                            \
  do {                                                                                            \
    const int sidx_ = xg + NX * ((seq_) >> 6);                                                    \
    ok_ = sidx_ < nSuper;                                                                         \
    const int tl_ = (seq_) & 63;                                                                  \
    tm_ = (sidx_ / nTnG) * 8 + (tl_ & 7);                                                         \
    tn_ = (sidx_ % nTnG) * 8 + (tl_ >> 3);                                                        \
  } while (0)
#define GEMM_STAGE(buf, kt)                                                                                                   \
  do {                                                                                                                        \
    _Pragma("unroll") for (int i = 0; i < 4; ++i) {                                                                           \
      __builtin_amdgcn_global_load_lds((const unsigned*)(Ag + (size_t)i * 32 * 1024 + (kt) * 64),                             \
                                       (unsigned*)(smem + (buf) * 32768 + (i * 4 + wave) * 1024), 16, 0, 0);                  \
      __builtin_amdgcn_global_load_lds((const unsigned*)(Bg + (size_t)i * 32 * 1024 + (kt) * 64),                             \
                                       (unsigned*)(smem + (buf) * 32768 + 16384 + (i * 4 + wave) * 1024), 16, 0, 0);          \
    }                                                                                                                         \
  } while (0)
  int seq = lb, tm, tn;
  bool ok;
  GEMM_TILE(seq, tm, tn, ok);
  const u16* Ag = A + (size_t)(tm * 128 + srow) * 1024 + sch * 8;
  const u16* Bg = Bt + (size_t)(tn * 128 + srow) * 1024 + sch * 8;
  if (ok) GEMM_STAGE(0, 0);
  while (ok) {
    int tm2, tn2;
    bool ok2;
    GEMM_TILE(seq + Lb, tm2, tn2, ok2);
    f32x4 acc[4][4];
#pragma unroll
    for (int a = 0; a < 4; ++a)
#pragma unroll
      for (int b = 0; b < 4; ++b) acc[a][b] = (f32x4){0.f, 0.f, 0.f, 0.f};
    asm volatile("s_waitcnt vmcnt(0)" ::: "memory");
    __syncthreads();
#pragma unroll 2
    for (int kt = 0; kt < 16; ++kt) {
      const int cur = kt & 1;
      if (kt + 1 < 16) GEMM_STAGE(cur ^ 1, kt + 1);
      else if (ok2) {
        Ag = A + (size_t)(tm2 * 128 + srow) * 1024 + sch * 8;
        Bg = Bt + (size_t)(tn2 * 128 + srow) * 1024 + sch * 8;
        GEMM_STAGE(0, 0);
      }
      const char* sa = smem + cur * 32768;
      const char* sb = sa + 16384;
#pragma unroll
      for (int ks = 0; ks < 2; ++ks) {
        bf16x8 fa[4], fb[4];
        const int ch = ks * 4 + quad;
#pragma unroll
        for (int mi = 0; mi < 4; ++mi) {
          const int row = wr * 64 + mi * 16 + l15;
          fa[mi] = *(const bf16x8*)(sa + row * 128 + ((ch ^ ((row >> 1) & 7)) << 4));
        }
#pragma unroll
        for (int ni = 0; ni < 4; ++ni) {
          const int row = wc * 64 + ni * 16 + l15;
          fb[ni] = *(const bf16x8*)(sb + row * 128 + ((ch ^ ((row >> 1) & 7)) << 4));
        }
#pragma unroll
        for (int ni = 0; ni < 4; ++ni)
#pragma unroll
          for (int mi = 0; mi < 4; ++mi) acc[ni][mi] = mfma16(fb[ni], fa[mi], acc[ni][mi]);
      }
      if (kt < 15) {
        asm volatile("s_waitcnt vmcnt(0)" ::: "memory");
        __syncthreads();
      }
    }
    float hnorm[4] = {1.f, 1.f, 1.f, 1.f};
    if constexpr (EPI == 3) {
      if (tn < 16) {
        float* part = (float*)(smem + 65536);
        float ssq[4];
#pragma unroll
        for (int mi = 0; mi < 4; ++mi) {
          const float rs = rsqrtf(((const float*)(ws + OFF_SS1))[tm * 128 + wr * 64 + mi * 16 + l15] * (1.f / 1024.f) + kEps);
          float s = 0.f;
#pragma unroll
          for (int ni = 0; ni < 4; ++ni) { const f32x4 v = acc[ni][mi] * rs; s += v[0] * v[0] + v[1] * v[1] + v[2] * v[2] + v[3] * v[3]; }
          s += __shfl_xor(s, 16);
          s += __shfl_xor(s, 32);
          ssq[mi] = s;
          if (quad == 0) part[(wr * 2 + wc) * 64 + mi * 16 + l15] = s;
        }
        __syncthreads();
#pragma unroll
        for (int mi = 0; mi < 4; ++mi) {
          const float tot = ssq[mi] + part[(wr * 2 + (wc ^ 1)) * 64 + mi * 16 + l15];
          hnorm[mi] = rsqrtf(tot * (1.f / 128.f) + kEps) * (tn < 8 ? kScale * kLog2e : 1.f);
        }
      }
    }
#pragma unroll
    for (int mi = 0; mi < 4; ++mi) {
      const int m = tm * 128 + wr * 64 + mi * 16 + l15;
      if constexpr (EPI == 1) {
        const float rs = ((const float*)(ws + OFF_RS0))[m];
        u16* proj = (u16*)(ws + OFF_PROJ);
        float* braw = (float*)(ws + OFF_BRAW);
#pragma unroll
        for (int ni = 0; ni < 4; ++ni) {
          const int nb = tn * 128 + wc * 64 + ni * 16 + quad * 4;
          f32x4 v = acc[ni][mi] * rs;
          if (nb < 4096) { u32x2 o = {pack2(v[0], v[1]), pack2(v[2], v[3])}; __builtin_nontemporal_store(o, (u32x2*)(proj + (size_t)m * 4096 + nb)); }
          else if (nb < 4112) { *(f32x4*)(braw + (size_t)m * 16 + (nb - 4096)) = v; }
        }
      } else if constexpr (EPI == 2 || EPI == 4) {
        float* ssp = (float*)(ws + (EPI == 2 ? OFF_SS1 : OFF_SS2));
        u16* hb = (u16*)(ws + OFF_R);
        float ssq = 0.f;
#pragma unroll
        for (int ni = 0; ni < 4; ++ni) {
          const int nb = tn * 128 + wc * 64 + ni * 16 + quad * 4;
          f32x4 v;
          if constexpr (EPI == 2) {
            v = acc[ni][mi] + __builtin_nontemporal_load((const f32x4*)(p.x + (size_t)m * 1024 + nb));
            u32x2 o = {pack2(v[0], v[1]), pack2(v[2], v[3])};
            *(u32x2*)(hb + (size_t)m * 1024 + nb) = o;
            v[0] = bflo(o.x); v[1] = bfhi(o.x); v[2] = bflo(o.y); v[3] = bfhi(o.y);
          } else {
            const u32x2 r = *(const u32x2*)(hb + (size_t)m * 1024 + nb);
            v = acc[ni][mi];
            v[0] += bflo(r.x); v[1] += bfhi(r.x); v[2] += bflo(r.y); v[3] += bfhi(r.y);
            const u32x2 o = {pack2(v[0], v[1]), pack2(v[2], v[3])};
            *(u32x2*)(hb + (size_t)m * 1024 + nb) = o;
            v[0] = bflo(o.x); v[1] = bfhi(o.x); v[2] = bflo(o.y); v[3] = bfhi(o.y);
          }
          ssq += v[0] * v[0] + v[1] * v[1] + v[2] * v[2] + v[3] * v[3];
        }
        ssq += __shfl_xor(ssq, 16);
        ssq += __shfl_xor(ssq, 32);
        if (quad == 0) atomicAdd(ssp + m, ssq);
      } else if constexpr (EPI == 3) {
        const float rs = rsqrtf(((const float*)(ws + OFF_SS1))[m] * (1.f / 1024.f) + kEps);
        u16* proj = (u16*)(ws + OFF_PROJ);
        u16* vT = (u16*)(ws + OFF_R + 32 * MiB);
        float* fraw = (float*)(ws + OFF_FRAW);
        float hs = 1.f;
        if (tn < 16) hs = hnorm[mi];
#pragma unroll
        for (int ni = 0; ni < 4; ++ni) {
          const int nb = tn * 128 + wc * 64 + ni * 16 + quad * 4;
          f32x4 v = acc[ni][mi] * rs;
          if (tn < 16) {
            const f32x4 wv = *(const f32x4*)((tn < 8 ? p.b_q_norm_w : p.b_k_norm_w) + (nb & 127));
            v = v * hs * wv;
          }
          if (nb < 4096) {
            if ((nb >> 10) != 2) { u32x2 o = {pack2(v[0], v[1]), pack2(v[2], v[3])}; __builtin_nontemporal_store(o, (u32x2*)(proj + (size_t)m * 4096 + nb)); }
            else {
              const int hd = nb - 2048;
              const int b = m >> 13, t = m & 8191;
              u16* dst = vT + ((size_t)(b * 1024 + hd)) * 8192 + t;
#pragma unroll
              for (int jj = 0; jj < 4; ++jj) dst[(size_t)jj * 8192] = (u16)f2bf(v[jj]);
            }
          } else if (nb < 4104) { *(f32x4*)(fraw + (size_t)m * 16 + (nb - 4096)) = v; }
        }
      }
    }
    seq += Lb; tm = tm2; tn = tn2; ok = ok2;
  }
#undef GEMM_STAGE
#undef GEMM_TILE
}


template <int MODE>
DI void skinny_gemm(const Params& p, const u16* __restrict__ A, const u16* __restrict__ Wt16, float* __restrict__ out) {
  const int tid = tidx(), lane = tid & 63, l15 = lane & 15, quad = lane >> 4;
  const int gw = blockIdx.x * 4 + (tid >> 6), nw = gridDim.x * 4;
  for (int mt = gw; mt < 1024; mt += nw) {
    const int m = mt * 16 + l15;
    const u16* ap = A + (size_t)m * 1024 + quad * 8;
    const u16* bp = Wt16 + (size_t)l15 * 1024 + quad * 8;
    f32x4 acc = {0.f, 0.f, 0.f, 0.f};
#pragma unroll 8
    for (int ks = 0; ks < 32; ++ks) acc = mfma16(*(const bf16x8*)(bp + ks * 32), *(const bf16x8*)(ap + ks * 32), acc);
    float rs;
    if constexpr (MODE == 0) rs = ((const float*)(p.ws + OFF_RS0))[m];
    else rs = rsqrtf(((const float*)(p.ws + OFF_SS1))[m] * (1.f / 1024.f) + kEps);
    f32x4 ov = acc * rs;
    if constexpr (MODE == 1) {
#pragma unroll
      for (int jj = 0; jj < 4; ++jj) {
        const int n = 4 * quad + jj;
        const float xv = ov[jj] + p.b_f_bias[n & 7];
        ov[jj] = fminf(xv, 0.f) - log1pf(__expf(-fabsf(xv)));
      }
    }
    *(f32x4*)(out + (size_t)m * 16 + 4 * quad) = ov;
  }
}

DI void delta_prep(const Params& p, char* smem, int first, int nblk) {
  char* ws = p.ws;
  const u16* proj = (const u16*)(ws + OFF_PROJ);
  const float* braw = (const float*)(ws + OFF_BRAW);
  u16* qd_g = (u16*)(ws + OFF_R);
  u16* kT_g = (u16*)(ws + OFF_R + 32 * MiB);
  u16* at_g = (u16*)(ws + OFF_R + 64 * MiB);
  u16* uT_g = (u16*)p.out;
  u16* w_g = (u16*)((char*)p.out + 32 * MiB);
  float* gend_g = (float*)(ws + OFF_GEND);
  char* qL = smem;
  char* kL = smem + 16384;
  char* vL = smem + 32768;
  float* As = (float*)(smem + 49152);
  float* sc = (float*)(smem + 66560);
  float* g_s = sc;
  float* beta_s = sc + 64;
  float* rq_s = sc + 128;
  float* rk_s = sc + 192;
  float* ssq_s = sc + 256;
  float* fu_s = sc + 384;
  float* fw_s = sc + 448;
  const int tid_ = tidx();

  unsigned* flags = (unsigned*)(ws + OFF_FLAGS);
  const __amdgpu_buffer_rsrc_t r_qd = __builtin_amdgcn_make_buffer_rsrc(qd_g, 0, 32 << 20, 0x00020000);
  const __amdgpu_buffer_rsrc_t r_kT = __builtin_amdgcn_make_buffer_rsrc(kT_g, 0, 32 << 20, 0x00020000);
  const __amdgpu_buffer_rsrc_t r_at = __builtin_amdgcn_make_buffer_rsrc(at_g, 0, 16 << 20, 0x00020000);
  const __amdgpu_buffer_rsrc_t r_uT = __builtin_amdgcn_make_buffer_rsrc(uT_g, 0, 32 << 20, 0x00020000);
  const __amdgpu_buffer_rsrc_t r_w = __builtin_amdgcn_make_buffer_rsrc(w_g, 0, 32 << 20, 0x00020000);
  if (nblk >= 256 && ((int)blockIdx.x - first) >= (nblk >> 1)) {
    for (int i = 0; i < 7; ++i) __builtin_amdgcn_s_sleep(127);
  }
  for (int j = (int)blockIdx.x - first; j < 2048; j += nblk) {
    const int c = j >> 4, b = (j >> 3) & 1, h = j & 7;
    const int item = (b * 128 + c) * 8 + h;
    const int tok0 = b * 8192 + c * 64;
    const int tid = relaunder(tid_), lane = tid & 63, wave = tid >> 6, l15 = lane & 15, quad = lane >> 4;
    if (wave == 3) {
      const int row = tok0 + lane;
      const float br = braw[(size_t)row * 16 + h];
      const float ar = braw[(size_t)row * 16 + 8 + h] + p.a_dt_bias[h];
      const float beta = 1.f / (1.f + __expf(-br));
      const float sp = fmaxf(ar, 0.f) + log1pf(__expf(-fabsf(ar)));
      float g = -__expf(p.a_A_log[h]) * sp;
#pragma unroll
      for (int o = 1; o < 64; o <<= 1) { float t = __shfl_up(g, o); if (lane >= o) g += t; }
      g_s[lane] = g;
      beta_s[lane] = beta;
    } else {
      const int sec = wave, cgi = l15, rr = quad;
      const int col = sec * 1024 + h * 128 + cgi * 8;
      float w0[8], w1[8], w2[8], w3[8];
#pragma unroll
      for (int e = 0; e < 8; ++e) {
        w0[e] = p.a_conv_w[0 * 3072 + col + e]; w1[e] = p.a_conv_w[1 * 3072 + col + e];
        w2[e] = p.a_conv_w[2 * 3072 + col + e]; w3[e] = p.a_conv_w[3 * 3072 + col + e];
      }
      const u16* src = proj + (size_t)(tok0 + rr * 16) * 4096 + col;
      float x0[8], x1[8], x2[8], x3[8];
      if (c == 0 && rr == 0) {
#pragma unroll
        for (int e = 0; e < 8; ++e) { x0[e] = 0.f; x1[e] = 0.f; x2[e] = 0.f; }
      } else {
        unpack8(*(const u32x4*)(src - 3 * 4096), x0);
        unpack8(*(const u32x4*)(src - 2 * 4096), x1);
        unpack8(*(const u32x4*)(src - 1 * 4096), x2);
      }
      char* dstL = smem + sec * 16384;
#pragma unroll 4
      for (int r = 0; r < 16; ++r) {
        unpack8(*(const u32x4*)(src + (size_t)r * 4096), x3);
        float y[8];
        float ssq = 0.f;
#pragma unroll
        for (int e = 0; e < 8; ++e) {
          float v = w0[e] * x0[e] + w1[e] * x1[e] + w2[e] * x2[e] + w3[e] * x3[e];
          v = silu(v);
          y[e] = v;
          ssq += v * v;
          x0[e] = x1[e]; x1[e] = x2[e]; x2[e] = x3[e];
        }
        ssq += dpp_f<0x121>(ssq); ssq += dpp_f<0x122>(ssq); ssq += dpp_f<0x124>(ssq); ssq += dpp_f<0x128>(ssq);
        const int row = rr * 16 + r;
        if (sec < 2 && cgi == 0) ssq_s[sec * 64 + row] = ssq;
        *(u32x4*)(dstL + row * 256 + ((cgi ^ (row & 15)) << 4)) = packf8(y);
      }
    }
    __syncthreads();
    if (tid < 64) {
      const float rq = rsqrtf(ssq_s[tid] + kEps), rk = rsqrtf(ssq_s[64 + tid] + kEps);
      const float gi = g_s[tid], g63 = g_s[63];
      const float eg = __expf(gi);
      rq_s[tid] = rq; rk_s[tid] = rk;
      const float be = beta_s[tid];
      fu_s[tid] = be;
      fw_s[tid] = be * rk * eg;
      ssq_s[tid] = rq * kScale * eg;
      ssq_s[64 + tid] = rk * __expf(g63 - gi);
      if (tid == 0) __hip_atomic_store(gend_g + item, __expf(g63), __ATOMIC_RELAXED, __HIP_MEMORY_SCOPE_AGENT);
    }
    __syncthreads();
    {
      const int tid = relaunder(tid_), lane = tid & 63, wave = tid >> 6, l15 = lane & 15, quad = lane >> 4;
      bf16x8 bk[4], bq[4];
      const int rowI = 16 * wave + l15;
#pragma unroll
      for (int ks = 0; ks < 4; ++ks) {
        const int off = rowI * 256 + (((ks * 4 + quad) ^ (rowI & 15)) << 4);
        bk[ks] = *(const bf16x8*)(kL + off);
        bq[ks] = *(const bf16x8*)(qL + off);
      }
      const int i = rowI;
      const float gi = g_s[i], bi = beta_s[i] * rk_s[i], qi = kScale * rq_s[i];
      u32x2 keep = {0u, 0u};
#pragma unroll
      for (int J = 0; J < 4; ++J) {
        f32x4 skk = {0.f, 0.f, 0.f, 0.f}, sqk = {0.f, 0.f, 0.f, 0.f};
        const int rowJ = 16 * J + l15;
#pragma unroll
        for (int ks = 0; ks < 4; ++ks) {
          const bf16x8 ak = *(const bf16x8*)(kL + rowJ * 256 + (((ks * 4 + quad) ^ (rowJ & 15)) << 4));
          skk = mfma16(ak, bk[ks], skk);
          sqk = mfma16(ak, bq[ks], sqk);
        }
        const f32x4 gj4 = *(const f32x4*)(g_s + 16 * J + 4 * quad);
        const f32x4 rk4 = *(const f32x4*)(rk_s + 16 * J + 4 * quad);
        f32x4 a4, t4;
#pragma unroll
        for (int jj = 0; jj < 4; ++jj) {
          const int j = 16 * J + 4 * quad + jj;
          const float dec = (i >= j) ? __expf(gi - gj4[jj]) : 0.f;
          a4[jj] = (i > j) ? bi * rk4[jj] * skk[jj] * dec : 0.f;
          t4[jj] = qi * rk4[jj] * sqk[jj] * dec;
        }
        *(f32x4*)(As + i * 68 + 16 * J + 4 * quad) = a4;
        const u32x2 half = {pack2(t4[0], t4[1]), pack2(t4[2], t4[3])};
        if ((J & 1) == 0) keep = half;
        else {
          const u32x4 fr = {keep.x, keep.y, half.x, half.y};
          __builtin_amdgcn_raw_buffer_store_b128(fr, r_at, item * 8192 + ((wave * 2 + (J >> 1)) * 64 + lane) * 16, 0, 16);
        }
      }
    }
    {
      const int tid = relaunder(tid_);
#pragma unroll
      for (int it = 0; it < 4; ++it) {
        const int idx = tid + 256 * it;
        const int f = idx >> 6, ln = idx & 63, fl = ln & 15, fq = ln >> 4;
        {
          const int mt = f >> 2, ks = f & 3, i = 16 * mt + fl;
          const int c0 = 4 * ks + (fq >> 1), o8 = (fq & 1) * 8;
          const u32x2 lo = *(const u32x2*)(qL + i * 256 + ((c0 ^ (i & 15)) << 4) + o8);
          const u32x2 hi = *(const u32x2*)(qL + i * 256 + (((c0 + 2) ^ (i & 15)) << 4) + o8);
          const float s = ssq_s[i];
          const u32x4 o = {pack2(bflo(lo.x) * s, bfhi(lo.x) * s), pack2(bflo(lo.y) * s, bfhi(lo.y) * s),
                           pack2(bflo(hi.x) * s, bfhi(hi.x) * s), pack2(bflo(hi.y) * s, bfhi(hi.y) * s)};
          __builtin_amdgcn_raw_buffer_store_b128(o, r_qd, item * 16384 + idx * 16, 0, 16);
        }
        {
          const int mt = f >> 1, ks = f & 1, dk = 16 * mt + fl;
          float v[8];
#pragma unroll
          for (int e = 0; e < 8; ++e) {
            const int i = 32 * ks + ((e < 4) ? (4 * fq + e) : (16 + 4 * fq + e - 4));
            const u16 raw = *(const u16*)(kL + i * 256 + (((dk >> 3) ^ (i & 15)) << 4) + (dk & 7) * 2);
            v[e] = __uint_as_float(((unsigned)raw) << 16) * ssq_s[64 + i];
          }
          __builtin_amdgcn_raw_buffer_store_b128(packf8(v), r_kT, item * 16384 + idx * 16, 0, 16);
        }
      }
    }
    __syncthreads();
    {
      float U[64];
      const int tid = relaunder(tid_), wave = tid >> 6;
      const int cc = tid & 127, ch = cc >> 3, e2 = (cc & 7) * 2;
      const char* srcL = (wave < 2) ? vL : kL;
      const float* fr = (wave < 2) ? fu_s : fw_s;
#pragma unroll
      for (int i = 0; i < 64; ++i) {
        int ii = i;
        asm volatile("" : "+v"(ii));
        const u16 raw = *(const u16*)(srcL + ii * 256 + ((ch ^ (ii & 15)) << 4) + e2);
        float acc = __uint_as_float(((unsigned)raw) << 16) * fr[ii];
#pragma unroll
        for (int j = 0; j < i; ++j) acc -= As[i * 68 + j] * U[j];
        U[i] = acc;
      }
      if (wave < 2) {
        const int dofs = item * 16384 + (((cc >> 4) * 4) * 256 + (cc & 15) * 4) * 2;
#pragma unroll
        for (int mi = 0; mi < 4; ++mi)
#pragma unroll
          for (int q4 = 0; q4 < 4; ++q4) {
            const u32x2 o = {pack2(U[16 * mi + 4 * q4], U[16 * mi + 4 * q4 + 1]), pack2(U[16 * mi + 4 * q4 + 2], U[16 * mi + 4 * q4 + 3])};
            __builtin_amdgcn_raw_buffer_store_b64(o, r_uT, dofs + (mi * 256 + q4 * 64) * 2, 0, 16);
          }
      } else {
#pragma unroll
        for (int i = 0; i < 64; ++i) {
          int ii = i;
          asm volatile("" : "+v"(ii));
          *(u16*)(qL + ii * 256 + ((ch ^ (ii & 15)) << 4) + e2) = (u16)f2bf(U[i]);
        }
      }
    }
    __syncthreads();
    {
      const int tid = relaunder(tid_);
#pragma unroll
      for (int it = 0; it < 4; ++it) {
        const int idx = tid + 256 * it;
        const int f = idx >> 6, ln = idx & 63, fl = ln & 15, fq = ln >> 4;
        const int mt = f >> 2, ks = f & 3, i = 16 * mt + fl;
        const int c0 = 4 * ks + (fq >> 1), o8 = (fq & 1) * 8;
        const u32x2 lo = *(const u32x2*)(qL + i * 256 + ((c0 ^ (i & 15)) << 4) + o8);
        const u32x2 hi = *(const u32x2*)(qL + i * 256 + (((c0 + 2) ^ (i & 15)) << 4) + o8);
        const u32x4 o = {lo.x, lo.y, hi.x, hi.y};
        __builtin_amdgcn_raw_buffer_store_b128(o, r_w, item * 16384 + idx * 16, 0, 16);
      }
    }
    asm volatile("s_waitcnt vmcnt(0)" ::: "memory");
    __syncthreads();
    if (relaunder(tid_) == 0) __hip_atomic_store(flags + item, 1u, __ATOMIC_RELAXED, __HIP_MEMORY_SCOPE_AGENT);
  }
}

#define RAW_BARRIER() do { asm volatile("s_waitcnt lgkmcnt(0)" ::: "memory"); __builtin_amdgcn_s_barrier(); asm volatile("" ::: "memory"); } while (0)
#define GAS __attribute__((address_space(1)))
#define SCAN_LOAD(item_)                                                                                          \
  do {                                                                                                            \
    const GAS char* wb_ = (const GAS char*)((const char*)w_g + (size_t)(item_) * 16384);                          \
    const GAS char* qb_ = (const GAS char*)((const char*)qd_g + (size_t)(item_) * 16384);                         \
    const GAS char* kb_ = (const GAS char*)((const char*)kT_g + (size_t)(item_) * 16384);                         \
    const GAS char* ab_ = (const GAS char*)((const char*)at_g + (size_t)(item_) * 8192);                          \
    const GAS char* ub_ = (const GAS char*)((const char*)uT_g + (size_t)(item_) * 16384);                         \
    asm volatile("" : "+s"(wb_), "+s"(qb_), "+s"(kb_), "+s"(ab_), "+s"(ub_));                                     \
    _Pragma("unroll") for (int j = 0; j < 4; ++j) {                                                               \
      R[j] = *(const GAS u32x4*)(wb_ + (toff + 4096u * j));                                                       \
      R[4 + j] = *(const GAS u32x4*)(qb_ + (toff + 4096u * j));                                                   \
      R[8 + j] = *(const GAS u32x4*)(kb_ + (toff + 4096u * j));                                                   \
    }                                                                                                             \
    _Pragma("unroll") for (int j = 0; j < 2; ++j) R[12 + j] = *(const GAS u32x4*)(ab_ + (toff + 4096u * j));     \
    _Pragma("unroll") for (int mi = 0; mi < 4; ++mi) un[mi] = *(const GAS u32x2*)(ub_ + (uoff + 512u * mi));     \
    gn = gend_g[item_];                                                                                           \
  } while (0)
DI void delta_scan(const Params& p, char* smem) {
  char* ws = p.ws;
  const u16* qd_g = (const u16*)(ws + OFF_R);
  const u16* kT_g = (const u16*)(ws + OFF_R + 32 * MiB);
  const u16* at_g = (const u16*)(ws + OFF_R + 64 * MiB);
  const u16* uT_g = (const u16*)p.out;
  const u16* w_g = (const u16*)((const char*)p.out + 32 * MiB);
  const float* gend_g = (const float*)(ws + OFF_GEND);
  u16* o_g = (u16*)(ws + OFF_PROJ);
  unsigned* flags = (unsigned*)(ws + OFF_FLAGS);
  const int tid = tidx(), lane = tid & 63, wave = tid >> 6, l15 = lane & 15, quad = lane >> 4;
  char* Lw = smem;
  char* Lq = smem + 16384;
  char* Lk = smem + 32768;
  char* La = smem + 49152;
  char* Lo = smem + 57344;
  for (int unit = blockIdx.x; unit < 32; unit += gridDim.x) {
    const int bh = unit & 15, half = unit >> 4, b = bh >> 3, h = bh & 7;
    const int slice = half * 4 + wave;
    f32x4 S[8];
#pragma unroll
    for (int i = 0; i < 8; ++i) S[i] = (f32x4){0.f, 0.f, 0.f, 0.f};
    const unsigned toff = (unsigned)tid * 16u, uoff = (unsigned)(slice * 256 + lane) * 8u;
    u32x4 R[14];
    u32x2 un[4];
    float gn;
#define SCAN_WAIT(flv_, item_)                                                                                         \
  do {                                                                                                                 \
    unsigned f_ = (flv_), sp_ = 0u;                                                                                    \
    while (f_ == 0u && sp_ < (1u << 24)) { __builtin_amdgcn_s_sleep(2); f_ = __hip_atomic_load(flags + (item_), __ATOMIC_RELAXED, __HIP_MEMORY_SCOPE_AGENT); ++sp_; } \
    __builtin_amdgcn_fence(__ATOMIC_ACQUIRE, "workgroup");           \
  } while (0)
    unsigned fl;
    {
      const int item = (b * 128) * 8 + h;
      SCAN_WAIT(0u, item);
      SCAN_LOAD(item);
      fl = __hip_atomic_load(flags + ((b * 128 + 1) * 8 + h), __ATOMIC_RELAXED, __HIP_MEMORY_SCOPE_AGENT);
    }
    for (int c = 0; c < 128; ++c) {
#pragma unroll
      for (int j = 0; j < 4; ++j) {
        *(u32x4*)(Lw + (tid + 256 * j) * 16) = R[j];
        *(u32x4*)(Lq + (tid + 256 * j) * 16) = R[4 + j];
        *(u32x4*)(Lk + (tid + 256 * j) * 16) = R[8 + j];
      }
#pragma unroll
      for (int j = 0; j < 2; ++j) *(u32x4*)(La + (tid + 256 * j) * 16) = R[12 + j];
      u32x2 uc[4];
#pragma unroll
      for (int mi = 0; mi < 4; ++mi) uc[mi] = un[mi];
      const float gend = gn;
      RAW_BARRIER();
      if (c + 1 < 128) SCAN_WAIT(fl, (b * 128 + c + 1) * 8 + h);
      if (c > 0) {
        const int tokp = b * 8192 + (c - 1) * 64;
#pragma unroll
        for (int k2 = 0; k2 < 2; ++k2) {
          const int idx = tid + 256 * k2, row = idx >> 3, part = idx & 7;
          *(u32x4*)(o_g + (size_t)(tokp + row) * 4096 + h * 128 + half * 64 + part * 8) = *(const u32x4*)(Lo + idx * 16);
        }
      }
      if (c + 1 < 128) {
        const int item = (b * 128 + c + 1) * 8 + h;
        SCAN_LOAD(item);
        fl = (c + 2 < 128) ? __hip_atomic_load(flags + (item + 8), __ATOMIC_RELAXED, __HIP_MEMORY_SCOPE_AGENT) : 1u;
      }
      __builtin_amdgcn_sched_barrier(0);
      bf16x8 bS[4];
#pragma unroll
      for (int ks = 0; ks < 4; ++ks) bS[ks] = pack8(S[2 * ks], S[2 * ks + 1]);
      bf16x8 fr[16];
#pragma unroll
      for (int i = 0; i < 16; ++i) fr[i] = *(const bf16x8*)(Lw + (i * 64 + lane) * 16);
      __builtin_amdgcn_sched_barrier(0);
      f32x4 vn[4];
#pragma unroll
      for (int mi = 0; mi < 4; ++mi) vn[mi] = (f32x4){0.f, 0.f, 0.f, 0.f};
#pragma unroll
      for (int ks = 0; ks < 4; ++ks)
#pragma unroll
        for (int mi = 0; mi < 4; ++mi) vn[mi] = mfma16(fr[mi * 4 + ks], bS[ks], vn[mi]);
      __builtin_amdgcn_sched_barrier(0);
#pragma unroll
      for (int i = 0; i < 16; ++i) fr[i] = *(const bf16x8*)(Lk + (i * 64 + lane) * 16);
#pragma unroll
      for (int mi = 0; mi < 4; ++mi) {
        vn[mi][0] = bflo(uc[mi].x) - vn[mi][0]; vn[mi][1] = bfhi(uc[mi].x) - vn[mi][1];
        vn[mi][2] = bflo(uc[mi].y) - vn[mi][2]; vn[mi][3] = bfhi(uc[mi].y) - vn[mi][3];
      }
      bf16x8 bV[2];
      bV[0] = pack8(vn[0], vn[1]);
      bV[1] = pack8(vn[2], vn[3]);
#pragma unroll
      for (int mt = 0; mt < 8; ++mt) S[mt] = S[mt] * gend;
      __builtin_amdgcn_sched_barrier(0);
#pragma unroll
      for (int ks = 0; ks < 2; ++ks)
#pragma unroll
        for (int mt = 0; mt < 8; ++mt) S[mt] = mfma16(fr[mt * 2 + ks], bV[ks], S[mt]);
      __builtin_amdgcn_sched_barrier(0);
#pragma unroll
      for (int i = 0; i < 16; ++i) fr[i] = *(const bf16x8*)(Lq + (i * 64 + lane) * 16);
      __builtin_amdgcn_sched_barrier(0);
      f32x4 oacc[4];
#pragma unroll
      for (int mi = 0; mi < 4; ++mi) oacc[mi] = (f32x4){0.f, 0.f, 0.f, 0.f};
#pragma unroll
      for (int ks = 0; ks < 4; ++ks)
#pragma unroll
        for (int mi = 0; mi < 4; ++mi) oacc[mi] = mfma16(fr[mi * 4 + ks], bS[ks], oacc[mi]);
      __builtin_amdgcn_sched_barrier(0);
#pragma unroll
      for (int i = 0; i < 8; ++i) fr[i] = *(const bf16x8*)(La + (i * 64 + lane) * 16);
      __builtin_amdgcn_sched_barrier(0);
#pragma unroll
      for (int ks = 0; ks < 2; ++ks)
#pragma unroll
        for (int mi = 0; mi < 4; ++mi) oacc[mi] = mfma16(fr[mi * 2 + ks], bV[ks], oacc[mi]);
      __builtin_amdgcn_sched_barrier(0);
#pragma unroll
      for (int mi = 0; mi < 4; ++mi)
#pragma unroll
        for (int jj = 0; jj < 4; ++jj)
          *(u16*)(Lo + (16 * mi + 4 * quad + jj) * 128 + (wave * 16 + l15) * 2) = (u16)f2bf(oacc[mi][jj]);
      RAW_BARRIER();
    }
    {
      const int tokp = b * 8192 + 127 * 64;
#pragma unroll
      for (int k2 = 0; k2 < 2; ++k2) {
        const int idx = tid + 256 * k2, row = idx >> 3, part = idx & 7;
        *(u32x4*)(o_g + (size_t)(tokp + row) * 4096 + h * 128 + half * 64 + part * 8) = *(const u32x4*)(Lo + idx * 16);
      }
      RAW_BARRIER();
    }
  }
}

#undef SCAN_LOAD
#undef SCAN_WAIT

DI void gate_phase(const Params& p) {
  char* ws = p.ws;
  const u16* proj = (const u16*)(ws + OFF_PROJ);
  u16* y0 = (u16*)(ws + OFF_R + 32 * MiB);
  const int tidg = tidx();
  const int lane = tidg & 63, l15 = lane & 15, quad = lane >> 4;
  const int gw = blockIdx.x * 4 + (tidg >> 6), nw = gridDim.x * 4;
  float wn[8];
#pragma unroll
  for (int e = 0; e < 8; ++e) wn[e] = p.a_o_norm_w[l15 * 8 + e];
  for (int r4 = gw; r4 < 32768; r4 += nw) {
    const int rh = r4 * 4 + quad, tok = rh >> 3, h = rh & 7;
    float o[8], z[8];
    unpack8(*(const u32x4*)(proj + (size_t)tok * 4096 + h * 128 + l15 * 8), o);
    unpack8(*(const u32x4*)(proj + (size_t)tok * 4096 + 3072 + h * 128 + l15 * 8), z);
    float ssq = 0.f;
#pragma unroll
    for (int e = 0; e < 8; ++e) ssq += o[e] * o[e];
    ssq += dpp_f<0x121>(ssq); ssq += dpp_f<0x122>(ssq); ssq += dpp_f<0x124>(ssq); ssq += dpp_f<0x128>(ssq);
    const float rs = rsqrtf(ssq * (1.f / 128.f) + kEps);
#pragma unroll
    for (int e = 0; e < 8; ++e) o[e] = o[e] * rs * wn[e] * silu(z[e]);
    *(u32x4*)(y0 + (size_t)tok * 1024 + h * 128 + l15 * 8) = packf8(o);
  }
}

DI void qknorm_cumsum(const Params& p, char* smem) {
  char* ws = p.ws;
  u16* proj = (u16*)(ws + OFF_PROJ);
  const int tid = tidx(), lane = tid & 63, l15 = lane & 15, quad = lane >> 4;
  const int gw = blockIdx.x * 4 + (tid >> 6), nw = gridDim.x * 4;
  for (int idx = gw; idx < 65536; idx += nw) {
    const int which = idx >> 15, r4 = idx & 32767;
    const int rh = r4 * 4 + quad, tok = rh >> 3, h = rh & 7;
    const float* wv = which ? p.b_k_norm_w : p.b_q_norm_w;
    u16* ptr = proj + (size_t)tok * 4096 + which * 1024 + h * 128 + l15 * 8;
    float v[8];
    unpack8(*(const u32x4*)ptr, v);
    float ssq = 0.f;
#pragma unroll
    for (int e = 0; e < 8; ++e) ssq += v[e] * v[e];
    ssq += __shfl_xor(ssq, 1); ssq += __shfl_xor(ssq, 2); ssq += __shfl_xor(ssq, 4); ssq += __shfl_xor(ssq, 8);
    const float rs = rsqrtf(ssq * (1.f / 128.f) + kEps) * (which ? 1.f : kScale);
#pragma unroll
    for (int e = 0; e < 8; ++e) v[e] = v[e] * rs * wv[l15 * 8 + e];
    *(u32x4*)ptr = packf8(v);
  }
}

DI void attn_phase(const Params& p, char* smem) {
  char* ws = p.ws;
  const u16* proj = (const u16*)(ws + OFF_PROJ);
  const u16* vT = (const u16*)(ws + OFF_R + 32 * MiB);
  const float* fraw = (const float*)(ws + OFF_FRAW);
  u16* y1 = (u16*)(ws + OFF_R + 64 * MiB);
  float* bias_s = (float*)(smem + 65536);
  float* ca_s = bias_s + 128;
  const int tid_ = tidx();
  float mq = 0.f, mk = 0.f;
  for (int i = 0; i < 128; ++i) { mq = fmaxf(mq, fabsf(p.b_q_norm_w[i])); mk = fmaxf(mk, fabsf(p.b_k_norm_w[i])); }
  const float QKB = 128.f * kScale * mq * mk;
  float* mmin_s = (float*)(smem + 66320);

  unsigned* qctr = (unsigned*)(ws + OFF_BAR) + XCD_BAR_WORDS;
  int* qslot = (int*)(smem + 66304);
  int qx = blockIdx.x & 7, qtries = 0;
  while (true) {
    const int tid = relaunder(tid_), lane = tid & 63, wave = tid >> 6, l15 = lane & 15, quad = lane >> 4;
    if (tid == 0) *qslot = (int)atomicAdd(qctr + qx * 16, 1u);
    __syncthreads();
    const int it = *qslot;
    __syncthreads();
    if (it >= 128) { if (++qtries >= 8) break; qx = (qx + 1) & 7; continue; }
    const int qb = 63 - (it & 63);
    const int b = it >> 6, h = b ? ((qx + 4) & 7) : qx, bh = b * 8 + h, i0 = qb * 128;
    const int qrow0 = i0 + 32 * wave;
    const float fb = p.b_f_bias[h];
    bf16x8 bq[2][4];
#pragma unroll
    for (int nq = 0; nq < 2; ++nq)
#pragma unroll
      for (int ks = 0; ks < 4; ++ks)
        bq[nq][ks] = *(const bf16x8*)(proj + (size_t)(b * 8192 + qrow0 + 16 * nq + l15) * 4096 + h * 128 + 32 * ks + 8 * quad);
    f32x4 O[8][2];
#pragma unroll
    for (int dt = 0; dt < 8; ++dt) { O[dt][0] = (f32x4){0.f, 0.f, 0.f, 0.f}; O[dt][1] = (f32x4){0.f, 0.f, 0.f, 0.f}; }
    float mrun[2] = {-1e30f, -1e30f}, lrun[2] = {0.f, 0.f};

    const int kkey = wave * 4 + (lane >> 4);
    const int kch = (lane & 15) ^ (kkey & 15);
    const u16* Kg = proj + (size_t)(b * 8192 + kkey) * 4096 + 1024 + h * 128 + kch * 8;
    const int vd = wave * 8 + (lane >> 3);
    const int vch = (lane & 7) ^ ((((wave & 1) << 2) + (lane >> 4)) & 7);
    const u16* Vg = vT + (size_t)(bh * 128 + vd) * 8192 + vch * 8;
#define ATT_STAGE(buf, j0_)                                                                                                   \
  do {                                                                                                                        \
    _Pragma("unroll") for (int i = 0; i < 4; ++i) {                                                                           \
      __builtin_amdgcn_global_load_lds((const unsigned*)(Kg + (size_t)((j0_) + 16 * i) * 4096),                               \
                                       (unsigned*)(smem + (buf) * 32768 + (i * 4 + wave) * 1024), 16, 0, 0);                  \
      __builtin_amdgcn_global_load_lds((const unsigned*)(Vg + (size_t)(32 * i) * 8192 + (j0_)),                               \
                                       (unsigned*)(smem + (buf) * 32768 + 16384 + (i * 4 + wave) * 1024), 16, 0, 0);          \
    }                                                                                                                         \
  } while (0)
    int j0 = i0 + 64;
    ATT_STAGE(0, j0);
    float carry = 0.f, biasA = 0.f, frn = 0.f;
    if (wave == 0) {
      const float lfA = fraw[(size_t)(b * 8192 + i0 + lane) * 16 + h];
      const float lfB = fraw[(size_t)(b * 8192 + i0 + 64 + lane) * 16 + h];
      float pa = lfA, pb = lfB;
      pa += dpp_f<0x111>(pa); pa += dpp_f<0x112>(pa); pa += dpp_f<0x114>(pa); pa += dpp_f<0x118>(pa);
      pb += dpp_f<0x111>(pb); pb += dpp_f<0x112>(pb); pb += dpp_f<0x114>(pb); pb += dpp_f<0x118>(pb);
      const float a0 = readlane_f(pa, 15), a1 = readlane_f(pa, 31), a2 = readlane_f(pa, 47), a3 = readlane_f(pa, 63);
      const float b0 = readlane_f(pb, 15), b1 = readlane_f(pb, 31), b2 = readlane_f(pb, 47);
      const int prow = lane >> 4;
      pa += (prow == 0) ? 0.f : (prow == 1) ? a0 : (prow == 2) ? (a0 + a1) : (a0 + a1 + a2);
      pb += (prow == 0) ? 0.f : (prow == 1) ? b0 : (prow == 2) ? (b0 + b1) : (b0 + b1 + b2);
      const float lf0 = readlane_f(lfA, 0), totA = (a0 + a1) + (a2 + a3);
      biasA = -(pa - lf0) * kLog2e;
      bias_s[lane] = -(totA - lf0 + pb) * kLog2e;
      carry = lf0;
    }
    if (lane == 0) { mmin_s[wave] = -1e30f; mmin_s[4 + wave] = -1e30f; }
    asm volatile("s_waitcnt vmcnt(0)" ::: "memory");
    __syncthreads();
    auto att_tile = [&](const int cur, const bool diag) __attribute__((always_inline)) -> bool {
      const int nj = j0 - 64;
      bool more = nj >= 0;
      if (more && j0 <= i0) {
        const float* mm = mmin_s + cur * 4;
        const float mmin = fminf(fminf(mm[0], mm[1]), fminf(mm[2], mm[3]));
        more = !((QKB + ca_s[cur]) * kLog2e < mmin - 30.f * kLog2e);
      }
      if (more) {
        ATT_STAGE(cur ^ 1, nj);
        if (wave == 0 && nj < i0) frn = fraw[(size_t)(b * 8192 + nj + lane) * 16 + h];
      }
      if (j0 <= qrow0 + 31) {
        const char* Ks = smem + cur * 32768;
        const char* Vs = Ks + 16384;
        const float* cs = bias_s + cur * 64;
        f32x4 s[4][2];
#pragma unroll
        for (int kt = 0; kt < 4; ++kt) { s[kt][0] = (f32x4){0.f, 0.f, 0.f, 0.f}; s[kt][1] = (f32x4){0.f, 0.f, 0.f, 0.f}; }
#pragma unroll
        for (int ks = 0; ks < 4; ++ks)
#pragma unroll
          for (int kt = 0; kt < 4; ++kt) {
            const int kl = 16 * kt + l15;
            const bf16x8 ak = *(const bf16x8*)(Ks + kl * 256 + (((ks * 4 + quad) ^ (kl & 15)) << 4));
            s[kt][0] = mfma16(ak, bq[0][ks], s[kt][0]);
            s[kt][1] = mfma16(ak, bq[1][ks], s[kt][1]);
          }
#pragma unroll
        for (int kt = 0; kt < 4; ++kt) {
          const f32x4 bias = *(const f32x4*)(cs + 16 * kt + 4 * quad);
#pragma unroll
          for (int nq = 0; nq < 2; ++nq)
#pragma unroll
            for (int jj = 0; jj < 4; ++jj) {
              float v = s[kt][nq][jj] + bias[jj];
              if (diag) { if (j0 + 16 * kt + 4 * quad + jj > qrow0 + 16 * nq + l15) v = -1e30f; }
              s[kt][nq][jj] = v;
            }
        }
        bf16x8 bP[2][2];
#pragma unroll
        for (int nq = 0; nq < 2; ++nq) {
          float tmax = -1e30f;
#pragma unroll
          for (int kt = 0; kt < 4; ++kt)
#pragma unroll
            for (int jj = 0; jj < 4; ++jj) tmax = fmaxf(tmax, s[kt][nq][jj]);
          tmax = fmaxf(tmax, __shfl_xor(tmax, 16));
          {
            const unsigned tc = __float_as_uint(tmax);
            const auto r32 = __builtin_amdgcn_permlane32_swap(tc, tc, false, false);
            tmax = fmaxf(__uint_as_float(r32[0]), __uint_as_float(r32[1]));
          }
          const float mnew = fmaxf(mrun[nq], tmax);
          const float alpha = __builtin_amdgcn_exp2f(mrun[nq] - mnew);
          const bool grew = mnew > mrun[nq];
          mrun[nq] = mnew;
          float psum = 0.f;
#pragma unroll
          for (int kt = 0; kt < 4; ++kt)
#pragma unroll
            for (int jj = 0; jj < 4; ++jj) { const float pv = __builtin_amdgcn_exp2f(s[kt][nq][jj] - mnew); s[kt][nq][jj] = pv; psum += pv; }
          lrun[nq] = lrun[nq] * alpha + psum;
          if (__builtin_amdgcn_ballot_w64(grew) != 0ull) {
#pragma unroll
            for (int dt = 0; dt < 8; ++dt) O[dt][nq] = O[dt][nq] * alpha;
          }
          bP[0][nq] = pack8(s[0][nq], s[1][nq]);
          bP[1][nq] = pack8(s[2][nq], s[3][nq]);
        }
#pragma unroll
        for (int ks = 0; ks < 2; ++ks)
#pragma unroll
          for (int dt = 0; dt < 8; ++dt) {
            const int d = 16 * dt + l15, sw = (d >> 1) & 7, c0 = 4 * ks + (quad >> 1);
            const u32x2 lo = *(const u32x2*)(Vs + d * 128 + ((c0 ^ sw) << 4) + (quad & 1) * 8);
            const u32x2 hi = *(const u32x2*)(Vs + d * 128 + (((c0 + 2) ^ sw) << 4) + (quad & 1) * 8);
            const bf16x8 av = mk8(lo, hi);
            O[dt][0] = mfma16(av, bP[ks][0], O[dt][0]);
            O[dt][1] = mfma16(av, bP[ks][1], O[dt][1]);
          }
        float wm = fminf(mrun[0], mrun[1]);
        wm = fminf(wm, dpp_f<0x121>(wm)); wm = fminf(wm, dpp_f<0x122>(wm)); wm = fminf(wm, dpp_f<0x124>(wm)); wm = fminf(wm, dpp_f<0x128>(wm));
        wm = fminf(fminf(readlane_f(wm, 0), readlane_f(wm, 16)), fminf(readlane_f(wm, 32), readlane_f(wm, 48)));
        if (lane == 0) mmin_s[(cur ^ 1) * 4 + wave] = wm;
      }
      if (more && wave == 0) {
        const int nb = cur ^ 1;
        if (nj == i0) {
          bias_s[nb * 64 + lane] = biasA;
          if (lane == 0) ca_s[nb] = carry;
        } else {
          const float lf = frn;
          float x = lf;
          x += dpp_f<0x101>(x); x += dpp_f<0x102>(x); x += dpp_f<0x104>(x); x += dpp_f<0x108>(x);
          const float t0 = readlane_f(x, 0), t1 = readlane_f(x, 16), t2 = readlane_f(x, 32), t3 = readlane_f(x, 48);
          const int rowi = lane >> 4;
          const float radd = (rowi == 0) ? (t1 + t2 + t3) : (rowi == 1) ? (t2 + t3) : (rowi == 2) ? t3 : 0.f;
          const float sf = x + radd;
          bias_s[nb * 64 + lane] = (sf - lf + carry) * kLog2e;
          carry += (t0 + t1) + (t2 + t3);
          if (lane == 0) ca_s[nb] = carry;
        }
      }
      asm volatile("s_waitcnt vmcnt(0)" ::: "memory");
      __syncthreads();
      if (!more) return false;
      j0 = nj;
      return true;
    };
    if (att_tile(0, true) && att_tile(1, true)) {
      while (true) {
        if (!att_tile(0, false)) break;
        if (!att_tile(1, false)) break;
      }
    }
#undef ATT_STAGE
#pragma unroll
    for (int nq = 0; nq < 2; ++nq) {
      float l = lrun[nq];
      l += __shfl_xor(l, 16);
      l += __shfl_xor(l, 32);
      const float inv = 1.f / l;
      const size_t tok = (size_t)(b * 8192 + qrow0 + 16 * nq + l15);
#pragma unroll
      for (int dt = 0; dt < 8; ++dt) {
        const int d = 16 * dt + 4 * quad;
        const u32x2 z2 = *(const u32x2*)(proj + tok * 4096 + 3072 + h * 128 + d);
        const f32x4 o = O[dt][nq] * inv;
        u32x2 r = {pack2(o[0] * silu(bflo(z2.x)), o[1] * silu(bfhi(z2.x))), pack2(o[2] * silu(bflo(z2.y)), o[3] * silu(bfhi(z2.y)))};
        *(u32x2*)(y1 + tok * 1024 + h * 128 + d) = r;
      }
    }
  }
}

DI void final_norm(const Params& p) {
  const float* ss2 = (const float*)(p.ws + OFF_SS2);
  const int tidf = tidx();
  const int lane = tidf & 63;
  const int gw = blockIdx.x * 4 + (tidf >> 6), nw = gridDim.x * 4;
  const f32x4* w = (const f32x4*)p.final_norm_w;
  f32x4 wv[4];
#pragma unroll
  for (int i = 0; i < 4; ++i) wv[i] = w[lane + 64 * i];
  for (int row = gw; row < 16384; row += 4 * nw) {
    u32x2 r[4][4];
    float rs[4];
#pragma unroll
    for (int k = 0; k < 4; ++k) {
      const int rr = row + k * nw;
      const bool okr = rr < 16384;
      const int rc = okr ? rr : row;
      rs[k] = rsqrtf(ss2[rc] * (1.f / 1024.f) + kEps);
      const u32x2* hsrc = (const u32x2*)((const u16*)(p.ws + OFF_R) + (size_t)rc * 1024);
#pragma unroll
      for (int i = 0; i < 4; ++i) r[k][i] = hsrc[lane + 64 * i];
    }
#pragma unroll
    for (int k = 0; k < 4; ++k) {
      const int rr = row + k * nw;
      if (rr < 16384) {
        f32x4* o = (f32x4*)(p.out + (size_t)rr * 1024);
#pragma unroll
        for (int i = 0; i < 4; ++i) {
          f32x4 v = {bflo(r[k][i].x), bfhi(r[k][i].x), bflo(r[k][i].y), bfhi(r[k][i].y)};
          __builtin_nontemporal_store(v * rs[k] * wv[i], o + lane + 64 * i);
        }
      }
    }
  }
}

__global__ void __launch_bounds__(kThreads, 2) fwd_megakernel(Params p) {
  extern __shared__ __attribute__((aligned(16))) char smem[];
  cg::grid_group grid = cg::this_grid();
  char* ws = p.ws;
  __shared__ uint4 xb_words;
  if (threadIdx.x == 0) xb_words = make_uint4(0u, 0u, 0u, 0u);
  __syncthreads();
  if (p.ws == nullptr) grid.sync();
  XcdBarrier xb = xcd_barrier_post((unsigned*)(ws + OFF_BAR), (volatile LAS unsigned*)&xb_words);
  phase0(p, smem);
  xcd_barrier(xb);
  gemm_phase<1>(p, (const u16*)(ws + OFF_R), (const u16*)(ws + OFF_WTA_IN), 32, smem);
  skinny_gemm<0>(p, (const u16*)(ws + OFF_R), (const u16*)(ws + OFF_WTA_IN) + (size_t)4096 * 1024, (float*)(ws + OFF_BRAW));
  xcd_barrier(xb);
  {
    const bool overlap = gridDim.x >= 128;
    const int G = (int)gridDim.x, hG = G >> 1, bi = (int)blockIdx.x;
    const bool is_scan = overlap && bi < 32, is_idle = overlap && bi >= hG && bi < hG + 32;
    const int pfirst = overlap ? (bi < hG ? 32 : 64) : 0, pn = overlap ? G - 64 : G;
    if (!is_scan && !is_idle) delta_prep(p, smem, pfirst, pn);
    if (!is_scan && !is_idle) phase0b(p, smem, pfirst, pn);
    if (!overlap) xcd_barrier(xb);
    if (!overlap || blockIdx.x < 32) delta_scan(p, smem);
    xcd_barrier(xb);
  }
  gate_phase(p);
  xcd_barrier(xb);
  gemm_phase<2>(p, (const u16*)(ws + OFF_R + 32 * MiB), (const u16*)(ws + OFF_WTA_OUT), 8, smem);
  xcd_barrier(xb);
  gemm_phase<3>(p, (const u16*)(ws + OFF_R), (const u16*)(ws + OFF_WTB_IN), 32, smem);
  skinny_gemm<1>(p, (const u16*)(ws + OFF_R), (const u16*)(ws + OFF_WTB_IN) + (size_t)4096 * 1024, (float*)(ws + OFF_FRAW));
  xcd_barrier(xb);
  attn_phase(p, smem);
  xcd_barrier(xb);
  gemm_phase<4>(p, (const u16*)(ws + OFF_R + 64 * MiB), (const u16*)(ws + OFF_WTB_OUT), 8, smem);
  xcd_barrier(xb);
  final_norm(p);
}

extern "C" void kernel_launch(void* const* d_in, const int* in_sizes, int n_in, void* d_out, int out_size, void* d_ws, size_t ws_size,
                              hipStream_t stream) {
  static int grid_blocks = 0;
  if (!grid_blocks) {
    int dev = 0, cus = 0, per_cu = 0;
    hipGetDevice(&dev);
    hipDeviceGetAttribute(&cus, hipDeviceAttributeMultiprocessorCount, dev);
    hipFuncSetAttribute((const void*)fwd_megakernel, hipFuncAttributeMaxDynamicSharedMemorySize, kLds);
    hipOccupancyMaxActiveBlocksPerMultiprocessor(&per_cu, (const void*)fwd_megakernel, kThreads, kLds);
    if (per_cu < 1) per_cu = 1;
    if (per_cu > 2) per_cu = 2;
    grid_blocks = cus * per_cu;
  }
  Params p{};
  p.x = (const float*)d_in[0]; p.a_norm_w = (const float*)d_in[1]; p.a_w_in = (const float*)d_in[2]; p.a_conv_w = (const float*)d_in[3];
  p.a_A_log = (const float*)d_in[4]; p.a_dt_bias = (const float*)d_in[5]; p.a_o_norm_w = (const float*)d_in[6]; p.a_w_out = (const float*)d_in[7];
  p.b_norm_w = (const float*)d_in[8]; p.b_w_in = (const float*)d_in[9]; p.b_f_bias = (const float*)d_in[10]; p.b_q_norm_w = (const float*)d_in[11];
  p.b_k_norm_w = (const float*)d_in[12]; p.b_w_out = (const float*)d_in[13]; p.final_norm_w = (const float*)d_in[14];
  p.out = (float*)d_out;
  p.ws = (char*)d_ws;
  hipMemsetAsync((char*)d_ws + OFF_BAR, 0, CTL_BYTES, stream);
  void* args[] = {&p};
  hipError_t e = hipLaunchCooperativeKernel((const void*)fwd_megakernel, dim3(grid_blocks), dim3(kThreads), args, kLds, stream);
  if (e != hipSuccess) fprintf(stderr, "cooperative launch failed: %s (grid %d)\n", hipGetErrorString(e), grid_blocks);
}
```
